# Optimizing an MI355X kernel written in HIP

```python
import math
import jax, jax.numpy as jnp
from jax import lax
import numpy as np

D_MODEL = 4096
BATCH = 32
SEQ = 256
DEPTH = 4
DEC_BATCH = 2
DEC_SEQ = 4096
PAST_LEN = 512

GRID_W = 64
HEAD_DIM = 128
ATTN_WIDTH = D_MODEL // 2
N_HEADS = ATTN_WIDTH // HEAD_DIM
N_KV_HEADS = N_HEADS // 4
KV_WIDTH = N_KV_HEADS * HEAD_DIM
SSM_WIDTH = D_MODEL // 4
SSM_GROUP = 16
N_SSM_GROUPS = SSM_WIDTH // SSM_GROUP
SSM_STATE = 64
FFT_WIDTH = D_MODEL // 4
N_FFT_GROUPS = 4
FFT_GROUP = FFT_WIDTH // N_FFT_GROUPS
MIX_WIDTH = ATTN_WIDTH + SSM_WIDTH + FFT_WIDTH
IN_SIZES = (ATTN_WIDTH, KV_WIDTH, KV_WIDTH, ATTN_WIDTH, SSM_WIDTH, SSM_WIDTH, FFT_WIDTH, FFT_WIDTH)
IN_WIDTH = 2 * ATTN_WIDTH + 2 * KV_WIDTH + 2 * SSM_WIDTH + 2 * FFT_WIDTH
Q_BLOCK = 128
ROPE_THETA = 10000.0
ROPE_PAIRS = HEAD_DIM // 4
NORM_EPS = 1e-6

kernel_name = 'hymba_style_flow_backbone_step'


def rms_norm(x, g):
    xf = x.astype(jnp.float32)
    y = xf * lax.rsqrt(jnp.mean(xf * xf, axis=-1, keepdims=True) + NORM_EPS)
    return (y * g.astype(jnp.float32)).astype(x.dtype)


def grid_angles(n_tokens):
    rows = n_tokens // GRID_W
    row = jnp.repeat(jnp.arange(rows, dtype=jnp.float32), GRID_W)
    col = jnp.tile(jnp.arange(GRID_W, dtype=jnp.float32), rows)
    inv = ROPE_THETA ** (-jnp.arange(ROPE_PAIRS, dtype=jnp.float32) / ROPE_PAIRS)
    return row[:, None] * inv[None, :], col[:, None] * inv[None, :]


def rope_1d(x, ang):
    r = ang.shape[-1]
    x1, x2 = x[..., :r], x[..., r:]
    cos = jnp.cos(ang)[None, :, None, :]
    sin = jnp.sin(ang)[None, :, None, :]
    return jnp.concatenate([x1 * cos - x2 * sin, x1 * sin + x2 * cos], axis=-1)


def axial_rope(x, row_ang, col_ang):
    half = HEAD_DIM // 2
    xf = x.astype(jnp.float32)
    out = jnp.concatenate([rope_1d(xf[..., :half], row_ang), rope_1d(xf[..., half:], col_ang)], axis=-1)
    return out.astype(x.dtype)


def blocked_attention(q, k, v):
    bsz, lq = q.shape[0], q.shape[1]
    nb = lq // Q_BLOCK
    grp = N_HEADS // N_KV_HEADS
    qb = q.reshape(bsz, nb, Q_BLOCK, N_KV_HEADS, grp, HEAD_DIM).transpose(1, 0, 2, 3, 4, 5)
    scale = HEAD_DIM ** -0.5

    def one_block(qblk):
        s = jnp.einsum('bqkgd,bskd->bkgqs', qblk, k, preferred_element_type=jnp.float32) * scale
        p = jax.nn.softmax(s, axis=-1)
        return jnp.einsum('bkgqs,bskd->bqkgd', p.astype(v.dtype), v)

    o = lax.map(one_block, qb)
    return o.transpose(1, 0, 2, 3, 4, 5).reshape(bsz, lq, N_HEADS * HEAD_DIM)


def zoh(lam_re, lam_im, log_step, b_re, b_im):
    lr = lam_re.astype(jnp.float32)
    li = lam_im.astype(jnp.float32)
    dt = jnp.exp(log_step.astype(jnp.float32))[:, None]
    mag = jnp.exp(lr * dt)
    ang = li * dt
    ab_re, ab_im = mag * jnp.cos(ang), mag * jnp.sin(ang)
    nr, ni = ab_re - 1.0, ab_im
    den = lr * lr + li * li
    f_re = (nr * lr + ni * li) / den
    f_im = (ni * lr - nr * li) / den
    br, bi = b_re.astype(jnp.float32), b_im.astype(jnp.float32)
    bb_re = f_re[..., None] * br - f_im[..., None] * bi
    bb_im = f_re[..., None] * bi + f_im[..., None] * br
    return ab_re, ab_im, bb_re, bb_im


def linrec_combine(e1, e2):
    a1r, a1i, b1r, b1i = e1
    a2r, a2i, b2r, b2i = e2
    return (a2r * a1r - a2i * a1i,
            a2r * a1i + a2i * a1r,
            a2r * b1r - a2i * b1i + b2r,
            a2r * b1i + a2i * b1r + b2i)


def ssm_direction(u, lam_re, lam_im, log_step, b_re, b_im, c_re, c_im, h0_re, h0_im, reverse):
    ab_re, ab_im, bb_re, bb_im = zoh(lam_re, lam_im, log_step, b_re, b_im)
    if reverse:
        u = jnp.flip(u, axis=1)
    bu_re = jnp.einsum('blgc,gpc->blgp', u, bb_re)
    bu_im = jnp.einsum('blgc,gpc->blgp', u, bb_im)
    a_re = jnp.broadcast_to(ab_re, bu_re.shape)
    a_im = jnp.broadcast_to(ab_im, bu_im.shape)
    cum_r, cum_i, s_r, s_i = lax.associative_scan(linrec_combine, (a_re, a_im, bu_re, bu_im), axis=1)
    h0r = h0_re.astype(jnp.float32)[:, None]
    h0i = h0_im.astype(jnp.float32)[:, None]
    h_r = cum_r * h0r - cum_i * h0i + s_r
    h_i = cum_r * h0i + cum_i * h0r + s_i
    y = (jnp.einsum('blgp,gcp->blgc', h_r, c_re.astype(jnp.float32))
         - jnp.einsum('blgp,gcp->blgc', h_i, c_im.astype(jnp.float32)))
    if reverse:
        y = jnp.flip(y, axis=1)
    return y, h_r[:, -1], h_i[:, -1]


def ssm_branch(u, p, h0):
    bsz, length = u.shape[0], u.shape[1]
    uf = u.astype(jnp.float32).reshape(bsz, length, N_SSM_GROUPS, SSM_GROUP)
    y_f, fr, fi = ssm_direction(uf, p['lam_re'][0], p['lam_im'][0], p['log_step'][0], p['b_re'][0], p['b_im'][0],
                                p['c_re'][0], p['c_im'][0], h0[0][0], h0[0][1], False)
    y_b, br, bi = ssm_direction(uf, p['lam_re'][1], p['lam_im'][1], p['log_step'][1], p['b_re'][1], p['b_im'][1],
                                p['c_re'][1], p['c_im'][1], h0[1][0], h0[1][1], True)
    y = ((y_f + y_b).reshape(bsz, length, SSM_WIDTH)
         + p['d_skip'].astype(jnp.float32) * uf.reshape(bsz, length, SSM_WIDTH))
    z = y.astype(u.dtype) @ p['w_glu']
    a, g = jnp.split(z, 2, axis=-1)
    return a * jax.nn.sigmoid(g), ((fr, fi), (br, bi))


def fourier_branch(f, w_fft):
    bsz, length = f.shape[0], f.shape[1]
    fg = f.astype(jnp.float32).reshape(bsz, length, N_FFT_GROUPS, FFT_GROUP)
    mixed = jnp.real(jnp.fft.fft2(fg, axes=(1, 3), norm='ortho'))
    return mixed.reshape(bsz, length, FFT_WIDTH).astype(f.dtype) @ w_fft


def modulated_input(x, cvec, p):
    mod = jax.nn.silu(cvec) @ p['w_mod'] + p['b_mod']
    shift, scale, gate = jnp.split(mod[:, None, :], 3, axis=-1)
    h = rms_norm(x, p['norm_g']) * (1 + scale) + shift
    return h @ p['w_in'], gate


def split_proj(proj):
    idx = np.cumsum(IN_SIZES)[:-1].tolist()
    return jnp.split(proj, idx, axis=-1)


def mixer_layer(x, cvec, p, ctx_k=None, ctx_v=None, h0=None, angles=None):
    bsz, length = x.shape[0], x.shape[1]
    proj, gate = modulated_input(x, cvec, p)
    q, k, v, g_attn, u, g_ssm, f, g_fft = split_proj(proj)
    q = rms_norm(q.reshape(bsz, length, N_HEADS, HEAD_DIM), p['q_norm'])
    k = rms_norm(k.reshape(bsz, length, N_KV_HEADS, HEAD_DIM), p['k_norm'])
    v = v.reshape(bsz, length, N_KV_HEADS, HEAD_DIM)
    if angles is None:
        keys, vals = k, v
        zeros = jnp.zeros((bsz, N_SSM_GROUPS, SSM_STATE), jnp.float32)
        h0 = ((zeros, zeros), (zeros, zeros))
    else:
        q = axial_rope(q, angles[0], angles[1])
        k = axial_rope(k, angles[0], angles[1])
        keys = jnp.concatenate([ctx_k.astype(k.dtype), k], axis=1)
        vals = jnp.concatenate([ctx_v.astype(v.dtype), v], axis=1)
    attn = blocked_attention(q, keys, vals) * jax.nn.silu(g_attn)
    ssm, finals = ssm_branch(u, p, h0)
    ssm = ssm * jax.nn.silu(g_ssm)
    four = fourier_branch(f, p['w_fft']) * jax.nn.silu(g_fft)
    out = jnp.concatenate([attn, ssm.astype(attn.dtype), four.astype(attn.dtype)], axis=-1) @ p['w_out']
    return x + gate * out, k, v, finals


def layer_params(l, norm_g, w_mod, b_mod, w_in, q_norm, k_norm, lam_re, lam_im, log_step,
                 b_re, b_im, c_re, c_im, d_skip, w_glu, w_fft, w_out):
    return dict(norm_g=norm_g[l], w_mod=w_mod[l], b_mod=b_mod[l], w_in=w_in[l],
                q_norm=q_norm[l], k_norm=k_norm[l], lam_re=lam_re[l], lam_im=lam_im[l],
                log_step=log_step[l], b_re=b_re[l], b_im=b_im[l], c_re=c_re[l], c_im=c_im[l],
                d_skip=d_skip[l], w_glu=w_glu[l], w_fft=w_fft[l], w_out=w_out[l])


def setup_inputs(seed: int = 0) -> dict:
    key = jax.random.key(seed)
    ks = jax.random.split(key, 32)
    f32 = jnp.float32

    def nrm(k, shape, s):
        return s * jax.random.normal(k, shape, f32)

    n_idx = jnp.arange(SSM_STATE, dtype=f32)
    ssm_shape = (DEPTH, 2, N_SSM_GROUPS, SSM_STATE)
    state_shape = (DEC_BATCH, DEPTH, N_SSM_GROUPS, SSM_STATE)
    kv_shape = (DEC_BATCH, DEPTH, PAST_LEN, N_KV_HEADS, HEAD_DIM)
    return {
        'x_prompt': nrm(ks[0], (BATCH, SEQ, D_MODEL), 1.0),
        'x_sample': nrm(ks[1], (DEC_BATCH, DEC_SEQ, D_MODEL), 1.0),
        'cache_k': nrm(ks[2], kv_shape, 1.0),
        'cache_v': nrm(ks[3], kv_shape, 1.0),
        'state_fwd_re': nrm(ks[4], state_shape, 0.5),
        'state_fwd_im': nrm(ks[5], state_shape, 0.5),
        'state_bwd_re': nrm(ks[6], state_shape, 0.5),
        'state_bwd_im': nrm(ks[7], state_shape, 0.5),
        'c': nrm(ks[8], (DEC_BATCH, D_MODEL), 1.0),
        'c_ctx': nrm(ks[9], (D_MODEL,), 1.0),
        'norm_g': 1.0 + nrm(ks[10], (DEPTH, D_MODEL), 0.02),
        'w_mod': nrm(ks[11], (DEPTH, D_MODEL, 3 * D_MODEL), 0.5 * D_MODEL ** -0.5),
        'b_mod': nrm(ks[12], (DEPTH, 3 * D_MODEL), 0.01),
        'w_in': nrm(ks[13], (DEPTH, D_MODEL, IN_WIDTH), D_MODEL ** -0.5),
        'q_norm': 1.0 + nrm(ks[14], (DEPTH, HEAD_DIM), 0.02),
        'k_norm': 1.0 + nrm(ks[15], (DEPTH, HEAD_DIM), 0.02),
        'lam_re': -0.5 + nrm(ks[16], ssm_shape, 0.01),
        'lam_im': math.pi * n_idx + nrm(ks[17], ssm_shape, 0.01),
        'log_step': jax.random.uniform(ks[18], (DEPTH, 2, N_SSM_GROUPS), f32,
                                       minval=math.log(1e-3), maxval=math.log(1e-1)),
        'b_re': nrm(ks[19], (DEPTH, 2, N_SSM_GROUPS, SSM_STATE, SSM_GROUP), (2 * SSM_GROUP) ** -0.5),
        'b_im': nrm(ks[20], (DEPTH, 2, N_SSM_GROUPS, SSM_STATE, SSM_GROUP), (2 * SSM_GROUP) ** -0.5),
        'c_re': nrm(ks[21], (DEPTH, 2, N_SSM_GROUPS, SSM_GROUP, SSM_STATE), (2 * SSM_STATE) ** -0.5),
        'c_im': nrm(ks[22], (DEPTH, 2, N_SSM_GROUPS, SSM_GROUP, SSM_STATE), (2 * SSM_STATE) ** -0.5),
        'd_skip': nrm(ks[23], (DEPTH, SSM_WIDTH), 0.5),
        'w_glu': nrm(ks[24], (DEPTH, SSM_WIDTH, 2 * SSM_WIDTH), SSM_WIDTH ** -0.5),
        'w_fft': nrm(ks[25], (DEPTH, FFT_WIDTH, FFT_WIDTH), FFT_WIDTH ** -0.5),
        'w_out': nrm(ks[26], (DEPTH, MIX_WIDTH, D_MODEL), MIX_WIDTH ** -0.5),
        'final_norm_g': 1.0 + nrm(ks[27], (D_MODEL,), 0.02),
    }


def reference(x_prompt, x_sample, cache_k, cache_v, state_fwd_re, state_fwd_im, state_bwd_re, state_bwd_im,
              c, c_ctx, norm_g, w_mod, b_mod, w_in, q_norm, k_norm, lam_re, lam_im, log_step,
              b_re, b_im, c_re, c_im, d_skip, w_glu, w_fft, w_out, final_norm_g):
    params = [layer_params(l, norm_g, w_mod, b_mod, w_in, q_norm, k_norm, lam_re, lam_im, log_step,
                           b_re, b_im, c_re, c_im, d_skip, w_glu, w_fft, w_out) for l in range(DEPTH)]

    ctx_vec = c_ctx[None, :]
    xp = x_prompt
    ks_, vs_, fr_, fi_, br_, bi_ = [], [], [], [], [], []
    for l in range(DEPTH):
        xp, k_l, v_l, fin = mixer_layer(xp, ctx_vec, params[l])
        ks_.append(k_l)
        vs_.append(v_l)
        fr_.append(fin[0][0])
        fi_.append(fin[0][1])
        br_.append(fin[1][0])
        bi_.append(fin[1][1])
    y_prompt = rms_norm(xp, final_norm_g)

    angles = grid_angles(x_sample.shape[1])
    xs = x_sample
    for l in range(DEPTH):
        h0 = ((state_fwd_re[:, l], state_fwd_im[:, l]), (state_bwd_re[:, l], state_bwd_im[:, l]))
        xs, _, _, _ = mixer_layer(xs, c, params[l], cache_k[:, l], cache_v[:, l], h0, angles)
    y_sample = rms_norm(xs, final_norm_g)

    return (y_prompt, y_sample,
            jnp.stack(ks_, axis=1), jnp.stack(vs_, axis=1),
            jnp.stack(fr_, axis=1), jnp.stack(fi_, axis=1),
            jnp.stack(br_, axis=1), jnp.stack(bi_, axis=1))
```

```cpp
#include <hip/hip_runtime.h>
#include <cstdio>
#include <cstdint>

#ifndef MK_ONE_LAUNCH
#define MK_ONE_LAUNCH 1
#endif

#ifndef GEMM1_ALIGN
#define GEMM1_ALIGN true
#endif
#ifndef DUP_MASK
#define DUP_MASK 0
#endif
#define DUP(k) for (int rep_ = 0; rep_ < (((DUP_MASK) >> (k)) & 1) + 1; ++rep_)
#define LAS __attribute__((address_space(3)))
#define GAS __attribute__((address_space(1)))
typedef unsigned short bf16;
typedef unsigned v4u __attribute__((ext_vector_type(4)));
typedef unsigned v2u __attribute__((ext_vector_type(2)));
typedef float f32x4 __attribute__((ext_vector_type(4)));
typedef float f32x2 __attribute__((ext_vector_type(2)));
typedef short bf16x8 __attribute__((ext_vector_type(8)));
typedef short s16x4 __attribute__((ext_vector_type(4)));
typedef float f32x16 __attribute__((ext_vector_type(16)));

constexpr int DM = 4096, NTOK = 16384, NCTX = 8192, DEPTH = 4, INW = 9216;
constexpr int OFF_K = 2048, OFF_V = 2560, OFF_GA = 3072, OFF_U = 5120, OFF_GS = 6144, OFF_F = 7168, OFF_GF = 8192;
constexpr float NORM_EPS = 1e-6f;
constexpr size_t OUT_NEWK = 67108864, OUT_NEWV = 83886080, OUT_FRE = 100663296, OUT_FIM = 101187584, OUT_BRE = 101711872, OUT_BIM = 102236160;

constexpr size_t MiB = 1u << 20;
constexpr size_t WS_CTL = 0, CTL_ZERO_BYTES = 1 * MiB;
constexpr size_t WS_MOD = 1 * MiB;
constexpr size_t WS_ROPE = 2 * MiB;
constexpr size_t WS_A16 = 3 * MiB;
constexpr size_t WS_D1 = 4 * MiB;
constexpr size_t WS_D2C = 5 * MiB;
constexpr size_t WS_CK = 6 * MiB;
constexpr size_t WS_CV = 10 * MiB;
constexpr size_t WS_PMAT = 14 * MiB;
constexpr size_t WS_KG = 46 * MiB;
constexpr size_t WS_D2L = 110 * MiB;
constexpr size_t WS_WGLU = 174 * MiB;
constexpr size_t WS_WFFT = 190 * MiB;
constexpr size_t WS_WOUT = 198 * MiB;
constexpr size_t WS_WIN = 326 * MiB;
constexpr size_t WS_H = 614 * MiB;
constexpr size_t WS_PROJ = 742 * MiB;
constexpr size_t WS_MIX = 1030 * MiB;
constexpr size_t WS_A2 = 1158 * MiB;
constexpr size_t WS_SBUF = 1222 * MiB;
constexpr size_t WS_YSSM = 1286 * MiB;
constexpr size_t WS_Z1L = 1318 * MiB;
constexpr size_t WS_Z1C = 1350 * MiB;
constexpr size_t WS_MIXED = 1382 * MiB;
constexpr size_t WS_DELTA = 1414 * MiB;
constexpr size_t WS_XBF = 1542 * MiB;
constexpr size_t WS_XBF2 = 1702 * MiB;
constexpr size_t WS_KC = 1670 * MiB;
constexpr size_t WS_VC = 1686 * MiB;
constexpr size_t WS_DELTA2 = 1830 * MiB;
constexpr size_t WS_END = 1958 * MiB;
constexpr int CW_BAR = 4096;

constexpr int LDS_BYTES = 147456;
constexpr int MISC_OFF = 143360;
constexpr int NWAVES = 8;

#define LDS_WAIT() asm volatile("s_waitcnt lgkmcnt(0)" ::: "memory")
#define VM_WAIT() asm volatile("s_waitcnt vmcnt(0)" ::: "memory")
#define RLX_AGENT __ATOMIC_RELAXED, __HIP_MEMORY_SCOPE_AGENT

__device__ __forceinline__ int tid_of(int wv) { int t = wv * 64 + (int)__builtin_amdgcn_mbcnt_hi(~0u, __builtin_amdgcn_mbcnt_lo(~0u, 0u)); asm volatile("" : "+v"(t)); return t; }
__device__ __forceinline__ unsigned cvt_pk_bf16(float lo, float hi) { unsigned r; asm volatile("v_cvt_pk_bf16_f32 %0, %1, %2" : "=v"(r) : "v"(lo), "v"(hi)); return r; }
__device__ __forceinline__ float bf_lo(unsigned w) { return __uint_as_float(w << 16); }
__device__ __forceinline__ float bf_hi(unsigned w) { return __uint_as_float(w & 0xffff0000u); }
__device__ __forceinline__ float silu_f(float x) { return x * __builtin_amdgcn_rcpf(1.0f + __expf(-x)); }
__device__ __forceinline__ float sigmoid_f(float x) { return __builtin_amdgcn_rcpf(1.0f + __expf(-x)); }
__device__ __forceinline__ float shflx(float v, int lane, int o) { return __int_as_float(__builtin_amdgcn_ds_bpermute((lane ^ o) << 2, __float_as_int(v))); }
__device__ __forceinline__ float wave_sum(float v, int lane) {
#pragma unroll
    for (int o = 1; o < 64; o <<= 1) v += shflx(v, lane, o);
    return v;
}

namespace pg8 {
constexpr int BM = 256, BK = 64, HALF = 128, HTB = HALF * BK * 2, STAGE_BYTES = 8 * HTB, NXCD = 8, WGM = 8;
__host__ __device__ __forceinline__ int lds_byte(int r, int c) { const int st = (r >> 4) * 2 + (c >> 5), rr = r & 15, cc = c & 31, ob = rr * 64 + cc * 2; return st * 1024 + (ob ^ (((ob >> 9) & 1) << 5)); }
__host__ __device__ __forceinline__ void stage_rc(int b, int& R, int& C) { const int st = b / 1024, sb = b % 1024, swz = sb ^ (((sb >> 9) & 1) << 5); R = (st >> 1) * 16 + swz / 64; C = (st & 1) * 32 + (swz % 64) / 2; }
__host__ __device__ __forceinline__ int perm32(int rho) { const int n = rho >> 4, i = rho & 15; return 8 * (i >> 2) + 4 * n + (i & 3); }

struct Unit { const char* a; const char* b; char* c; int ldc; int pm, pn, z, kt; };

struct GemmOrder {
    int nM, nN, nwg, G, c, kt; const char* A; const char* B; size_t atile, btile;
    __device__ void init(int M, int N, int G_, int c_, const void* A_, int lda, const void* B_, int ldb, int K) { kt = K / BK; nM = M / BM; nN = N / BM; nwg = nM * nN; G = G_; c = c_; A = (const char*)A_; B = (const char*)B_; atile = (size_t)BM * lda * 2; btile = (size_t)BM * ldb * 2; }
    __device__ bool next(int i, Unit& u) const {
        const long L = (long)i * G + c; if (L >= nwg) return false;
        int wgid = (int)L; const int xcd = wgid % NXCD; { const int q = nwg / NXCD, r = nwg % NXCD, off = wgid / NXCD; wgid = (xcd < r ? xcd * (q + 1) : r * (q + 1) + (xcd - r) * q) + off; }
        const int nig = WGM * nN, gid = wgid / nig, fm = gid * WGM, gsz = (nM - fm) < WGM ? (nM - fm) : WGM;
        u.pm = fm + ((wgid % nig) % gsz); u.pn = (wgid % nig) / gsz; u.z = 0; u.c = nullptr; u.ldc = 0; u.kt = kt;
        u.a = A + (size_t)u.pm * atile; u.b = B + (size_t)u.pn * btile; return true;
    }
};
template <class O> struct SliceOrder { O g; int i0, cnt; __device__ bool next(int i, Unit& u) const { if (i >= cnt) return false; return g.next(i0 + i, u); } };
struct OneUnit { Unit u0; __device__ bool next(int i, Unit& u) const { if (i != 0) return false; u = u0; return true; } };

template <class Epi, class Sched, bool ALIGN_EPI = true>
__device__ __forceinline__ void gemm_phase(LAS unsigned char* lds, const int wv, const int lda, const int ldb, const Sched& S, const Epi& E) {
    const int tid = tid_of(wv);
    const int wid = __builtin_amdgcn_readfirstlane(tid >> 6), lane = tid & 63, wr = wid >> 2, wc = wid & 3, fr = lane & 15, fq = lane >> 4;
    unsigned voffA[2], voffB[2];
#pragma unroll
    for (int i = 0; i < 2; ++i) { int R, C; stage_rc(tid * 16 + i * 8192, R, C); const int Rb = Epi::PERM ? ((R & ~31) + perm32(R & 31)) : R;
        voffA[i] = (unsigned)(R * lda + C) * 2u; voffB[i] = (unsigned)(Rb * ldb + C) * 2u; }
    (void)fr; (void)fq;
    const size_t kstep = (size_t)(BK * 2);
    const unsigned hstepA = (unsigned)HALF * lda * 2u, hstepB = (unsigned)HALF * ldb * 2u;
    const unsigned ldsw = (unsigned)wid * 1024u;
    const int aoff = lds_byte(wr * 64 + fr, fq * 8), boff = lds_byte(wc * 32 + fr, fq * 8);
#define PG8_SA(b, h) (((b) * 2 + (h)) * HTB)
#define PG8_SB(b, h) ((4 + (b) * 2 + (h)) * HTB)
#define PG8_STAGE(bufoff, gbase, voff) do { _Pragma("unroll") for (int _i = 0; _i < 2; ++_i) \
        __builtin_amdgcn_global_load_lds((const unsigned*)((const char*)(gbase) + (voff)[_i]), (LAS unsigned*)(lds + (bufoff) + ldsw + _i * 8192), 16, 0, 0); } while (0)
#define PG8_LDA(dst, b, h) do { _Pragma("unroll") for (int m = 0; m < 4; ++m) _Pragma("unroll") for (int k = 0; k < 2; ++k) dst[m][k] = *(const LAS bf16x8*)(lds + PG8_SA(b, h) + aoff + m * 2048 + k * 1024); } while (0)
#define PG8_LDB(dst, b, h) do { _Pragma("unroll") for (int n = 0; n < 2; ++n) _Pragma("unroll") for (int k = 0; k < 2; ++k) dst[n][k] = *(const LAS bf16x8*)(lds + PG8_SB(b, h) + boff + n * 2048 + k * 1024); } while (0)
#define PG8_MMA(ai, bj, At, Bt) do { __builtin_amdgcn_s_setprio(1); _Pragma("unroll") for (int m = 0; m < 4; ++m) _Pragma("unroll") for (int n = 0; n < 2; ++n) _Pragma("unroll") for (int k = 0; k < 2; ++k) \
        acc[ai][bj][m][n] = __builtin_amdgcn_mfma_f32_16x16x32_bf16(Bt[n][k], At[m][k], acc[ai][bj][m][n], 0, 0, 0); __builtin_amdgcn_s_setprio(0); } while (0)
#define PG8_WAIT_V(n) asm volatile("s_waitcnt vmcnt(" #n ")" ::: "memory")
#define PG8_WAIT_L(n) asm volatile("s_waitcnt lgkmcnt(" #n ")" ::: "memory")
#define PG8_BAR __builtin_amdgcn_s_barrier()
#define PG8_SCHED __builtin_amdgcn_sched_barrier(0)
    int ui = 0, nt;
    const char* cA; const char* cB;
    { Unit u0; if (!S.next(0, u0)) return; cA = u0.a; cB = u0.b; nt = u0.kt; }
    f32x4 acc[2][2][4][2];
#pragma unroll
    for (int a = 0; a < 2; ++a)
#pragma unroll
        for (int b = 0; b < 2; ++b)
#pragma unroll
            for (int m = 0; m < 4; ++m)
#pragma unroll
                for (int n = 0; n < 2; ++n) acc[a][b][m][n] = (f32x4){0.f, 0.f, 0.f, 0.f};
    bf16x8 At[4][2], B0[2][2], B1[2][2];
    PG8_STAGE(PG8_SB(0, 0), cB, voffB); PG8_STAGE(PG8_SB(0, 1), cB + hstepB, voffB); PG8_STAGE(PG8_SA(0, 0), cA, voffA); PG8_STAGE(PG8_SA(0, 1), cA + hstepA, voffA);
    if (wr == 1) PG8_BAR;
    PG8_WAIT_V(2); PG8_BAR;
    PG8_STAGE(PG8_SB(1, 0), cB + kstep, voffB); PG8_STAGE(PG8_SA(1, 0), cA + kstep, voffA); PG8_STAGE(PG8_SB(1, 1), cB + hstepB + kstep, voffB);
    PG8_WAIT_V(6); PG8_BAR;
    for (;;) {
        bool has_next; const char* nA; const char* nB; int nnt;
        { Unit nx; has_next = S.next(ui + 1, nx); nA = has_next ? nx.a : cA; nB = has_next ? nx.b : cB; nnt = has_next ? nx.kt : nt; }
        for (int t = 0; t < nt; t += 2) {
            const bool last = (t == nt - 2);
            const char* a1 = cA + (size_t)(t + 1) * kstep;
            const char* a2 = last ? nA : cA + (size_t)(t + 2) * kstep; const char* b2 = last ? nB : cB + (size_t)(t + 2) * kstep;
            const char* a3 = a2 + kstep; const char* b3 = b2 + kstep;
            PG8_LDB(B0, 0, 0); PG8_LDB(B1, 0, 1); PG8_SCHED; PG8_LDA(At, 0, 0); PG8_STAGE(PG8_SA(1, 1), a1 + hstepA, voffA);
            PG8_WAIT_V(8); PG8_WAIT_L(0); PG8_BAR; PG8_MMA(0, 0, At, B0); PG8_MMA(0, 1, At, B1); PG8_BAR; PG8_SCHED;
            PG8_LDA(At, 0, 1); PG8_STAGE(PG8_SB(0, 0), b2, voffB); PG8_STAGE(PG8_SB(0, 1), b2 + hstepB, voffB); PG8_STAGE(PG8_SA(0, 0), a2, voffA);
            PG8_WAIT_V(8); PG8_WAIT_L(0); PG8_BAR; PG8_MMA(1, 0, At, B0); PG8_MMA(1, 1, At, B1); PG8_BAR; PG8_SCHED;
            PG8_LDB(B0, 1, 0); PG8_LDB(B1, 1, 1); PG8_SCHED; PG8_LDA(At, 1, 0); PG8_STAGE(PG8_SA(0, 1), a2 + hstepA, voffA);
            PG8_WAIT_V(8); PG8_WAIT_L(0); PG8_BAR; PG8_MMA(0, 0, At, B0); PG8_MMA(0, 1, At, B1); PG8_BAR; PG8_SCHED;
            PG8_LDA(At, 1, 1); PG8_STAGE(PG8_SB(1, 0), b3, voffB); PG8_STAGE(PG8_SB(1, 1), b3 + hstepB, voffB); PG8_STAGE(PG8_SA(1, 0), a3, voffA);
            PG8_WAIT_V(8); PG8_WAIT_L(0); PG8_BAR; PG8_MMA(1, 0, At, B0); PG8_MMA(1, 1, At, B1); PG8_BAR; PG8_SCHED;
        }
        if constexpr (ALIGN_EPI) { if (wr == 0) PG8_BAR; }
        { Unit cu; (void)S.next(ui, cu); const int t2 = tid_of(wv);
          const int w2 = __builtin_amdgcn_readfirstlane(t2 >> 6); E(acc, cu, w2 >> 2, w2 & 3, t2 & 15, (t2 & 63) >> 4); }
        if (!has_next) break;
#pragma unroll
        for (int a = 0; a < 2; ++a)
#pragma unroll
            for (int b = 0; b < 2; ++b)
#pragma unroll
                for (int m = 0; m < 4; ++m)
#pragma unroll
                    for (int n = 0; n < 2; ++n) acc[a][b][m][n] = (f32x4){0.f, 0.f, 0.f, 0.f};
        cA = nA; cB = nB; nt = nnt; ++ui;
        if constexpr (ALIGN_EPI) { if (wr == 1) PG8_BAR; }
    }
    PG8_WAIT_V(0);
    if constexpr (!ALIGN_EPI) { if (wr == 0) PG8_BAR; }
    PG8_BAR;
#undef PG8_SA
#undef PG8_SB
#undef PG8_STAGE
#undef PG8_LDA
#undef PG8_LDB
#undef PG8_MMA
#undef PG8_WAIT_V
#undef PG8_WAIT_L
#undef PG8_BAR
#undef PG8_SCHED
}

struct EpiProj {
    static constexpr bool PERM = true;
    bf16* proj; bf16* a2;
    __device__ __forceinline__ void operator()(const f32x4 (&acc)[2][2][4][2], const Unit& u, int wr, int wc, int fr, int fq) const {
        const int pn = u.pn; const bool gate = (pn >= 12 && pn < 20) || (pn >= 24 && pn < 28) || (pn >= 32); const bool isu = (pn >= 20 && pn < 24);
        const int row0 = u.pm * BM + wr * 64 + fr, col0 = pn * BM + wc * 32 + 8 * fq;
#pragma unroll
        for (int ai = 0; ai < 2; ++ai)
#pragma unroll
            for (int m = 0; m < 4; ++m) { const int row = row0 + ai * HALF + m * 16;
#pragma unroll
                for (int bj = 0; bj < 2; ++bj) { f32x4 v0 = acc[ai][bj][m][0], v1 = acc[ai][bj][m][1];
                    if (gate) {
#pragma unroll
                        for (int j = 0; j < 4; ++j) { v0[j] = silu_f(v0[j]); v1[j] = silu_f(v1[j]); } }
                    v4u w; w.x = cvt_pk_bf16(v0[0], v0[1]); w.y = cvt_pk_bf16(v0[2], v0[3]); w.z = cvt_pk_bf16(v1[0], v1[1]); w.w = cvt_pk_bf16(v1[2], v1[3]);
                    const int col = col0 + bj * HALF;
                    bf16* dst;
                    if (isu) { const int g = (col - OFF_U) >> 4, c0 = col & 15; dst = a2 + ((size_t)(g * 1024 + (row >> 4)) * 512 + (row & 15) * 16 + c0); }
                    else dst = proj + (size_t)row * INW + col;
                    *(v4u*)dst = w; } }
    }
};
struct EpiBf16 {
    static constexpr bool PERM = true;
    float scale;
    __device__ __forceinline__ void operator()(const f32x4 (&acc)[2][2][4][2], const Unit& u, int wr, int wc, int fr, int fq) const {
        bf16* base = (bf16*)u.c; const int ldc = u.ldc; const int row0 = wr * 64 + fr, col0 = wc * 32 + 8 * fq;
#pragma unroll
        for (int ai = 0; ai < 2; ++ai)
#pragma unroll
            for (int m = 0; m < 4; ++m) { bf16* rowp = base + (size_t)(row0 + ai * HALF + m * 16) * ldc + col0;
#pragma unroll
                for (int bj = 0; bj < 2; ++bj) { const f32x4 v0 = acc[ai][bj][m][0] * scale, v1 = acc[ai][bj][m][1] * scale;
                    v4u w; w.x = cvt_pk_bf16(v0[0], v0[1]); w.y = cvt_pk_bf16(v0[2], v0[3]); w.z = cvt_pk_bf16(v1[0], v1[1]); w.w = cvt_pk_bf16(v1[2], v1[3]);
                    *(v4u*)(rowp + bj * HALF) = w; } }
    }
};
struct EpiF32 {
    static constexpr bool PERM = false;
    __device__ __forceinline__ void operator()(const f32x4 (&acc)[2][2][4][2], const Unit& u, int wr, int wc, int fr, int fq) const {
        float* base = (float*)u.c; const int ldc = u.ldc; const int row0 = wr * 64 + fr, col0 = wc * 32 + 4 * fq;
#pragma unroll
        for (int ai = 0; ai < 2; ++ai)
#pragma unroll
            for (int m = 0; m < 4; ++m) { float* rowp = base + (size_t)(row0 + ai * HALF + m * 16) * ldc + col0;
#pragma unroll
                for (int bj = 0; bj < 2; ++bj)
#pragma unroll
                    for (int n = 0; n < 2; ++n) *(f32x4*)(rowp + bj * HALF + n * 16) = acc[ai][bj][m][n]; }
    }
};
struct EpiSsmY {
    static constexpr bool PERM = true;
    bf16* yssm;
    __device__ __forceinline__ void operator()(const f32x4 (&acc)[2][2][4][2], const Unit& u, int wr, int wc, int fr, int fq) const {
        const int row0 = u.z + wr * 64 + fr, col0 = wc * 32 + 8 * fq, g = u.pn;
#pragma unroll
        for (int ai = 0; ai < 2; ++ai)
#pragma unroll
            for (int m = 0; m < 4; ++m) { const int chunk = row0 + ai * HALF + m * 16;
#pragma unroll
                for (int bj = 0; bj < 2; ++bj) { const f32x4 v0 = acc[ai][bj][m][0], v1 = acc[ai][bj][m][1];
                    v4u w; w.x = cvt_pk_bf16(v0[0], v0[1]); w.y = cvt_pk_bf16(v0[2], v0[3]); w.z = cvt_pk_bf16(v1[0], v1[1]); w.w = cvt_pk_bf16(v1[2], v1[3]);
                    const int col = col0 + bj * HALF, i = col >> 4, c0 = col & 15;
                    *(v4u*)(yssm + (size_t)(chunk * 16 + i) * 1024 + g * 16 + c0) = w; } }
    }
};
struct EpiGlu {
    static constexpr bool PERM = true;
    const bf16* proj; bf16* mix;
    __device__ __forceinline__ void operator()(const f32x4 (&acc)[2][2][4][2], const Unit& u, int wr, int wc, int fr, int fq) const {
        const int row0 = u.pm * BM + wr * 64 + fr, col0 = u.pn * HALF + wc * 32 + 8 * fq;
#pragma unroll
        for (int ai = 0; ai < 2; ++ai)
#pragma unroll
            for (int m = 0; m < 4; ++m) { const int row = row0 + ai * HALF + m * 16;
                const v4u gs = *(const v4u*)(proj + (size_t)row * INW + OFF_GS + col0);
                const f32x4 a0 = acc[ai][0][m][0], a1 = acc[ai][0][m][1], g0 = acc[ai][1][m][0], g1 = acc[ai][1][m][1];
                float o[8];
#pragma unroll
                for (int j = 0; j < 4; ++j) { o[j] = a0[j] * sigmoid_f(g0[j]); o[4 + j] = a1[j] * sigmoid_f(g1[j]); }
                o[0] *= bf_lo(gs.x); o[1] *= bf_hi(gs.x); o[2] *= bf_lo(gs.y); o[3] *= bf_hi(gs.y); o[4] *= bf_lo(gs.z); o[5] *= bf_hi(gs.z); o[6] *= bf_lo(gs.w); o[7] *= bf_hi(gs.w);
                v4u w; w.x = cvt_pk_bf16(o[0], o[1]); w.y = cvt_pk_bf16(o[2], o[3]); w.z = cvt_pk_bf16(o[4], o[5]); w.w = cvt_pk_bf16(o[6], o[7]);
                *(v4u*)(mix + (size_t)row * DM + 2048 + col0) = w; }
    }
};
struct EpiFftW {
    static constexpr bool PERM = true;
    const bf16* proj; bf16* mix;
    __device__ __forceinline__ void operator()(const f32x4 (&acc)[2][2][4][2], const Unit& u, int wr, int wc, int fr, int fq) const {
        const int row0 = u.pm * BM + wr * 64 + fr, col0 = u.pn * BM + wc * 32 + 8 * fq;
#pragma unroll
        for (int ai = 0; ai < 2; ++ai)
#pragma unroll
            for (int m = 0; m < 4; ++m) { const int row = row0 + ai * HALF + m * 16;
#pragma unroll
                for (int bj = 0; bj < 2; ++bj) { const int col = col0 + bj * HALF;
                    const v4u gs = *(const v4u*)(proj + (size_t)row * INW + OFF_GF + col);
                    const f32x4 v0 = acc[ai][bj][m][0], v1 = acc[ai][bj][m][1];
                    v4u w; w.x = cvt_pk_bf16(v0[0] * bf_lo(gs.x), v0[1] * bf_hi(gs.x)); w.y = cvt_pk_bf16(v0[2] * bf_lo(gs.y), v0[3] * bf_hi(gs.y));
                    w.z = cvt_pk_bf16(v1[0] * bf_lo(gs.z), v1[1] * bf_hi(gs.z)); w.w = cvt_pk_bf16(v1[2] * bf_lo(gs.w), v1[3] * bf_hi(gs.w));
                    *(v4u*)(mix + (size_t)row * DM + 3072 + col) = w; } }
    }
};
struct EpiOut {
    static constexpr bool PERM = true;
    bf16* delta; const float* modl;
    __device__ __forceinline__ void operator()(const f32x4 (&acc)[2][2][4][2], const Unit& u, int wr, int wc, int fr, int fq) const {
        const int rt = u.pm * BM; const int v = rt < NCTX ? 0 : (rt < NCTX + 4096 ? 1 : 2);
        const float* gv = modl + v * 12288 + 8192;
        const int row0 = rt + wr * 64 + fr, col0 = u.pn * BM + wc * 32 + 8 * fq;
        f32x4 gt[2][2];
#pragma unroll
        for (int bj = 0; bj < 2; ++bj)
#pragma unroll
            for (int n = 0; n < 2; ++n) gt[bj][n] = *(const f32x4*)(gv + col0 + bj * HALF + n * 4);
#pragma unroll
        for (int ai = 0; ai < 2; ++ai)
#pragma unroll
            for (int m = 0; m < 4; ++m) { bf16* rowp = delta + (size_t)(row0 + ai * HALF + m * 16) * DM + col0;
#pragma unroll
                for (int bj = 0; bj < 2; ++bj) { const f32x4 v0 = acc[ai][bj][m][0] * gt[bj][0], v1 = acc[ai][bj][m][1] * gt[bj][1];
                    v4u w; w.x = cvt_pk_bf16(v0[0], v0[1]); w.y = cvt_pk_bf16(v0[2], v0[3]); w.z = cvt_pk_bf16(v1[0], v1[1]); w.w = cvt_pk_bf16(v1[2], v1[3]);
                    *(v4u*)(rowp + bj * HALF) = w; } }
    }
};
}

namespace att {
constexpr int D = 128, QBLK = 32, KVBLK = 64;
constexpr float SCALE = 0.088388347648318440f;
constexpr float THR = 8.f;
constexpr int SHM_V = KVBLK * D * 2, SHM_K = KVBLK * D * 2;
constexpr int WS_OFF = 2 * SHM_V + 2 * SHM_K, OSTG_OFF = WS_OFF + NWAVES * 64 * 4, OSTG_ROW = 272, OSTG_WAVE = 32 * OSTG_ROW;
static_assert(DEPTH >= 2, "the bf16 stream is first written by layer 1's norm phase");
static_assert(OSTG_OFF + NWAVES * OSTG_WAVE <= MISC_OFF, "attention LDS");
#define KSWZ(row, colB) ((row) * 256 + ((colB) ^ (((row) & 7) << 4)))
#define SBAR() __builtin_amdgcn_sched_barrier(0)
__device__ __forceinline__ int crow(int r, int hi) { return (r & 3) + 8 * (r >> 2) + 4 * hi; }
__device__ __forceinline__ void partialSM(f32x16& p0, f32x16& p1, float& m_reg, float& mn, float& alpha) {
  constexpr float C = SCALE * 1.4426950408889634f;
  float pmax = p0[0]; for (int r = 1; r < 16; ++r) pmax = fmaxf(pmax, p0[r]); for (int r = 0; r < 16; ++r) pmax = fmaxf(pmax, p1[r]);
  { auto rr = __builtin_amdgcn_permlane32_swap(__float_as_uint(pmax), __float_as_uint(pmax), false, false);
    pmax = fmaxf(__uint_as_float(rr[0]), __uint_as_float(rr[1])); }
  if (__builtin_expect(__all(pmax - m_reg <= THR / SCALE), 1)) { mn = m_reg; alpha = 1.f; }
  else { mn = fmaxf(m_reg, pmax); alpha = __builtin_amdgcn_exp2f((m_reg - mn) * C); m_reg = mn; }
  float mnC = -mn * C;
  for (int r = 0; r < 16; ++r) p0[r] = fmaf(p0[r], C, mnC); for (int r = 0; r < 16; ++r) p1[r] = fmaf(p1[r], C, mnC);
  for (int r = 0; r < 16; ++r) p0[r] = __builtin_amdgcn_exp2f(p0[r]);
}
__device__ __forceinline__ void finishSM(f32x16& p0, f32x16& p1, float alpha, float& l_reg, bf16x8& pa0, bf16x8& pa1, bf16x8& pa2, bf16x8& pa3) {
  for (int r = 0; r < 16; ++r) p1[r] = __builtin_amdgcn_exp2f(p1[r]);
  float ps = 0; for (int r = 0; r < 16; ++r) ps += p0[r]; for (int r = 0; r < 16; ++r) ps += p1[r];
  { auto rr = __builtin_amdgcn_permlane32_swap(__float_as_uint(ps), __float_as_uint(ps), false, false);
    ps = __uint_as_float(rr[0]) + __uint_as_float(rr[1]); }
  l_reg = l_reg * alpha + ps;
#define PK4(P, BASE, OUT) do { unsigned a0 = cvt_pk_bf16(P[BASE + 0], P[BASE + 1]), a1 = cvt_pk_bf16(P[BASE + 2], P[BASE + 3]);   \
    unsigned b0 = cvt_pk_bf16(P[BASE + 4], P[BASE + 5]), b1 = cvt_pk_bf16(P[BASE + 6], P[BASE + 7]);                              \
    auto r0 = __builtin_amdgcn_permlane32_swap(a0, b0, false, false); auto r1 = __builtin_amdgcn_permlane32_swap(a1, b1, false, false); \
    v4u w = {r0[0], r1[0], r0[1], r1[1]}; OUT = *reinterpret_cast<bf16x8*>(&w); } while (0)
  PK4(p0, 0, pa0); PK4(p0, 8, pa1); PK4(p1, 0, pa2); PK4(p1, 8, pa3);
#undef PK4
}
__device__ __forceinline__ void qkt(f32x16& p0, f32x16& p1, const char* Ks, const bf16x8* qr, int r32, int hi) {
  p0 = f32x16{}; p1 = f32x16{};
  for (int d0 = 0; d0 < 8; ++d0) { int cb = (d0 * 16 + hi * 8) * 2;
    bf16x8 b0 = *reinterpret_cast<const bf16x8*>(Ks + KSWZ(r32, cb));
    bf16x8 b1 = *reinterpret_cast<const bf16x8*>(Ks + KSWZ(32 + r32, cb));
    p0 = __builtin_amdgcn_mfma_f32_32x32x16_bf16(b0, qr[d0], p0, 0, 0, 0);
    p1 = __builtin_amdgcn_mfma_f32_32x32x16_bf16(b1, qr[d0], p1, 0, 0, 0); }
}
__device__ __forceinline__ int v_st(int k, int c) { const int kk = (k & ~0xC) | ((k & 4) << 1) | ((k & 8) >> 1); return ((kk >> 3) * 4 + (c >> 5)) * 512 + ((kk & 7) * 32 + (c & 31)) * 2; }
__device__ __forceinline__ int v_rd_base(int lane) { return ((lane & 3) << 3) | (((lane >> 2) & 3) << 6) | (((lane >> 4) & 1) << 5) | (((lane >> 5) & 1) << 8); }
constexpr int v_rd_off(int d0, int ks, int half) { return d0 * 512 + ks * 4096 + half * 2048; }
template <int OFF> __device__ __forceinline__ s16x4 tr_read(int vb) {
  s16x4 r; asm volatile("ds_read_b64_tr_b16 %0, %1 offset:%2" : "=&v"(r) : "v"(vb), "i"(OFF) : "memory"); return r;
}
template <int D0> __device__ __forceinline__ void pv_one(f32x16& od, int vb, bf16x8 pa0, bf16x8 pa1, bf16x8 pa2, bf16x8 pa3) {
  const s16x4 l0 = tr_read<v_rd_off(D0, 0, 0)>(vb), h0 = tr_read<v_rd_off(D0, 0, 1)>(vb), l1 = tr_read<v_rd_off(D0, 1, 0)>(vb), h1 = tr_read<v_rd_off(D0, 1, 1)>(vb);
  const s16x4 l2 = tr_read<v_rd_off(D0, 2, 0)>(vb), h2 = tr_read<v_rd_off(D0, 2, 1)>(vb), l3 = tr_read<v_rd_off(D0, 3, 0)>(vb), h3 = tr_read<v_rd_off(D0, 3, 1)>(vb);
  asm volatile("s_waitcnt lgkmcnt(0)" ::: "memory"); SBAR();
#define PK(L, H) (bf16x8){L[0], L[1], L[2], L[3], H[0], H[1], H[2], H[3]}
  od = __builtin_amdgcn_mfma_f32_32x32x16_bf16(pa0, PK(l0, h0), od, 0, 0, 0);
  od = __builtin_amdgcn_mfma_f32_32x32x16_bf16(pa1, PK(l1, h1), od, 0, 0, 0);
  od = __builtin_amdgcn_mfma_f32_32x32x16_bf16(pa2, PK(l2, h2), od, 0, 0, 0);
  od = __builtin_amdgcn_mfma_f32_32x32x16_bf16(pa3, PK(l3, h3), od, 0, 0, 0);
#undef PK
}
__device__ __forceinline__ void pv_d0(f32x16* o, int vb, bf16x8 pa0, bf16x8 pa1, bf16x8 pa2, bf16x8 pa3) {
  pv_one<0>(o[0], vb, pa0, pa1, pa2, pa3); pv_one<1>(o[1], vb, pa0, pa1, pa2, pa3); pv_one<2>(o[2], vb, pa0, pa1, pa2, pa3); pv_one<3>(o[3], vb, pa0, pa1, pa2, pa3);
}

__device__ __forceinline__ void attn_unit(const bf16* __restrict__ Qb, const bf16* __restrict__ Gb, bf16* __restrict__ Ob,
                                          const bf16* __restrict__ K0, const bf16* __restrict__ V0, int ld0, int nt0,
                                          const bf16* __restrict__ K1, const bf16* __restrict__ V1, int ld1, int nt1,
                                          const float* __restrict__ qn, const f32x2* __restrict__ rope, int tok0, char* lds, int wv) {
  const int tid = tid_of(wv);
  const int wid = tid >> 6, lane = tid & 63, r32 = lane & 31, hi = lane >> 5;
  char* V_lds = lds; char* K_lds = lds + 2 * SHM_V;
  float* ws = (float*)(lds + WS_OFF) + wid * 64; float* li_l = ws; float* al_l = ws + 32;
  float m_reg = -1e30f, l_reg = 0; f32x16 o[4] = {}; bf16x8 qr[8];
  const int sr = tid >> 4, sc = (tid & 15) * 8, vst0 = v_st(sr, sc), vst1 = v_st(32 + sr, sc);
  const int vb0 = (int)(uintptr_t)V_lds + v_rd_base(lane);
  struct { bf16x8 vs0, vs1, ks0, ks1; } sr_[2];
#define SLOAD(i, jt) do { const bf16* kb_; const bf16* vb_; long ld_; \
    if ((jt) < nt0) { kb_ = K0 + (long)(jt) * KVBLK * ld0; vb_ = V0 + (long)(jt) * KVBLK * ld0; ld_ = ld0; } else { kb_ = K1 + (long)((jt) - nt0) * KVBLK * ld1; vb_ = V1 + (long)((jt) - nt0) * KVBLK * ld1; ld_ = ld1; } \
    sr_[i].vs0 = *reinterpret_cast<const bf16x8*>(vb_ + (long)sr * ld_ + sc); sr_[i].vs1 = *reinterpret_cast<const bf16x8*>(vb_ + (long)(32 + sr) * ld_ + sc); \
    sr_[i].ks0 = *reinterpret_cast<const bf16x8*>(kb_ + (long)sr * ld_ + sc); sr_[i].ks1 = *reinterpret_cast<const bf16x8*>(kb_ + (long)(32 + sr) * ld_ + sc); } while (0)
  SLOAD(0, 0);
  __syncthreads();
  {
    const bf16* Qw = Qb + (long)(wid * QBLK + r32) * INW + hi * 8;
    float x[8][8]; float ss = 0.f;
#pragma unroll
    for (int d0 = 0; d0 < 8; ++d0) { const v4u raw = *reinterpret_cast<const v4u*>(Qw + d0 * 16);
      x[d0][0] = bf_lo(raw.x); x[d0][1] = bf_hi(raw.x); x[d0][2] = bf_lo(raw.y); x[d0][3] = bf_hi(raw.y); x[d0][4] = bf_lo(raw.z); x[d0][5] = bf_hi(raw.z); x[d0][6] = bf_lo(raw.w); x[d0][7] = bf_hi(raw.w);
#pragma unroll
      for (int j = 0; j < 8; ++j) ss += x[d0][j] * x[d0][j]; }
    { auto rr = __builtin_amdgcn_permlane32_swap(__float_as_uint(ss), __float_as_uint(ss), false, false); ss = __uint_as_float(rr[0]) + __uint_as_float(rr[1]); }
    const float rstd = rsqrtf(ss * (1.0f / 128.0f) + NORM_EPS);
#pragma unroll
    for (int d0 = 0; d0 < 8; ++d0) { const f32x4 w0 = *reinterpret_cast<const f32x4*>(qn + d0 * 16 + hi * 8), w1 = *reinterpret_cast<const f32x4*>(qn + d0 * 16 + hi * 8 + 4);
#pragma unroll
      for (int j = 0; j < 4; ++j) { x[d0][j] *= rstd * w0[j]; x[d0][4 + j] *= rstd * w1[j]; } }
    if (rope) {
      const int t = tok0 + wid * QBLK + r32, prow = t >> 6, pcol = t & 63;
#pragma unroll
      for (int half = 0; half < 2; ++half) { const f32x2* rp = rope + (half ? pcol : prow) * 32;
#pragma unroll
        for (int dd = 0; dd < 2; ++dd) { const int d0 = half * 4 + dd;
#pragma unroll
          for (int j = 0; j < 8; ++j) { const f32x2 cs = rp[dd * 16 + hi * 8 + j]; const float x1 = x[d0][j], x2 = x[d0 + 2][j];
            x[d0][j] = x1 * cs.x - x2 * cs.y; x[d0 + 2][j] = x1 * cs.y + x2 * cs.x; } } }
    }
#pragma unroll
    for (int d0 = 0; d0 < 8; ++d0) { v4u w = {cvt_pk_bf16(x[d0][0], x[d0][1]), cvt_pk_bf16(x[d0][2], x[d0][3]), cvt_pk_bf16(x[d0][4], x[d0][5]), cvt_pk_bf16(x[d0][6], x[d0][7])}; qr[d0] = *reinterpret_cast<bf16x8*>(&w); }
  }
#define SWRITE(b, i) do { *(bf16x8*)(V_lds + (b) * SHM_V + vst0) = sr_[i].vs0;          \
    *(bf16x8*)(V_lds + (b) * SHM_V + vst1) = sr_[i].vs1; int kc = sc * 2;               \
    *(bf16x8*)(K_lds + (b) * SHM_K + KSWZ(sr, kc)) = sr_[i].ks0;                       \
    *(bf16x8*)(K_lds + (b) * SHM_K + KSWZ(32 + sr, kc)) = sr_[i].ks1; } while (0)
#define SWAIT() asm volatile("s_waitcnt vmcnt(4)" ::: "memory")
#define RESC(a) do { if (__any((a) < 1.f)) { if (hi == 0) al_l[r32] = (a); asm volatile("s_waitcnt lgkmcnt(0)" ::: "memory"); \
    for (int d = 0; d < 4; ++d) for (int r = 0; r < 16; ++r) o[d][r] *= al_l[crow(r, hi)]; } } while (0)
  f32x16 pA0, pA1, pB0, pB1; float mnA, mnB, alA, alB; bf16x8 pa0, pa1, pa2, pa3; const int NT = nt0 + nt1;
  constexpr int SE = 0, SO = 1;
  asm volatile("s_waitcnt vmcnt(0)" ::: "memory"); SWRITE(0, SE); __syncthreads();
  qkt(pA0, pA1, K_lds, qr, r32, hi); partialSM(pA0, pA1, m_reg, mnA, alA);
  SLOAD(SO, 1); if (2 < NT) SLOAD(SE, 2);
  SWAIT(); SWRITE(1, SO); __syncthreads();
  for (int j = 1; j + 1 < NT; j += 2) {
    SBAR(); qkt(pB0, pB1, K_lds + SHM_K, qr, r32, hi);
    finishSM(pA0, pA1, alA, l_reg, pa0, pa1, pa2, pa3); SBAR();
    SLOAD(SO, j + 2); SBAR();
    pv_d0(o, vb0, pa0, pa1, pa2, pa3); partialSM(pB0, pB1, m_reg, mnB, alB);
    __syncthreads(); SWAIT(); SWRITE(0, SE);
    RESC(alB); __syncthreads();
    SBAR(); qkt(pA0, pA1, K_lds, qr, r32, hi);
    finishSM(pB0, pB1, alB, l_reg, pa0, pa1, pa2, pa3); SBAR();
    if (j + 3 < NT) SLOAD(SE, j + 3); SBAR();
    pv_d0(o, vb0 + SHM_V, pa0, pa1, pa2, pa3); partialSM(pA0, pA1, m_reg, mnA, alA);
    __syncthreads(); SWAIT(); SWRITE(1, SO);
    RESC(alA); __syncthreads();
  }
  SBAR(); qkt(pB0, pB1, K_lds + SHM_K, qr, r32, hi);
  finishSM(pA0, pA1, alA, l_reg, pa0, pa1, pa2, pa3); SBAR();
  pv_d0(o, vb0, pa0, pa1, pa2, pa3); partialSM(pB0, pB1, m_reg, mnB, alB);
  __syncthreads(); RESC(alB);
  finishSM(pB0, pB1, alB, l_reg, pa0, pa1, pa2, pa3); SBAR();
  pv_d0(o, vb0 + SHM_V, pa0, pa1, pa2, pa3);
  if (hi == 0) li_l[r32] = l_reg; asm volatile("s_waitcnt lgkmcnt(0)" ::: "memory");
  char* stg = lds + OSTG_OFF + wid * OSTG_WAVE;
  v4u gvv[8];
#pragma unroll
  for (int it = 0; it < 8; ++it) gvv[it] = *reinterpret_cast<const v4u*>(Gb + (long)(wid * QBLK + it * 4 + (lane >> 4)) * INW + (lane & 15) * 8);
#pragma unroll
  for (int r = 0; r < 16; ++r) { const int orow = crow(r, hi); const float rl = __builtin_amdgcn_rcpf(li_l[orow]);
#pragma unroll
    for (int d0 = 0; d0 < 4; ++d0) { const unsigned w = cvt_pk_bf16(o[d0][r] * rl, 0.f); *(bf16*)(stg + orow * OSTG_ROW + (d0 * 32 + r32) * 2) = (bf16)(w & 0xffffu); }
    if ((r & 3) == 3) asm volatile("" ::: "memory"); }
  asm volatile("s_waitcnt lgkmcnt(0)" ::: "memory");
#pragma unroll
  for (int it = 0; it < 8; ++it) { const int row = it * 4 + (lane >> 4), cc = (lane & 15) * 8;
    const v4u ov = *(const v4u*)(stg + row * OSTG_ROW + cc * 2);
    const v4u gv = gvv[it];
    v4u w; w.x = cvt_pk_bf16(bf_lo(ov.x) * bf_lo(gv.x), bf_hi(ov.x) * bf_hi(gv.x)); w.y = cvt_pk_bf16(bf_lo(ov.y) * bf_lo(gv.y), bf_hi(ov.y) * bf_hi(gv.y));
    w.z = cvt_pk_bf16(bf_lo(ov.z) * bf_lo(gv.z), bf_hi(ov.z) * bf_hi(gv.z)); w.w = cvt_pk_bf16(bf_lo(ov.w) * bf_lo(gv.w), bf_hi(ov.w) * bf_hi(gv.w));
    *reinterpret_cast<v4u*>(Ob + (long)(wid * QBLK + row) * DM + cc) = w; }
#undef SLOAD
#undef SWRITE
#undef SWAIT
#undef RESC
}
}

#define XB_TMO      128
#define XB_XCNT(j)  (256  + 64 * (j))
#define XB_XSUB(j)  (1280 + 64 * (j))
#define XB_XGEN(j)  (2304 + 64 * (j))
#define XB_TOP      3328
#define XB_TOPGEN   3392
#define XCD_BAR_WORDS 3456
#define XB_SPIN_CAP (1u << 18)
__device__ __forceinline__ unsigned xb_ld(unsigned* p)              { return __hip_atomic_load(p, __ATOMIC_RELAXED, __HIP_MEMORY_SCOPE_AGENT); }
__device__ __forceinline__ unsigned xb_add(unsigned* p, unsigned v) { return __hip_atomic_fetch_add(p, v, __ATOMIC_RELAXED, __HIP_MEMORY_SCOPE_AGENT); }
__device__ __forceinline__ unsigned xb_xcc_id() { return (unsigned)__builtin_amdgcn_s_getreg((3 << 11) | 20) & 0xFu; }
#define XB_SPIN(cond, bar) do { unsigned _sp = 0; while (cond) { __builtin_amdgcn_s_sleep(1); \
    if ((++_sp & 255u) == 0u) { if (xb_ld(&(bar)[XB_TMO])) break; if (_sp > XB_SPIN_CAP) { atomicAdd(&(bar)[XB_TMO], 1u); break; } } } } while (0)
struct XcdBarrier { unsigned* bar; unsigned x; volatile LAS unsigned* st; };
__device__ __forceinline__ XcdBarrier xcd_barrier_post(unsigned* bar, volatile LAS unsigned* st, int tid) {
    XcdBarrier b; b.bar = bar; b.x = xb_xcc_id(); b.st = st;
    if (tid == 0) (void)xb_add(&bar[XB_XCNT(b.x)], 1u);
    return b;
}
__device__ __forceinline__ void xcd_barrier_complete(unsigned* bar, unsigned x, unsigned& nloc, unsigned& nx) {
    const unsigned G = gridDim.x * gridDim.y * gridDim.z;
    unsigned sum, cnt, mine, sp = 0u;
    for (;;) {
        sum = 0u; cnt = 0u; mine = 0u;
#pragma nounroll
        for (unsigned j = 0; j < 16; ++j) { const unsigned c = xb_ld(&bar[XB_XCNT(j)]); sum += c; cnt += (c > 0u) ? 1u : 0u; mine = (j == x) ? c : mine; }
        if (sum == G) break;
        __builtin_amdgcn_s_sleep(1);
        if ((++sp & 255u) == 0u) { if (xb_ld(&bar[XB_TMO])) break; if (sp > XB_SPIN_CAP) { atomicAdd(&bar[XB_TMO], 1u); break; } }
    }
    nloc = mine > 0u ? mine : 1u; nx = cnt > 0u ? cnt : 1u;
}
__device__ __forceinline__ void xcd_barrier(const XcdBarrier& b, int wv) {
    asm volatile("s_waitcnt vmcnt(0)" ::: "memory");
    __syncthreads();
    if (tid_of(wv) == 0) {
        unsigned* bar = b.bar;
        __builtin_amdgcn_s_waitcnt(0);
        unsigned nloc = b.st[0], nx = b.st[1];
        if (nloc == 0u) { xcd_barrier_complete(bar, b.x, nloc, nx); b.st[0] = nloc; b.st[1] = nx; }
        const unsigned old = xb_add(&bar[XB_XSUB(b.x)], 1u);
        const unsigned gen = old / nloc;
        if (old + 1u == (gen + 1u) * nloc) {
            __builtin_amdgcn_fence(__ATOMIC_RELEASE, "agent");
            asm volatile("s_waitcnt vmcnt(0)" ::: "memory");
            const unsigned og = xb_add(&bar[XB_TOP], 1u);
            const unsigned tg = og / nx;
            if (og + 1u == (tg + 1u) * nx) xb_add(&bar[XB_TOPGEN], 1u);
            else XB_SPIN(xb_ld(&bar[XB_TOPGEN]) == tg, bar);
            __builtin_amdgcn_fence(__ATOMIC_ACQUIRE, "agent");
            xb_add(&bar[XB_XGEN(b.x)], 1u);
            asm volatile("s_waitcnt vmcnt(0)" ::: "memory");
        } else {
            XB_SPIN(xb_ld(&bar[XB_XGEN(b.x)]) == gen, bar);
            __builtin_amdgcn_fence(__ATOMIC_ACQUIRE, "agent");
            asm volatile("s_waitcnt vmcnt(0)" ::: "memory");
        }
    }
    __syncthreads();
}
__device__ __forceinline__ void wg_global_sync() {
    asm volatile("s_waitcnt vmcnt(0)" ::: "memory");
    __syncthreads();
    __builtin_amdgcn_fence(__ATOMIC_ACQUIRE, "agent");
    asm volatile("s_waitcnt vmcnt(0)" ::: "memory");
}

struct Args { const float* in[28]; float* out; unsigned char* ws; int ph_lo, ph_hi; };
typedef const __attribute__((address_space(4))) Args* KAP;
#define KA_HERE() KAP ka = (KAP)__builtin_amdgcn_kernarg_segment_ptr(); asm volatile("" : "+s"(ka))
enum { I_XP = 0, I_XS, I_CK, I_CV, I_SFR, I_SFI, I_SBR, I_SBI, I_C, I_CCTX, I_NG, I_WMOD, I_BMOD, I_WIN, I_QN, I_KN, I_LRE, I_LIM, I_LSTEP, I_BRE, I_BIM, I_CRE, I_CIM, I_DSKIP, I_WGLU, I_WFFT, I_WOUT, I_FNG };

__device__ __forceinline__ int glu_row(int n) { return n < 1024 ? ((n >> 7) * 256 + (n & 127)) : (((n - 1024) >> 7) * 256 + 128 + ((n - 1024) & 127)); }
template <bool GLU>
__device__ __forceinline__ void tr_item(const float* __restrict__ W, int K, int N, bf16* __restrict__ WT, LAS float* scr, int item, int lane) {
    const int nblk = N / 64, kb = item / nblk, nb = item % nblk, k0 = 64 * kb, n0 = 64 * nb;
#pragma unroll 8
    for (int i = 0; i < 64; ++i) scr[i * 65 + lane] = W[(size_t)(k0 + i) * N + n0 + lane];
    LDS_WAIT(); asm volatile("" ::: "memory");
    const int c = lane & 7;
#pragma unroll
    for (int j = 0; j < 8; ++j) { const int n = (lane >> 3) + 8 * j; const LAS float* s = scr + (8 * c) * 65 + n;
        v4u o; o.x = cvt_pk_bf16(s[0 * 65], s[1 * 65]); o.y = cvt_pk_bf16(s[2 * 65], s[3 * 65]); o.z = cvt_pk_bf16(s[4 * 65], s[5 * 65]); o.w = cvt_pk_bf16(s[6 * 65], s[7 * 65]);
        int nd = n0 + n; if (GLU) nd = glu_row(nd);
        *(v4u*)(WT + (size_t)nd * K + k0 + 8 * c) = o; }
    LDS_WAIT(); asm volatile("" ::: "memory");
}

__device__ __forceinline__ void ssm_matrices(KAP A, int l, int g, LAS unsigned char* lds, int tid) {
    LAS f32x2* pw = (LAS f32x2*)lds;
    LAS f32x2* bb = pw + 2 * 17 * 64;
    LAS f32x2* cc = bb + 2 * 64 * 16;
    LAS float* kk = (LAS float*)(cc + 2 * 16 * 64);
    if (tid < 128) {
        const int dir = tid >> 6, p = tid & 63, ig = (l * 2 + dir) * 64 + g;
        const float dt = expf(A->in[I_LSTEP][ig]);
        const float lr = A->in[I_LRE][(size_t)ig * 64 + p], li = A->in[I_LIM][(size_t)ig * 64 + p];
        for (int tau = 0; tau <= 16; ++tau) {
            const float mag = expf(lr * dt * (float)tau);
            const double turns = (double)li * (double)dt * (double)tau * 0.15915494309189535;
            const float fr = (float)(turns - rint(turns));
            pw[(dir * 17 + tau) * 64 + p] = (f32x2){mag * cospif(2.f * fr), mag * sinpif(2.f * fr)};
        }
        const f32x2 ab = pw[(dir * 17 + 1) * 64 + p];
        const float nr = ab.x - 1.0f, ni = ab.y, den = lr * lr + li * li;
        const float f_re = (nr * lr + ni * li) / den, f_im = (ni * lr - nr * li) / den;
        for (int c = 0; c < 16; ++c) { const float br = A->in[I_BRE][((size_t)ig * 64 + p) * 16 + c], bi = A->in[I_BIM][((size_t)ig * 64 + p) * 16 + c];
            bb[(dir * 64 + p) * 16 + c] = (f32x2){f_re * br - f_im * bi, f_re * bi + f_im * br}; }
        ((f32x2*)(A->ws + WS_A16))[(size_t)ig * 64 + p] = pw[(dir * 17 + 16) * 64 + p];
    }
    for (int idx = tid; idx < 2048; idx += 512) { const int dir = idx >> 10, c = (idx >> 6) & 15, p = idx & 63; const size_t gi = (((size_t)(l * 2 + dir) * 64 + g) * 16 + c) * 64 + p;
        cc[idx] = (f32x2){A->in[I_CRE][gi], A->in[I_CIM][gi]}; }
    __syncthreads();
    {
        const int dir = tid >> 8, tau = (tid >> 4) & 15, c = tid & 15;
        float accv[16];
#pragma unroll
        for (int j = 0; j < 16; ++j) accv[j] = 0.f;
        for (int p = 0; p < 64; ++p) { const f32x2 cv = cc[(dir * 16 + c) * 64 + p], pv = pw[(dir * 17 + tau) * 64 + p];
            const float wre = cv.x * pv.x - cv.y * pv.y, wim = cv.x * pv.y + cv.y * pv.x;
#pragma unroll
            for (int j = 0; j < 16; ++j) { const f32x2 bv = bb[(dir * 64 + p) * 16 + j]; accv[j] += wre * bv.x - wim * bv.y; } }
#pragma unroll
        for (int j = 0; j < 16; ++j) kk[((dir * 16 + tau) * 16 + c) * 16 + j] = accv[j];
    }
    __syncthreads();
    const int lg = l * 64 + g;
    bf16* Pm = (bf16*)(A->ws + WS_PMAT) + (size_t)lg * 256 * 256;
    for (int q = tid; q < 8192; q += 512) { const int R = q >> 5, col = (q & 31) * 8, s = col >> 4, c0 = col & 15, dir = R >> 7, reim = (R >> 6) & 1, p = R & 63, e = dir ? s : 15 - s;
        const f32x2 pv = pw[(dir * 17 + e) * 64 + p]; float v[8];
#pragma unroll
        for (int j = 0; j < 8; ++j) { const f32x2 bv = bb[(dir * 64 + p) * 16 + c0 + j]; v[j] = reim ? (pv.x * bv.y + pv.y * bv.x) : (pv.x * bv.x - pv.y * bv.y); }
        v4u w; w.x = cvt_pk_bf16(v[0], v[1]); w.y = cvt_pk_bf16(v[2], v[3]); w.z = cvt_pk_bf16(v[4], v[5]); w.w = cvt_pk_bf16(v[6], v[7]);
        *(v4u*)(Pm + (size_t)R * 256 + col) = w; }
    bf16* KGm = (bf16*)(A->ws + WS_KG) + (size_t)lg * 256 * 512;
    for (int q = tid; q < 16384; q += 512) { const int R = q >> 6, col = (q & 63) * 8, i = R >> 4, c = R & 15; float v[8];
        if (col < 256) { const int s = col >> 4, c0 = col & 15;
#pragma unroll
            for (int j = 0; j < 8; ++j) { const int cp = c0 + j; float x;
                if (s < i) x = kk[((0 * 16 + (i - s)) * 16 + c) * 16 + cp];
                else if (s > i) x = kk[((1 * 16 + (s - i)) * 16 + c) * 16 + cp];
                else { x = kk[((0 * 16 + 0) * 16 + c) * 16 + cp] + kk[((1 * 16 + 0) * 16 + c) * 16 + cp]; if (cp == c) x += A->in[I_DSKIP][l * 1024 + g * 16 + c]; }
                v[j] = x; }
        } else { const int k = col - 256, dir = k >> 7, reim = (k >> 6) & 1, p0 = k & 63, e = dir ? 16 - i : i + 1;
#pragma unroll
            for (int j = 0; j < 8; ++j) { const f32x2 cv = cc[(dir * 16 + c) * 64 + p0 + j], pv = pw[(dir * 17 + e) * 64 + p0 + j];
                v[j] = reim ? -(cv.x * pv.y + cv.y * pv.x) : (cv.x * pv.x - cv.y * pv.y); } }
        v4u w; w.x = cvt_pk_bf16(v[0], v[1]); w.y = cvt_pk_bf16(v[2], v[3]); w.z = cvt_pk_bf16(v[4], v[5]); w.w = cvt_pk_bf16(v[6], v[7]);
        *(v4u*)(KGm + (size_t)R * 512 + col) = w; }
    __syncthreads();
}

__device__ __forceinline__ void mod_unit(KAP A, int un, LAS unsigned char* lds, int tid, int wave, int lane) {
    LAS float* sl = (LAS float*)lds;
    LAS float* red = sl + 3 * 4096;
    const int l = un >> 6, nb = un & 63;
    for (int i = tid; i < 3 * 4096; i += 512) { const int v = i >> 12, k = i & 4095; const float x = v == 0 ? A->in[I_CCTX][k] : A->in[I_C][(v - 1) * 4096 + k]; sl[i] = x / (1.0f + expf(-x)); }
    __syncthreads();
    const int ln = lane < 48 ? lane : 47;
    const float* wp = A->in[I_WMOD] + ((size_t)l * 4096 + wave * 512) * 12288 + nb * 192 + ln * 4;
    f32x4 a0 = {0.f, 0.f, 0.f, 0.f}, a1 = a0, a2 = a0;
#pragma unroll 8
    for (int kq = 0; kq < 512; ++kq) { const f32x4 w = *(const f32x4*)(wp + (size_t)kq * 12288); const int k = wave * 512 + kq;
        a0 += sl[k] * w; a1 += sl[4096 + k] * w; a2 += sl[8192 + k] * w; }
    if (lane < 48) {
#pragma unroll
        for (int j = 0; j < 4; ++j) { red[(wave * 3 + 0) * 256 + lane * 4 + j] = a0[j]; red[(wave * 3 + 1) * 256 + lane * 4 + j] = a1[j]; red[(wave * 3 + 2) * 256 + lane * 4 + j] = a2[j]; } }
    __syncthreads();
    for (int i = tid; i < 768; i += 512) { const int v = i >> 8, col = i & 255; if (col < 192) { float s = 0.f;
#pragma unroll
        for (int w = 0; w < 8; ++w) s += red[(w * 3 + v) * 256 + col];
        ((float*)(A->ws + WS_MOD))[(size_t)(l * 3 + v) * 12288 + nb * 192 + col] = s + A->in[I_BMOD][l * 12288 + nb * 192 + col]; } }
    __syncthreads();
}

__device__ __forceinline__ void p0_prologue(KAP A, LAS unsigned char* lds, int G, int bx, int wv) {
    const int tid = tid_of(wv); const int lane = tid & 63, wave = __builtin_amdgcn_readfirstlane(tid >> 6);
    { LAS float* scr = (LAS float*)(lds + wave * 16640);
      const int gw = bx * NWAVES + wave, NGW = G * NWAVES;
      constexpr int I_IN = 64 * 144, I_OUT = 64 * 64, I_GLU = 16 * 32, I_FFT = 16 * 16, I_L = I_IN + I_OUT + I_GLU + I_FFT;
      for (int it = gw; it < 4 * I_L; it += NGW) { const int l = it / I_L; int r = it % I_L;
          if (r < I_IN) { tr_item<false>(A->in[I_WIN] + (size_t)l * 4096 * 9216, 4096, 9216, (bf16*)(A->ws + WS_WIN) + (size_t)l * 9216 * 4096, scr, r, lane); continue; } r -= I_IN;
          if (r < I_OUT) { tr_item<false>(A->in[I_WOUT] + (size_t)l * 4096 * 4096, 4096, 4096, (bf16*)(A->ws + WS_WOUT) + (size_t)l * 4096 * 4096, scr, r, lane); continue; } r -= I_OUT;
          if (r < I_GLU) { tr_item<true>(A->in[I_WGLU] + (size_t)l * 1024 * 2048, 1024, 2048, (bf16*)(A->ws + WS_WGLU) + (size_t)l * 2048 * 1024, scr, r, lane); continue; } r -= I_GLU;
          tr_item<false>(A->in[I_WFFT] + (size_t)l * 1024 * 1024, 1024, 1024, (bf16*)(A->ws + WS_WFFT) + (size_t)l * 1024 * 1024, scr, r, lane); }
    }
    __syncthreads();
    for (int un = bx; un < 256; un += G) mod_unit(A, un, lds, tid, wave, lane);
    const size_t gt = (size_t)bx * 512 + tid, NGT = (size_t)G * 512;
    { bf16* D2L = (bf16*)(A->ws + WS_D2L);
      LAS bf16* lut = (LAS bf16*)lds;
      for (int i = tid; i < 4096; i += 512) lut[i] = (bf16)(cvt_pk_bf16(cospif((float)i * (1.0f / 2048.0f)), 0.f) & 0xffffu);
      __syncthreads();
      for (size_t q = gt; q < (size_t)4096 * 1024; q += NGT) { const int k = (int)(q >> 10), K0 = (int)(q & 1023) * 8; unsigned h[8];
          const int sh = K0 < 4096 ? 0 : 1024;
#pragma unroll
          for (int j = 0; j < 8; ++j) { const int K = (K0 + j) & 4095; h[j] = lut[(k * K + sh) & 4095]; }
          v4u w; w.x = h[0] | (h[1] << 16); w.y = h[2] | (h[3] << 16); w.z = h[4] | (h[5] << 16); w.w = h[6] | (h[7] << 16);
          *(v4u*)(D2L + (size_t)k * 8192 + K0) = w; }
      __syncthreads(); }
    { bf16* D1 = (bf16*)(A->ws + WS_D1);
      for (size_t q = gt; q < (size_t)512 * 256; q += NGT) { const int mp = (int)(q >> 8), c = (int)(q & 255), m = mp & 255; const float x = (float)((m * c) & 255) * (1.0f / 128.0f);
          const float v = mp < 256 ? cospif(x) : sinpif(x); D1[q] = (bf16)(cvt_pk_bf16(v, 0.f) & 0xffffu); } }
    { bf16* D2C = (bf16*)(A->ws + WS_D2C);
      for (size_t q = gt; q < (size_t)256 * 512; q += NGT) { const int k = (int)(q >> 9), K = (int)(q & 511); const float x = (float)((k * (K & 255)) & 255) * (1.0f / 128.0f);
          const float v = K < 256 ? cospif(x) : -sinpif(x); D2C[q] = (bf16)(cvt_pk_bf16(v, 0.f) & 0xffffu); } }
    { f32x2* rope = (f32x2*)(A->ws + WS_ROPE);
      for (size_t q = gt; q < 64 * 32; q += NGT) { const int pos = (int)(q >> 5), i = (int)(q & 31); const float inv = exp2f(-(float)i * (13.287712379549449f / 32.0f));
          const double turns = (double)pos * (double)inv * 0.15915494309189535; const float fr = (float)(turns - rint(turns));
          rope[q] = (f32x2){cospif(2.f * fr), sinpif(2.f * fr)}; } }
    { const size_t n8 = (size_t)2 * 4 * 512 * 512 / 8;
      for (size_t q = gt; q < 2 * n8; q += NGT) { const bool isk = q < n8; const size_t j = isk ? q : q - n8; const float* src = (isk ? A->in[I_CK] : A->in[I_CV]) + j * 8;
          const f32x4 x0 = *(const f32x4*)src, x1 = *(const f32x4*)(src + 4);
          v4u w; w.x = cvt_pk_bf16(x0[0], x0[1]); w.y = cvt_pk_bf16(x0[2], x0[3]); w.z = cvt_pk_bf16(x1[0], x1[1]); w.w = cvt_pk_bf16(x1[2], x1[3]);
          *(v4u*)((bf16*)(A->ws + (isk ? WS_CK : WS_CV)) + j * 8) = w; } }
    __syncthreads();
    for (int lg = bx; lg < 256; lg += G) ssm_matrices(A, lg >> 6, lg & 63, lds, tid);
}

__device__ __forceinline__ f32x4 ldg16(const void* base, unsigned off, int imm) { return *(const f32x4*)(((const char*)base + off) + imm); }
__device__ __forceinline__ void pa_norm(KAP A, int l, int bx, int G, int tid, LAS unsigned char* lds) {
    const float* mod = (const float*)(A->ws + WS_MOD) + (size_t)l * 3 * 12288;
    const f32x4* ng4 = (const f32x4*)(A->in[I_NG] + l * DM);
    bf16* H = (bf16*)(A->ws + WS_H);
    const int lane = tid & 63, wave = __builtin_amdgcn_readfirstlane(tid >> 6);
    const unsigned lo = (unsigned)lane * 16u;
    LAS f32x4* avl = (LAS f32x4*)lds; LAS f32x4* svl = avl + 1024;
    for (int rb = bx; rb < NTOK / 64; rb += G) {
        const int m0 = rb * 64; const int v = m0 < NCTX ? 0 : (m0 < NCTX + 4096 ? 1 : 2);
        const f32x4* sh4 = (const f32x4*)(mod + v * 12288); const f32x4* sc4 = (const f32x4*)(mod + v * 12288 + 4096);
        __syncthreads();
        for (int i = tid; i < 1024; i += NWAVES * 64) { avl[i] = ng4[i] * (sc4[i] + 1.0f); svl[i] = sh4[i]; }
        __syncthreads();
#pragma unroll 2
        for (int r = 0; r < 8; ++r) { const int m = m0 + wave * 8 + r;
            f32x4 x[16]; float ss = 0.f;
            char* xb = (char*)((bf16*)(A->ws + ((l & 1) ? WS_XBF2 : WS_XBF)) + (size_t)m * DM);
            const char* xbi = (const char*)((const bf16*)(A->ws + ((l & 1) ? WS_XBF : WS_XBF2)) + (size_t)m * DM);
            if (l <= 1) { const float* xr = m < NCTX ? A->in[I_XP] + (size_t)m * DM : A->in[I_XS] + (size_t)(m - NCTX) * DM;
#pragma unroll
                for (int j = 0; j < 16; ++j) x[j] = ldg16(xr, lo + (j >> 2) * 4096u, (j & 3) * 1024);
            } else {
#pragma unroll
                for (int j = 0; j < 16; ++j) { const v2u d = *(const v2u*)((xbi + ((unsigned)lane * 8u + (j >> 3) * 4096u)) + (j & 7) * 512); x[j] = (f32x4){bf_lo(d.x), bf_hi(d.x), bf_lo(d.y), bf_hi(d.y)}; }
            }
            if (l > 0) {
                const char* dr = (const char*)((const bf16*)(A->ws + ((l & 1) ? WS_DELTA : WS_DELTA2)) + (size_t)m * DM);
#pragma unroll
                for (int j = 0; j < 16; ++j) { const v2u d = *(const v2u*)((dr + ((unsigned)lane * 8u + (j >> 3) * 4096u)) + (j & 7) * 512);
                    x[j] += (f32x4){bf_lo(d.x), bf_hi(d.x), bf_lo(d.y), bf_hi(d.y)};
                    v2u w; w.x = cvt_pk_bf16(x[j].x, x[j].y); w.y = cvt_pk_bf16(x[j].z, x[j].w);
                    *(v2u*)((xb + ((unsigned)lane * 8u + (j >> 3) * 4096u)) + (j & 7) * 512) = w; }
            }
#pragma unroll
            for (int j = 0; j < 16; ++j) ss += (x[j].x * x[j].x + x[j].y * x[j].y) + (x[j].z * x[j].z + x[j].w * x[j].w);
            const float rstd = rsqrtf(wave_sum(ss, lane) * (1.0f / DM) + NORM_EPS);
            char* orow = (char*)(H + (size_t)m * DM);
#pragma unroll
            for (int j = 0; j < 16; ++j) { const f32x4 y = x[j] * rstd * avl[lane + 64 * j] + svl[lane + 64 * j];
                v2u w; w.x = cvt_pk_bf16(y.x, y.y); w.y = cvt_pk_bf16(y.z, y.w); *(v2u*)((orow + ((unsigned)lane * 8u + (j >> 3) * 4096u)) + (j & 7) * 512) = w;
                if ((j & 3) == 3) asm volatile("" ::: "memory"); }
        }
    }
    __syncthreads();
}
__device__ __forceinline__ void final_norm(KAP A, int gw, int NGW, int lane) {
    const float* fg = A->in[I_FNG];
    const unsigned lo = (unsigned)lane * 16u;
    f32x4 gv[16];
#pragma unroll
    for (int j = 0; j < 16; ++j) gv[j] = ldg16(fg, lo + (j >> 2) * 4096u, (j & 3) * 1024);
    for (int ci = gw; ci < NTOK / 8; ci += NGW) {
#pragma unroll 2
        for (int r = 0; r < 8; ++r) { const int m = ci * 8 + r;
            char* xr = (char*)(A->out + (size_t)m * DM);
            const char* xs = (const char*)((const bf16*)(A->ws + (((DEPTH - 1) & 1) ? WS_XBF2 : WS_XBF)) + (size_t)m * DM);
            const char* dr = (const char*)((const bf16*)(A->ws + (((DEPTH - 1) & 1) ? WS_DELTA2 : WS_DELTA)) + (size_t)m * DM);
            f32x4 x[16]; float ss = 0.f;
#pragma unroll
            for (int j = 0; j < 16; ++j) { const v2u xv = *(const v2u*)((xs + ((unsigned)lane * 8u + (j >> 3) * 4096u)) + (j & 7) * 512); x[j] = (f32x4){bf_lo(xv.x), bf_hi(xv.x), bf_lo(xv.y), bf_hi(xv.y)};
                const v2u d = *(const v2u*)((dr + ((unsigned)lane * 8u + (j >> 3) * 4096u)) + (j & 7) * 512);
                x[j] += (f32x4){bf_lo(d.x), bf_hi(d.x), bf_lo(d.y), bf_hi(d.y)};
                ss += (x[j].x * x[j].x + x[j].y * x[j].y) + (x[j].z * x[j].z + x[j].w * x[j].w); }
            const float rstd = rsqrtf(wave_sum(ss, lane) * (1.0f / DM) + NORM_EPS);
#pragma unroll
            for (int j = 0; j < 16; ++j) { *(f32x4*)((xr + (lo + (j >> 2) * 4096u)) + (j & 3) * 1024) = x[j] * rstd * gv[j]; if ((j & 3) == 3) asm volatile("" ::: "memory"); }
        }
    }
}

__device__ __forceinline__ void kv_prep(KAP A, int l, int gw, int NGW, int lane) {
    const bf16* PROJ = (const bf16*)(A->ws + WS_PROJ);
    const f32x2* rope = (const f32x2*)(A->ws + WS_ROPE);
    const int hl = lane & 15;
    const f32x4 kn0 = *(const f32x4*)(A->in[I_KN] + l * 128 + hl * 8), kn1 = *(const f32x4*)(A->in[I_KN] + l * 128 + hl * 8 + 4);
    for (int ci = gw; ci < NTOK / 4; ci += NGW) {
        const int m0 = ci * 4; const bool ctx = m0 < NCTX;
        v4u kr[4], vr[4];
#pragma unroll
        for (int r = 0; r < 4; ++r) { const bf16* pr = PROJ + (size_t)(m0 + r) * INW; kr[r] = *(const v4u*)(pr + OFF_K + 8 * lane); vr[r] = *(const v4u*)(pr + OFF_V + 8 * lane); }
#pragma unroll
        for (int r = 0; r < 4; ++r) { const int m = m0 + r;
            float k[8] = {bf_lo(kr[r].x), bf_hi(kr[r].x), bf_lo(kr[r].y), bf_hi(kr[r].y), bf_lo(kr[r].z), bf_hi(kr[r].z), bf_lo(kr[r].w), bf_hi(kr[r].w)};
            float ss = 0.f;
#pragma unroll
            for (int j = 0; j < 8; ++j) ss += k[j] * k[j];
            ss += shflx(ss, lane, 1); ss += shflx(ss, lane, 2); ss += shflx(ss, lane, 4); ss += shflx(ss, lane, 8);
            const float rstd = rsqrtf(ss * (1.0f / 128.0f) + NORM_EPS);
#pragma unroll
            for (int j = 0; j < 4; ++j) { k[j] *= rstd * kn0[j]; k[4 + j] *= rstd * kn1[j]; }
            if (ctx) {
                const int b = m >> 8, t = m & 255; const size_t oi = (((size_t)(b * 4 + l) * 256 + t) * 512 + 8 * lane);
                float* ok = A->out + OUT_NEWK + oi; *(f32x4*)ok = (f32x4){k[0], k[1], k[2], k[3]}; *(f32x4*)(ok + 4) = (f32x4){k[4], k[5], k[6], k[7]};
                float* ov = A->out + OUT_NEWV + oi; *(f32x4*)ov = (f32x4){bf_lo(vr[r].x), bf_hi(vr[r].x), bf_lo(vr[r].y), bf_hi(vr[r].y)}; *(f32x4*)(ov + 4) = (f32x4){bf_lo(vr[r].z), bf_hi(vr[r].z), bf_lo(vr[r].w), bf_hi(vr[r].w)};
            } else {
                const int t = (m - NCTX) & 4095, pos = hl < 8 ? (t >> 6) : (t & 63); const f32x2* rp = rope + pos * 32 + (lane & 3) * 8; const bool first = (lane & 4) == 0;
#pragma unroll
                for (int j = 0; j < 8; ++j) { const float other = shflx(k[j], lane, 4); const f32x2 cs = rp[j];
                    k[j] = first ? (k[j] * cs.x - other * cs.y) : (other * cs.y + k[j] * cs.x); }
            }
            v4u w; w.x = cvt_pk_bf16(k[0], k[1]); w.y = cvt_pk_bf16(k[2], k[3]); w.z = cvt_pk_bf16(k[4], k[5]); w.w = cvt_pk_bf16(k[6], k[7]);
            *(v4u*)((bf16*)(A->ws + WS_KC) + (size_t)m * 512 + 8 * lane) = w;
            *(v4u*)((bf16*)(A->ws + WS_VC) + (size_t)m * 512 + 8 * lane) = vr[r];
        }
    }
}

__device__ __forceinline__ void ssm_scan(KAP A, int l, int g, int mt, int tid, LAS unsigned char* lds) {
    const float* S = (const float*)(A->ws + WS_SBUF) + (size_t)g * 1024 * 256;
    bf16* A2 = (bf16*)(A->ws + WS_A2) + (size_t)g * 1024 * 512;
    const f32x2* A16 = (const f32x2*)(A->ws + WS_A16);
    const int dirp = tid & 127, dir = dirp >> 6, p = dirp & 63, grp = tid >> 7;
    const f32x2 a = A16[((size_t)(l * 2 + dir) * 64 + g) * 64 + p];
    const int cre = 256 + dir * 128 + p, cim = cre + 64, sre = dir * 128 + p, sim = sre + 64;
    LAS f32x2* T = (LAS f32x2*)lds;
    LAS f32x2* EB = T + 16 * 128;
    const bool lat = mt >= 2;
    const int tile0 = mt * 256;
    if (lat) {
#pragma unroll 1
        for (int kk = 0; kk < 4; ++kk) { const int bb = grp + 4 * kk; const int rb = tile0 + bb * 16;
            float sr[16], si[16];
#pragma unroll
            for (int i = 0; i < 16; ++i) { const int row = rb + (dir ? 15 - i : i); sr[i] = S[(size_t)row * 256 + sre]; si[i] = S[(size_t)row * 256 + sim]; }
            float er = 0.f, ei = 0.f;
#pragma unroll
            for (int i = 0; i < 16; ++i) { const float nr = a.x * er - a.y * ei + sr[i], ni = a.x * ei + a.y * er + si[i]; er = nr; ei = ni; }
            T[bb * 128 + dirp] = (f32x2){er, ei}; }
        __syncthreads();
        if (tid < 128) { const int b = mt - 2; const size_t si0 = (((size_t)b * 4 + l) * 64 + g) * 64 + p;
            float er = A->in[dir ? I_SBR : I_SFR][si0], ei = A->in[dir ? I_SBI : I_SFI][si0];
            f32x2 q = a;
#pragma unroll
            for (int k = 0; k < 4; ++k) q = (f32x2){q.x * q.x - q.y * q.y, 2.f * q.x * q.y};
#pragma unroll 1
            for (int jb = 0; jb < 16; ++jb) { const int bb = dir ? 15 - jb : jb; EB[bb * 128 + dirp] = (f32x2){er, ei}; const f32x2 t = T[bb * 128 + dirp];
                const float nr = q.x * er - q.y * ei + t.x, ni = q.x * ei + q.y * er + t.y; er = nr; ei = ni; } }
        __syncthreads();
    }
#pragma unroll 1
    for (int kk = 0; kk < 4; ++kk) { const int bb = grp + 4 * kk; const int rb = tile0 + bb * 16;
        float sr[16], si[16];
#pragma unroll
        for (int i = 0; i < 16; ++i) { const int row = rb + (dir ? 15 - i : i); sr[i] = S[(size_t)row * 256 + sre]; si[i] = S[(size_t)row * 256 + sim]; }
        float er = 0.f, ei = 0.f;
        if (lat) { const f32x2 e0 = EB[bb * 128 + dirp]; er = e0.x; ei = e0.y; }
#pragma unroll
        for (int i = 0; i < 16; ++i) { const int row = rb + (dir ? 15 - i : i);
            A2[(size_t)row * 512 + cre] = (bf16)(cvt_pk_bf16(er, 0.f) & 0xffffu); A2[(size_t)row * 512 + cim] = (bf16)(cvt_pk_bf16(ei, 0.f) & 0xffffu);
            const float nr = a.x * er - a.y * ei + sr[i], ni = a.x * ei + a.y * er + si[i]; er = nr; ei = ni; }
        if (!lat) { const int b = mt * 16 + bb; const size_t oi = (((size_t)b * 4 + l) * 64 + g) * 64 + p;
            A->out[(dir ? OUT_BRE : OUT_FRE) + oi] = er; A->out[(dir ? OUT_BIM : OUT_FIM) + oi] = ei; }
    }
}
__device__ __forceinline__ void ssm_step1(KAP A, int l, int un, LAS unsigned char* lds, int wv) {
    const int g = un >> 2, mt = un & 3, lg = l * 64 + g;
    pg8::OneUnit S1; S1.u0.a = (const char*)(A->ws + WS_A2) + ((size_t)g * 1024 + mt * 256) * 512 * 2; S1.u0.b = (const char*)(A->ws + WS_PMAT) + (size_t)lg * 256 * 256 * 2;
    S1.u0.c = (char*)(A->ws + WS_SBUF) + ((size_t)g * 1024 + mt * 256) * 256 * 4; S1.u0.ldc = 256; S1.u0.pm = mt; S1.u0.pn = g; S1.u0.z = 0; S1.u0.kt = 4;
    pg8::EpiF32 E; pg8::gemm_phase<pg8::EpiF32, pg8::OneUnit>(lds, wv, 512, 256, S1, E);
}
__device__ __forceinline__ void ssm_step2(KAP A, int l, int un, LAS unsigned char* lds, int wv) {
    const int g = un >> 2, mt = un & 3; const int tid = tid_of(wv); ssm_scan(A, l, g, mt, tid, lds);
}
__device__ __forceinline__ void ssm_step3(KAP A, int l, int un, LAS unsigned char* lds, int wv) {
    const int g = un >> 2, mt = un & 3, lg = l * 64 + g;
    pg8::OneUnit S2; S2.u0.a = (const char*)(A->ws + WS_A2) + ((size_t)g * 1024 + mt * 256) * 512 * 2; S2.u0.b = (const char*)(A->ws + WS_KG) + (size_t)lg * 256 * 512 * 2;
    S2.u0.c = nullptr; S2.u0.ldc = 0; S2.u0.pm = mt; S2.u0.pn = g; S2.u0.z = mt * 256; S2.u0.kt = 8;
    pg8::EpiSsmY E{(bf16*)(A->ws + WS_YSSM)}; pg8::gemm_phase<pg8::EpiSsmY, pg8::OneUnit>(lds, wv, 512, 512, S2, E);
}

struct Fft1Order {
    int G, c; const char* D1; const char* proj; char* z1l; char* z1c;
    __device__ bool next(int i, pg8::Unit& u) const { const int L = i * G + c; if (L >= 512) return false;
        const int cs = L & 1, g = (L >> 1) & 3, tt = L >> 3;
        u.kt = 4; u.a = D1 + (size_t)cs * 256 * 256 * 2; u.b = proj + ((size_t)tt * 256 * INW + OFF_F + g * 256) * 2; u.pm = cs; u.pn = tt; u.z = g;
        if (tt < 32) { u.c = z1c + (((size_t)tt * 1024 + g * 256) * 512 + cs * 256) * 2; u.ldc = 512; }
        else { const int b = (tt - 32) >> 4, t0 = ((tt - 32) & 15) * 256; u.c = z1l + (((size_t)b * 1024 + g * 256) * 8192 + cs * 4096 + t0) * 2; u.ldc = 8192; }
        return true; }
};
struct Fft2LOrder {
    int G, c; const char* D2; const char* z1; char* mixed;
    __device__ bool next(int i, pg8::Unit& u) const { const int L = i * G + c; if (L >= 128) return false;
        const int nt = L & 3, mt = (L >> 2) & 15, b = L >> 6;
        u.kt = 128; u.a = D2 + (size_t)mt * 256 * 8192 * 2; u.b = z1 + ((size_t)b * 1024 + nt * 256) * 8192 * 2; u.pm = mt; u.pn = nt; u.z = b;
        u.c = mixed + (((size_t)NCTX + b * 4096 + mt * 256) * 1024 + nt * 256) * 2; u.ldc = 1024; return true; }
};
struct Fft2COrder {
    int G, c; const char* D2; const char* z1; char* mixed;
    __device__ bool next(int i, pg8::Unit& u) const { const int L = i * G + c; if (L >= 128) return false;
        const int nt = L & 3, b = L >> 2;
        u.kt = 8; u.a = D2; u.b = z1 + ((size_t)b * 1024 + nt * 256) * 512 * 2; u.pm = 0; u.pn = nt; u.z = b;
        u.c = mixed + (((size_t)b * 256) * 1024 + nt * 256) * 2; u.ldc = 1024; return true; }
};

__global__ void __launch_bounds__(NWAVES * 64, 2) hymba_fwd(Args args) {
    extern __shared__ __attribute__((aligned(16))) unsigned char lds_raw[];
    LAS unsigned char* lds = (LAS unsigned char*)lds_raw;
    volatile LAS unsigned* MISC = (volatile LAS unsigned*)(lds + MISC_OFF);
    const int G = gridDim.x, bx = blockIdx.x;
    const int wv = __builtin_amdgcn_readfirstlane(threadIdx.x >> 6);
#define TID_HERE() const int tid = tid_of(wv); const int lane = tid & 63, wave = __builtin_amdgcn_readfirstlane(tid >> 6), gw = bq * NWAVES + wave, NGWq = Gq * NWAVES; (void)lane; (void)gw; (void)NGWq
#define PH_IDS() int Gq = G, bq = bx; asm volatile("" : "+s"(Gq), "+s"(bq))
    for (int u = tid_of(wv); u < (LDS_BYTES - MISC_OFF) / 4; u += NWAVES * 64) ((LAS unsigned*)(lds + MISC_OFF))[u] = 0u;
    __syncthreads();
    int lo, hi; XcdBarrier bar;
    { KA_HERE(); PH_IDS(); lo = ka->ph_lo; hi = ka->ph_hi; unsigned* ctl = (unsigned*)(ka->ws + WS_CTL);
      bar.bar = ctl + CW_BAR; bar.x = 0; bar.st = nullptr;
      if (hi - lo > 1) bar = xcd_barrier_post(ctl + CW_BAR, MISC + 8, tid_of(wv)); }
#define IN(k) (lo <= (k) && (k) < hi)
#define SEAM(k) do { if (IN(k) && IN((k) + 1)) { xcd_barrier(bar, wv); if (((DUP_MASK) >> 12) & 1) xcd_barrier(bar, wv); } } while (0)

    if (IN(0)) DUP(0) { KA_HERE(); PH_IDS(); p0_prologue(ka, lds, Gq, bq, wv); }
    SEAM(0);

    for (int l = 0; l < DEPTH; ++l) for (int lrep_ = 0; lrep_ < 1 + (((DUP_MASK) >> 19) & 1); ++lrep_) {
        const int pb = 1 + 6 * l;
        if (IN(pb)) DUP(1) { KA_HERE(); PH_IDS(); TID_HERE(); pa_norm(ka, l, bq, Gq, tid, lds);
        }
        SEAM(pb);
        if (IN(pb + 1)) DUP(2) {
            KA_HERE(); PH_IDS(); unsigned char* ws = ka->ws;
            pg8::GemmOrder S; S.init(NTOK, INW, Gq, bq, ws + WS_H, DM, ws + WS_WIN + (size_t)l * INW * DM * 2, DM, DM);
            pg8::EpiProj E{(bf16*)(ws + WS_PROJ), (bf16*)(ws + WS_A2)};
            pg8::gemm_phase<pg8::EpiProj, pg8::GemmOrder, GEMM1_ALIGN>(lds, wv, DM, DM, S, E);
        }
        SEAM(pb + 1);
        if (IN(pb + 2)) {
            DUP(16) for (int un = bx; un < 256; un += G) { KA_HERE(); ssm_step1(ka, l, un, lds, wv); }
            DUP(14) { KA_HERE(); PH_IDS(); TID_HERE(); kv_prep(ka, l, gw, NGWq, lane); }
            wg_global_sync();
            DUP(17) { for (int un = bx; un < 256; un += G) { KA_HERE(); ssm_step2(ka, l, un, lds, wv); } __syncthreads(); }
            DUP(3) { KA_HERE(); PH_IDS(); unsigned char* ws = ka->ws;
              Fft1Order S{Gq, bq, (const char*)(ws + WS_D1), (const char*)(ws + WS_PROJ), (char*)(ws + WS_Z1L), (char*)(ws + WS_Z1C)};
              pg8::EpiBf16 E{1.0f}; pg8::gemm_phase<pg8::EpiBf16, Fft1Order>(lds, wv, 256, INW, S, E); }
            wg_global_sync();
            DUP(18) for (int un = bx; un < 256; un += G) { KA_HERE(); ssm_step3(ka, l, un, lds, wv); }
        }
        SEAM(pb + 2);
        if (IN(pb + 3)) {
            DUP(5) for (int U = bx; U < 512; U += G) {
                KA_HERE(); PH_IDS(); unsigned char* ws = ka->ws; bf16* const PROJ = (bf16*)(ws + WS_PROJ); bf16* const MIX = (bf16*)(ws + WS_MIX);
                const float* qn = ka->in[I_QN] + l * 128; const f32x2* rope = (const f32x2*)(ws + WS_ROPE);
                const int pr = U & 7, idx = U >> 3, b = pr >> 2, kvh = pr & 3, hq = kvh * 4 + (idx >> 4), qb = idx & 15;
                const size_t row0 = (size_t)NCTX + b * 4096 + qb * 256;
                const bf16* ck = (const bf16*)(ws + WS_CK) + ((size_t)(b * 4 + l) * 512) * 512 + kvh * 128;
                const bf16* cv = (const bf16*)(ws + WS_CV) + ((size_t)(b * 4 + l) * 512) * 512 + kvh * 128;
                const bf16* k1 = (const bf16*)(ws + WS_KC) + ((size_t)NCTX + b * 4096) * 512 + kvh * 128; const bf16* v1 = (const bf16*)(ws + WS_VC) + ((size_t)NCTX + b * 4096) * 512 + kvh * 128;
                att::attn_unit(PROJ + row0 * INW + hq * 128, PROJ + row0 * INW + OFF_GA + hq * 128, MIX + row0 * DM + hq * 128,
                               ck, cv, 512, 8, k1, v1, 512, 64, qn, rope, qb * 256, (char*)lds_raw, wv);
            }
            if (bx >= (G >> 1)) {
                const int nB = G - (G >> 1), cB = bx - (G >> 1);
                DUP(6) for (int U = cB; U < 512; U += nB) {
                    KA_HERE(); unsigned char* ws = ka->ws; bf16* const PROJ = (bf16*)(ws + WS_PROJ); bf16* const MIX = (bf16*)(ws + WS_MIX);
                    const float* qn = ka->in[I_QN] + l * 128;
                    const int xx = U & 7, idx = U >> 3, b = xx * 4 + (idx >> 4), hq = idx & 15, kvh = hq >> 2;
                    const size_t row0 = (size_t)b * 256;
                    const bf16* k1 = (const bf16*)(ws + WS_KC) + row0 * 512 + kvh * 128; const bf16* v1 = (const bf16*)(ws + WS_VC) + row0 * 512 + kvh * 128;
                    att::attn_unit(PROJ + row0 * INW + hq * 128, PROJ + row0 * INW + OFF_GA + hq * 128, MIX + row0 * DM + hq * 128,
                                   k1, v1, 512, 0, k1, v1, 512, 4, qn, nullptr, 0, (char*)lds_raw, wv);
                }
                __syncthreads();
                DUP(9) { KA_HERE(); unsigned char* ws = ka->ws; int nBq = nB, cBq = cB; asm volatile("" : "+s"(nBq), "+s"(cBq));
                  pg8::GemmOrder S; S.init(NTOK, 2048, nBq, cBq, ws + WS_YSSM, 1024, ws + WS_WGLU + (size_t)l * 2048 * 1024 * 2, 1024, 1024);
                  pg8::EpiGlu E{(const bf16*)(ws + WS_PROJ), (bf16*)(ws + WS_MIX)}; pg8::gemm_phase<pg8::EpiGlu, pg8::GemmOrder>(lds, wv, 1024, 1024, S, E); }
            } else {
                __syncthreads();
                DUP(7) { KA_HERE(); unsigned char* ws = ka->ws; int nAq = G >> 1, cAq = bx; asm volatile("" : "+s"(nAq), "+s"(cAq));
                  Fft2LOrder S{nAq, cAq, (const char*)(ws + WS_D2L), (const char*)(ws + WS_Z1L), (char*)(ws + WS_MIXED)};
                  pg8::EpiBf16 E{1.0f / 1024.0f}; pg8::gemm_phase<pg8::EpiBf16, Fft2LOrder>(lds, wv, 8192, 8192, S, E); }
                DUP(8) { KA_HERE(); unsigned char* ws = ka->ws; int nAq = G >> 1, cAq = bx; asm volatile("" : "+s"(nAq), "+s"(cAq));
                  Fft2COrder S{nAq, cAq, (const char*)(ws + WS_D2C), (const char*)(ws + WS_Z1C), (char*)(ws + WS_MIXED)};
                  pg8::EpiBf16 E{1.0f / 256.0f}; pg8::gemm_phase<pg8::EpiBf16, Fft2COrder>(lds, wv, 512, 512, S, E); }
            }
        }
        SEAM(pb + 3);
        if (IN(pb + 4)) {
            DUP(10) { KA_HERE(); PH_IDS(); unsigned char* ws = ka->ws;
              pg8::GemmOrder S; S.init(NTOK, 1024, Gq, bq, ws + WS_MIXED, 1024, ws + WS_WFFT + (size_t)l * 1024 * 1024 * 2, 1024, 1024);
              pg8::EpiFftW E{(const bf16*)(ws + WS_PROJ), (bf16*)(ws + WS_MIX)}; pg8::gemm_phase<pg8::EpiFftW, pg8::GemmOrder>(lds, wv, 1024, 1024, S, E); }
        }
        SEAM(pb + 4);
        if (IN(pb + 5)) DUP(11) {
            KA_HERE(); PH_IDS(); unsigned char* ws = ka->ws;
            pg8::GemmOrder S; S.init(NTOK, DM, Gq, bq, ws + WS_MIX, DM, ws + WS_WOUT + (size_t)l * DM * DM * 2, DM, DM);
            pg8::EpiOut E{(bf16*)(ws + ((l & 1) ? WS_DELTA2 : WS_DELTA)), (const float*)(ws + WS_MOD) + (size_t)l * 3 * 12288};
            if (((DUP_MASK) >> 13) & 1) {
                { pg8::SliceOrder<pg8::GemmOrder> S2{S, 0, 2}; pg8::gemm_phase<pg8::EpiOut, pg8::SliceOrder<pg8::GemmOrder>, GEMM1_ALIGN>(lds, wv, DM, DM, S2, E); }
                xcd_barrier(bar, wv);
                { pg8::SliceOrder<pg8::GemmOrder> S2{S, 2, 1000}; pg8::gemm_phase<pg8::EpiOut, pg8::SliceOrder<pg8::GemmOrder>, GEMM1_ALIGN>(lds, wv, DM, DM, S2, E); }
            } else
            pg8::gemm_phase<pg8::EpiOut, pg8::GemmOrder, GEMM1_ALIGN>(lds, wv, DM, DM, S, E);
        }
        SEAM(pb + 5);
    }
    if (IN(25)) DUP(15) { KA_HERE(); PH_IDS(); TID_HERE(); final_norm(ka, gw, NGWq, lane); }
#undef IN
#undef SEAM
}

extern "C" void kernel_launch(void* const* d_in, const int* in_sizes, int n_in, void* d_out, int out_size, void* d_ws, size_t ws_size, hipStream_t stream) {
    static int grid = 0;
    if (grid == 0) {
        if (n_in != 28 || ws_size < WS_END || out_size != 102760448) { fprintf(stderr, "kernel_launch: unexpected shapes (n_in %d, out %d, ws %zu)\n", n_in, out_size, ws_size); grid = -1; return; }
        int dev = 0, cus = 0, per_cu = 0;
        if (hipGetDevice(&dev) != hipSuccess || hipDeviceGetAttribute(&cus, hipDeviceAttributeMultiprocessorCount, dev) != hipSuccess) { grid = -1; return; }
        if (hipFuncSetAttribute((const void*)hymba_fwd, hipFuncAttributeMaxDynamicSharedMemorySize, LDS_BYTES) != hipSuccess) { fprintf(stderr, "kernel_launch: hipFuncSetAttribute failed\n"); grid = -1; return; }
        if (hipOccupancyMaxActiveBlocksPerMultiprocessor(&per_cu, (const void*)hymba_fwd, NWAVES * 64, LDS_BYTES) != hipSuccess || per_cu < 1)
            fprintf(stderr, "kernel_launch: occupancy query reports %d workgroups per CU\n", per_cu);
        (void)hipGetLastError();
        grid = cus;
    }
    if (grid < 0) return;
    (void)hipMemsetAsync((char*)d_ws + WS_CTL, 0, CTL_ZERO_BYTES, stream);
    Args a{};
    for (int i = 0; i < 28; ++i) a.in[i] = (const float*)d_in[i];
    a.out = (float*)d_out; a.ws = (unsigned char*)d_ws;
#if MK_ONE_LAUNCH == 2
    a.ph_lo = 0; a.ph_hi = 1;
    hipLaunchKernelGGL(hymba_fwd, dim3(grid), dim3(NWAVES * 64), LDS_BYTES, stream, a);
    a.ph_lo = 0; a.ph_hi = 26;
    hipLaunchKernelGGL(hymba_fwd, dim3(grid), dim3(NWAVES * 64), LDS_BYTES, stream, a);
#elif MK_ONE_LAUNCH
    a.ph_lo = 0; a.ph_hi = 26;
    hipLaunchKernelGGL(hymba_fwd, dim3(grid), dim3(NWAVES * 64), LDS_BYTES, stream, a);
#else
    for (int ph = 0; ph < 26; ++ph) { a.ph_lo = ph; a.ph_hi = ph + 1; hipLaunchKernelGGL(hymba_fwd, dim3(grid), dim3(NWAVES * 64), LDS_BYTES, stream, a); }
#endif
    const hipError_t le = hipPeekAtLastError();
    if (le != hipSuccess) fprintf(stderr, "kernel_launch: launch failed: %s\n", hipGetErrorName(le));
}
```

```cpp
#include <hip/hip_runtime.h>
#include <cstdio>
#include <cstdint>

#ifndef MK_ONE_LAUNCH
#define MK_ONE_LAUNCH 1
#endif

#ifndef GEMM1_ALIGN
#define GEMM1_ALIGN true
#endif
#ifndef DUP_MASK
#define DUP_MASK 0
#endif
#define DUP(k) for (int rep_ = 0; rep_ < (((DUP_MASK) >> (k)) & 1) + 1; ++rep_)
#define LAS __attribute__((address_space(3)))
#define GAS __attribute__((address_space(1)))
typedef unsigned short bf16;
typedef unsigned v4u __attribute__((ext_vector_type(4)));
typedef unsigned v2u __attribute__((ext_vector_type(2)));
typedef float f32x4 __attribute__((ext_vector_type(4)));
typedef float f32x2 __attribute__((ext_vector_type(2)));
typedef short bf16x8 __attribute__((ext_vector_type(8)));
typedef short s16x4 __attribute__((ext_vector_type(4)));
typedef float f32x16 __attribute__((ext_vector_type(16)));

constexpr int DM = 4096, NTOK = 16384, NCTX = 8192, DEPTH = 4, INW = 9216;
constexpr int OFF_K = 2048, OFF_V = 2560, OFF_GA = 3072, OFF_U = 5120, OFF_GS = 6144, OFF_F = 7168, OFF_GF = 8192;
constexpr float NORM_EPS = 1e-6f;
constexpr size_t OUT_NEWK = 67108864, OUT_NEWV = 83886080, OUT_FRE = 100663296, OUT_FIM = 101187584, OUT_BRE = 101711872, OUT_BIM = 102236160;

constexpr size_t MiB = 1u << 20;
constexpr size_t WS_CTL = 0, CTL_ZERO_BYTES = 1 * MiB;
constexpr size_t WS_MOD = 1 * MiB;
constexpr size_t WS_ROPE = 2 * MiB;
constexpr size_t WS_A16 = 3 * MiB;
constexpr size_t WS_D1 = 4 * MiB;
constexpr size_t WS_D2C = 5 * MiB;
constexpr size_t WS_CK = 6 * MiB;
constexpr size_t WS_CV = 10 * MiB;
constexpr size_t WS_PMAT = 14 * MiB;
constexpr size_t WS_KG = 46 * MiB;
constexpr size_t WS_D2L = 110 * MiB;
constexpr size_t WS_WGLU = 174 * MiB;
constexpr size_t WS_WFFT = 190 * MiB;
constexpr size_t WS_WOUT = 198 * MiB;
constexpr size_t WS_WIN = 326 * MiB;
constexpr size_t WS_H = 614 * MiB;
constexpr size_t WS_PROJ = 742 * MiB;
constexpr size_t WS_MIX = 1030 * MiB;
constexpr size_t WS_A2 = 1158 * MiB;
constexpr size_t WS_SBUF = 1222 * MiB;
constexpr size_t WS_YSSM = 1286 * MiB;
constexpr size_t WS_Z1L = 1318 * MiB;
constexpr size_t WS_Z1C = 1350 * MiB;
constexpr size_t WS_MIXED = 1382 * MiB;
constexpr size_t WS_DELTA = 1414 * MiB;
constexpr size_t WS_XBF = 1542 * MiB;
constexpr size_t WS_XBF2 = 1702 * MiB;
constexpr size_t WS_KC = 1670 * MiB;
constexpr size_t WS_VC = 1686 * MiB;
constexpr size_t WS_DELTA2 = 1830 * MiB;
constexpr size_t WS_END = 1958 * MiB;
constexpr int CW_BAR = 4096;

constexpr int LDS_BYTES = 147456;
constexpr int MISC_OFF = 143360;
constexpr int NWAVES = 8;

#define LDS_WAIT() asm volatile("s_waitcnt lgkmcnt(0)" ::: "memory")
#define VM_WAIT() asm volatile("s_waitcnt vmcnt(0)" ::: "memory")
#define RLX_AGENT __ATOMIC_RELAXED, __HIP_MEMORY_SCOPE_AGENT

__device__ __forceinline__ int tid_of(int wv) { int t = wv * 64 + (int)__builtin_amdgcn_mbcnt_hi(~0u, __builtin_amdgcn_mbcnt_lo(~0u, 0u)); asm volatile("" : "+v"(t)); return t; }
__device__ __forceinline__ unsigned cvt_pk_bf16(float lo, float hi) { unsigned r; asm volatile("v_cvt_pk_bf16_f32 %0, %1, %2" : "=v"(r) : "v"(lo), "v"(hi)); return r; }
__device__ __forceinline__ float bf_lo(unsigned w) { return __uint_as_float(w << 16); }
__device__ __forceinline__ float bf_hi(unsigned w) { return __uint_as_float(w & 0xffff0000u); }
__device__ __forceinline__ float silu_f(float x) { return x * __builtin_amdgcn_rcpf(1.0f + __expf(-x)); }
__device__ __forceinline__ float sigmoid_f(float x) { return __builtin_amdgcn_rcpf(1.0f + __expf(-x)); }
__device__ __forceinline__ float shflx(float v, int lane, int o) { return __int_as_float(__builtin_amdgcn_ds_bpermute((lane ^ o) << 2, __float_as_int(v))); }
__device__ __forceinline__ float wave_sum(float v, int lane) {
#pragma unroll
    for (int o = 1; o < 64; o <<= 1) v += shflx(v, lane, o);
    return v;
}

namespace pg8 {
constexpr int BM = 256, BK = 64, HALF = 128, HTB = HALF * BK * 2, STAGE_BYTES = 8 * HTB, NXCD = 8, WGM = 8;
__host__ __device__ __forceinline__ int lds_byte(int r, int c) { const int st = (r >> 4) * 2 + (c >> 5), rr = r & 15, cc = c & 31, ob = rr * 64 + cc * 2; return st * 1024 + (ob ^ (((ob >> 9) & 1) << 5)); }
__host__ __device__ __forceinline__ void stage_rc(int b, int& R, int& C) { const int st = b / 1024, sb = b % 1024, swz = sb ^ (((sb >> 9) & 1) << 5); R = (st >> 1) * 16 + swz / 64; C = (st & 1) * 32 + (swz % 64) / 2; }
__host__ __device__ __forceinline__ int perm32(int rho) { const int n = rho >> 4, i = rho & 15; return 8 * (i >> 2) + 4 * n + (i & 3); }

struct Unit { const char* a; const char* b; char* c; int ldc; int pm, pn, z, kt; };

struct GemmOrder {
    int nM, nN, nwg, G, c, kt; const char* A; const char* B; size_t atile, btile;
    __device__ void init(int M, int N, int G_, int c_, const void* A_, int lda, const void* B_, int ldb, int K) { kt = K / BK; nM = M / BM; nN = N / BM; nwg = nM * nN; G = G_; c = c_; A = (const char*)A_; B = (const char*)B_; atile = (size_t)BM * lda * 2; btile = (size_t)BM * ldb * 2; }
    __device__ bool next(int i, Unit& u) const {
        const long L = (long)i * G + c; if (L >= nwg) return false;
        int wgid = (int)L; const int xcd = wgid % NXCD; { const int q = nwg / NXCD, r = nwg % NXCD, off = wgid / NXCD; wgid = (xcd < r ? xcd * (q + 1) : r * (q + 1) + (xcd - r) * q) + off; }
        const int nig = WGM * nN, gid = wgid / nig, fm = gid * WGM, gsz = (nM - fm) < WGM ? (nM - fm) : WGM;
        u.pm = fm + ((wgid % nig) % gsz); u.pn = (wgid % nig) / gsz; u.z = 0; u.c = nullptr; u.ldc = 0; u.kt = kt;
        u.a = A + (size_t)u.pm * atile; u.b = B + (size_t)u.pn * btile; return true;
    }
};
template <class O> struct SliceOrder { O g; int i0, cnt; __device__ bool next(int i, Unit& u) const { if (i >= cnt) return false; return g.next(i0 + i, u); } };
struct OneUnit { Unit u0; __device__ bool next(int i, Unit& u) const { if (i != 0) return false; u = u0; return true; } };

template <class Epi, class Sched, bool ALIGN_EPI = true>
__device__ __forceinline__ void gemm_phase(LAS unsigned char* lds, const int wv, const int lda, const int ldb, const Sched& S, const Epi& E) {
    const int tid = tid_of(wv);
    const int wid = __builtin_amdgcn_readfirstlane(tid >> 6), lane = tid & 63, wr = wid >> 2, wc = wid & 3, fr = lane & 15, fq = lane >> 4;
    unsigned voffA[2], voffB[2];
#pragma unroll
    for (int i = 0; i < 2; ++i) { int R, C; stage_rc(tid * 16 + i * 8192, R, C); const int Rb = Epi::PERM ? ((R & ~31) + perm32(R & 31)) : R;
        voffA[i] = (unsigned)(R * lda + C) * 2u; voffB[i] = (unsigned)(Rb * ldb + C) * 2u; }
    (void)fr; (void)fq;
    const size_t kstep = (size_t)(BK * 2);
    const unsigned hstepA = (unsigned)HALF * lda * 2u, hstepB = (unsigned)HALF * ldb * 2u;
    const unsigned ldsw = (unsigned)wid * 1024u;
    const int aoff = lds_byte(wr * 64 + fr, fq * 8), boff = lds_byte(wc * 32 + fr, fq * 8);
#define PG8_SA(b, h) (((b) * 2 + (h)) * HTB)
#define PG8_SB(b, h) ((4 + (b) * 2 + (h)) * HTB)
#define PG8_STAGE(bufoff, gbase, voff) do { _Pragma("unroll") for (int _i = 0; _i < 2; ++_i) \
        __builtin_amdgcn_global_load_lds((const unsigned*)((const char*)(gbase) + (voff)[_i]), (LAS unsigned*)(lds + (bufoff) + ldsw + _i * 8192), 16, 0, 0); } while (0)
#define PG8_LDA(dst, b, h) do { _Pragma("unroll") for (int m = 0; m < 4; ++m) _Pragma("unroll") for (int k = 0; k < 2; ++k) dst[m][k] = *(const LAS bf16x8*)(lds + PG8_SA(b, h) + aoff + m * 2048 + k * 1024); } while (0)
#define PG8_LDB(dst, b, h) do { _Pragma("unroll") for (int n = 0; n < 2; ++n) _Pragma("unroll") for (int k = 0; k < 2; ++k) dst[n][k] = *(const LAS bf16x8*)(lds + PG8_SB(b, h) + boff + n * 2048 + k * 1024); } while (0)
#define PG8_MMA(ai, bj, At, Bt) do { __builtin_amdgcn_s_setprio(1); _Pragma("unroll") for (int m = 0; m < 4; ++m) _Pragma("unroll") for (int n = 0; n < 2; ++n) _Pragma("unroll") for (int k = 0; k < 2; ++k) \
        acc[ai][bj][m][n] = __builtin_amdgcn_mfma_f32_16x16x32_bf16(Bt[n][k], At[m][k], acc[ai][bj][m][n], 0, 0, 0); __builtin_amdgcn_s_setprio(0); } while (0)
#define PG8_WAIT_V(n) asm volatile("s_waitcnt vmcnt(" #n ")" ::: "memory")
#define PG8_WAIT_L(n) asm volatile("s_waitcnt lgkmcnt(" #n ")" ::: "memory")
#define PG8_BAR __builtin_amdgcn_s_barrier()
#define PG8_SCHED __builtin_amdgcn_sched_barrier(0)
    int ui = 0, nt;
    const char* cA; const char* cB;
    { Unit u0; if (!S.next(0, u0)) return; cA = u0.a; cB = u0.b; nt = u0.kt; }
    f32x4 acc[2][2][4][2];
#pragma unroll
    for (int a = 0; a < 2; ++a)
#pragma unroll
        for (int b = 0; b < 2; ++b)
#pragma unroll
            for (int m = 0; m < 4; ++m)
#pragma unroll
                for (int n = 0; n < 2; ++n) acc[a][b][m][n] = (f32x4){0.f, 0.f, 0.f, 0.f};
    bf16x8 At[4][2], B0[2][2], B1[2][2];
    PG8_STAGE(PG8_SB(0, 0), cB, voffB); PG8_STAGE(PG8_SB(0, 1), cB + hstepB, voffB); PG8_STAGE(PG8_SA(0, 0), cA, voffA); PG8_STAGE(PG8_SA(0, 1), cA + hstepA, voffA);
    if (wr == 1) PG8_BAR;
    PG8_WAIT_V(2); PG8_BAR;
    PG8_STAGE(PG8_SB(1, 0), cB + kstep, voffB); PG8_STAGE(PG8_SA(1, 0), cA + kstep, voffA); PG8_STAGE(PG8_SB(1, 1), cB + hstepB + kstep, voffB);
    PG8_WAIT_V(6); PG8_BAR;
    for (;;) {
        bool has_next; const char* nA; const char* nB; int nnt;
        { Unit nx; has_next = S.next(ui + 1, nx); nA = has_next ? nx.a : cA; nB = has_next ? nx.b : cB; nnt = has_next ? nx.kt : nt; }
        for (int t = 0; t < nt; t += 2) {
            const bool last = (t == nt - 2);
            const char* a1 = cA + (size_t)(t + 1) * kstep;
            const char* a2 = last ? nA : cA + (size_t)(t + 2) * kstep; const char* b2 = last ? nB : cB + (size_t)(t + 2) * kstep;
            const char* a3 = a2 + kstep; const char* b3 = b2 + kstep;
            PG8_LDB(B0, 0, 0); PG8_LDB(B1, 0, 1); PG8_SCHED; PG8_LDA(At, 0, 0); PG8_STAGE(PG8_SA(1, 1), a1 + hstepA, voffA);
            PG8_WAIT_V(8); PG8_WAIT_L(0); PG8_BAR; PG8_MMA(0, 0, At, B0); PG8_MMA(0, 1, At, B1); PG8_BAR; PG8_SCHED;
            PG8_LDA(At, 0, 1); PG8_STAGE(PG8_SB(0, 0), b2, voffB); PG8_STAGE(PG8_SB(0, 1), b2 + hstepB, voffB); PG8_STAGE(PG8_SA(0, 0), a2, voffA);
            PG8_WAIT_V(8); PG8_WAIT_L(0); PG8_BAR; PG8_MMA(1, 0, At, B0); PG8_MMA(1, 1, At, B1); PG8_BAR; PG8_SCHED;
            PG8_LDB(B0, 1, 0); PG8_LDB(B1, 1, 1); PG8_SCHED; PG8_LDA(At, 1, 0); PG8_STAGE(PG8_SA(0, 1), a2 + hstepA, voffA);
            PG8_WAIT_V(8); PG8_WAIT_L(0); PG8_BAR; PG8_MMA(0, 0, At, B0); PG8_MMA(0, 1, At, B1); PG8_BAR; PG8_SCHED;
            PG8_LDA(At, 1, 1); PG8_STAGE(PG8_SB(1, 0), b3, voffB); PG8_STAGE(PG8_SB(1, 1), b3 + hstepB, voffB); PG8_STAGE(PG8_SA(1, 0), a3, voffA);
            PG8_WAIT_V(8); PG8_WAIT_L(0); PG8_BAR; PG8_MMA(1, 0, At, B0); PG8_MMA(1, 1, At, B1); PG8_BAR; PG8_SCHED;
        }
        if constexpr (ALIGN_EPI) { if (wr == 0) PG8_BAR; }
        { Unit cu; (void)S.next(ui, cu); const int t2 = tid_of(wv);
          const int w2 = __builtin_amdgcn_readfirstlane(t2 >> 6); E(acc, cu, w2 >> 2, w2 & 3, t2 & 15, (t2 & 63) >> 4); }
        if (!has_next) break;
#pragma unroll
        for (int a = 0; a < 2; ++a)
#pragma unroll
            for (int b = 0; b < 2; ++b)
#pragma unroll
                for (int m = 0; m < 4; ++m)
#pragma unroll
                    for (int n = 0; n < 2; ++n) acc[a][b][m][n] = (f32x4){0.f, 0.f, 0.f, 0.f};
        cA = nA; cB = nB; nt = nnt; ++ui;
        if constexpr (ALIGN_EPI) { if (wr == 1) PG8_BAR; }
    }
    PG8_WAIT_V(0);
    if constexpr (!ALIGN_EPI) { if (wr == 0) PG8_BAR; }
    PG8_BAR;
#undef PG8_SA
#undef PG8_SB
#undef PG8_STAGE
#undef PG8_LDA
#undef PG8_LDB
#undef PG8_MMA
#undef PG8_WAIT_V
#undef PG8_WAIT_L
#undef PG8_BAR
#undef PG8_SCHED
}

struct EpiProj {
    static constexpr bool PERM = true;
    bf16* proj; bf16* a2;
    __device__ __forceinline__ void operator()(const f32x4 (&acc)[2][2][4][2], const Unit& u, int wr, int wc, int fr, int fq) const {
        const int pn = u.pn; const bool gate = (pn >= 12 && pn < 20) || (pn >= 24 && pn < 28) || (pn >= 32); const bool isu = (pn >= 20 && pn < 24);
        const int row0 = u.pm * BM + wr * 64 + fr, col0 = pn * BM + wc * 32 + 8 * fq;
#pragma unroll
        for (int ai = 0; ai < 2; ++ai)
#pragma unroll
            for (int m = 0; m < 4; ++m) { const int row = row0 + ai * HALF + m * 16;
#pragma unroll
                for (int bj = 0; bj < 2; ++bj) { f32x4 v0 = acc[ai][bj][m][0], v1 = acc[ai][bj][m][1];
                    if (gate) {
#pragma unroll
                        for (int j = 0; j < 4; ++j) { v0[j] = silu_f(v0[j]); v1[j] = silu_f(v1[j]); } }
                    v4u w; w.x = cvt_pk_bf16(v0[0], v0[1]); w.y = cvt_pk_bf16(v0[2], v0[3]); w.z = cvt_pk_bf16(v1[0], v1[1]); w.w = cvt_pk_bf16(v1[2], v1[3]);
                    const int col = col0 + bj * HALF;
                    bf16* dst;
                    if (isu) { const int g = (col - OFF_U) >> 4, c0 = col & 15; dst = a2 + ((size_t)(g * 1024 + (row >> 4)) * 512 + (row & 15) * 16 + c0); }
                    else dst = proj + (size_t)row * INW + col;
                    *(v4u*)dst = w; } }
    }
};
struct EpiBf16 {
    static constexpr bool PERM = true;
    float scale;
    __device__ __forceinline__ void operator()(const f32x4 (&acc)[2][2][4][2], const Unit& u, int wr, int wc, int fr, int fq) const {
        bf16* base = (bf16*)u.c; const int ldc = u.ldc; const int row0 = wr * 64 + fr, col0 = wc * 32 + 8 * fq;
#pragma unroll
        for (int ai = 0; ai < 2; ++ai)
#pragma unroll
            for (int m = 0; m < 4; ++m) { bf16* rowp = base + (size_t)(row0 + ai * HALF + m * 16) * ldc + col0;
#pragma unroll
                for (int bj = 0; bj < 2; ++bj) { const f32x4 v0 = acc[ai][bj][m][0] * scale, v1 = acc[ai][bj][m][1] * scale;
                    v4u w; w.x = cvt_pk_bf16(v0[0], v0[1]); w.y = cvt_pk_bf16(v0[2], v0[3]); w.z = cvt_pk_bf16(v1[0], v1[1]); w.w = cvt_pk_bf16(v1[2], v1[3]);
                    *(v4u*)(rowp + bj * HALF) = w; } }
    }
};
struct EpiF32 {
    static constexpr bool PERM = false;
    __device__ __forceinline__ void operator()(const f32x4 (&acc)[2][2][4][2], const Unit& u, int wr, int wc, int fr, int fq) const {
        float* base = (float*)u.c; const int ldc = u.ldc; const int row0 = wr * 64 + fr, col0 = wc * 32 + 4 * fq;
#pragma unroll
        for (int ai = 0; ai < 2; ++ai)
#pragma unroll
            for (int m = 0; m < 4; ++m) { float* rowp = base + (size_t)(row0 + ai * HALF + m * 16) * ldc + col0;
#pragma unroll
                for (int bj = 0; bj < 2; ++bj)
#pragma unroll
                    for (int n = 0; n < 2; ++n) *(f32x4*)(rowp + bj * HALF + n * 16) = acc[ai][bj][m][n]; }
    }
};
struct EpiSsmY {
    static constexpr bool PERM = true;
    bf16* yssm;
    __device__ __forceinline__ void operator()(const f32x4 (&acc)[2][2][4][2], const Unit& u, int wr, int wc, int fr, int fq) const {
        const int row0 = u.z + wr * 64 + fr, col0 = wc * 32 + 8 * fq, g = u.pn;
#pragma unroll
        for (int ai = 0; ai < 2; ++ai)
#pragma unroll
            for (int m = 0; m < 4; ++m) { const int chunk = row0 + ai * HALF + m * 16;
#pragma unroll
                for (int bj = 0; bj < 2; ++bj) { const f32x4 v0 = acc[ai][bj][m][0], v1 = acc[ai][bj][m][1];
                    v4u w; w.x = cvt_pk_bf16(v0[0], v0[1]); w.y = cvt_pk_bf16(v0[2], v0[3]); w.z = cvt_pk_bf16(v1[0], v1[1]); w.w = cvt_pk_bf16(v1[2], v1[3]);
                    const int col = col0 + bj * HALF, i = col >> 4, c0 = col & 15;
                    *(v4u*)(yssm + (size_t)(chunk * 16 + i) * 1024 + g * 16 + c0) = w; } }
    }
};
struct EpiGlu {
    static constexpr bool PERM = true;
    const bf16* proj; bf16* mix;
    __device__ __forceinline__ void operator()(const f32x4 (&acc)[2][2][4][2], const Unit& u, int wr, int wc, int fr, int fq) const {
        const int row0 = u.pm * BM + wr * 64 + fr, col0 = u.pn * HALF + wc * 32 + 8 * fq;
#pragma unroll
        for (int ai = 0; ai < 2; ++ai)
#pragma unroll
            for (int m = 0; m < 4; ++m) { const int row = row0 + ai * HALF + m * 16;
                const v4u gs = *(const v4u*)(proj + (size_t)row * INW + OFF_GS + col0);
                const f32x4 a0 = acc[ai][0][m][0], a1 = acc[ai][0][m][1], g0 = acc[ai][1][m][0], g1 = acc[ai][1][m][1];
                float o[8];
#pragma unroll
                for (int j = 0; j < 4; ++j) { o[j] = a0[j] * sigmoid_f(g0[j]); o[4 + j] = a1[j] * sigmoid_f(g1[j]); }
                o[0] *= bf_lo(gs.x); o[1] *= bf_hi(gs.x); o[2] *= bf_lo(gs.y); o[3] *= bf_hi(gs.y); o[4] *= bf_lo(gs.z); o[5] *= bf_hi(gs.z); o[6] *= bf_lo(gs.w); o[7] *= bf_hi(gs.w);
                v4u w; w.x = cvt_pk_bf16(o[0], o[1]); w.y = cvt_pk_bf16(o[2], o[3]); w.z = cvt_pk_bf16(o[4], o[5]); w.w = cvt_pk_bf16(o[6], o[7]);
                *(v4u*)(mix + (size_t)row * DM + 2048 + col0) = w; }
    }
};
struct EpiFftW {
    static constexpr bool PERM = true;
    const bf16* proj; bf16* mix;
    __device__ __forceinline__ void operator()(const f32x4 (&acc)[2][2][4][2], const Unit& u, int wr, int wc, int fr, int fq) const {
        const int row0 = u.pm * BM + wr * 64 + fr, col0 = u.pn * BM + wc * 32 + 8 * fq;
#pragma unroll
        for (int ai = 0; ai < 2; ++ai)
#pragma unroll
            for (int m = 0; m < 4; ++m) { const int row = row0 + ai * HALF + m * 16;
#pragma unroll
                for (int bj = 0; bj < 2; ++bj) { const int col = col0 + bj * HALF;
                    const v4u gs = *(const v4u*)(proj + (size_t)row * INW + OFF_GF + col);
                    const f32x4 v0 = acc[ai][bj][m][0], v1 = acc[ai][bj][m][1];
                    v4u w; w.x = cvt_pk_bf16(v0[0] * bf_lo(gs.x), v0[1] * bf_hi(gs.x)); w.y = cvt_pk_bf16(v0[2] * bf_lo(gs.y), v0[3] * bf_hi(gs.y));
                    w.z = cvt_pk_bf16(v1[0] * bf_lo(gs.z), v1[1] * bf_hi(gs.z)); w.w = cvt_pk_bf16(v1[2] * bf_lo(gs.w), v1[3] * bf_hi(gs.w));
                    *(v4u*)(mix + (size_t)row * DM + 3072 + col) = w; } }
    }
};
struct EpiOut {
    static constexpr bool PERM = true;
    bf16* delta; const float* modl;
    __device__ __forceinline__ void operator()(const f32x4 (&acc)[2][2][4][2], const Unit& u, int wr, int wc, int fr, int fq) const {
        const int rt = u.pm * BM; const int v = rt < NCTX ? 0 : (rt < NCTX + 4096 ? 1 : 2);
        const float* gv = modl + v * 12288 + 8192;
        const int row0 = rt + wr * 64 + fr, col0 = u.pn * BM + wc * 32 + 8 * fq;
        f32x4 gt[2][2];
#pragma unroll
        for (int bj = 0; bj < 2; ++bj)
#pragma unroll
            for (int n = 0; n < 2; ++n) gt[bj][n] = *(const f32x4*)(gv + col0 + bj * HALF + n * 4);
#pragma unroll
        for (int ai = 0; ai < 2; ++ai)
#pragma unroll
            for (int m = 0; m < 4; ++m) { bf16* rowp = delta + (size_t)(row0 + ai * HALF + m * 16) * DM + col0;
#pragma unroll
                for (int bj = 0; bj < 2; ++bj) { const f32x4 v0 = acc[ai][bj][m][0] * gt[bj][0], v1 = acc[ai][bj][m][1] * gt[bj][1];
                    v4u w; w.x = cvt_pk_bf16(v0[0], v0[1]); w.y = cvt_pk_bf16(v0[2], v0[3]); w.z = cvt_pk_bf16(v1[0], v1[1]); w.w = cvt_pk_bf16(v1[2], v1[3]);
                    *(v4u*)(rowp + bj * HALF) = w; } }
    }
};
}

namespace att {
constexpr int D = 128, QBLK = 32, KVBLK = 64;
constexpr float SCALE = 0.088388347648318440f;
constexpr float THR = 8.f;
constexpr int SHM_V = KVBLK * D * 2, SHM_K = KVBLK * D * 2;
constexpr int WS_OFF = 2 * SHM_V + 2 * SHM_K, OSTG_OFF = WS_OFF + NWAVES * 64 * 4, OSTG_ROW = 272, OSTG_WAVE = 32 * OSTG_ROW;
static_assert(DEPTH >= 2, "the bf16 stream is first written by layer 1's norm phase");
static_assert(OSTG_OFF + NWAVES * OSTG_WAVE <= MISC_OFF, "attention LDS");
#define KSWZ(row, colB) ((row) * 256 + ((colB) ^ (((row) & 7) << 4)))
#define SBAR() __builtin_amdgcn_sched_barrier(0)
__device__ __forceinline__ int crow(int r, int hi) { return (r & 3) + 8 * (r >> 2) + 4 * hi; }
__device__ __forceinline__ void partialSM(f32x16& p0, f32x16& p1, float& m_reg, float& mn, float& alpha) {
  constexpr float C = SCALE * 1.4426950408889634f;
  float pmax = p0[0]; for (int r = 1; r < 16; ++r) pmax = fmaxf(pmax, p0[r]); for (int r = 0; r < 16; ++r) pmax = fmaxf(pmax, p1[r]);
  { auto rr = __builtin_amdgcn_permlane32_swap(__float_as_uint(pmax), __float_as_uint(pmax), false, false);
    pmax = fmaxf(__uint_as_float(rr[0]), __uint_as_float(rr[1])); }
  if (__builtin_expect(__all(pmax - m_reg <= THR / SCALE), 1)) { mn = m_reg; alpha = 1.f; }
  else { mn = fmaxf(m_reg, pmax); alpha = __builtin_amdgcn_exp2f((m_reg - mn) * C); m_reg = mn; }
  float mnC = -mn * C;
  for (int r = 0; r < 16; ++r) p0[r] = fmaf(p0[r], C, mnC); for (int r = 0; r < 16; ++r) p1[r] = fmaf(p1[r], C, mnC);
  for (int r = 0; r < 16; ++r) p0[r] = __builtin_amdgcn_exp2f(p0[r]);
}
__device__ __forceinline__ void finishSM(f32x16& p0, f32x16& p1, float alpha, float& l_reg, bf16x8& pa0, bf16x8& pa1, bf16x8& pa2, bf16x8& pa3) {
  for (int r = 0; r < 16; ++r) p1[r] = __builtin_amdgcn_exp2f(p1[r]);
  float ps = 0; for (int r = 0; r < 16; ++r) ps += p0[r]; for (int r = 0; r < 16; ++r) ps += p1[r];
  { auto rr = __builtin_amdgcn_permlane32_swap(__float_as_uint(ps), __float_as_uint(ps), false, false);
    ps = __uint_as_float(rr[0]) + __uint_as_float(rr[1]); }
  l_reg = l_reg * alpha + ps;
#define PK4(P, BASE, OUT) do { unsigned a0 = cvt_pk_bf16(P[BASE + 0], P[BASE + 1]), a1 = cvt_pk_bf16(P[BASE + 2], P[BASE + 3]);   \
    unsigned b0 = cvt_pk_bf16(P[BASE + 4], P[BASE + 5]), b1 = cvt_pk_bf16(P[BASE + 6], P[BASE + 7]);                              \
    auto r0 = __builtin_amdgcn_permlane32_swap(a0, b0, false, false); auto r1 = __builtin_amdgcn_permlane32_swap(a1, b1, false, false); \
    v4u w = {r0[0], r1[0], r0[1], r1[1]}; OUT = *reinterpret_cast<bf16x8*>(&w); } while (0)
  PK4(p0, 0, pa0); PK4(p0, 8, pa1); PK4(p1, 0, pa2); PK4(p1, 8, pa3);
#undef PK4
}
__device__ __forceinline__ void qkt(f32x16& p0, f32x16& p1, const char* Ks, const bf16x8* qr, int r32, int hi) {
  p0 = f32x16{}; p1 = f32x16{};
  for (int d0 = 0; d0 < 8; ++d0) { int cb = (d0 * 16 + hi * 8) * 2;
    bf16x8 b0 = *reinterpret_cast<const bf16x8*>(Ks + KSWZ(r32, cb));
    bf16x8 b1 = *reinterpret_cast<const bf16x8*>(Ks + KSWZ(32 + r32, cb));
    p0 = __builtin_amdgcn_mfma_f32_32x32x16_bf16(b0, qr[d0], p0, 0, 0, 0);
    p1 = __builtin_amdgcn_mfma_f32_32x32x16_bf16(b1, qr[d0], p1, 0, 0, 0); }
}
__device__ __forceinline__ int v_st(int k, int c) { const int kk = (k & ~0xC) | ((k & 4) << 1) | ((k & 8) >> 1); return ((kk >> 3) * 4 + (c >> 5)) * 512 + ((kk & 7) * 32 + (c & 31)) * 2; }
__device__ __forceinline__ int v_rd_base(int lane) { return ((lane & 3) << 3) | (((lane >> 2) & 3) << 6) | (((lane >> 4) & 1) << 5) | (((lane >> 5) & 1) << 8); }
constexpr int v_rd_off(int d0, int ks, int half) { return d0 * 512 + ks * 4096 + half * 2048; }
template <int OFF> __device__ __forceinline__ s16x4 tr_read(int vb) {
  s16x4 r; asm volatile("ds_read_b64_tr_b16 %0, %1 offset:%2" : "=&v"(r) : "v"(vb), "i"(OFF) : "memory"); return r;
}
template <int D0> __device__ __forceinline__ void pv_one(f32x16& od, int vb, bf16x8 pa0, bf16x8 pa1, bf16x8 pa2, bf16x8 pa3) {
  const s16x4 l0 = tr_read<v_rd_off(D0, 0, 0)>(vb), h0 = tr_read<v_rd_off(D0, 0, 1)>(vb), l1 = tr_read<v_rd_off(D0, 1, 0)>(vb), h1 = tr_read<v_rd_off(D0, 1, 1)>(vb);
  const s16x4 l2 = tr_read<v_rd_off(D0, 2, 0)>(vb), h2 = tr_read<v_rd_off(D0, 2, 1)>(vb), l3 = tr_read<v_rd_off(D0, 3, 0)>(vb), h3 = tr_read<v_rd_off(D0, 3, 1)>(vb);
  asm volatile("s_waitcnt lgkmcnt(0)" ::: "memory"); SBAR();
#define PK(L, H) (bf16x8){L[0], L[1], L[2], L[3], H[0], H[1], H[2], H[3]}
  od = __builtin_amdgcn_mfma_f32_32x32x16_bf16(pa0, PK(l0, h0), od, 0, 0, 0);
  od = __builtin_amdgcn_mfma_f32_32x32x16_bf16(pa1, PK(l1, h1), od, 0, 0, 0);
  od = __builtin_amdgcn_mfma_f32_32x32x16_bf16(pa2, PK(l2, h2), od, 0, 0, 0);
  od = __builtin_amdgcn_mfma_f32_32x32x16_bf16(pa3, PK(l3, h3), od, 0, 0, 0);
#undef PK
}
__device__ __forceinline__ void pv_d0(f32x16* o, int vb, bf16x8 pa0, bf16x8 pa1, bf16x8 pa2, bf16x8 pa3) {
  pv_one<0>(o[0], vb, pa0, pa1, pa2, pa3); pv_one<1>(o[1], vb, pa0, pa1, pa2, pa3); pv_one<2>(o[2], vb, pa0, pa1, pa2, pa3); pv_one<3>(o[3], vb, pa0, pa1, pa2, pa3);
}

__device__ __forceinline__ void attn_unit(const bf16* __restrict__ Qb, const bf16* __restrict__ Gb, bf16* __restrict__ Ob,
                                          const bf16* __restrict__ K0, const bf16* __restrict__ V0, int ld0, int nt0,
                                          const bf16* __restrict__ K1, const bf16* __restrict__ V1, int ld1, int nt1,
                                          const float* __restrict__ qn, const f32x2* __restrict__ rope, int tok0, char* lds, int wv) {
  const int tid = tid_of(wv);
  const int wid = tid >> 6, lane = tid & 63, r32 = lane & 31, hi = lane >> 5;
  char* V_lds = lds; char* K_lds = lds + 2 * SHM_V;
  float* ws = (float*)(lds + WS_OFF) + wid * 64; float* li_l = ws; float* al_l = ws + 32;
  float m_reg = -1e30f, l_reg = 0; f32x16 o[4] = {}; bf16x8 qr[8];
  const int sr = tid >> 4, sc = (tid & 15) * 8, vst0 = v_st(sr, sc), vst1 = v_st(32 + sr, sc);
  const int vb0 = (int)(uintptr_t)V_lds + v_rd_base(lane);
  struct { bf16x8 vs0, vs1, ks0, ks1; } sr_[2];
#define SLOAD(i, jt) do { const bf16* kb_; const bf16* vb_; long ld_; \
    if ((jt) < nt0) { kb_ = K0 + (long)(jt) * KVBLK * ld0; vb_ = V0 + (long)(jt) * KVBLK * ld0; ld_ = ld0; } else { kb_ = K1 + (long)((jt) - nt0) * KVBLK * ld1; vb_ = V1 + (long)((jt) - nt0) * KVBLK * ld1; ld_ = ld1; } \
    sr_[i].vs0 = *reinterpret_cast<const bf16x8*>(vb_ + (long)sr * ld_ + sc); sr_[i].vs1 = *reinterpret_cast<const bf16x8*>(vb_ + (long)(32 + sr) * ld_ + sc); \
    sr_[i].ks0 = *reinterpret_cast<const bf16x8*>(kb_ + (long)sr * ld_ + sc); sr_[i].ks1 = *reinterpret_cast<const bf16x8*>(kb_ + (long)(32 + sr) * ld_ + sc); } while (0)
  SLOAD(0, 0);
  __syncthreads();
  {
    const bf16* Qw = Qb + (long)(wid * QBLK + r32) * INW + hi * 8;
    float x[8][8]; float ss = 0.f;
#pragma unroll
    for (int d0 = 0; d0 < 8; ++d0) { const v4u raw = *reinterpret_cast<const v4u*>(Qw + d0 * 16);
      x[d0][0] = bf_lo(raw.x); x[d0][1] = bf_hi(raw.x); x[d0][2] = bf_lo(raw.y); x[d0][3] = bf_hi(raw.y); x[d0][4] = bf_lo(raw.z); x[d0][5] = bf_hi(raw.z); x[d0][6] = bf_lo(raw.w); x[d0][7] = bf_hi(raw.w);
#pragma unroll
      for (int j = 0; j < 8; ++j) ss += x[d0][j] * x[d0][j]; }
    { auto rr = __builtin_amdgcn_permlane32_swap(__float_as_uint(ss), __float_as_uint(ss), false, false); ss = __uint_as_float(rr[0]) + __uint_as_float(rr[1]); }
    const float rstd = rsqrtf(ss * (1.0f / 128.0f) + NORM_EPS);
#pragma unroll
    for (int d0 = 0; d0 < 8; ++d0) { const f32x4 w0 = *reinterpret_cast<const f32x4*>(qn + d0 * 16 + hi * 8), w1 = *reinterpret_cast<const f32x4*>(qn + d0 * 16 + hi * 8 + 4);
#pragma unroll
      for (int j = 0; j < 4; ++j) { x[d0][j] *= rstd * w0[j]; x[d0][4 + j] *= rstd * w1[j]; } }
    if (rope) {
      const int t = tok0 + wid * QBLK + r32, prow = t >> 6, pcol = t & 63;
#pragma unroll
      for (int half = 0; half < 2; ++half) { const f32x2* rp = rope + (half ? pcol : prow) * 32;
#pragma unroll
        for (int dd = 0; dd < 2; ++dd) { const int d0 = half * 4 + dd;
#pragma unroll
          for (int j = 0; j < 8; ++j) { const f32x2 cs = rp[dd * 16 + hi * 8 + j]; const float x1 = x[d0][j], x2 = x[d0 + 2][j];
            x[d0][j] = x1 * cs.x - x2 * cs.y; x[d0 + 2][j] = x1 * cs.y + x2 * cs.x; } } }
    }
#pragma unroll
    for (int d0 = 0; d0 < 8; ++d0) { v4u w = {cvt_pk_bf16(x[d0][0], x[d0][1]), cvt_pk_bf16(x[d0][2], x[d0][3]), cvt_pk_bf16(x[d0][4], x[d0][5]), cvt_pk_bf16(x[d0][6], x[d0][7])}; qr[d0] = *reinterpret_cast<bf16x8*>(&w); }
  }
#define SWRITE(b, i) do { *(bf16x8*)(V_lds + (b) * SHM_V + vst0) = sr_[i].vs0;          \
    *(bf16x8*)(V_lds + (b) * SHM_V + vst1) = sr_[i].vs1; int kc = sc * 2;               \
    *(bf16x8*)(K_lds + (b) * SHM_K + KSWZ(sr, kc)) = sr_[i].ks0;                       \
    *(bf16x8*)(K_lds + (b) * SHM_K + KSWZ(32 + sr, kc)) = sr_[i].ks1; } while (0)
#define SWAIT() asm volatile("s_waitcnt vmcnt(4)" ::: "memory")
#define RESC(a) do { if (__any((a) < 1.f)) { if (hi == 0) al_l[r32] = (a); asm volatile("s_waitcnt lgkmcnt(0)" ::: "memory"); \
    for (int d = 0; d < 4; ++d) for (int r = 0; r < 16; ++r) o[d][r] *= al_l[crow(r, hi)]; } } while (0)
  f32x16 pA0, pA1, pB0, pB1; float mnA, mnB, alA, alB; bf16x8 pa0, pa1, pa2, pa3; const int NT = nt0 + nt1;
  constexpr int SE = 0, SO = 1;
  asm volatile("s_waitcnt vmcnt(0)" ::: "memory"); SWRITE(0, SE); __syncthreads();
  qkt(pA0, pA1, K_lds, qr, r32, hi); partialSM(pA0, pA1, m_reg, mnA, alA);
  SLOAD(SO, 1); if (2 < NT) SLOAD(SE, 2);
  SWAIT(); SWRITE(1, SO); __syncthreads();
  for (int j = 1; j + 1 < NT; j += 2) {
    SBAR(); qkt(pB0, pB1, K_lds + SHM_K, qr, r32, hi);
    finishSM(pA0, pA1, alA, l_reg, pa0, pa1, pa2, pa3); SBAR();
    SLOAD(SO, j + 2); SBAR();
    pv_d0(o, vb0, pa0, pa1, pa2, pa3); partialSM(pB0, pB1, m_reg, mnB, alB);
    __syncthreads(); SWAIT(); SWRITE(0, SE);
    RESC(alB); __syncthreads();
    SBAR(); qkt(pA0, pA1, K_lds, qr, r32, hi);
    finishSM(pB0, pB1, alB, l_reg, pa0, pa1, pa2, pa3); SBAR();
    if (j + 3 < NT) SLOAD(SE, j + 3); SBAR();
    pv_d0(o, vb0 + SHM_V, pa0, pa1, pa2, pa3); partialSM(pA0, pA1, m_reg, mnA, alA);
    __syncthreads(); SWAIT(); SWRITE(1, SO);
    RESC(alA); __syncthreads();
  }
  SBAR(); qkt(pB0, pB1, K_lds + SHM_K, qr, r32, hi);
  finishSM(pA0, pA1, alA, l_reg, pa0, pa1, pa2, pa3); SBAR();
  pv_d0(o, vb0, pa0, pa1, pa2, pa3); partialSM(pB0, pB1, m_reg, mnB, alB);
  __syncthreads(); RESC(alB);
  finishSM(pB0, pB1, alB, l_reg, pa0, pa1, pa2, pa3); SBAR();
  pv_d0(o, vb0 + SHM_V, pa0, pa1, pa2, pa3);
  if (hi == 0) li_l[r32] = l_reg; asm volatile("s_waitcnt lgkmcnt(0)" ::: "memory");
  char* stg = lds + OSTG_OFF + wid * OSTG_WAVE;
  v4u gvv[8];
#pragma unroll
  for (int it = 0; it < 8; ++it) gvv[it] = *reinterpret_cast<const v4u*>(Gb + (long)(wid * QBLK + it * 4 + (lane >> 4)) * INW + (lane & 15) * 8);
#pragma unroll
  for (int r = 0; r < 16; ++r) { const int orow = crow(r, hi); const float rl = __builtin_amdgcn_rcpf(li_l[orow]);
#pragma unroll
    for (int d0 = 0; d0 < 4; ++d0) { const unsigned w = cvt_pk_bf16(o[d0][r] * rl, 0.f); *(bf16*)(stg + orow * OSTG_ROW + (d0 * 32 + r32) * 2) = (bf16)(w & 0xffffu); }
    if ((r & 3) == 3) asm volatile("" ::: "memory"); }
  asm volatile("s_waitcnt lgkmcnt(0)" ::: "memory");
#pragma unroll
  for (int it = 0; it < 8; ++it) { const int row = it * 4 + (lane >> 4), cc = (lane & 15) * 8;
    const v4u ov = *(const v4u*)(stg + row * OSTG_ROW + cc * 2);
    const v4u gv = gvv[it];
    v4u w; w.x = cvt_pk_bf16(bf_lo(ov.x) * bf_lo(gv.x), bf_hi(ov.x) * bf_hi(gv.x)); w.y = cvt_pk_bf16(bf_lo(ov.y) * bf_lo(gv.y), bf_hi(ov.y) * bf_hi(gv.y));
    w.z = cvt_pk_bf16(bf_lo(ov.z) * bf_lo(gv.z), bf_hi(ov.z) * bf_hi(gv.z)); w.w = cvt_pk_bf16(bf_lo(ov.w) * bf_lo(gv.w), bf_hi(ov.w) * bf_hi(gv.w));
    *reinterpret_cast<v4u*>(Ob + (long)(wid * QBLK + row) * DM + cc) = w; }
#undef SLOAD
#undef SWRITE
#undef SWAIT
#undef RESC
}
}

#define XB_TMO      128
#define XB_XCNT(j)  (256  + 64 * (j))
#define XB_XSUB(j)  (1280 + 64 * (j))
#define XB_XGEN(j)  (2304 + 64 * (j))
#define XB_TOP      3328
#define XB_TOPGEN   3392
#define XCD_BAR_WORDS 3456
#define XB_SPIN_CAP (1u << 18)
__device__ __forceinline__ unsigned xb_ld(unsigned* p)              { return __hip_atomic_load(p, __ATOMIC_RELAXED, __HIP_MEMORY_SCOPE_AGENT); }
__device__ __forceinline__ unsigned xb_add(unsigned* p, unsigned v) { return __hip_atomic_fetch_add(p, v, __ATOMIC_RELAXED, __HIP_MEMORY_SCOPE_AGENT); }
__device__ __forceinline__ unsigned xb_xcc_id() { return (unsigned)__builtin_amdgcn_s_getreg((3 << 11) | 20) & 0xFu; }
#define XB_SPIN(cond, bar) do { unsigned _sp = 0; while (cond) { __builtin_amdgcn_s_sleep(1); \
    if ((++_sp & 255u) == 0u) { if (xb_ld(&(bar)[XB_TMO])) break; if (_sp > XB_SPIN_CAP) { atomicAdd(&(bar)[XB_TMO], 1u); break; } } } } while (0)
struct XcdBarrier { unsigned* bar; unsigned x; volatile LAS unsigned* st; };
__device__ __forceinline__ XcdBarrier xcd_barrier_post(unsigned* bar, volatile LAS unsigned* st, int tid) {
    XcdBarrier b; b.bar = bar; b.x = xb_xcc_id(); b.st = st;
    if (tid == 0) (void)xb_add(&bar[XB_XCNT(b.x)], 1u);
    return b;
}
__device__ __forceinline__ void xcd_barrier_complete(unsigned* bar, unsigned x, unsigned& nloc, unsigned& nx) {
    const unsigned G = gridDim.x * gridDim.y * gridDim.z;
    unsigned sum, cnt, mine, sp = 0u;
    for (;;) {
        sum = 0u; cnt = 0u; mine = 0u;
#pragma nounroll
        for (unsigned j = 0; j < 16; ++j) { const unsigned c = xb_ld(&bar[XB_XCNT(j)]); sum += c; cnt += (c > 0u) ? 1u : 0u; mine = (j == x) ? c : mine; }
        if (sum == G) break;
        __builtin_amdgcn_s_sleep(1);
        if ((++sp & 255u) == 0u) { if (xb_ld(&bar[XB_TMO])) break; if (sp > XB_SPIN_CAP) { atomicAdd(&bar[XB_TMO], 1u); break; } }
    }
    nloc = mine > 0u ? mine : 1u; nx = cnt > 0u ? cnt : 1u;
}
__device__ __forceinline__ void xcd_barrier(const XcdBarrier& b, int wv) {
    asm volatile("s_waitcnt vmcnt(0)" ::: "memory");
    __syncthreads();
    if (tid_of(wv) == 0) {
        unsigned* bar = b.bar;
        __builtin_amdgcn_s_waitcnt(0);
        unsigned nloc = b.st[0], nx = b.st[1];
        if (nloc == 0u) { xcd_barrier_complete(bar, b.x, nloc, nx); b.st[0] = nloc; b.st[1] = nx; }
        const unsigned old = xb_add(&bar[XB_XSUB(b.x)], 1u);
        const unsigned gen = old / nloc;
        if (old + 1u == (gen + 1u) * nloc) {
            __builtin_amdgcn_fence(__ATOMIC_RELEASE, "agent");
            asm volatile("s_waitcnt vmcnt(0)" ::: "memory");
            const unsigned og = xb_add(&bar[XB_TOP], 1u);
            const unsigned tg = og / nx;
            if (og + 1u == (tg + 1u) * nx) xb_add(&bar[XB_TOPGEN], 1u);
            else XB_SPIN(xb_ld(&bar[XB_TOPGEN]) == tg, bar);
            __builtin_amdgcn_fence(__ATOMIC_ACQUIRE, "agent");
            xb_add(&bar[XB_XGEN(b.x)], 1u);
            asm volatile("s_waitcnt vmcnt(0)" ::: "memory");
        } else {
            XB_SPIN(xb_ld(&bar[XB_XGEN(b.x)]) == gen, bar);
            __builtin_amdgcn_fence(__ATOMIC_ACQUIRE, "agent");
            asm volatile("s_waitcnt vmcnt(0)" ::: "memory");
        }
    }
    __syncthreads();
}
__device__ __forceinline__ void wg_global_sync() {
    asm volatile("s_waitcnt vmcnt(0)" ::: "memory");
    __syncthreads();
    __builtin_amdgcn_fence(__ATOMIC_ACQUIRE, "agent");
    asm volatile("s_waitcnt vmcnt(0)" ::: "memory");
}

struct Args { const float* in[28]; float* out; unsigned char* ws; int ph_lo, ph_hi; };
typedef const __attribute__((address_space(4))) Args* KAP;
#define KA_HERE() KAP ka = (KAP)__builtin_amdgcn_kernarg_segment_ptr(); asm volatile("" : "+s"(ka))
enum { I_XP = 0, I_XS, I_CK, I_CV, I_SFR, I_SFI, I_SBR, I_SBI, I_C, I_CCTX, I_NG, I_WMOD, I_BMOD, I_WIN, I_QN, I_KN, I_LRE, I_LIM, I_LSTEP, I_BRE, I_BIM, I_CRE, I_CIM, I_DSKIP, I_WGLU, I_WFFT, I_WOUT, I_FNG };

__device__ __forceinline__ int glu_row(int n) { return n < 1024 ? ((n >> 7) * 256 + (n & 127)) : (((n - 1024) >> 7) * 256 + 128 + ((n - 1024) & 127)); }
template <bool GLU>
__device__ __forceinline__ void tr_item(const float* __restrict__ W, int K, int N, bf16* __restrict__ WT, LAS float* scr, int item, int lane) {
    const int nblk = N / 64, kb = item / nblk, nb = item % nblk, k0 = 64 * kb, n0 = 64 * nb;
#pragma unroll 8
    for (int i = 0; i < 64; ++i) scr[i * 65 + lane] = W[(size_t)(k0 + i) * N + n0 + lane];
    LDS_WAIT(); asm volatile("" ::: "memory");
    const int c = lane & 7;
#pragma unroll
    for (int j = 0; j < 8; ++j) { const int n = (lane >> 3) + 8 * j; const LAS float* s = scr + (8 * c) * 65 + n;
        v4u o; o.x = cvt_pk_bf16(s[0 * 65], s[1 * 65]); o.y = cvt_pk_bf16(s[2 * 65], s[3 * 65]); o.z = cvt_pk_bf16(s[4 * 65], s[5 * 65]); o.w = cvt_pk_bf16(s[6 * 65], s[7 * 65]);
        int nd = n0 + n; if (GLU) nd = glu_row(nd);
        *(v4u*)(WT + (size_t)nd * K + k0 + 8 * c) = o; }
    LDS_WAIT(); asm volatile("" ::: "memory");
}

__device__ __forceinline__ void ssm_matrices(KAP A, int l, int g, LAS unsigned char* lds, int tid) {
    LAS f32x2* pw = (LAS f32x2*)lds;
    LAS f32x2* bb = pw + 2 * 17 * 64;
    LAS f32x2* cc = bb + 2 * 64 * 16;
    LAS float* kk = (LAS float*)(cc + 2 * 16 * 64);
    if (tid < 128) {
        const int dir = tid >> 6, p = tid & 63, ig = (l * 2 + dir) * 64 + g;
        const float dt = expf(A->in[I_LSTEP][ig]);
        const float lr = A->in[I_LRE][(size_t)ig * 64 + p], li = A->in[I_LIM][(size_t)ig * 64 + p];
        for (int tau = 0; tau <= 16; ++tau) {
            const float mag = expf(lr * dt * (float)tau);
            const double turns = (double)li * (double)dt * (double)tau * 0.15915494309189535;
            const float fr = (float)(turns - rint(turns));
            pw[(dir * 17 + tau) * 64 + p] = (f32x2){mag * cospif(2.f * fr), mag * sinpif(2.f * fr)};
        }
        const f32x2 ab = pw[(dir * 17 + 1) * 64 + p];
        const float nr = ab.x - 1.0f, ni = ab.y, den = lr * lr + li * li;
        const float f_re = (nr * lr + ni * li) / den, f_im = (ni * lr - nr * li) / den;
        for (int c = 0; c < 16; ++c) { const float br = A->in[I_BRE][((size_t)ig * 64 + p) * 16 + c], bi = A->in[I_BIM][((size_t)ig * 64 + p) * 16 + c];
            bb[(dir * 64 + p) * 16 + c] = (f32x2){f_re * br - f_im * bi, f_re * bi + f_im * br}; }
        ((f32x2*)(A->ws + WS_A16))[(size_t)ig * 64 + p] = pw[(dir * 17 + 16) * 64 + p];
    }
    for (int idx = tid; idx < 2048; idx += 512) { const int dir = idx >> 10, c = (idx >> 6) & 15, p = idx & 63; const size_t gi = (((size_t)(l * 2 + dir) * 64 + g) * 16 + c) * 64 + p;
        cc[idx] = (f32x2){A->in[I_CRE][gi], A->in[I_CIM][gi]}; }
    __syncthreads();
    {
        const int dir = tid >> 8, tau = (tid >> 4) & 15, c = tid & 15;
        float accv[16];
#pragma unroll
        for (int j = 0; j < 16; ++j) accv[j] = 0.f;
        for (int p = 0; p < 64; ++p) { const f32x2 cv = cc[(dir * 16 + c) * 64 + p], pv = pw[(dir * 17 + tau) * 64 + p];
            const float wre = cv.x * pv.x - cv.y * pv.y, wim = cv.x * pv.y + cv.y * pv.x;
#pragma unroll
            for (int j = 0; j < 16; ++j) { const f32x2 bv = bb[(dir * 64 + p) * 16 + j]; accv[j] += wre * bv.x - wim * bv.y; } }
#pragma unroll
        for (int j = 0; j < 16; ++j) kk[((dir * 16 + tau) * 16 + c) * 16 + j] = accv[j];
    }
    __syncthreads();
    const int lg = l * 64 + g;
    bf16* Pm = (bf16*)(A->ws + WS_PMAT) + (size_t)lg * 256 * 256;
    for (int q = tid; q < 8192; q += 512) { const int R = q >> 5, col = (q & 31) * 8, s = col >> 4, c0 = col & 15, dir = R >> 7, reim = (R >> 6) & 1, p = R & 63, e = dir ? s : 15 - s;
        const f32x2 pv = pw[(dir * 17 + e) * 64 + p]; float v[8];
#pragma unroll
        for (int j = 0; j < 8; ++j) { const f32x2 bv = bb[(dir * 64 + p) * 16 + c0 + j]; v[j] = reim ? (pv.x * bv.y + pv.y * bv.x) : (pv.x * bv.x - pv.y * bv.y); }
        v4u w; w.x = cvt_pk_bf16(v[0], v[1]); w.y = cvt_pk_bf16(v[2], v[3]); w.z = cvt_pk_bf16(v[4], v[5]); w.w = cvt_pk_bf16(v[6], v[7]);
        *(v4u*)(Pm + (size_t)R * 256 + col) = w; }
    bf16* KGm = (bf16*)(A->ws + WS_KG) + (size_t)lg * 256 * 512;
    for (int q = tid; q < 16384; q += 512) { const int R = q >> 6, col = (q & 63) * 8, i = R >> 4, c = R & 15; float v[8];
        if (col < 256) { const int s = col >> 4, c0 = col & 15;
#pragma unroll
            for (int j = 0; j < 8; ++j) { const int cp = c0 + j; float x;
                if (s < i) x = kk[((0 * 16 + (i - s)) * 16 + c) * 16 + cp];
                else if (s > i) x = kk[((1 * 16 + (s - i)) * 16 + c) * 16 + cp];
                else { x = kk[((0 * 16 + 0) * 16 + c) * 16 + cp] + kk[((1 * 16 + 0) * 16 + c) * 16 + cp]; if (cp == c) x += A->in[I_DSKIP][l * 1024 + g * 16 + c]; }
                v[j] = x; }
        } else { const int k = col - 256, dir = k >> 7, reim = (k >> 6) & 1, p0 = k & 63, e = dir ? 16 - i : i + 1;
#pragma unroll
            for (int j = 0; j < 8; ++j) { const f32x2 cv = cc[(dir * 16 + c) * 64 + p0 + j], pv = pw[(dir * 17 + e) * 64 + p0 + j];
                v[j] = reim ? -(cv.x * pv.y + cv.y * pv.x) : (cv.x * pv.x - cv.y * pv.y); } }
        v4u w; w.x = cvt_pk_bf16(v[0], v[1]); w.y = cvt_pk_bf16(v[2], v[3]); w.z = cvt_pk_bf16(v[4], v[5]); w.w = cvt_pk_bf16(v[6], v[7]);
        *(v4u*)(KGm + (size_t)R * 512 + col) = w; }
    __syncthreads();
}

__device__ __forceinline__ void mod_unit(KAP A, int un, LAS unsigned char* lds, int tid, int wave, int lane) {
    LAS float* sl = (LAS float*)lds;
    LAS float* red = sl + 3 * 4096;
    const int l = un >> 6, nb = un & 63;
    for (int i = tid; i < 3 * 4096; i += 512) { const int v = i >> 12, k = i & 4095; const float x = v == 0 ? A->in[I_CCTX][k] : A->in[I_C][(v - 1) * 4096 + k]; sl[i] = x / (1.0f + expf(-x)); }
    __syncthreads();
    const int ln = lane < 48 ? lane : 47;
    const float* wp = A->in[I_WMOD] + ((size_t)l * 4096 + wave * 512) * 12288 + nb * 192 + ln * 4;
    f32x4 a0 = {0.f, 0.f, 0.f, 0.f}, a1 = a0, a2 = a0;
#pragma unroll 8
    for (int kq = 0; kq < 512; ++kq) { const f32x4 w = *(const f32x4*)(wp + (size_t)kq * 12288); const int k = wave * 512 + kq;
        a0 += sl[k] * w; a1 += sl[4096 + k] * w; a2 += sl[8192 + k] * w; }
    if (lane < 48) {
#pragma unroll
        for (int j = 0; j < 4; ++j) { red[(wave * 3 + 0) * 256 + lane * 4 + j] = a0[j]; red[(wave * 3 + 1) * 256 + lane * 4 + j] = a1[j]; red[(wave * 3 + 2) * 256 + lane * 4 + j] = a2[j]; } }
    __syncthreads();
    for (int i = tid; i < 768; i += 512) { const int v = i >> 8, col = i & 255; if (col < 192) { float s = 0.f;
#pragma unroll
        for (int w = 0; w < 8; ++w) s += red[(w * 3 + v) * 256 + col];
        ((float*)(A->ws + WS_MOD))[(size_t)(l * 3 + v) * 12288 + nb * 192 + col] = s + A->in[I_BMOD][l * 12288 + nb * 192 + col]; } }
    __syncthreads();
}

__device__ __forceinline__ void p0_prologue(KAP A, LAS unsigned char* lds, int G, int bx, int wv) {
    const int tid = tid_of(wv); const int lane = tid & 63, wave = __builtin_amdgcn_readfirstlane(tid >> 6);
    { LAS float* scr = (LAS float*)(lds + wave * 16640);
      const int gw = bx * NWAVES + wave, NGW = G * NWAVES;
      constexpr int I_IN = 64 * 144, I_OUT = 64 * 64, I_GLU = 16 * 32, I_FFT = 16 * 16, I_L = I_IN + I_OUT + I_GLU + I_FFT;
      for (int it = gw; it < 4 * I_L; it += NGW) { const int l = it / I_L; int r = it % I_L;
          if (r < I_IN) { tr_item<false>(A->in[I_WIN] + (size_t)l * 4096 * 9216, 4096, 9216, (bf16*)(A->ws + WS_WIN) + (size_t)l * 9216 * 4096, scr, r, lane); continue; } r -= I_IN;
          if (r < I_OUT) { tr_item<false>(A->in[I_WOUT] + (size_t)l * 4096 * 4096, 4096, 4096, (bf16*)(A->ws + WS_WOUT) + (size_t)l * 4096 * 4096, scr, r, lane); continue; } r -= I_OUT;
          if (r < I_GLU) { tr_item<true>(A->in[I_WGLU] + (size_t)l * 1024 * 2048, 1024, 2048, (bf16*)(A->ws + WS_WGLU) + (size_t)l * 2048 * 1024, scr, r, lane); continue; } r -= I_GLU;
          tr_item<false>(A->in[I_WFFT] + (size_t)l * 1024 * 1024, 1024, 1024, (bf16*)(A->ws + WS_WFFT) + (size_t)l * 1024 * 1024, scr, r, lane); }
    }
    __syncthreads();
    for (int un = bx; un < 256; un += G) mod_unit(A, un, lds, tid, wave, lane);
    const size_t gt = (size_t)bx * 512 + tid, NGT = (size_t)G * 512;
    { bf16* D2L = (bf16*)(A->ws + WS_D2L);
      LAS bf16* lut = (LAS bf16*)lds;
      for (int i = tid; i < 4096; i += 512) lut[i] = (bf16)(cvt_pk_bf16(cospif((float)i * (1.0f / 2048.0f)), 0.f) & 0xffffu);
      __syncthreads();
      for (size_t q = gt; q < (size_t)4096 * 1024; q += NGT) { const int k = (int)(q >> 10), K0 = (int)(q & 1023) * 8; unsigned h[8];
          const int sh = K0 < 4096 ? 0 : 1024;
#pragma unroll
          for (int j = 0; j < 8; ++j) { const int K = (K0 + j) & 4095; h[j] = lut[(k * K + sh) & 4095]; }
          v4u w; w.x = h[0] | (h[1] << 16); w.y = h[2] | (h[3] << 16); w.z = h[4] | (h[5] << 16); w.w = h[6] | (h[7] << 16);
          *(v4u*)(D2L + (size_t)k * 8192 + K0) = w; }
      __syncthreads(); }
    { bf16* D1 = (bf16*)(A->ws + WS_D1);
      for (size_t q = gt; q < (size_t)512 * 256; q += NGT) { const int mp = (int)(q >> 8), c = (int)(q & 255), m = mp & 255; const float x = (float)((m * c) & 255) * (1.0f / 128.0f);
          const float v = mp < 256 ? cospif(x) : sinpif(x); D1[q] = (bf16)(cvt_pk_bf16(v, 0.f) & 0xffffu); } }
    { bf16* D2C = (bf16*)(A->ws + WS_D2C);
      for (size_t q = gt; q < (size_t)256 * 512; q += NGT) { const int k = (int)(q >> 9), K = (int)(q & 511); const float x = (float)((k * (K & 255)) & 255) * (1.0f / 128.0f);
          const float v = K < 256 ? cospif(x) : -sinpif(x); D2C[q] = (bf16)(cvt_pk_bf16(v, 0.f) & 0xffffu); } }
    { f32x2* rope = (f32x2*)(A->ws + WS_ROPE);
      for (size_t q = gt; q < 64 * 32; q += NGT) { const int pos = (int)(q >> 5), i = (int)(q & 31); const float inv = exp2f(-(float)i * (13.287712379549449f / 32.0f));
          const double turns = (double)pos * (double)inv * 0.15915494309189535; const float fr = (float)(turns - rint(turns));
          rope[q] = (f32x2){cospif(2.f * fr), sinpif(2.f * fr)}; } }
    { const size_t n8 = (size_t)2 * 4 * 512 * 512 / 8;
      for (size_t q = gt; q < 2 * n8; q += NGT) { const bool isk = q < n8; const size_t j = isk ? q : q - n8; const float* src = (isk ? A->in[I_CK] : A->in[I_CV]) + j * 8;
          const f32x4 x0 = *(const f32x4*)src, x1 = *(const f32x4*)(src + 4);
          v4u w; w.x = cvt_pk_bf16(x0[0], x0[1]); w.y = cvt_pk_bf16(x0[2], x0[3]); w.z = cvt_pk_bf16(x1[0], x1[1]); w.w = cvt_pk_bf16(x1[2], x1[3]);
          *(v4u*)((bf16*)(A->ws + (isk ? WS_CK : WS_CV)) + j * 8) = w; } }
    __syncthreads();
    for (int lg = bx; lg < 256; lg += G) ssm_matrices(A, lg >> 6, lg & 63, lds, tid);
}

__device__ __forceinline__ f32x4 ldg16(const void* base, unsigned off, int imm) { return *(const f32x4*)(((const char*)base + off) + imm); }
__device__ __forceinline__ void pa_norm(KAP A, int l, int bx, int G, int tid, LAS unsigned char* lds) {
    const float* mod = (const float*)(A->ws + WS_MOD) + (size_t)l * 3 * 12288;
    const f32x4* ng4 = (const f32x4*)(A->in[I_NG] + l * DM);
    bf16* H = (bf16*)(A->ws + WS_H);
    const int lane = tid & 63, wave = __builtin_amdgcn_readfirstlane(tid >> 6);
    const unsigned lo2 = (unsigned)lane * 16u, lo4 = (unsigned)lane * 32u;
    LAS f32x4* avl = (LAS f32x4*)lds; LAS f32x4* svl = avl + 1024;
    for (int rb = bx; rb < NTOK / 64; rb += G) {
        const int m0 = rb * 64; const int v = m0 < NCTX ? 0 : (m0 < NCTX + 4096 ? 1 : 2);
        const f32x4* sh4 = (const f32x4*)(mod + v * 12288); const f32x4* sc4 = (const f32x4*)(mod + v * 12288 + 4096);
        __syncthreads();
        for (int i = tid; i < 1024; i += NWAVES * 64) { const int d = ((i >> 7) * 2 + (i & 1)) * 64 + ((i & 127) >> 1);
            avl[d] = ng4[i] * (sc4[i] + 1.0f); svl[d] = sh4[i]; }
        __syncthreads();
#pragma unroll 2
        for (int r = 0; r < 8; ++r) { const int m = m0 + wave * 8 + r;
            f32x4 x[16]; float ss = 0.f;
            char* xb = (char*)((bf16*)(A->ws + ((l & 1) ? WS_XBF2 : WS_XBF)) + (size_t)m * DM);
            const char* xbi = (const char*)((const bf16*)(A->ws + ((l & 1) ? WS_XBF : WS_XBF2)) + (size_t)m * DM);
            if (l <= 1) { const float* xr = m < NCTX ? A->in[I_XP] + (size_t)m * DM : A->in[I_XS] + (size_t)(m - NCTX) * DM;
#pragma unroll
                for (int j = 0; j < 8; ++j) { x[2 * j] = ldg16(xr, lo4 + (j >> 1) * 4096u, (j & 1) * 2048); x[2 * j + 1] = ldg16(xr, lo4 + (j >> 1) * 4096u, (j & 1) * 2048 + 16); }
            } else {
#pragma unroll
                for (int j = 0; j < 8; ++j) { const v4u d = *(const v4u*)((xbi + (lo2 + (j >> 2) * 4096u)) + (j & 3) * 1024);
                    x[2 * j] = (f32x4){bf_lo(d.x), bf_hi(d.x), bf_lo(d.y), bf_hi(d.y)}; x[2 * j + 1] = (f32x4){bf_lo(d.z), bf_hi(d.z), bf_lo(d.w), bf_hi(d.w)}; }
            }
            if (l > 0) {
                const char* dr = (const char*)((const bf16*)(A->ws + ((l & 1) ? WS_DELTA : WS_DELTA2)) + (size_t)m * DM);
#pragma unroll
                for (int j = 0; j < 8; ++j) { const v4u d = *(const v4u*)((dr + (lo2 + (j >> 2) * 4096u)) + (j & 3) * 1024);
                    x[2 * j] += (f32x4){bf_lo(d.x), bf_hi(d.x), bf_lo(d.y), bf_hi(d.y)}; x[2 * j + 1] += (f32x4){bf_lo(d.z), bf_hi(d.z), bf_lo(d.w), bf_hi(d.w)};
                    v4u w; w.x = cvt_pk_bf16(x[2 * j].x, x[2 * j].y); w.y = cvt_pk_bf16(x[2 * j].z, x[2 * j].w); w.z = cvt_pk_bf16(x[2 * j + 1].x, x[2 * j + 1].y); w.w = cvt_pk_bf16(x[2 * j + 1].z, x[2 * j + 1].w);
                    *(v4u*)((xb + (lo2 + (j >> 2) * 4096u)) + (j & 3) * 1024) = w; }
            }
#pragma unroll
            for (int j = 0; j < 16; ++j) ss += (x[j].x * x[j].x + x[j].y * x[j].y) + (x[j].z * x[j].z + x[j].w * x[j].w);
            const float rstd = rsqrtf(wave_sum(ss, lane) * (1.0f / DM) + NORM_EPS);
            char* orow = (char*)(H + (size_t)m * DM);
#pragma unroll
            for (int j = 0; j < 8; ++j) { const f32x4 y0 = x[2 * j] * rstd * avl[(2 * j) * 64 + lane] + svl[(2 * j) * 64 + lane], y1 = x[2 * j + 1] * rstd * avl[(2 * j + 1) * 64 + lane] + svl[(2 * j + 1) * 64 + lane];
                v4u w; w.x = cvt_pk_bf16(y0.x, y0.y); w.y = cvt_pk_bf16(y0.z, y0.w); w.z = cvt_pk_bf16(y1.x, y1.y); w.w = cvt_pk_bf16(y1.z, y1.w);
                *(v4u*)((orow + (lo2 + (j >> 2) * 4096u)) + (j & 3) * 1024) = w;
                if ((j & 1) == 1) asm volatile("" ::: "memory"); }
        }
    }
    __syncthreads();
}
__device__ __forceinline__ void final_norm(KAP A, int gw, int NGW, int lane) {
    const float* fg = A->in[I_FNG];
    const unsigned lo2 = (unsigned)lane * 16u, lo4 = (unsigned)lane * 32u;
    f32x4 gv[16];
#pragma unroll
    for (int j = 0; j < 8; ++j) { gv[2 * j] = ldg16(fg, lo4 + (j >> 1) * 4096u, (j & 1) * 2048); gv[2 * j + 1] = ldg16(fg, lo4 + (j >> 1) * 4096u, (j & 1) * 2048 + 16); }
    for (int ci = gw; ci < NTOK / 8; ci += NGW) {
#pragma unroll 2
        for (int r = 0; r < 8; ++r) { const int m = ci * 8 + r;
            char* xr = (char*)(A->out + (size_t)m * DM);
            const char* xs = (const char*)((const bf16*)(A->ws + (((DEPTH - 1) & 1) ? WS_XBF2 : WS_XBF)) + (size_t)m * DM);
            const char* dr = (const char*)((const bf16*)(A->ws + (((DEPTH - 1) & 1) ? WS_DELTA2 : WS_DELTA)) + (size_t)m * DM);
            f32x4 x[16]; float ss = 0.f;
#pragma unroll
            for (int j = 0; j < 8; ++j) { const v4u xv = *(const v4u*)((xs + (lo2 + (j >> 2) * 4096u)) + (j & 3) * 1024); const v4u d = *(const v4u*)((dr + (lo2 + (j >> 2) * 4096u)) + (j & 3) * 1024);
                x[2 * j] = (f32x4){bf_lo(xv.x) + bf_lo(d.x), bf_hi(xv.x) + bf_hi(d.x), bf_lo(xv.y) + bf_lo(d.y), bf_hi(xv.y) + bf_hi(d.y)};
                x[2 * j + 1] = (f32x4){bf_lo(xv.z) + bf_lo(d.z), bf_hi(xv.z) + bf_hi(d.z), bf_lo(xv.w) + bf_lo(d.w), bf_hi(xv.w) + bf_hi(d.w)}; }
#pragma unroll
            for (int j = 0; j < 16; ++j) ss += (x[j].x * x[j].x + x[j].y * x[j].y) + (x[j].z * x[j].z + x[j].w * x[j].w);
            const float rstd = rsqrtf(wave_sum(ss, lane) * (1.0f / DM) + NORM_EPS);
#pragma unroll
            for (int j = 0; j < 8; ++j) { *(f32x4*)((xr + (lo4 + (j >> 1) * 4096u)) + (j & 1) * 2048) = x[2 * j] * rstd * gv[2 * j]; *(f32x4*)((xr + (lo4 + (j >> 1) * 4096u)) + (j & 1) * 2048 + 16) = x[2 * j + 1] * rstd * gv[2 * j + 1];
                if ((j & 1) == 1) asm volatile("" ::: "memory"); }
        }
    }
}

__device__ __forceinline__ void kv_prep(KAP A, int l, int gw, int NGW, int lane) {
    const bf16* PROJ = (const bf16*)(A->ws + WS_PROJ);
    const f32x2* rope = (const f32x2*)(A->ws + WS_ROPE);
    const int hl = lane & 15;
    const f32x4 kn0 = *(const f32x4*)(A->in[I_KN] + l * 128 + hl * 8), kn1 = *(const f32x4*)(A->in[I_KN] + l * 128 + hl * 8 + 4);
    for (int ci = gw; ci < NTOK / 4; ci += NGW) {
        const int m0 = ci * 4; const bool ctx = m0 < NCTX;
        v4u kr[4], vr[4];
#pragma unroll
        for (int r = 0; r < 4; ++r) { const bf16* pr = PROJ + (size_t)(m0 + r) * INW; kr[r] = *(const v4u*)(pr + OFF_K + 8 * lane); vr[r] = *(const v4u*)(pr + OFF_V + 8 * lane); }
#pragma unroll
        for (int r = 0; r < 4; ++r) { const int m = m0 + r;
            float k[8] = {bf_lo(kr[r].x), bf_hi(kr[r].x), bf_lo(kr[r].y), bf_hi(kr[r].y), bf_lo(kr[r].z), bf_hi(kr[r].z), bf_lo(kr[r].w), bf_hi(kr[r].w)};
            float ss = 0.f;
#pragma unroll
            for (int j = 0; j < 8; ++j) ss += k[j] * k[j];
            ss += shflx(ss, lane, 1); ss += shflx(ss, lane, 2); ss += shflx(ss, lane, 4); ss += shflx(ss, lane, 8);
            const float rstd = rsqrtf(ss * (1.0f / 128.0f) + NORM_EPS);
#pragma unroll
            for (int j = 0; j < 4; ++j) { k[j] *= rstd * kn0[j]; k[4 + j] *= rstd * kn1[j]; }
            if (ctx) {
                const int b = m >> 8, t = m & 255; const size_t oi = (((size_t)(b * 4 + l) * 256 + t) * 512 + 8 * lane);
                float* ok = A->out + OUT_NEWK + oi; *(f32x4*)ok = (f32x4){k[0], k[1], k[2], k[3]}; *(f32x4*)(ok + 4) = (f32x4){k[4], k[5], k[6], k[7]};
                float* ov = A->out + OUT_NEWV + oi; *(f32x4*)ov = (f32x4){bf_lo(vr[r].x), bf_hi(vr[r].x), bf_lo(vr[r].y), bf_hi(vr[r].y)}; *(f32x4*)(ov + 4) = (f32x4){bf_lo(vr[r].z), bf_hi(vr[r].z), bf_lo(vr[r].w), bf_hi(vr[r].w)};
            } else {
                const int t = (m - NCTX) & 4095, pos = hl < 8 ? (t >> 6) : (t & 63); const f32x2* rp = rope + pos * 32 + (lane & 3) * 8; const bool first = (lane & 4) == 0;
#pragma unroll
                for (int j = 0; j < 8; ++j) { const float other = shflx(k[j], lane, 4); const f32x2 cs = rp[j];
                    k[j] = first ? (k[j] * cs.x - other * cs.y) : (other * cs.y + k[j] * cs.x); }
            }
            v4u w; w.x = cvt_pk_bf16(k[0], k[1]); w.y = cvt_pk_bf16(k[2], k[3]); w.z = cvt_pk_bf16(k[4], k[5]); w.w = cvt_pk_bf16(k[6], k[7]);
            *(v4u*)((bf16*)(A->ws + WS_KC) + (size_t)m * 512 + 8 * lane) = w;
            *(v4u*)((bf16*)(A->ws + WS_VC) + (size_t)m * 512 + 8 * lane) = vr[r];
        }
    }
}

__device__ __forceinline__ void ssm_scan(KAP A, int l, int g, int mt, int tid, LAS unsigned char* lds) {
    const float* S = (const float*)(A->ws + WS_SBUF) + (size_t)g * 1024 * 256;
    bf16* A2 = (bf16*)(A->ws + WS_A2) + (size_t)g * 1024 * 512;
    const f32x2* A16 = (const f32x2*)(A->ws + WS_A16);
    const int dirp = tid & 127, dir = dirp >> 6, p = dirp & 63, grp = tid >> 7;
    const f32x2 a = A16[((size_t)(l * 2 + dir) * 64 + g) * 64 + p];
    const int cre = 256 + dir * 128 + p, cim = cre + 64, sre = dir * 128 + p, sim = sre + 64;
    LAS f32x2* T = (LAS f32x2*)lds;
    LAS f32x2* EB = T + 16 * 128;
    const bool lat = mt >= 2;
    const int tile0 = mt * 256;
    if (lat) {
#pragma unroll 1
        for (int kk = 0; kk < 4; ++kk) { const int bb = grp + 4 * kk; const int rb = tile0 + bb * 16;
            float sr[16], si[16];
#pragma unroll
            for (int i = 0; i < 16; ++i) { const int row = rb + (dir ? 15 - i : i); sr[i] = S[(size_t)row * 256 + sre]; si[i] = S[(size_t)row * 256 + sim]; }
            float er = 0.f, ei = 0.f;
#pragma unroll
            for (int i = 0; i < 16; ++i) { const float nr = a.x * er - a.y * ei + sr[i], ni = a.x * ei + a.y * er + si[i]; er = nr; ei = ni; }
            T[bb * 128 + dirp] = (f32x2){er, ei}; }
        __syncthreads();
        if (tid < 128) { const int b = mt - 2; const size_t si0 = (((size_t)b * 4 + l) * 64 + g) * 64 + p;
            float er = A->in[dir ? I_SBR : I_SFR][si0], ei = A->in[dir ? I_SBI : I_SFI][si0];
            f32x2 q = a;
#pragma unroll
            for (int k = 0; k < 4; ++k) q = (f32x2){q.x * q.x - q.y * q.y, 2.f * q.x * q.y};
#pragma unroll 1
            for (int jb = 0; jb < 16; ++jb) { const int bb = dir ? 15 - jb : jb; EB[bb * 128 + dirp] = (f32x2){er, ei}; const f32x2 t = T[bb * 128 + dirp];
                const float nr = q.x * er - q.y * ei + t.x, ni = q.x * ei + q.y * er + t.y; er = nr; ei = ni; } }
        __syncthreads();
    }
#pragma unroll 1
    for (int kk = 0; kk < 4; ++kk) { const int bb = grp + 4 * kk; const int rb = tile0 + bb * 16;
        float sr[16], si[16];
#pragma unroll
        for (int i = 0; i < 16; ++i) { const int row = rb + (dir ? 15 - i : i); sr[i] = S[(size_t)row * 256 + sre]; si[i] = S[(size_t)row * 256 + sim]; }
        float er = 0.f, ei = 0.f;
        if (lat) { const f32x2 e0 = EB[bb * 128 + dirp]; er = e0.x; ei = e0.y; }
#pragma unroll
        for (int i = 0; i < 16; ++i) { const int row = rb + (dir ? 15 - i : i);
            A2[(size_t)row * 512 + cre] = (bf16)(cvt_pk_bf16(er, 0.f) & 0xffffu); A2[(size_t)row * 512 + cim] = (bf16)(cvt_pk_bf16(ei, 0.f) & 0xffffu);
            const float nr = a.x * er - a.y * ei + sr[i], ni = a.x * ei + a.y * er + si[i]; er = nr; ei = ni; }
        if (!lat) { const int b = mt * 16 + bb; const size_t oi = (((size_t)b * 4 + l) * 64 + g) * 64 + p;
            A->out[(dir ? OUT_BRE : OUT_FRE) + oi] = er; A->out[(dir ? OUT_BIM : OUT_FIM) + oi] = ei; }
    }
}
__device__ __forceinline__ void ssm_step1(KAP A, int l, int un, LAS unsigned char* lds, int wv) {
    const int g = un >> 2, mt = un & 3, lg = l * 64 + g;
    pg8::OneUnit S1; S1.u0.a = (const char*)(A->ws + WS_A2) + ((size_t)g * 1024 + mt * 256) * 512 * 2; S1.u0.b = (const char*)(A->ws + WS_PMAT) + (size_t)lg * 256 * 256 * 2;
    S1.u0.c = (char*)(A->ws + WS_SBUF) + ((size_t)g * 1024 + mt * 256) * 256 * 4; S1.u0.ldc = 256; S1.u0.pm = mt; S1.u0.pn = g; S1.u0.z = 0; S1.u0.kt = 4;
    pg8::EpiF32 E; pg8::gemm_phase<pg8::EpiF32, pg8::OneUnit>(lds, wv, 512, 256, S1, E);
}
__device__ __forceinline__ void ssm_step2(KAP A, int l, int un, LAS unsigned char* lds, int wv) {
    const int g = un >> 2, mt = un & 3; const int tid = tid_of(wv); ssm_scan(A, l, g, mt, tid, lds);
}
__device__ __forceinline__ void ssm_step3(KAP A, int l, int un, LAS unsigned char* lds, int wv) {
    const int g = un >> 2, mt = un & 3, lg = l * 64 + g;
    pg8::OneUnit S2; S2.u0.a = (const char*)(A->ws + WS_A2) + ((size_t)g * 1024 + mt * 256) * 512 * 2; S2.u0.b = (const char*)(A->ws + WS_KG) + (size_t)lg * 256 * 512 * 2;
    S2.u0.c = nullptr; S2.u0.ldc = 0; S2.u0.pm = mt; S2.u0.pn = g; S2.u0.z = mt * 256; S2.u0.kt = 8;
    pg8::EpiSsmY E{(bf16*)(A->ws + WS_YSSM)}; pg8::gemm_phase<pg8::EpiSsmY, pg8::OneUnit>(lds, wv, 512, 512, S2, E);
}

struct Fft1Order {
    int G, c; const char* D1; const char* proj; char* z1l; char* z1c;
    __device__ bool next(int i, pg8::Unit& u) const { const int L = i * G + c; if (L >= 512) return false;
        const int cs = L & 1, g = (L >> 1) & 3, tt = L >> 3;
        u.kt = 4; u.a = D1 + (size_t)cs * 256 * 256 * 2; u.b = proj + ((size_t)tt * 256 * INW + OFF_F + g * 256) * 2; u.pm = cs; u.pn = tt; u.z = g;
        if (tt < 32) { u.c = z1c + (((size_t)tt * 1024 + g * 256) * 512 + cs * 256) * 2; u.ldc = 512; }
        else { const int b = (tt - 32) >> 4, t0 = ((tt - 32) & 15) * 256; u.c = z1l + (((size_t)b * 1024 + g * 256) * 8192 + cs * 4096 + t0) * 2; u.ldc = 8192; }
        return true; }
};
struct Fft2LOrder {
    int G, c; const char* D2; const char* z1; char* mixed;
    __device__ bool next(int i, pg8::Unit& u) const { const int L = i * G + c; if (L >= 128) return false;
        const int nt = L & 3, mt = (L >> 2) & 15, b = L >> 6;
        u.kt = 128; u.a = D2 + (size_t)mt * 256 * 8192 * 2; u.b = z1 + ((size_t)b * 1024 + nt * 256) * 8192 * 2; u.pm = mt; u.pn = nt; u.z = b;
        u.c = mixed + (((size_t)NCTX + b * 4096 + mt * 256) * 1024 + nt * 256) * 2; u.ldc = 1024; return true; }
};
struct Fft2COrder {
    int G, c; const char* D2; const char* z1; char* mixed;
    __device__ bool next(int i, pg8::Unit& u) const { const int L = i * G + c; if (L >= 128) return false;
        const int nt = L & 3, b = L >> 2;
        u.kt = 8; u.a = D2; u.b = z1 + ((size_t)b * 1024 + nt * 256) * 512 * 2; u.pm = 0; u.pn = nt; u.z = b;
        u.c = mixed + (((size_t)b * 256) * 1024 + nt * 256) * 2; u.ldc = 1024; return true; }
};

__global__ void __launch_bounds__(NWAVES * 64, 2) hymba_fwd(Args args) {
    extern __shared__ __attribute__((aligned(16))) unsigned char lds_raw[];
    LAS unsigned char* lds = (LAS unsigned char*)lds_raw;
    volatile LAS unsigned* MISC = (volatile LAS unsigned*)(lds + MISC_OFF);
    const int G = gridDim.x, bx = blockIdx.x;
    const int wv = __builtin_amdgcn_readfirstlane(threadIdx.x >> 6);
#define TID_HERE() const int tid = tid_of(wv); const int lane = tid & 63, wave = __builtin_amdgcn_readfirstlane(tid >> 6), gw = bq * NWAVES + wave, NGWq = Gq * NWAVES; (void)lane; (void)gw; (void)NGWq
#define PH_IDS() int Gq = G, bq = bx; asm volatile("" : "+s"(Gq), "+s"(bq))
    for (int u = tid_of(wv); u < (LDS_BYTES - MISC_OFF) / 4; u += NWAVES * 64) ((LAS unsigned*)(lds + MISC_OFF))[u] = 0u;
    __syncthreads();
    int lo, hi; XcdBarrier bar;
    { KA_HERE(); PH_IDS(); lo = ka->ph_lo; hi = ka->ph_hi; unsigned* ctl = (unsigned*)(ka->ws + WS_CTL);
      bar.bar = ctl + CW_BAR; bar.x = 0; bar.st = nullptr;
      if (hi - lo > 1) bar = xcd_barrier_post(ctl + CW_BAR, MISC + 8, tid_of(wv)); }
#define IN(k) (lo <= (k) && (k) < hi)
#define SEAM(k) do { if (IN(k) && IN((k) + 1)) { xcd_barrier(bar, wv); if (((DUP_MASK) >> 12) & 1) xcd_barrier(bar, wv); } } while (0)

    if (IN(0)) DUP(0) { KA_HERE(); PH_IDS(); p0_prologue(ka, lds, Gq, bq, wv); }
    SEAM(0);

    for (int l = 0; l < DEPTH; ++l) for (int lrep_ = 0; lrep_ < 1 + (((DUP_MASK) >> 19) & 1); ++lrep_) {
        const int pb = 1 + 6 * l;
        if (IN(pb)) DUP(1) { KA_HERE(); PH_IDS(); TID_HERE(); pa_norm(ka, l, bq, Gq, tid, lds);
        }
        SEAM(pb);
        if (IN(pb + 1)) DUP(2) {
            KA_HERE(); PH_IDS(); unsigned char* ws = ka->ws;
            pg8::GemmOrder S; S.init(NTOK, INW, Gq, bq, ws + WS_H, DM, ws + WS_WIN + (size_t)l * INW * DM * 2, DM, DM);
            pg8::EpiProj E{(bf16*)(ws + WS_PROJ), (bf16*)(ws + WS_A2)};
            pg8::gemm_phase<pg8::EpiProj, pg8::GemmOrder, GEMM1_ALIGN>(lds, wv, DM, DM, S, E);
        }
        SEAM(pb + 1);
        if (IN(pb + 2)) {
            DUP(16) for (int un = bx; un < 256; un += G) { KA_HERE(); ssm_step1(ka, l, un, lds, wv); }
            DUP(14) { KA_HERE(); PH_IDS(); TID_HERE(); kv_prep(ka, l, gw, NGWq, lane); }
            wg_global_sync();
            DUP(17) { for (int un = bx; un < 256; un += G) { KA_HERE(); ssm_step2(ka, l, un, lds, wv); } __syncthreads(); }
            DUP(3) { KA_HERE(); PH_IDS(); unsigned char* ws = ka->ws;
              Fft1Order S{Gq, bq, (const char*)(ws + WS_D1), (const char*)(ws + WS_PROJ), (char*)(ws + WS_Z1L), (char*)(ws + WS_Z1C)};
              pg8::EpiBf16 E{1.0f}; pg8::gemm_phase<pg8::EpiBf16, Fft1Order>(lds, wv, 256, INW, S, E); }
            wg_global_sync();
            DUP(18) for (int un = bx; un < 256; un += G) { KA_HERE(); ssm_step3(ka, l, un, lds, wv); }
        }
        SEAM(pb + 2);
        if (IN(pb + 3)) {
            DUP(5) for (int U = bx; U < 512; U += G) {
                KA_HERE(); PH_IDS(); unsigned char* ws = ka->ws; bf16* const PROJ = (bf16*)(ws + WS_PROJ); bf16* const MIX = (bf16*)(ws + WS_MIX);
                const float* qn = ka->in[I_QN] + l * 128; const f32x2* rope = (const f32x2*)(ws + WS_ROPE);
                const int pr = U & 7, idx = U >> 3, b = pr >> 2, kvh = pr & 3, hq = kvh * 4 + (idx >> 4), qb = idx & 15;
                const size_t row0 = (size_t)NCTX + b * 4096 + qb * 256;
                const bf16* ck = (const bf16*)(ws + WS_CK) + ((size_t)(b * 4 + l) * 512) * 512 + kvh * 128;
                const bf16* cv = (const bf16*)(ws + WS_CV) + ((size_t)(b * 4 + l) * 512) * 512 + kvh * 128;
                const bf16* k1 = (const bf16*)(ws + WS_KC) + ((size_t)NCTX + b * 4096) * 512 + kvh * 128; const bf16* v1 = (const bf16*)(ws + WS_VC) + ((size_t)NCTX + b * 4096) * 512 + kvh * 128;
                att::attn_unit(PROJ + row0 * INW + hq * 128, PROJ + row0 * INW + OFF_GA + hq * 128, MIX + row0 * DM + hq * 128,
                               ck, cv, 512, 8, k1, v1, 512, 64, qn, rope, qb * 256, (char*)lds_raw, wv);
            }
            if (bx >= (G >> 1)) {
                const int nB = G - (G >> 1), cB = bx - (G >> 1);
                DUP(6) for (int U = cB; U < 512; U += nB) {
                    KA_HERE(); unsigned char* ws = ka->ws; bf16* const PROJ = (bf16*)(ws + WS_PROJ); bf16* const MIX = (bf16*)(ws + WS_MIX);
                    const float* qn = ka->in[I_QN] + l * 128;
                    const int xx = U & 7, idx = U >> 3, b = xx * 4 + (idx >> 4), hq = idx & 15, kvh = hq >> 2;
                    const size_t row0 = (size_t)b * 256;
                    const bf16* k1 = (const bf16*)(ws + WS_KC) + row0 * 512 + kvh * 128; const bf16* v1 = (const bf16*)(ws + WS_VC) + row0 * 512 + kvh * 128;
                    att::attn_unit(PROJ + row0 * INW + hq * 128, PROJ + row0 * INW + OFF_GA + hq * 128, MIX + row0 * DM + hq * 128,
                                   k1, v1, 512, 0, k1, v1, 512, 4, qn, nullptr, 0, (char*)lds_raw, wv);
                }
                __syncthreads();
                DUP(9) { KA_HERE(); unsigned char* ws = ka->ws; int nBq = nB, cBq = cB; asm volatile("" : "+s"(nBq), "+s"(cBq));
                  pg8::GemmOrder S; S.init(NTOK, 2048, nBq, cBq, ws + WS_YSSM, 1024, ws + WS_WGLU + (size_t)l * 2048 * 1024 * 2, 1024, 1024);
                  pg8::EpiGlu E{(const bf16*)(ws + WS_PROJ), (bf16*)(ws + WS_MIX)}; pg8::gemm_phase<pg8::EpiGlu, pg8::GemmOrder>(lds, wv, 1024, 1024, S, E); }
            } else {
                __syncthreads();
                DUP(7) { KA_HERE(); unsigned char* ws = ka->ws; int nAq = G >> 1, cAq = bx; asm volatile("" : "+s"(nAq), "+s"(cAq));
                  Fft2LOrder S{nAq, cAq, (const char*)(ws + WS_D2L), (const char*)(ws + WS_Z1L), (char*)(ws + WS_MIXED)};
                  pg8::EpiBf16 E{1.0f / 1024.0f}; pg8::gemm_phase<pg8::EpiBf16, Fft2LOrder>(lds, wv, 8192, 8192, S, E); }
                DUP(8) { KA_HERE(); unsigned char* ws = ka->ws; int nAq = G >> 1, cAq = bx; asm volatile("" : "+s"(nAq), "+s"(cAq));
                  Fft2COrder S{nAq, cAq, (const char*)(ws + WS_D2C), (const char*)(ws + WS_Z1C), (char*)(ws + WS_MIXED)};
                  pg8::EpiBf16 E{1.0f / 256.0f}; pg8::gemm_phase<pg8::EpiBf16, Fft2COrder>(lds, wv, 512, 512, S, E); }
            }
        }
        SEAM(pb + 3);
        if (IN(pb + 4)) {
            DUP(10) { KA_HERE(); PH_IDS(); unsigned char* ws = ka->ws;
              pg8::GemmOrder S; S.init(NTOK, 1024, Gq, bq, ws + WS_MIXED, 1024, ws + WS_WFFT + (size_t)l * 1024 * 1024 * 2, 1024, 1024);
              pg8::EpiFftW E{(const bf16*)(ws + WS_PROJ), (bf16*)(ws + WS_MIX)}; pg8::gemm_phase<pg8::EpiFftW, pg8::GemmOrder>(lds, wv, 1024, 1024, S, E); }
        }
        SEAM(pb + 4);
        if (IN(pb + 5)) DUP(11) {
            KA_HERE(); PH_IDS(); unsigned char* ws = ka->ws;
            pg8::GemmOrder S; S.init(NTOK, DM, Gq, bq, ws + WS_MIX, DM, ws + WS_WOUT + (size_t)l * DM * DM * 2, DM, DM);
            pg8::EpiOut E{(bf16*)(ws + ((l & 1) ? WS_DELTA2 : WS_DELTA)), (const float*)(ws + WS_MOD) + (size_t)l * 3 * 12288};
            if (((DUP_MASK) >> 13) & 1) {
                { pg8::SliceOrder<pg8::GemmOrder> S2{S, 0, 2}; pg8::gemm_phase<pg8::EpiOut, pg8::SliceOrder<pg8::GemmOrder>, GEMM1_ALIGN>(lds, wv, DM, DM, S2, E); }
                xcd_barrier(bar, wv);
                { pg8::SliceOrder<pg8::GemmOrder> S2{S, 2, 1000}; pg8::gemm_phase<pg8::EpiOut, pg8::SliceOrder<pg8::GemmOrder>, GEMM1_ALIGN>(lds, wv, DM, DM, S2, E); }
            } else
            pg8::gemm_phase<pg8::EpiOut, pg8::GemmOrder, GEMM1_ALIGN>(lds, wv, DM, DM, S, E);
        }
        SEAM(pb + 5);
    }
    if (IN(25)) DUP(15) { KA_HERE(); PH_IDS(); TID_HERE(); final_norm(ka, gw, NGWq, lane); }
#undef IN
#undef SEAM
}

extern "C" void kernel_launch(void* const* d_in, const int* in_sizes, int n_in, void* d_out, int out_size, void* d_ws, size_t ws_size, hipStream_t stream) {
    static int grid = 0;
    if (grid == 0) {
        if (n_in != 28 || ws_size < WS_END || out_size != 102760448) { fprintf(stderr, "kernel_launch: unexpected shapes (n_in %d, out %d, ws %zu)\n", n_in, out_size, ws_size); grid = -1; return; }
        int dev = 0, cus = 0, per_cu = 0;
        if (hipGetDevice(&dev) != hipSuccess || hipDeviceGetAttribute(&cus, hipDeviceAttributeMultiprocessorCount, dev) != hipSuccess) { grid = -1; return; }
        if (hipFuncSetAttribute((const void*)hymba_fwd, hipFuncAttributeMaxDynamicSharedMemorySize, LDS_BYTES) != hipSuccess) { fprintf(stderr, "kernel_launch: hipFuncSetAttribute failed\n"); grid = -1; return; }
        if (hipOccupancyMaxActiveBlocksPerMultiprocessor(&per_cu, (const void*)hymba_fwd, NWAVES * 64, LDS_BYTES) != hipSuccess || per_cu < 1)
            fprintf(stderr, "kernel_launch: occupancy query reports %d workgroups per CU\n", per_cu);
        (void)hipGetLastError();
        grid = cus;
    }
    if (grid < 0) return;
    (void)hipMemsetAsync((char*)d_ws + WS_CTL, 0, CTL_ZERO_BYTES, stream);
    Args a{};
    for (int i = 0; i < 28; ++i) a.in[i] = (const float*)d_in[i];
    a.out = (float*)d_out; a.ws = (unsigned char*)d_ws;
#if MK_ONE_LAUNCH == 2
    a.ph_lo = 0; a.ph_hi = 1;
    hipLaunchKernelGGL(hymba_fwd, dim3(grid), dim3(NWAVES * 64), LDS_BYTES, stream, a);
    a.ph_lo = 0; a.ph_hi = 26;
    hipLaunchKernelGGL(hymba_fwd, dim3(grid), dim3(NWAVES * 64), LDS_BYTES, stream, a);
#elif MK_ONE_LAUNCH
    a.ph_lo = 0; a.ph_hi = 26;
    hipLaunchKernelGGL(hymba_fwd, dim3(grid), dim3(NWAVES * 64), LDS_BYTES, stream, a);
#else
    for (int ph = 0; ph < 26; ++ph) { a.ph_lo = ph; a.ph_hi = ph + 1; hipLaunchKernelGGL(hymba_fwd, dim3(grid), dim3(NWAVES * 64), LDS_BYTES, stream, a); }
#endif
    const hipError_t le = hipPeekAtLastError();
    if (le != hipSuccess) fprintf(stderr, "kernel_launch: launch failed: %s\n", hipGetErrorName(le));
}
```

```cpp
#include <hip/hip_runtime.h>
#include <cstdio>
#include <cstdint>

#ifndef MK_ONE_LAUNCH
#define MK_ONE_LAUNCH 1
#endif

#ifndef GEMM1_ALIGN
#define GEMM1_ALIGN true
#endif
#ifndef DUP_MASK
#define DUP_MASK 0
#endif
#define DUP(k) for (int rep_ = 0; rep_ < (((DUP_MASK) >> (k)) & 1) + 1; ++rep_)
#define LAS __attribute__((address_space(3)))
#define GAS __attribute__((address_space(1)))
typedef unsigned short bf16;
typedef unsigned v4u __attribute__((ext_vector_type(4)));
typedef unsigned v2u __attribute__((ext_vector_type(2)));
typedef float f32x4 __attribute__((ext_vector_type(4)));
typedef float f32x2 __attribute__((ext_vector_type(2)));
typedef short bf16x8 __attribute__((ext_vector_type(8)));
typedef short s16x4 __attribute__((ext_vector_type(4)));
typedef float f32x16 __attribute__((ext_vector_type(16)));

constexpr int DM = 4096, NTOK = 16384, NCTX = 8192, DEPTH = 4, INW = 9216;
constexpr int OFF_K = 2048, OFF_V = 2560, OFF_GA = 3072, OFF_U = 5120, OFF_GS = 6144, OFF_F = 7168, OFF_GF = 8192;
constexpr float NORM_EPS = 1e-6f;
constexpr size_t OUT_NEWK = 67108864, OUT_NEWV = 83886080, OUT_FRE = 100663296, OUT_FIM = 101187584, OUT_BRE = 101711872, OUT_BIM = 102236160;

constexpr size_t MiB = 1u << 20;
constexpr size_t WS_CTL = 0, CTL_ZERO_BYTES = 1 * MiB;
constexpr size_t WS_MOD = 1 * MiB;
constexpr size_t WS_ROPE = 2 * MiB;
constexpr size_t WS_A16 = 3 * MiB;
constexpr size_t WS_D1 = 4 * MiB;
constexpr size_t WS_D2C = 5 * MiB;
constexpr size_t WS_CK = 6 * MiB;
constexpr size_t WS_CV = 10 * MiB;
constexpr size_t WS_PMAT = 14 * MiB;
constexpr size_t WS_KG = 46 * MiB;
constexpr size_t WS_D2L = 110 * MiB;
constexpr size_t WS_WGLU = 174 * MiB;
constexpr size_t WS_WFFT = 190 * MiB;
constexpr size_t WS_WOUT = 198 * MiB;
constexpr size_t WS_WIN = 326 * MiB;
constexpr size_t WS_H = 614 * MiB;
constexpr size_t WS_PROJ = 742 * MiB;
constexpr size_t WS_MIX = 1030 * MiB;
constexpr size_t WS_A2 = 1158 * MiB;
constexpr size_t WS_SBUF = 1222 * MiB;
constexpr size_t WS_YSSM = 1286 * MiB;
constexpr size_t WS_Z1L = 1318 * MiB;
constexpr size_t WS_Z1C = 1350 * MiB;
constexpr size_t WS_MIXED = 1382 * MiB;
constexpr size_t WS_DELTA = 1414 * MiB;
constexpr size_t WS_XBF = 1542 * MiB;
constexpr size_t WS_XBF2 = 1702 * MiB;
constexpr size_t WS_KC = 1670 * MiB;
constexpr size_t WS_VC = 1686 * MiB;
constexpr size_t WS_DELTA2 = 1830 * MiB;
constexpr size_t WS_END = 1958 * MiB;
constexpr int CW_BAR = 4096;

constexpr int LDS_BYTES = 147456;
constexpr int MISC_OFF = 143360;
constexpr int NWAVES = 8;

#define LDS_WAIT() asm volatile("s_waitcnt lgkmcnt(0)" ::: "memory")
#define VM_WAIT() asm volatile("s_waitcnt vmcnt(0)" ::: "memory")
#define RLX_AGENT __ATOMIC_RELAXED, __HIP_MEMORY_SCOPE_AGENT

__device__ __forceinline__ int tid_of(int wv) { int t = wv * 64 + (int)__builtin_amdgcn_mbcnt_hi(~0u, __builtin_amdgcn_mbcnt_lo(~0u, 0u)); asm volatile("" : "+v"(t)); return t; }
__device__ __forceinline__ unsigned cvt_pk_bf16(float lo, float hi) { unsigned r; asm volatile("v_cvt_pk_bf16_f32 %0, %1, %2" : "=v"(r) : "v"(lo), "v"(hi)); return r; }
__device__ __forceinline__ float bf_lo(unsigned w) { return __uint_as_float(w << 16); }
__device__ __forceinline__ float bf_hi(unsigned w) { return __uint_as_float(w & 0xffff0000u); }
__device__ __forceinline__ float silu_f(float x) { return x * __builtin_amdgcn_rcpf(1.0f + __expf(-x)); }
__device__ __forceinline__ float sigmoid_f(float x) { return __builtin_amdgcn_rcpf(1.0f + __expf(-x)); }
__device__ __forceinline__ float shflx(float v, int lane, int o) { return __int_as_float(__builtin_amdgcn_ds_bpermute((lane ^ o) << 2, __float_as_int(v))); }
__device__ __forceinline__ float wave_sum(float v, int lane) {
#pragma unroll
    for (int o = 1; o < 64; o <<= 1) v += shflx(v, lane, o);
    return v;
}

namespace pg8 {
constexpr int BM = 256, BK = 64, HALF = 128, HTB = HALF * BK * 2, STAGE_BYTES = 8 * HTB, NXCD = 8, WGM = 8;
__host__ __device__ __forceinline__ int lds_byte(int r, int c) { const int st = (r >> 4) * 2 + (c >> 5), rr = r & 15, cc = c & 31, ob = rr * 64 + cc * 2; return st * 1024 + (ob ^ (((ob >> 9) & 1) << 5)); }
__host__ __device__ __forceinline__ void stage_rc(int b, int& R, int& C) { const int st = b / 1024, sb = b % 1024, swz = sb ^ (((sb >> 9) & 1) << 5); R = (st >> 1) * 16 + swz / 64; C = (st & 1) * 32 + (swz % 64) / 2; }
__host__ __device__ __forceinline__ int perm32(int rho) { const int n = rho >> 4, i = rho & 15; return 8 * (i >> 2) + 4 * n + (i & 3); }

struct Unit { const char* a; const char* b; char* c; int ldc; int pm, pn, z, kt; };

struct GemmOrder {
    int nM, nN, nwg, G, c, kt; const char* A; const char* B; size_t atile, btile;
    __device__ void init(int M, int N, int G_, int c_, const void* A_, int lda, const void* B_, int ldb, int K) { kt = K / BK; nM = M / BM; nN = N / BM; nwg = nM * nN; G = G_; c = c_; A = (const char*)A_; B = (const char*)B_; atile = (size_t)BM * lda * 2; btile = (size_t)BM * ldb * 2; }
    __device__ bool next(int i, Unit& u) const {
        const long L = (long)i * G + c; if (L >= nwg) return false;
        int wgid = (int)L; const int xcd = wgid % NXCD; { const int q = nwg / NXCD, r = nwg % NXCD, off = wgid / NXCD; wgid = (xcd < r ? xcd * (q + 1) : r * (q + 1) + (xcd - r) * q) + off; }
        const int nig = WGM * nN, gid = wgid / nig, fm = gid * WGM, gsz = (nM - fm) < WGM ? (nM - fm) : WGM;
        u.pm = fm + ((wgid % nig) % gsz); u.pn = (wgid % nig) / gsz; u.z = 0; u.c = nullptr; u.ldc = 0; u.kt = kt;
        u.a = A + (size_t)u.pm * atile; u.b = B + (size_t)u.pn * btile; return true;
    }
};
template <class O> struct SliceOrder { O g; int i0, cnt; __device__ bool next(int i, Unit& u) const { if (i >= cnt) return false; return g.next(i0 + i, u); } };
struct OneUnit { Unit u0; __device__ bool next(int i, Unit& u) const { if (i != 0) return false; u = u0; return true; } };

template <class Epi, class Sched, bool ALIGN_EPI = true>
__device__ __forceinline__ void gemm_phase(LAS unsigned char* lds, const int wv, const int lda, const int ldb, const Sched& S, const Epi& E) {
    const int tid = tid_of(wv);
    const int wid = __builtin_amdgcn_readfirstlane(tid >> 6), lane = tid & 63, wr = wid >> 2, wc = wid & 3, fr = lane & 15, fq = lane >> 4;
    unsigned voffA[2], voffB[2];
#pragma unroll
    for (int i = 0; i < 2; ++i) { int R, C; stage_rc(tid * 16 + i * 8192, R, C); const int Rb = Epi::PERM ? ((R & ~31) + perm32(R & 31)) : R;
        voffA[i] = (unsigned)(R * lda + C) * 2u; voffB[i] = (unsigned)(Rb * ldb + C) * 2u; }
    (void)fr; (void)fq;
    const size_t kstep = (size_t)(BK * 2);
    const unsigned hstepA = (unsigned)HALF * lda * 2u, hstepB = (unsigned)HALF * ldb * 2u;
    const unsigned ldsw = (unsigned)wid * 1024u;
    const int aoff = lds_byte(wr * 64 + fr, fq * 8), boff = lds_byte(wc * 32 + fr, fq * 8);
#define PG8_SA(b, h) (((b) * 2 + (h)) * HTB)
#define PG8_SB(b, h) ((4 + (b) * 2 + (h)) * HTB)
#define PG8_STAGE(bufoff, gbase, voff) do { _Pragma("unroll") for (int _i = 0; _i < 2; ++_i) \
        __builtin_amdgcn_global_load_lds((const unsigned*)((const char*)(gbase) + (voff)[_i]), (LAS unsigned*)(lds + (bufoff) + ldsw + _i * 8192), 16, 0, 0); } while (0)
#define PG8_LDA(dst, b, h) do { _Pragma("unroll") for (int m = 0; m < 4; ++m) _Pragma("unroll") for (int k = 0; k < 2; ++k) dst[m][k] = *(const LAS bf16x8*)(lds + PG8_SA(b, h) + aoff + m * 2048 + k * 1024); } while (0)
#define PG8_LDB(dst, b, h) do { _Pragma("unroll") for (int n = 0; n < 2; ++n) _Pragma("unroll") for (int k = 0; k < 2; ++k) dst[n][k] = *(const LAS bf16x8*)(lds + PG8_SB(b, h) + boff + n * 2048 + k * 1024); } while (0)
#define PG8_MMA(ai, bj, At, Bt) do { __builtin_amdgcn_s_setprio(1); _Pragma("unroll") for (int m = 0; m < 4; ++m) _Pragma("unroll") for (int n = 0; n < 2; ++n) _Pragma("unroll") for (int k = 0; k < 2; ++k) \
        acc[ai][bj][m][n] = __builtin_amdgcn_mfma_f32_16x16x32_bf16(Bt[n][k], At[m][k], acc[ai][bj][m][n], 0, 0, 0); __builtin_amdgcn_s_setprio(0); } while (0)
#define PG8_WAIT_V(n) asm volatile("s_waitcnt vmcnt(" #n ")" ::: "memory")
#define PG8_WAIT_L(n) asm volatile("s_waitcnt lgkmcnt(" #n ")" ::: "memory")
#define PG8_BAR __builtin_amdgcn_s_barrier()
#define PG8_SCHED __builtin_amdgcn_sched_barrier(0)
    int ui = 0, nt;
    const char* cA; const char* cB;
    { Unit u0; if (!S.next(0, u0)) return; cA = u0.a; cB = u0.b; nt = u0.kt; }
    f32x4 acc[2][2][4][2];
#pragma unroll
    for (int a = 0; a < 2; ++a)
#pragma unroll
        for (int b = 0; b < 2; ++b)
#pragma unroll
            for (int m = 0; m < 4; ++m)
#pragma unroll
                for (int n = 0; n < 2; ++n) acc[a][b][m][n] = (f32x4){0.f, 0.f, 0.f, 0.f};
    bf16x8 At[4][2], B0[2][2], B1[2][2];
    PG8_STAGE(PG8_SB(0, 0), cB, voffB); PG8_STAGE(PG8_SB(0, 1), cB + hstepB, voffB); PG8_STAGE(PG8_SA(0, 0), cA, voffA); PG8_STAGE(PG8_SA(0, 1), cA + hstepA, voffA);
    if (wr == 1) PG8_BAR;
    PG8_WAIT_V(2); PG8_BAR;
    PG8_STAGE(PG8_SB(1, 0), cB + kstep, voffB); PG8_STAGE(PG8_SA(1, 0), cA + kstep, voffA); PG8_STAGE(PG8_SB(1, 1), cB + hstepB + kstep, voffB);
    PG8_WAIT_V(6); PG8_BAR;
    for (;;) {
        bool has_next; const char* nA; const char* nB; int nnt;
        { Unit nx; has_next = S.next(ui + 1, nx); nA = has_next ? nx.a : cA; nB = has_next ? nx.b : cB; nnt = has_next ? nx.kt : nt; }
        for (int t = 0; t < nt; t += 2) {
            const bool last = (t == nt - 2);
            const char* a1 = cA + (size_t)(t + 1) * kstep;
            const char* a2 = last ? nA : cA + (size_t)(t + 2) * kstep; const char* b2 = last ? nB : cB + (size_t)(t + 2) * kstep;
            const char* a3 = a2 + kstep; const char* b3 = b2 + kstep;
            PG8_LDB(B0, 0, 0); PG8_LDB(B1, 0, 1); PG8_SCHED; PG8_LDA(At, 0, 0); PG8_STAGE(PG8_SA(1, 1), a1 + hstepA, voffA);
            PG8_WAIT_V(8); PG8_WAIT_L(0); PG8_BAR; PG8_MMA(0, 0, At, B0); PG8_MMA(0, 1, At, B1); PG8_BAR; PG8_SCHED;
            PG8_LDA(At, 0, 1); PG8_STAGE(PG8_SB(0, 0), b2, voffB); PG8_STAGE(PG8_SB(0, 1), b2 + hstepB, voffB); PG8_STAGE(PG8_SA(0, 0), a2, voffA);
            PG8_WAIT_V(8); PG8_WAIT_L(0); PG8_BAR; PG8_MMA(1, 0, At, B0); PG8_MMA(1, 1, At, B1); PG8_BAR; PG8_SCHED;
            PG8_LDB(B0, 1, 0); PG8_LDB(B1, 1, 1); PG8_SCHED; PG8_LDA(At, 1, 0); PG8_STAGE(PG8_SA(0, 1), a2 + hstepA, voffA);
            PG8_WAIT_V(8); PG8_WAIT_L(0); PG8_BAR; PG8_MMA(0, 0, At, B0); PG8_MMA(0, 1, At, B1); PG8_BAR; PG8_SCHED;
            PG8_LDA(At, 1, 1); PG8_STAGE(PG8_SB(1, 0), b3, voffB); PG8_STAGE(PG8_SB(1, 1), b3 + hstepB, voffB); PG8_STAGE(PG8_SA(1, 0), a3, voffA);
            PG8_WAIT_V(8); PG8_WAIT_L(0); PG8_BAR; PG8_MMA(1, 0, At, B0); PG8_MMA(1, 1, At, B1); PG8_BAR; PG8_SCHED;
        }
        if constexpr (ALIGN_EPI) { if (wr == 0) PG8_BAR; }
        { Unit cu; (void)S.next(ui, cu); const int t2 = tid_of(wv);
          const int w2 = __builtin_amdgcn_readfirstlane(t2 >> 6); E(acc, cu, w2 >> 2, w2 & 3, t2 & 15, (t2 & 63) >> 4); }
        if (!has_next) break;
#pragma unroll
        for (int a = 0; a < 2; ++a)
#pragma unroll
            for (int b = 0; b < 2; ++b)
#pragma unroll
                for (int m = 0; m < 4; ++m)
#pragma unroll
                    for (int n = 0; n < 2; ++n) acc[a][b][m][n] = (f32x4){0.f, 0.f, 0.f, 0.f};
        cA = nA; cB = nB; nt = nnt; ++ui;
        if constexpr (ALIGN_EPI) { if (wr == 1) PG8_BAR; }
    }
    PG8_WAIT_V(0);
    if constexpr (!ALIGN_EPI) { if (wr == 0) PG8_BAR; }
    PG8_BAR;
#undef PG8_SA
#undef PG8_SB
#undef PG8_STAGE
#undef PG8_LDA
#undef PG8_LDB
#undef PG8_MMA
#undef PG8_WAIT_V
#undef PG8_WAIT_L
#undef PG8_BAR
#undef PG8_SCHED
}

struct EpiProj {
    static constexpr bool PERM = true;
    bf16* proj; bf16* a2;
    __device__ __forceinline__ void operator()(const f32x4 (&acc)[2][2][4][2], const Unit& u, int wr, int wc, int fr, int fq) const {
        const int pn = u.pn; const bool gate = (pn >= 12 && pn < 20) || (pn >= 24 && pn < 28) || (pn >= 32); const bool isu = (pn >= 20 && pn < 24);
        const int row0 = u.pm * BM + wr * 64 + fr, col0 = pn * BM + wc * 32 + 8 * fq;
#pragma unroll
        for (int ai = 0; ai < 2; ++ai)
#pragma unroll
            for (int m = 0; m < 4; ++m) { const int row = row0 + ai * HALF + m * 16;
#pragma unroll
                for (int bj = 0; bj < 2; ++bj) { f32x4 v0 = acc[ai][bj][m][0], v1 = acc[ai][bj][m][1];
                    if (gate) {
#pragma unroll
                        for (int j = 0; j < 4; ++j) { v0[j] = silu_f(v0[j]); v1[j] = silu_f(v1[j]); } }
                    v4u w; w.x = cvt_pk_bf16(v0[0], v0[1]); w.y = cvt_pk_bf16(v0[2], v0[3]); w.z = cvt_pk_bf16(v1[0], v1[1]); w.w = cvt_pk_bf16(v1[2], v1[3]);
                    const int col = col0 + bj * HALF;
                    bf16* dst;
                    if (isu) { const int g = (col - OFF_U) >> 4, c0 = col & 15; dst = a2 + ((size_t)(g * 1024 + (row >> 4)) * 512 + (row & 15) * 16 + c0); }
                    else dst = proj + (size_t)row * INW + col;
                    *(v4u*)dst = w; } }
    }
};
struct EpiBf16 {
    static constexpr bool PERM = true;
    float scale;
    __device__ __forceinline__ void operator()(const f32x4 (&acc)[2][2][4][2], const Unit& u, int wr, int wc, int fr, int fq) const {
        bf16* base = (bf16*)u.c; const int ldc = u.ldc; const int row0 = wr * 64 + fr, col0 = wc * 32 + 8 * fq;
#pragma unroll
        for (int ai = 0; ai < 2; ++ai)
#pragma unroll
            for (int m = 0; m < 4; ++m) { bf16* rowp = base + (size_t)(row0 + ai * HALF + m * 16) * ldc + col0;
#pragma unroll
                for (int bj = 0; bj < 2; ++bj) { const f32x4 v0 = acc[ai][bj][m][0] * scale, v1 = acc[ai][bj][m][1] * scale;
                    v4u w; w.x = cvt_pk_bf16(v0[0], v0[1]); w.y = cvt_pk_bf16(v0[2], v0[3]); w.z = cvt_pk_bf16(v1[0], v1[1]); w.w = cvt_pk_bf16(v1[2], v1[3]);
                    *(v4u*)(rowp + bj * HALF) = w; } }
    }
};
struct EpiF32 {
    static constexpr bool PERM = false;
    __device__ __forceinline__ void operator()(const f32x4 (&acc)[2][2][4][2], const Unit& u, int wr, int wc, int fr, int fq) const {
        float* base = (float*)u.c; const int ldc = u.ldc; const int row0 = wr * 64 + fr, col0 = wc * 32 + 4 * fq;
#pragma unroll
        for (int ai = 0; ai < 2; ++ai)
#pragma unroll
            for (int m = 0; m < 4; ++m) { float* rowp = base + (size_t)(row0 + ai * HALF + m * 16) * ldc + col0;
#pragma unroll
                for (int bj = 0; bj < 2; ++bj)
#pragma unroll
                    for (int n = 0; n < 2; ++n) *(f32x4*)(rowp + bj * HALF + n * 16) = acc[ai][bj][m][n]; }
    }
};
struct EpiSsmY {
    static constexpr bool PERM = true;
    bf16* yssm;
    __device__ __forceinline__ void operator()(const f32x4 (&acc)[2][2][4][2], const Unit& u, int wr, int wc, int fr, int fq) const {
        const int row0 = u.z + wr * 64 + fr, col0 = wc * 32 + 8 * fq, g = u.pn;
#pragma unroll
        for (int ai = 0; ai < 2; ++ai)
#pragma unroll
            for (int m = 0; m < 4; ++m) { const int chunk = row0 + ai * HALF + m * 16;
#pragma unroll
                for (int bj = 0; bj < 2; ++bj) { const f32x4 v0 = acc[ai][bj][m][0], v1 = acc[ai][bj][m][1];
                    v4u w; w.x = cvt_pk_bf16(v0[0], v0[1]); w.y = cvt_pk_bf16(v0[2], v0[3]); w.z = cvt_pk_bf16(v1[0], v1[1]); w.w = cvt_pk_bf16(v1[2], v1[3]);
                    const int col = col0 + bj * HALF, i = col >> 4, c0 = col & 15;
                    *(v4u*)(yssm + (size_t)(chunk * 16 + i) * 1024 + g * 16 + c0) = w; } }
    }
};
struct EpiGlu {
    static constexpr bool PERM = true;
    const bf16* proj; bf16* mix;
    __device__ __forceinline__ void operator()(const f32x4 (&acc)[2][2][4][2], const Unit& u, int wr, int wc, int fr, int fq) const {
        const int row0 = u.pm * BM + wr * 64 + fr, col0 = u.pn * HALF + wc * 32 + 8 * fq;
#pragma unroll
        for (int ai = 0; ai < 2; ++ai)
#pragma unroll
            for (int m = 0; m < 4; ++m) { const int row = row0 + ai * HALF + m * 16;
                const v4u gs = *(const v4u*)(proj + (size_t)row * INW + OFF_GS + col0);
                const f32x4 a0 = acc[ai][0][m][0], a1 = acc[ai][0][m][1], g0 = acc[ai][1][m][0], g1 = acc[ai][1][m][1];
                float o[8];
#pragma unroll
                for (int j = 0; j < 4; ++j) { o[j] = a0[j] * sigmoid_f(g0[j]); o[4 + j] = a1[j] * sigmoid_f(g1[j]); }
                o[0] *= bf_lo(gs.x); o[1] *= bf_hi(gs.x); o[2] *= bf_lo(gs.y); o[3] *= bf_hi(gs.y); o[4] *= bf_lo(gs.z); o[5] *= bf_hi(gs.z); o[6] *= bf_lo(gs.w); o[7] *= bf_hi(gs.w);
                v4u w; w.x = cvt_pk_bf16(o[0], o[1]); w.y = cvt_pk_bf16(o[2], o[3]); w.z = cvt_pk_bf16(o[4], o[5]); w.w = cvt_pk_bf16(o[6], o[7]);
                *(v4u*)(mix + (size_t)row * DM + 2048 + col0) = w; }
    }
};
struct EpiFftW {
    static constexpr bool PERM = true;
    const bf16* proj; bf16* mix;
    __device__ __forceinline__ void operator()(const f32x4 (&acc)[2][2][4][2], const Unit& u, int wr, int wc, int fr, int fq) const {
        const int row0 = u.pm * BM + wr * 64 + fr, col0 = u.pn * BM + wc * 32 + 8 * fq;
#pragma unroll
        for (int ai = 0; ai < 2; ++ai)
#pragma unroll
            for (int m = 0; m < 4; ++m) { const int row = row0 + ai * HALF + m * 16;
#pragma unroll
                for (int bj = 0; bj < 2; ++bj) { const int col = col0 + bj * HALF;
                    const v4u gs = *(const v4u*)(proj + (size_t)row * INW + OFF_GF + col);
                    const f32x4 v0 = acc[ai][bj][m][0], v1 = acc[ai][bj][m][1];
                    v4u w; w.x = cvt_pk_bf16(v0[0] * bf_lo(gs.x), v0[1] * bf_hi(gs.x)); w.y = cvt_pk_bf16(v0[2] * bf_lo(gs.y), v0[3] * bf_hi(gs.y));
                    w.z = cvt_pk_bf16(v1[0] * bf_lo(gs.z), v1[1] * bf_hi(gs.z)); w.w = cvt_pk_bf16(v1[2] * bf_lo(gs.w), v1[3] * bf_hi(gs.w));
                    *(v4u*)(mix + (size_t)row * DM + 3072 + col) = w; } }
    }
};
struct EpiOut {
    static constexpr bool PERM = true;
    bf16* delta; const float* modl;
    __device__ __forceinline__ void operator()(const f32x4 (&acc)[2][2][4][2], const Unit& u, int wr, int wc, int fr, int fq) const {
        const int rt = u.pm * BM; const int v = rt < NCTX ? 0 : (rt < NCTX + 4096 ? 1 : 2);
        const float* gv = modl + v * 12288 + 8192;
        const int row0 = rt + wr * 64 + fr, col0 = u.pn * BM + wc * 32 + 8 * fq;
        f32x4 gt[2][2];
#pragma unroll
        for (int bj = 0; bj < 2; ++bj)
#pragma unroll
            for (int n = 0; n < 2; ++n) gt[bj][n] = *(const f32x4*)(gv + col0 + bj * HALF + n * 4);
#pragma unroll
        for (int ai = 0; ai < 2; ++ai)
#pragma unroll
            for (int m = 0; m < 4; ++m) { bf16* rowp = delta + (size_t)(row0 + ai * HALF + m * 16) * DM + col0;
#pragma unroll
                for (int bj = 0; bj < 2; ++bj) { const f32x4 v0 = acc[ai][bj][m][0] * gt[bj][0], v1 = acc[ai][bj][m][1] * gt[bj][1];
                    v4u w; w.x = cvt_pk_bf16(v0[0], v0[1]); w.y = cvt_pk_bf16(v0[2], v0[3]); w.z = cvt_pk_bf16(v1[0], v1[1]); w.w = cvt_pk_bf16(v1[2], v1[3]);
                    *(v4u*)(rowp + bj * HALF) = w; } }
    }
};
}

namespace att {
constexpr int D = 128, QBLK = 32, KVBLK = 64;
constexpr float SCALE = 0.088388347648318440f;
constexpr float THR = 8.f;
constexpr int SHM_V = KVBLK * D * 2, SHM_K = KVBLK * D * 2;
constexpr int WS_OFF = 2 * SHM_V + 2 * SHM_K, OSTG_OFF = WS_OFF + NWAVES * 64 * 4, OSTG_ROW = 272, OSTG_WAVE = 32 * OSTG_ROW;
static_assert(DEPTH >= 2, "the bf16 stream is first written by layer 1's norm phase");
static_assert(OSTG_OFF + NWAVES * OSTG_WAVE <= MISC_OFF, "attention LDS");
#define KSWZ(row, colB) ((row) * 256 + ((colB) ^ (((row) & 7) << 4)))
#define SBAR() __builtin_amdgcn_sched_barrier(0)
__device__ __forceinline__ int crow(int r, int hi) { return (r & 3) + 8 * (r >> 2) + 4 * hi; }
__device__ __forceinline__ void partialSM(f32x16& p0, f32x16& p1, float& m_reg, float& mn, float& alpha) {
  constexpr float C = SCALE * 1.4426950408889634f;
  float pmax = p0[0]; for (int r = 1; r < 16; ++r) pmax = fmaxf(pmax, p0[r]); for (int r = 0; r < 16; ++r) pmax = fmaxf(pmax, p1[r]);
  { auto rr = __builtin_amdgcn_permlane32_swap(__float_as_uint(pmax), __float_as_uint(pmax), false, false);
    pmax = fmaxf(__uint_as_float(rr[0]), __uint_as_float(rr[1])); }
  if (__builtin_expect(__all(pmax - m_reg <= THR / SCALE), 1)) { mn = m_reg; alpha = 1.f; }
  else { mn = fmaxf(m_reg, pmax); alpha = __builtin_amdgcn_exp2f((m_reg - mn) * C); m_reg = mn; }
  float mnC = -mn * C;
  for (int r = 0; r < 16; ++r) p0[r] = fmaf(p0[r], C, mnC); for (int r = 0; r < 16; ++r) p1[r] = fmaf(p1[r], C, mnC);
  for (int r = 0; r < 16; ++r) p0[r] = __builtin_amdgcn_exp2f(p0[r]);
}
__device__ __forceinline__ void finishSM(f32x16& p0, f32x16& p1, float alpha, float& l_reg, bf16x8& pa0, bf16x8& pa1, bf16x8& pa2, bf16x8& pa3) {
  for (int r = 0; r < 16; ++r) p1[r] = __builtin_amdgcn_exp2f(p1[r]);
  float ps = 0; for (int r = 0; r < 16; ++r) ps += p0[r]; for (int r = 0; r < 16; ++r) ps += p1[r];
  { auto rr = __builtin_amdgcn_permlane32_swap(__float_as_uint(ps), __float_as_uint(ps), false, false);
    ps = __uint_as_float(rr[0]) + __uint_as_float(rr[1]); }
  l_reg = l_reg * alpha + ps;
#define PK4(P, BASE, OUT) do { unsigned a0 = cvt_pk_bf16(P[BASE + 0], P[BASE + 1]), a1 = cvt_pk_bf16(P[BASE + 2], P[BASE + 3]);   \
    unsigned b0 = cvt_pk_bf16(P[BASE + 4], P[BASE + 5]), b1 = cvt_pk_bf16(P[BASE + 6], P[BASE + 7]);                              \
    auto r0 = __builtin_amdgcn_permlane32_swap(a0, b0, false, false); auto r1 = __builtin_amdgcn_permlane32_swap(a1, b1, false, false); \
    v4u w = {r0[0], r1[0], r0[1], r1[1]}; OUT = *reinterpret_cast<bf16x8*>(&w); } while (0)
  PK4(p0, 0, pa0); PK4(p0, 8, pa1); PK4(p1, 0, pa2); PK4(p1, 8, pa3);
#undef PK4
}
__device__ __forceinline__ void qkt(f32x16& p0, f32x16& p1, const char* Ks, const bf16x8* qr, int r32, int hi) {
  p0 = f32x16{}; p1 = f32x16{};
  for (int d0 = 0; d0 < 8; ++d0) { int cb = (d0 * 16 + hi * 8) * 2;
    bf16x8 b0 = *reinterpret_cast<const bf16x8*>(Ks + KSWZ(r32, cb));
    bf16x8 b1 = *reinterpret_cast<const bf16x8*>(Ks + KSWZ(32 + r32, cb));
    p0 = __builtin_amdgcn_mfma_f32_32x32x16_bf16(b0, qr[d0], p0, 0, 0, 0);
    p1 = __builtin_amdgcn_mfma_f32_32x32x16_bf16(b1, qr[d0], p1, 0, 0, 0); }
}
__device__ __forceinline__ int v_st(int k, int c) { const int kk = (k & ~0xC) | ((k & 4) << 1) | ((k & 8) >> 1); return ((kk >> 3) * 4 + (c >> 5)) * 512 + ((kk & 7) * 32 + (c & 31)) * 2; }
__device__ __forceinline__ int v_rd_base(int lane) { return ((lane & 3) << 3) | (((lane >> 2) & 3) << 6) | (((lane >> 4) & 1) << 5) | (((lane >> 5) & 1) << 8); }
constexpr int v_rd_off(int d0, int ks, int half) { return d0 * 512 + ks * 4096 + half * 2048; }
template <int OFF> __device__ __forceinline__ s16x4 tr_read(int vb) {
  s16x4 r; asm volatile("ds_read_b64_tr_b16 %0, %1 offset:%2" : "=&v"(r) : "v"(vb), "i"(OFF) : "memory"); return r;
}
template <int D0> __device__ __forceinline__ void pv_one(f32x16& od, int vb, bf16x8 pa0, bf16x8 pa1, bf16x8 pa2, bf16x8 pa3) {
  const s16x4 l0 = tr_read<v_rd_off(D0, 0, 0)>(vb), h0 = tr_read<v_rd_off(D0, 0, 1)>(vb), l1 = tr_read<v_rd_off(D0, 1, 0)>(vb), h1 = tr_read<v_rd_off(D0, 1, 1)>(vb);
  const s16x4 l2 = tr_read<v_rd_off(D0, 2, 0)>(vb), h2 = tr_read<v_rd_off(D0, 2, 1)>(vb), l3 = tr_read<v_rd_off(D0, 3, 0)>(vb), h3 = tr_read<v_rd_off(D0, 3, 1)>(vb);
  asm volatile("s_waitcnt lgkmcnt(0)" ::: "memory"); SBAR();
#define PK(L, H) (bf16x8){L[0], L[1], L[2], L[3], H[0], H[1], H[2], H[3]}
  od = __builtin_amdgcn_mfma_f32_32x32x16_bf16(pa0, PK(l0, h0), od, 0, 0, 0);
  od = __builtin_amdgcn_mfma_f32_32x32x16_bf16(pa1, PK(l1, h1), od, 0, 0, 0);
  od = __builtin_amdgcn_mfma_f32_32x32x16_bf16(pa2, PK(l2, h2), od, 0, 0, 0);
  od = __builtin_amdgcn_mfma_f32_32x32x16_bf16(pa3, PK(l3, h3), od, 0, 0, 0);
#undef PK
}
__device__ __forceinline__ void pv_d0(f32x16* o, int vb, bf16x8 pa0, bf16x8 pa1, bf16x8 pa2, bf16x8 pa3) {
  pv_one<0>(o[0], vb, pa0, pa1, pa2, pa3); pv_one<1>(o[1], vb, pa0, pa1, pa2, pa3); pv_one<2>(o[2], vb, pa0, pa1, pa2, pa3); pv_one<3>(o[3], vb, pa0, pa1, pa2, pa3);
}

__device__ __forceinline__ void attn_unit(const bf16* __restrict__ Qb, const bf16* __restrict__ Gb, bf16* __restrict__ Ob,
                                          const bf16* __restrict__ K0, const bf16* __restrict__ V0, int ld0, int nt0,
                                          const bf16* __restrict__ K1, const bf16* __restrict__ V1, int ld1, int nt1,
                                          const float* __restrict__ qn, const f32x2* __restrict__ rope, int tok0, char* lds, int wv) {
  const int tid = tid_of(wv);
  const int wid = tid >> 6, lane = tid & 63, r32 = lane & 31, hi = lane >> 5;
  char* V_lds = lds; char* K_lds = lds + 2 * SHM_V;
  float* ws = (float*)(lds + WS_OFF) + wid * 64; float* li_l = ws; float* al_l = ws + 32;
  float m_reg = -1e30f, l_reg = 0; f32x16 o[4] = {}; bf16x8 qr[8];
  const int sr = tid >> 4, sc = (tid & 15) * 8, vst0 = v_st(sr, sc), vst1 = v_st(32 + sr, sc);
  const int vb0 = (int)(uintptr_t)V_lds + v_rd_base(lane);
  struct { bf16x8 vs0, vs1, ks0, ks1; } sr_[2];
#define SLOAD(i, jt) do { const bf16* kb_; const bf16* vb_; long ld_; \
    if ((jt) < nt0) { kb_ = K0 + (long)(jt) * KVBLK * ld0; vb_ = V0 + (long)(jt) * KVBLK * ld0; ld_ = ld0; } else { kb_ = K1 + (long)((jt) - nt0) * KVBLK * ld1; vb_ = V1 + (long)((jt) - nt0) * KVBLK * ld1; ld_ = ld1; } \
    sr_[i].vs0 = *reinterpret_cast<const bf16x8*>(vb_ + (long)sr * ld_ + sc); sr_[i].vs1 = *reinterpret_cast<const bf16x8*>(vb_ + (long)(32 + sr) * ld_ + sc); \
    sr_[i].ks0 = *reinterpret_cast<const bf16x8*>(kb_ + (long)sr * ld_ + sc); sr_[i].ks1 = *reinterpret_cast<const bf16x8*>(kb_ + (long)(32 + sr) * ld_ + sc); } while (0)
  SLOAD(0, 0);
  __syncthreads();
  {
    const bf16* Qw = Qb + (long)(wid * QBLK + r32) * INW + hi * 8;
    float x[8][8]; float ss = 0.f;
#pragma unroll
    for (int d0 = 0; d0 < 8; ++d0) { const v4u raw = *reinterpret_cast<const v4u*>(Qw + d0 * 16);
      x[d0][0] = bf_lo(raw.x); x[d0][1] = bf_hi(raw.x); x[d0][2] = bf_lo(raw.y); x[d0][3] = bf_hi(raw.y); x[d0][4] = bf_lo(raw.z); x[d0][5] = bf_hi(raw.z); x[d0][6] = bf_lo(raw.w); x[d0][7] = bf_hi(raw.w);
#pragma unroll
      for (int j = 0; j < 8; ++j) ss += x[d0][j] * x[d0][j]; }
    { auto rr = __builtin_amdgcn_permlane32_swap(__float_as_uint(ss), __float_as_uint(ss), false, false); ss = __uint_as_float(rr[0]) + __uint_as_float(rr[1]); }
    const float rstd = rsqrtf(ss * (1.0f / 128.0f) + NORM_EPS);
#pragma unroll
    for (int d0 = 0; d0 < 8; ++d0) { const f32x4 w0 = *reinterpret_cast<const f32x4*>(qn + d0 * 16 + hi * 8), w1 = *reinterpret_cast<const f32x4*>(qn + d0 * 16 + hi * 8 + 4);
#pragma unroll
      for (int j = 0; j < 4; ++j) { x[d0][j] *= rstd * w0[j]; x[d0][4 + j] *= rstd * w1[j]; } }
    if (rope) {
      const int t = tok0 + wid * QBLK + r32, prow = t >> 6, pcol = t & 63;
#pragma unroll
      for (int half = 0; half < 2; ++half) { const f32x2* rp = rope + (half ? pcol : prow) * 32;
#pragma unroll
        for (int dd = 0; dd < 2; ++dd) { const int d0 = half * 4 + dd;
#pragma unroll
          for (int j = 0; j < 8; ++j) { const f32x2 cs = rp[dd * 16 + hi * 8 + j]; const float x1 = x[d0][j], x2 = x[d0 + 2][j];
            x[d0][j] = x1 * cs.x - x2 * cs.y; x[d0 + 2][j] = x1 * cs.y + x2 * cs.x; } } }
    }
#pragma unroll
    for (int d0 = 0; d0 < 8; ++d0) { v4u w = {cvt_pk_bf16(x[d0][0], x[d0][1]), cvt_pk_bf16(x[d0][2], x[d0][3]), cvt_pk_bf16(x[d0][4], x[d0][5]), cvt_pk_bf16(x[d0][6], x[d0][7])}; qr[d0] = *reinterpret_cast<bf16x8*>(&w); }
  }
#define SWRITE(b, i) do { *(bf16x8*)(V_lds + (b) * SHM_V + vst0) = sr_[i].vs0;          \
    *(bf16x8*)(V_lds + (b) * SHM_V + vst1) = sr_[i].vs1; int kc = sc * 2;               \
    *(bf16x8*)(K_lds + (b) * SHM_K + KSWZ(sr, kc)) = sr_[i].ks0;                       \
    *(bf16x8*)(K_lds + (b) * SHM_K + KSWZ(32 + sr, kc)) = sr_[i].ks1; } while (0)
#define SWAIT() asm volatile("s_waitcnt vmcnt(4)" ::: "memory")
#define RESC(a) do { if (__any((a) < 1.f)) { if (hi == 0) al_l[r32] = (a); asm volatile("s_waitcnt lgkmcnt(0)" ::: "memory"); \
    for (int d = 0; d < 4; ++d) for (int r = 0; r < 16; ++r) o[d][r] *= al_l[crow(r, hi)]; } } while (0)
  f32x16 pA0, pA1, pB0, pB1; float mnA, mnB, alA, alB; bf16x8 pa0, pa1, pa2, pa3; const int NT = nt0 + nt1;
  constexpr int SE = 0, SO = 1;
  asm volatile("s_waitcnt vmcnt(0)" ::: "memory"); SWRITE(0, SE); __syncthreads();
  qkt(pA0, pA1, K_lds, qr, r32, hi); partialSM(pA0, pA1, m_reg, mnA, alA);
  SLOAD(SO, 1); if (2 < NT) SLOAD(SE, 2);
  SWAIT(); SWRITE(1, SO); __syncthreads();
  for (int j = 1; j + 1 < NT; j += 2) {
    SBAR(); qkt(pB0, pB1, K_lds + SHM_K, qr, r32, hi);
    finishSM(pA0, pA1, alA, l_reg, pa0, pa1, pa2, pa3); SBAR();
    SLOAD(SO, j + 2); SBAR();
    pv_d0(o, vb0, pa0, pa1, pa2, pa3); partialSM(pB0, pB1, m_reg, mnB, alB);
    __syncthreads(); SWAIT(); SWRITE(0, SE);
    RESC(alB); __syncthreads();
    SBAR(); qkt(pA0, pA1, K_lds, qr, r32, hi);
    finishSM(pB0, pB1, alB, l_reg, pa0, pa1, pa2, pa3); SBAR();
    if (j + 3 < NT) SLOAD(SE, j + 3); SBAR();
    pv_d0(o, vb0 + SHM_V, pa0, pa1, pa2, pa3); partialSM(pA0, pA1, m_reg, mnA, alA);
    __syncthreads(); SWAIT(); SWRITE(1, SO);
    RESC(alA); __syncthreads();
  }
  SBAR(); qkt(pB0, pB1, K_lds + SHM_K, qr, r32, hi);
  finishSM(pA0, pA1, alA, l_reg, pa0, pa1, pa2, pa3); SBAR();
  pv_d0(o, vb0, pa0, pa1, pa2, pa3); partialSM(pB0, pB1, m_reg, mnB, alB);
  __syncthreads(); RESC(alB);
  finishSM(pB0, pB1, alB, l_reg, pa0, pa1, pa2, pa3); SBAR();
  pv_d0(o, vb0 + SHM_V, pa0, pa1, pa2, pa3);
  if (hi == 0) li_l[r32] = l_reg; asm volatile("s_waitcnt lgkmcnt(0)" ::: "memory");
  char* stg = lds + OSTG_OFF + wid * OSTG_WAVE;
  v4u gvv[8];
#pragma unroll
  for (int it = 0; it < 8; ++it) gvv[it] = *reinterpret_cast<const v4u*>(Gb + (long)(wid * QBLK + it * 4 + (lane >> 4)) * INW + (lane & 15) * 8);
#pragma unroll
  for (int r = 0; r < 16; ++r) { const int orow = crow(r, hi); const float rl = __builtin_amdgcn_rcpf(li_l[orow]);
#pragma unroll
    for (int d0 = 0; d0 < 4; ++d0) { const unsigned w = cvt_pk_bf16(o[d0][r] * rl, 0.f); *(bf16*)(stg + orow * OSTG_ROW + (d0 * 32 + r32) * 2) = (bf16)(w & 0xffffu); }
    if ((r & 3) == 3) asm volatile("" ::: "memory"); }
  asm volatile("s_waitcnt lgkmcnt(0)" ::: "memory");
#pragma unroll
  for (int it = 0; it < 8; ++it) { const int row = it * 4 + (lane >> 4), cc = (lane & 15) * 8;
    const v4u ov = *(const v4u*)(stg + row * OSTG_ROW + cc * 2);
    const v4u gv = gvv[it];
    v4u w; w.x = cvt_pk_bf16(bf_lo(ov.x) * bf_lo(gv.x), bf_hi(ov.x) * bf_hi(gv.x)); w.y = cvt_pk_bf16(bf_lo(ov.y) * bf_lo(gv.y), bf_hi(ov.y) * bf_hi(gv.y));
    w.z = cvt_pk_bf16(bf_lo(ov.z) * bf_lo(gv.z), bf_hi(ov.z) * bf_hi(gv.z)); w.w = cvt_pk_bf16(bf_lo(ov.w) * bf_lo(gv.w), bf_hi(ov.w) * bf_hi(gv.w));
    *reinterpret_cast<v4u*>(Ob + (long)(wid * QBLK + row) * DM + cc) = w; }
#undef SLOAD
#undef SWRITE
#undef SWAIT
#undef RESC
}
}

#define XB_TMO      128
#define XB_XCNT(j)  (256  + 64 * (j))
#define XB_XSUB(j)  (1280 + 64 * (j))
#define XB_XGEN(j)  (2304 + 64 * (j))
#define XB_TOP      3328
#define XB_TOPGEN   3392
#define XCD_BAR_WORDS 3456
#define XB_SPIN_CAP (1u << 18)
__device__ __forceinline__ unsigned xb_ld(unsigned* p)              { return __hip_atomic_load(p, __ATOMIC_RELAXED, __HIP_MEMORY_SCOPE_AGENT); }
__device__ __forceinline__ unsigned xb_add(unsigned* p, unsigned v) { return __hip_atomic_fetch_add(p, v, __ATOMIC_RELAXED, __HIP_MEMORY_SCOPE_AGENT); }
__device__ __forceinline__ unsigned xb_xcc_id() { return (unsigned)__builtin_amdgcn_s_getreg((3 << 11) | 20) & 0xFu; }
#define XB_SPIN(cond, bar) do { unsigned _sp = 0; while (cond) { __builtin_amdgcn_s_sleep(1); \
    if ((++_sp & 255u) == 0u) { if (xb_ld(&(bar)[XB_TMO])) break; if (_sp > XB_SPIN_CAP) { atomicAdd(&(bar)[XB_TMO], 1u); break; } } } } while (0)
struct XcdBarrier { unsigned* bar; unsigned x; volatile LAS unsigned* st; };
__device__ __forceinline__ XcdBarrier xcd_barrier_post(unsigned* bar, volatile LAS unsigned* st, int tid) {
    XcdBarrier b; b.bar = bar; b.x = xb_xcc_id(); b.st = st;
    if (tid == 0) (void)xb_add(&bar[XB_XCNT(b.x)], 1u);
    return b;
}
__device__ __forceinline__ void xcd_barrier_complete(unsigned* bar, unsigned x, unsigned& nloc, unsigned& nx) {
    const unsigned G = gridDim.x * gridDim.y * gridDim.z;
    unsigned sum, cnt, mine, sp = 0u;
    for (;;) {
        sum = 0u; cnt = 0u; mine = 0u;
#pragma nounroll
        for (unsigned j = 0; j < 16; ++j) { const unsigned c = xb_ld(&bar[XB_XCNT(j)]); sum += c; cnt += (c > 0u) ? 1u : 0u; mine = (j == x) ? c : mine; }
        if (sum == G) break;
        __builtin_amdgcn_s_sleep(1);
        if ((++sp & 255u) == 0u) { if (xb_ld(&bar[XB_TMO])) break; if (sp > XB_SPIN_CAP) { atomicAdd(&bar[XB_TMO], 1u); break; } }
    }
    nloc = mine > 0u ? mine : 1u; nx = cnt > 0u ? cnt : 1u;
}
__device__ __forceinline__ void xcd_barrier(const XcdBarrier& b, int wv) {
    asm volatile("s_waitcnt vmcnt(0)" ::: "memory");
    __syncthreads();
    if (tid_of(wv) == 0) {
        unsigned* bar = b.bar;
        __builtin_amdgcn_s_waitcnt(0);
        unsigned nloc = b.st[0], nx = b.st[1];
        if (nloc == 0u) { xcd_barrier_complete(bar, b.x, nloc, nx); b.st[0] = nloc; b.st[1] = nx; }
        const unsigned old = xb_add(&bar[XB_XSUB(b.x)], 1u);
        const unsigned gen = old / nloc;
        if (old + 1u == (gen + 1u) * nloc) {
            __builtin_amdgcn_fence(__ATOMIC_RELEASE, "agent");
            asm volatile("s_waitcnt vmcnt(0)" ::: "memory");
            const unsigned og = xb_add(&bar[XB_TOP], 1u);
            const unsigned tg = og / nx;
            if (og + 1u == (tg + 1u) * nx) xb_add(&bar[XB_TOPGEN], 1u);
            else XB_SPIN(xb_ld(&bar[XB_TOPGEN]) == tg, bar);
            __builtin_amdgcn_fence(__ATOMIC_ACQUIRE, "agent");
            xb_add(&bar[XB_XGEN(b.x)], 1u);
            asm volatile("s_waitcnt vmcnt(0)" ::: "memory");
        } else {
            XB_SPIN(xb_ld(&bar[XB_XGEN(b.x)]) == gen, bar);
            __builtin_amdgcn_fence(__ATOMIC_ACQUIRE, "agent");
            asm volatile("s_waitcnt vmcnt(0)" ::: "memory");
        }
    }
    __syncthreads();
}
__device__ __forceinline__ void wg_global_sync() {
    asm volatile("s_waitcnt vmcnt(0)" ::: "memory");
    __syncthreads();
    __builtin_amdgcn_fence(__ATOMIC_ACQUIRE, "agent");
    asm volatile("s_waitcnt vmcnt(0)" ::: "memory");
}

struct Args { const float* in[28]; float* out; unsigned char* ws; int ph_lo, ph_hi; };
typedef const __attribute__((address_space(4))) Args* KAP;
#define KA_HERE() KAP ka = (KAP)__builtin_amdgcn_kernarg_segment_ptr(); asm volatile("" : "+s"(ka))
enum { I_XP = 0, I_XS, I_CK, I_CV, I_SFR, I_SFI, I_SBR, I_SBI, I_C, I_CCTX, I_NG, I_WMOD, I_BMOD, I_WIN, I_QN, I_KN, I_LRE, I_LIM, I_LSTEP, I_BRE, I_BIM, I_CRE, I_CIM, I_DSKIP, I_WGLU, I_WFFT, I_WOUT, I_FNG };

__device__ __forceinline__ int glu_row(int n) { return n < 1024 ? ((n >> 7) * 256 + (n & 127)) : (((n - 1024) >> 7) * 256 + 128 + ((n - 1024) & 127)); }
template <bool GLU>
__device__ __forceinline__ void tr_item(const float* __restrict__ W, int K, int N, bf16* __restrict__ WT, LAS float* scr, int item, int lane) {
    const int nblk = N / 64, kb = item / nblk, nb = item % nblk, k0 = 64 * kb, n0 = 64 * nb;
#pragma unroll 8
    for (int i = 0; i < 64; ++i) scr[i * 65 + lane] = W[(size_t)(k0 + i) * N + n0 + lane];
    LDS_WAIT(); asm volatile("" ::: "memory");
    const int c = lane & 7;
#pragma unroll
    for (int j = 0; j < 8; ++j) { const int n = (lane >> 3) + 8 * j; const LAS float* s = scr + (8 * c) * 65 + n;
        v4u o; o.x = cvt_pk_bf16(s[0 * 65], s[1 * 65]); o.y = cvt_pk_bf16(s[2 * 65], s[3 * 65]); o.z = cvt_pk_bf16(s[4 * 65], s[5 * 65]); o.w = cvt_pk_bf16(s[6 * 65], s[7 * 65]);
        int nd = n0 + n; if (GLU) nd = glu_row(nd);
        *(v4u*)(WT + (size_t)nd * K + k0 + 8 * c) = o; }
    LDS_WAIT(); asm volatile("" ::: "memory");
}

__device__ __forceinline__ void ssm_matrices(KAP A, int l, int g, LAS unsigned char* lds, int tid) {
    LAS f32x2* pw = (LAS f32x2*)lds;
    LAS f32x2* bb = pw + 2 * 17 * 64;
    LAS f32x2* cc = bb + 2 * 64 * 16;
    LAS float* kk = (LAS float*)(cc + 2 * 16 * 64);
    if (tid < 128) {
        const int dir = tid >> 6, p = tid & 63, ig = (l * 2 + dir) * 64 + g;
        const float dt = expf(A->in[I_LSTEP][ig]);
        const float lr = A->in[I_LRE][(size_t)ig * 64 + p], li = A->in[I_LIM][(size_t)ig * 64 + p];
        for (int tau = 0; tau <= 16; ++tau) {
            const float mag = expf(lr * dt * (float)tau);
            const double turns = (double)li * (double)dt * (double)tau * 0.15915494309189535;
            const float fr = (float)(turns - rint(turns));
            pw[(dir * 17 + tau) * 64 + p] = (f32x2){mag * cospif(2.f * fr), mag * sinpif(2.f * fr)};
        }
        const f32x2 ab = pw[(dir * 17 + 1) * 64 + p];
        const float nr = ab.x - 1.0f, ni = ab.y, den = lr * lr + li * li;
        const float f_re = (nr * lr + ni * li) / den, f_im = (ni * lr - nr * li) / den;
        for (int c = 0; c < 16; ++c) { const float br = A->in[I_BRE][((size_t)ig * 64 + p) * 16 + c], bi = A->in[I_BIM][((size_t)ig * 64 + p) * 16 + c];
            bb[(dir * 64 + p) * 16 + c] = (f32x2){f_re * br - f_im * bi, f_re * bi + f_im * br}; }
        ((f32x2*)(A->ws + WS_A16))[(size_t)ig * 64 + p] = pw[(dir * 17 + 16) * 64 + p];
    }
    for (int idx = tid; idx < 2048; idx += 512) { const int dir = idx >> 10, c = (idx >> 6) & 15, p = idx & 63; const size_t gi = (((size_t)(l * 2 + dir) * 64 + g) * 16 + c) * 64 + p;
        cc[idx] = (f32x2){A->in[I_CRE][gi], A->in[I_CIM][gi]}; }
    __syncthreads();
    {
        const int dir = tid >> 8, tau = (tid >> 4) & 15, c = tid & 15;
        float accv[16];
#pragma unroll
        for (int j = 0; j < 16; ++j) accv[j] = 0.f;
        for (int p = 0; p < 64; ++p) { const f32x2 cv = cc[(dir * 16 + c) * 64 + p], pv = pw[(dir * 17 + tau) * 64 + p];
            const float wre = cv.x * pv.x - cv.y * pv.y, wim = cv.x * pv.y + cv.y * pv.x;
#pragma unroll
            for (int j = 0; j < 16; ++j) { const f32x2 bv = bb[(dir * 64 + p) * 16 + j]; accv[j] += wre * bv.x - wim * bv.y; } }
#pragma unroll
        for (int j = 0; j < 16; ++j) kk[((dir * 16 + tau) * 16 + c) * 16 + j] = accv[j];
    }
    __syncthreads();
    const int lg = l * 64 + g;
    bf16* Pm = (bf16*)(A->ws + WS_PMAT) + (size_t)lg * 256 * 256;
    for (int q = tid; q < 8192; q += 512) { const int R = q >> 5, col = (q & 31) * 8, s = col >> 4, c0 = col & 15, dir = R >> 7, reim = (R >> 6) & 1, p = R & 63, e = dir ? s : 15 - s;
        const f32x2 pv = pw[(dir * 17 + e) * 64 + p]; float v[8];
#pragma unroll
        for (int j = 0; j < 8; ++j) { const f32x2 bv = bb[(dir * 64 + p) * 16 + c0 + j]; v[j] = reim ? (pv.x * bv.y + pv.y * bv.x) : (pv.x * bv.x - pv.y * bv.y); }
        v4u w; w.x = cvt_pk_bf16(v[0], v[1]); w.y = cvt_pk_bf16(v[2], v[3]); w.z = cvt_pk_bf16(v[4], v[5]); w.w = cvt_pk_bf16(v[6], v[7]);
        *(v4u*)(Pm + (size_t)R * 256 + col) = w; }
    bf16* KGm = (bf16*)(A->ws + WS_KG) + (size_t)lg * 256 * 512;
    for (int q = tid; q < 16384; q += 512) { const int R = q >> 6, col = (q & 63) * 8, i = R >> 4, c = R & 15; float v[8];
        if (col < 256) { const int s = col >> 4, c0 = col & 15;
#pragma unroll
            for (int j = 0; j < 8; ++j) { const int cp = c0 + j; float x;
                if (s < i) x = kk[((0 * 16 + (i - s)) * 16 + c) * 16 + cp];
                else if (s > i) x = kk[((1 * 16 + (s - i)) * 16 + c) * 16 + cp];
                else { x = kk[((0 * 16 + 0) * 16 + c) * 16 + cp] + kk[((1 * 16 + 0) * 16 + c) * 16 + cp]; if (cp == c) x += A->in[I_DSKIP][l * 1024 + g * 16 + c]; }
                v[j] = x; }
        } else { const int k = col - 256, dir = k >> 7, reim = (k >> 6) & 1, p0 = k & 63, e = dir ? 16 - i : i + 1;
#pragma unroll
            for (int j = 0; j < 8; ++j) { const f32x2 cv = cc[(dir * 16 + c) * 64 + p0 + j], pv = pw[(dir * 17 + e) * 64 + p0 + j];
                v[j] = reim ? -(cv.x * pv.y + cv.y * pv.x) : (cv.x * pv.x - cv.y * pv.y); } }
        v4u w; w.x = cvt_pk_bf16(v[0], v[1]); w.y = cvt_pk_bf16(v[2], v[3]); w.z = cvt_pk_bf16(v[4], v[5]); w.w = cvt_pk_bf16(v[6], v[7]);
        *(v4u*)(KGm + (size_t)R * 512 + col) = w; }
    __syncthreads();
}

__device__ __forceinline__ void mod_unit(KAP A, int un, LAS unsigned char* lds, int tid, int wave, int lane) {
    LAS float* sl = (LAS float*)lds;
    LAS float* red = sl + 3 * 4096;
    const int l = un >> 6, nb = un & 63;
    for (int i = tid; i < 3 * 4096; i += 512) { const int v = i >> 12, k = i & 4095; const float x = v == 0 ? A->in[I_CCTX][k] : A->in[I_C][(v - 1) * 4096 + k]; sl[i] = x / (1.0f + expf(-x)); }
    __syncthreads();
    const int ln = lane < 48 ? lane : 47;
    const float* wp = A->in[I_WMOD] + ((size_t)l * 4096 + wave * 512) * 12288 + nb * 192 + ln * 4;
    f32x4 a0 = {0.f, 0.f, 0.f, 0.f}, a1 = a0, a2 = a0;
#pragma unroll 8
    for (int kq = 0; kq < 512; ++kq) { const f32x4 w = *(const f32x4*)(wp + (size_t)kq * 12288); const int k = wave * 512 + kq;
        a0 += sl[k] * w; a1 += sl[4096 + k] * w; a2 += sl[8192 + k] * w; }
    if (lane < 48) {
#pragma unroll
        for (int j = 0; j < 4; ++j) { red[(wave * 3 + 0) * 256 + lane * 4 + j] = a0[j]; red[(wave * 3 + 1) * 256 + lane * 4 + j] = a1[j]; red[(wave * 3 + 2) * 256 + lane * 4 + j] = a2[j]; } }
    __syncthreads();
    for (int i = tid; i < 768; i += 512) { const int v = i >> 8, col = i & 255; if (col < 192) { float s = 0.f;
#pragma unroll
        for (int w = 0; w < 8; ++w) s += red[(w * 3 + v) * 256 + col];
        ((float*)(A->ws + WS_MOD))[(size_t)(l * 3 + v) * 12288 + nb * 192 + col] = s + A->in[I_BMOD][l * 12288 + nb * 192 + col]; } }
    __syncthreads();
}

__device__ __forceinline__ void p0_prologue(KAP A, LAS unsigned char* lds, int G, int bx, int wv) {
    const int tid = tid_of(wv); const int lane = tid & 63, wave = __builtin_amdgcn_readfirstlane(tid >> 6);
    { LAS float* scr = (LAS float*)(lds + wave * 16640);
      const int gw = bx * NWAVES + wave, NGW = G * NWAVES;
      constexpr int I_IN = 64 * 144, I_OUT = 64 * 64, I_GLU = 16 * 32, I_FFT = 16 * 16, I_L = I_IN + I_OUT + I_GLU + I_FFT;
      for (int it = gw; it < 4 * I_L; it += NGW) { const int l = it / I_L; int r = it % I_L;
          if (r < I_IN) { tr_item<false>(A->in[I_WIN] + (size_t)l * 4096 * 9216, 4096, 9216, (bf16*)(A->ws + WS_WIN) + (size_t)l * 9216 * 4096, scr, r, lane); continue; } r -= I_IN;
          if (r < I_OUT) { tr_item<false>(A->in[I_WOUT] + (size_t)l * 4096 * 4096, 4096, 4096, (bf16*)(A->ws + WS_WOUT) + (size_t)l * 4096 * 4096, scr, r, lane); continue; } r -= I_OUT;
          if (r < I_GLU) { tr_item<true>(A->in[I_WGLU] + (size_t)l * 1024 * 2048, 1024, 2048, (bf16*)(A->ws + WS_WGLU) + (size_t)l * 2048 * 1024, scr, r, lane); continue; } r -= I_GLU;
          tr_item<false>(A->in[I_WFFT] + (size_t)l * 1024 * 1024, 1024, 1024, (bf16*)(A->ws + WS_WFFT) + (size_t)l * 1024 * 1024, scr, r, lane); }
    }
    __syncthreads();
    for (int un = bx; un < 256; un += G) mod_unit(A, un, lds, tid, wave, lane);
    const size_t gt = (size_t)bx * 512 + tid, NGT = (size_t)G * 512;
    { bf16* D2L = (bf16*)(A->ws + WS_D2L);
      LAS bf16* lut = (LAS bf16*)lds;
      for (int i = tid; i < 4096; i += 512) lut[i] = (bf16)(cvt_pk_bf16(cospif((float)i * (1.0f / 2048.0f)), 0.f) & 0xffffu);
      __syncthreads();
      for (size_t q = gt; q < (size_t)4096 * 1024; q += NGT) { const int k = (int)(q >> 10), K0 = (int)(q & 1023) * 8; unsigned h[8];
          const int sh = K0 < 4096 ? 0 : 1024;
#pragma unroll
          for (int j = 0; j < 8; ++j) { const int K = (K0 + j) & 4095; h[j] = lut[(k * K + sh) & 4095]; }
          v4u w; w.x = h[0] | (h[1] << 16); w.y = h[2] | (h[3] << 16); w.z = h[4] | (h[5] << 16); w.w = h[6] | (h[7] << 16);
          *(v4u*)(D2L + (size_t)k * 8192 + K0) = w; }
      __syncthreads(); }
    { bf16* D1 = (bf16*)(A->ws + WS_D1);
      for (size_t q = gt; q < (size_t)512 * 256; q += NGT) { const int mp = (int)(q >> 8), c = (int)(q & 255), m = mp & 255; const float x = (float)((m * c) & 255) * (1.0f / 128.0f);
          const float v = mp < 256 ? cospif(x) : sinpif(x); D1[q] = (bf16)(cvt_pk_bf16(v, 0.f) & 0xffffu); } }
    { bf16* D2C = (bf16*)(A->ws + WS_D2C);
      for (size_t q = gt; q < (size_t)256 * 512; q += NGT) { const int k = (int)(q >> 9), K = (int)(q & 511); const float x = (float)((k * (K & 255)) & 255) * (1.0f / 128.0f);
          const float v = K < 256 ? cospif(x) : -sinpif(x); D2C[q] = (bf16)(cvt_pk_bf16(v, 0.f) & 0xffffu); } }
    { f32x2* rope = (f32x2*)(A->ws + WS_ROPE);
      for (size_t q = gt; q < 64 * 32; q += NGT) { const int pos = (int)(q >> 5), i = (int)(q & 31); const float inv = exp2f(-(float)i * (13.287712379549449f / 32.0f));
          const double turns = (double)pos * (double)inv * 0.15915494309189535; const float fr = (float)(turns - rint(turns));
          rope[q] = (f32x2){cospif(2.f * fr), sinpif(2.f * fr)}; } }
    { const size_t n8 = (size_t)2 * 4 * 512 * 512 / 8;
      for (size_t q = gt; q < 2 * n8; q += NGT) { const bool isk = q < n8; const size_t j = isk ? q : q - n8; const float* src = (isk ? A->in[I_CK] : A->in[I_CV]) + j * 8;
          const f32x4 x0 = *(const f32x4*)src, x1 = *(const f32x4*)(src + 4);
          v4u w; w.x = cvt_pk_bf16(x0[0], x0[1]); w.y = cvt_pk_bf16(x0[2], x0[3]); w.z = cvt_pk_bf16(x1[0], x1[1]); w.w = cvt_pk_bf16(x1[2], x1[3]);
          *(v4u*)((bf16*)(A->ws + (isk ? WS_CK : WS_CV)) + j * 8) = w; } }
    __syncthreads();
    for (int lg = bx; lg < 256; lg += G) ssm_matrices(A, lg >> 6, lg & 63, lds, tid);
}

__device__ __forceinline__ f32x4 ldg16(const void* base, unsigned off, int imm) { return *(const f32x4*)(((const char*)base + off) + imm); }
__device__ __forceinline__ void pa_norm(KAP A, int l, int bx, int G, int tid, LAS unsigned char* lds) {
    const float* mod = (const float*)(A->ws + WS_MOD) + (size_t)l * 3 * 12288;
    const f32x4* ng4 = (const f32x4*)(A->in[I_NG] + l * DM);
    bf16* H = (bf16*)(A->ws + WS_H);
    const int lane = tid & 63, wave = __builtin_amdgcn_readfirstlane(tid >> 6);
    const unsigned lo2 = (unsigned)lane * 16u, lo4 = (unsigned)lane * 32u;
    LAS f32x4* avl = (LAS f32x4*)lds; LAS f32x4* svl = avl + 1024;
    for (int rb = bx; rb < NTOK / 64; rb += G) {
        const int m0 = rb * 64; const int v = m0 < NCTX ? 0 : (m0 < NCTX + 4096 ? 1 : 2);
        const f32x4* sh4 = (const f32x4*)(mod + v * 12288); const f32x4* sc4 = (const f32x4*)(mod + v * 12288 + 4096);
        __syncthreads();
        for (int i = tid; i < 1024; i += NWAVES * 64) { const int d = ((i >> 7) * 2 + (i & 1)) * 64 + ((i & 127) >> 1);
            avl[d] = ng4[i] * (sc4[i] + 1.0f); svl[d] = sh4[i]; }
        __syncthreads();
#pragma unroll 2
        for (int r = 0; r < 8; ++r) { const int m = m0 + wave * 8 + r;
            f32x4 x[16]; float ss = 0.f;
            char* xb = (char*)((bf16*)(A->ws + ((l & 1) ? WS_XBF2 : WS_XBF)) + (size_t)m * DM);
            const char* xbi = (const char*)((const bf16*)(A->ws + ((l & 1) ? WS_XBF : WS_XBF2)) + (size_t)m * DM);
            if (l <= 1) { const float* xr = m < NCTX ? A->in[I_XP] + (size_t)m * DM : A->in[I_XS] + (size_t)(m - NCTX) * DM;
#pragma unroll
                for (int j = 0; j < 8; ++j) { x[2 * j] = ldg16(xr, lo4 + (j >> 1) * 4096u, (j & 1) * 2048); x[2 * j + 1] = ldg16(xr, lo4 + (j >> 1) * 4096u, (j & 1) * 2048 + 16); }
            } else {
#pragma unroll
                for (int j = 0; j < 8; ++j) { const v4u d = *(const v4u*)((xbi + (lo2 + (j >> 2) * 4096u)) + (j & 3) * 1024);
                    x[2 * j] = (f32x4){bf_lo(d.x), bf_hi(d.x), bf_lo(d.y), bf_hi(d.y)}; x[2 * j + 1] = (f32x4){bf_lo(d.z), bf_hi(d.z), bf_lo(d.w), bf_hi(d.w)}; }
            }
            if (l > 0) {
                const char* dr = (const char*)((const bf16*)(A->ws + ((l & 1) ? WS_DELTA : WS_DELTA2)) + (size_t)m * DM);
#pragma unroll
                for (int j = 0; j < 8; ++j) { const v4u d = *(const v4u*)((dr + (lo2 + (j >> 2) * 4096u)) + (j & 3) * 1024);
                    x[2 * j] += (f32x4){bf_lo(d.x), bf_hi(d.x), bf_lo(d.y), bf_hi(d.y)}; x[2 * j + 1] += (f32x4){bf_lo(d.z), bf_hi(d.z), bf_lo(d.w), bf_hi(d.w)};
                    v4u w; w.x = cvt_pk_bf16(x[2 * j].x, x[2 * j].y); w.y = cvt_pk_bf16(x[2 * j].z, x[2 * j].w); w.z = cvt_pk_bf16(x[2 * j + 1].x, x[2 * j + 1].y); w.w = cvt_pk_bf16(x[2 * j + 1].z, x[2 * j + 1].w);
                    *(v4u*)((xb + (lo2 + (j >> 2) * 4096u)) + (j & 3) * 1024) = w; }
            }
#pragma unroll
            for (int j = 0; j < 16; ++j) ss += (x[j].x * x[j].x + x[j].y * x[j].y) + (x[j].z * x[j].z + x[j].w * x[j].w);
            const float rstd = rsqrtf(wave_sum(ss, lane) * (1.0f / DM) + NORM_EPS);
            char* orow = (char*)(H + (size_t)m * DM);
#pragma unroll
            for (int j = 0; j < 8; ++j) { const f32x4 y0 = x[2 * j] * rstd * avl[(2 * j) * 64 + lane] + svl[(2 * j) * 64 + lane], y1 = x[2 * j + 1] * rstd * avl[(2 * j + 1) * 64 + lane] + svl[(2 * j + 1) * 64 + lane];
                v4u w; w.x = cvt_pk_bf16(y0.x, y0.y); w.y = cvt_pk_bf16(y0.z, y0.w); w.z = cvt_pk_bf16(y1.x, y1.y); w.w = cvt_pk_bf16(y1.z, y1.w);
                *(v4u*)((orow + (lo2 + (j >> 2) * 4096u)) + (j & 3) * 1024) = w;
                if ((j & 1) == 1) asm volatile("" ::: "memory"); }
        }
    }
    __syncthreads();
}
__device__ __forceinline__ void final_norm(KAP A, int gw, int NGW, int lane) {
    const float* fg = A->in[I_FNG];
    const unsigned lo2 = (unsigned)lane * 16u, lo4 = (unsigned)lane * 32u;
    f32x4 gv[16];
#pragma unroll
    for (int j = 0; j < 8; ++j) { gv[2 * j] = ldg16(fg, lo4 + (j >> 1) * 4096u, (j & 1) * 2048); gv[2 * j + 1] = ldg16(fg, lo4 + (j >> 1) * 4096u, (j & 1) * 2048 + 16); }
    for (int ci = gw; ci < NTOK / 8; ci += NGW) {
#pragma unroll 2
        for (int r = 0; r < 8; ++r) { const int m = ci * 8 + r;
            char* xr = (char*)(A->out + (size_t)m * DM);
            const char* xs = (const char*)((const bf16*)(A->ws + (((DEPTH - 1) & 1) ? WS_XBF2 : WS_XBF)) + (size_t)m * DM);
            const char* dr = (const char*)((const bf16*)(A->ws + (((DEPTH - 1) & 1) ? WS_DELTA2 : WS_DELTA)) + (size_t)m * DM);
            f32x4 x[16]; float ss = 0.f;
#pragma unroll
            for (int j = 0; j < 8; ++j) { const v4u xv = *(const v4u*)((xs + (lo2 + (j >> 2) * 4096u)) + (j & 3) * 1024); const v4u d = *(const v4u*)((dr + (lo2 + (j >> 2) * 4096u)) + (j & 3) * 1024);
                x[2 * j] = (f32x4){bf_lo(xv.x) + bf_lo(d.x), bf_hi(xv.x) + bf_hi(d.x), bf_lo(xv.y) + bf_lo(d.y), bf_hi(xv.y) + bf_hi(d.y)};
                x[2 * j + 1] = (f32x4){bf_lo(xv.z) + bf_lo(d.z), bf_hi(xv.z) + bf_hi(d.z), bf_lo(xv.w) + bf_lo(d.w), bf_hi(xv.w) + bf_hi(d.w)}; }
#pragma unroll
            for (int j = 0; j < 16; ++j) ss += (x[j].x * x[j].x + x[j].y * x[j].y) + (x[j].z * x[j].z + x[j].w * x[j].w);
            const float rstd = rsqrtf(wave_sum(ss, lane) * (1.0f / DM) + NORM_EPS);
#pragma unroll
            for (int j = 0; j < 8; ++j) { *(f32x4*)((xr + (lo4 + (j >> 1) * 4096u)) + (j & 1) * 2048) = x[2 * j] * rstd * gv[2 * j]; *(f32x4*)((xr + (lo4 + (j >> 1) * 4096u)) + (j & 1) * 2048 + 16) = x[2 * j + 1] * rstd * gv[2 * j + 1];
                if ((j & 1) == 1) asm volatile("" ::: "memory"); }
        }
    }
}

__device__ __forceinline__ void kv_prep(KAP A, int l, int gw, int NGW, int lane) {
    const bf16* PROJ = (const bf16*)(A->ws + WS_PROJ);
    const f32x2* rope = (const f32x2*)(A->ws + WS_ROPE);
    const int hl = lane & 15;
    const f32x4 kn0 = *(const f32x4*)(A->in[I_KN] + l * 128 + hl * 8), kn1 = *(const f32x4*)(A->in[I_KN] + l * 128 + hl * 8 + 4);
    for (int ci = gw; ci < NTOK / 4; ci += NGW) {
        const int m0 = ci * 4; const bool ctx = m0 < NCTX;
        v4u kr[4], vr[4];
#pragma unroll
        for (int r = 0; r < 4; ++r) { const bf16* pr = PROJ + (size_t)(m0 + r) * INW; kr[r] = *(const v4u*)(pr + OFF_K + 8 * lane); vr[r] = *(const v4u*)(pr + OFF_V + 8 * lane); }
#pragma unroll
        for (int r = 0; r < 4; ++r) { const int m = m0 + r;
            float k[8] = {bf_lo(kr[r].x), bf_hi(kr[r].x), bf_lo(kr[r].y), bf_hi(kr[r].y), bf_lo(kr[r].z), bf_hi(kr[r].z), bf_lo(kr[r].w), bf_hi(kr[r].w)};
            float ss = 0.f;
#pragma unroll
            for (int j = 0; j < 8; ++j) ss += k[j] * k[j];
            ss += shflx(ss, lane, 1); ss += shflx(ss, lane, 2); ss += shflx(ss, lane, 4); ss += shflx(ss, lane, 8);
            const float rstd = rsqrtf(ss * (1.0f / 128.0f) + NORM_EPS);
#pragma unroll
            for (int j = 0; j < 4; ++j) { k[j] *= rstd * kn0[j]; k[4 + j] *= rstd * kn1[j]; }
            if (ctx) {
                const int b = m >> 8, t = m & 255; const size_t oi = (((size_t)(b * 4 + l) * 256 + t) * 512 + 8 * lane);
                float* ok = A->out + OUT_NEWK + oi; *(f32x4*)ok = (f32x4){k[0], k[1], k[2], k[3]}; *(f32x4*)(ok + 4) = (f32x4){k[4], k[5], k[6], k[7]};
                float* ov = A->out + OUT_NEWV + oi; *(f32x4*)ov = (f32x4){bf_lo(vr[r].x), bf_hi(vr[r].x), bf_lo(vr[r].y), bf_hi(vr[r].y)}; *(f32x4*)(ov + 4) = (f32x4){bf_lo(vr[r].z), bf_hi(vr[r].z), bf_lo(vr[r].w), bf_hi(vr[r].w)};
            } else {
                const int t = (m - NCTX) & 4095, pos = hl < 8 ? (t >> 6) : (t & 63); const f32x2* rp = rope + pos * 32 + (lane & 3) * 8; const bool first = (lane & 4) == 0;
#pragma unroll
                for (int j = 0; j < 8; ++j) { const float other = shflx(k[j], lane, 4); const f32x2 cs = rp[j];
                    k[j] = first ? (k[j] * cs.x - other * cs.y) : (other * cs.y + k[j] * cs.x); }
            }
            v4u w; w.x = cvt_pk_bf16(k[0], k[1]); w.y = cvt_pk_bf16(k[2], k[3]); w.z = cvt_pk_bf16(k[4], k[5]); w.w = cvt_pk_bf16(k[6], k[7]);
            *(v4u*)((bf16*)(A->ws + WS_KC) + (size_t)m * 512 + 8 * lane) = w;
            *(v4u*)((bf16*)(A->ws + WS_VC) + (size_t)m * 512 + 8 * lane) = vr[r];
        }
    }
}

__device__ __forceinline__ void ssm_scan(KAP A, int l, int g, int mt, int tid, LAS unsigned char* lds) {
    const float* S = (const float*)(A->ws + WS_SBUF) + (size_t)g * 1024 * 256;
    bf16* A2 = (bf16*)(A->ws + WS_A2) + (size_t)g * 1024 * 512;
    const int blk = tid >> 5, sub = tid & 31, dir = sub >> 4, p0 = (sub & 15) * 4;
    f32x4 ar, ai;
    { const f32x4* a4 = (const f32x4*)((const float*)(A->ws + WS_A16) + (((size_t)(l * 2 + dir) * 64 + g) * 64 + p0) * 2); const f32x4 t0 = a4[0], t1 = a4[1];
      ar = (f32x4){t0.x, t0.z, t1.x, t1.z}; ai = (f32x4){t0.y, t0.w, t1.y, t1.w}; }
    const int ecol = 256 + dir * 128 + p0, scol = dir * 128 + p0;
    LAS f32x4* T = (LAS f32x4*)lds;
    LAS f32x4* EB = T + 16 * 32 * 2;
    const bool lat = mt >= 2;
    const int rb = mt * 256 + blk * 16;
    f32x4 sr[16], si[16];
#pragma unroll
    for (int i = 0; i < 16; ++i) { const int row = rb + (dir ? 15 - i : i); sr[i] = *(const f32x4*)(S + (size_t)row * 256 + scol); si[i] = *(const f32x4*)(S + (size_t)row * 256 + scol + 64); }
    f32x4 er = {0.f, 0.f, 0.f, 0.f}, ei = er;
    if (lat) {
#pragma unroll
        for (int i = 0; i < 16; ++i) { const f32x4 nr = ar * er - ai * ei + sr[i], ni = ar * ei + ai * er + si[i]; er = nr; ei = ni; }
        T[(blk * 32 + sub) * 2] = er; T[(blk * 32 + sub) * 2 + 1] = ei;
        __syncthreads();
        if (tid < 32) { const int b = mt - 2; const size_t si0 = (((size_t)b * 4 + l) * 64 + g) * 64 + p0;
            f32x4 cr = *(const f32x4*)(A->in[dir ? I_SBR : I_SFR] + si0), ci = *(const f32x4*)(A->in[dir ? I_SBI : I_SFI] + si0);
            f32x4 qr = ar, qi = ai;
#pragma unroll
            for (int k = 0; k < 4; ++k) { const f32x4 t = qr * qr - qi * qi; qi = 2.f * qr * qi; qr = t; }
#pragma unroll 1
            for (int jb = 0; jb < 16; ++jb) { const int bb = dir ? 15 - jb : jb; EB[(bb * 32 + sub) * 2] = cr; EB[(bb * 32 + sub) * 2 + 1] = ci;
                const f32x4 tr = T[(bb * 32 + sub) * 2], ti = T[(bb * 32 + sub) * 2 + 1];
                const f32x4 nr = qr * cr - qi * ci + tr, ni = qr * ci + qi * cr + ti; cr = nr; ci = ni; } }
        __syncthreads();
        er = EB[(blk * 32 + sub) * 2]; ei = EB[(blk * 32 + sub) * 2 + 1];
    }
#pragma unroll
    for (int i = 0; i < 16; ++i) { const int row = rb + (dir ? 15 - i : i);
        v2u wr, wi; wr.x = cvt_pk_bf16(er.x, er.y); wr.y = cvt_pk_bf16(er.z, er.w); wi.x = cvt_pk_bf16(ei.x, ei.y); wi.y = cvt_pk_bf16(ei.z, ei.w);
        *(v2u*)(A2 + (size_t)row * 512 + ecol) = wr; *(v2u*)(A2 + (size_t)row * 512 + ecol + 64) = wi;
        const f32x4 nr = ar * er - ai * ei + sr[i], ni = ar * ei + ai * er + si[i]; er = nr; ei = ni; }
    if (!lat) { const int b = mt * 16 + blk; const size_t oi = (((size_t)b * 4 + l) * 64 + g) * 64 + p0;
        *(f32x4*)(A->out + (dir ? OUT_BRE : OUT_FRE) + oi) = er; *(f32x4*)(A->out + (dir ? OUT_BIM : OUT_FIM) + oi) = ei; }
}
__device__ __forceinline__ void ssm_step1(KAP A, int l, int un, LAS unsigned char* lds, int wv) {
    const int g = un >> 2, mt = un & 3, lg = l * 64 + g;
    pg8::OneUnit S1; S1.u0.a = (const char*)(A->ws + WS_A2) + ((size_t)g * 1024 + mt * 256) * 512 * 2; S1.u0.b = (const char*)(A->ws + WS_PMAT) + (size_t)lg * 256 * 256 * 2;
    S1.u0.c = (char*)(A->ws + WS_SBUF) + ((size_t)g * 1024 + mt * 256) * 256 * 4; S1.u0.ldc = 256; S1.u0.pm = mt; S1.u0.pn = g; S1.u0.z = 0; S1.u0.kt = 4;
    pg8::EpiF32 E; pg8::gemm_phase<pg8::EpiF32, pg8::OneUnit>(lds, wv, 512, 256, S1, E);
}
__device__ __forceinline__ void ssm_step2(KAP A, int l, int un, LAS unsigned char* lds, int wv) {
    const int g = un >> 2, mt = un & 3; const int tid = tid_of(wv); ssm_scan(A, l, g, mt, tid, lds);
}
__device__ __forceinline__ void ssm_step3(KAP A, int l, int un, LAS unsigned char* lds, int wv) {
    const int g = un >> 2, mt = un & 3, lg = l * 64 + g;
    pg8::OneUnit S2; S2.u0.a = (const char*)(A->ws + WS_A2) + ((size_t)g * 1024 + mt * 256) * 512 * 2; S2.u0.b = (const char*)(A->ws + WS_KG) + (size_t)lg * 256 * 512 * 2;
    S2.u0.c = nullptr; S2.u0.ldc = 0; S2.u0.pm = mt; S2.u0.pn = g; S2.u0.z = mt * 256; S2.u0.kt = 8;
    pg8::EpiSsmY E{(bf16*)(A->ws + WS_YSSM)}; pg8::gemm_phase<pg8::EpiSsmY, pg8::OneUnit>(lds, wv, 512, 512, S2, E);
}

struct Fft1Order {
    int G, c; const char* D1; const char* proj; char* z1l; char* z1c;
    __device__ bool next(int i, pg8::Unit& u) const { const int L = i * G + c; if (L >= 512) return false;
        const int cs = L & 1, g = (L >> 1) & 3, tt = L >> 3;
        u.kt = 4; u.a = D1 + (size_t)cs * 256 * 256 * 2; u.b = proj + ((size_t)tt * 256 * INW + OFF_F + g * 256) * 2; u.pm = cs; u.pn = tt; u.z = g;
        if (tt < 32) { u.c = z1c + (((size_t)tt * 1024 + g * 256) * 512 + cs * 256) * 2; u.ldc = 512; }
        else { const int b = (tt - 32) >> 4, t0 = ((tt - 32) & 15) * 256; u.c = z1l + (((size_t)b * 1024 + g * 256) * 8192 + cs * 4096 + t0) * 2; u.ldc = 8192; }
        return true; }
};
struct Fft2LOrder {
    int G, c; const char* D2; const char* z1; char* mixed;
    __device__ bool next(int i, pg8::Unit& u) const { const int L = i * G + c; if (L >= 128) return false;
        const int nt = L & 3, mt = (L >> 2) & 15, b = L >> 6;
        u.kt = 128; u.a = D2 + (size_t)mt * 256 * 8192 * 2; u.b = z1 + ((size_t)b * 1024 + nt * 256) * 8192 * 2; u.pm = mt; u.pn = nt; u.z = b;
        u.c = mixed + (((size_t)NCTX + b * 4096 + mt * 256) * 1024 + nt * 256) * 2; u.ldc = 1024; return true; }
};
struct Fft2COrder {
    int G, c; const char* D2; const char* z1; char* mixed;
    __device__ bool next(int i, pg8::Unit& u) const { const int L = i * G + c; if (L >= 128) return false;
        const int nt = L & 3, b = L >> 2;
        u.kt = 8; u.a = D2; u.b = z1 + ((size_t)b * 1024 + nt * 256) * 512 * 2; u.pm = 0; u.pn = nt; u.z = b;
        u.c = mixed + (((size_t)b * 256) * 1024 + nt * 256) * 2; u.ldc = 1024; return true; }
};

__global__ void __launch_bounds__(NWAVES * 64, 2) hymba_fwd(Args args) {
    extern __shared__ __attribute__((aligned(16))) unsigned char lds_raw[];
    LAS unsigned char* lds = (LAS unsigned char*)lds_raw;
    volatile LAS unsigned* MISC = (volatile LAS unsigned*)(lds + MISC_OFF);
    const int G = gridDim.x, bx = blockIdx.x;
    const int wv = __builtin_amdgcn_readfirstlane(threadIdx.x >> 6);
#define TID_HERE() const int tid = tid_of(wv); const int lane = tid & 63, wave = __builtin_amdgcn_readfirstlane(tid >> 6), gw = bq * NWAVES + wave, NGWq = Gq * NWAVES; (void)lane; (void)gw; (void)NGWq
#define PH_IDS() int Gq = G, bq = bx; asm volatile("" : "+s"(Gq), "+s"(bq))
    for (int u = tid_of(wv); u < (LDS_BYTES - MISC_OFF) / 4; u += NWAVES * 64) ((LAS unsigned*)(lds + MISC_OFF))[u] = 0u;
    __syncthreads();
    int lo, hi; XcdBarrier bar;
    { KA_HERE(); PH_IDS(); lo = ka->ph_lo; hi = ka->ph_hi; unsigned* ctl = (unsigned*)(ka->ws + WS_CTL);
      bar.bar = ctl + CW_BAR; bar.x = 0; bar.st = nullptr;
      if (hi - lo > 1) bar = xcd_barrier_post(ctl + CW_BAR, MISC + 8, tid_of(wv)); }
#define IN(k) (lo <= (k) && (k) < hi)
#define SEAM(k) do { if (IN(k) && IN((k) + 1)) { xcd_barrier(bar, wv); if (((DUP_MASK) >> 12) & 1) xcd_barrier(bar, wv); } } while (0)

    if (IN(0)) DUP(0) { KA_HERE(); PH_IDS(); p0_prologue(ka, lds, Gq, bq, wv); }
    SEAM(0);

    for (int l = 0; l < DEPTH; ++l) for (int lrep_ = 0; lrep_ < 1 + (((DUP_MASK) >> 19) & 1); ++lrep_) {
        const int pb = 1 + 6 * l;
        if (IN(pb)) DUP(1) { KA_HERE(); PH_IDS(); TID_HERE(); pa_norm(ka, l, bq, Gq, tid, lds);
        }
        SEAM(pb);
        if (IN(pb + 1)) DUP(2) {
            KA_HERE(); PH_IDS(); unsigned char* ws = ka->ws;
            pg8::GemmOrder S; S.init(NTOK, INW, Gq, bq, ws + WS_H, DM, ws + WS_WIN + (size_t)l * INW * DM * 2, DM, DM);
            pg8::EpiProj E{(bf16*)(ws + WS_PROJ), (bf16*)(ws + WS_A2)};
            pg8::gemm_phase<pg8::EpiProj, pg8::GemmOrder, GEMM1_ALIGN>(lds, wv, DM, DM, S, E);
        }
        SEAM(pb + 1);
        if (IN(pb + 2)) {
            DUP(16) for (int un = bx; un < 256; un += G) { KA_HERE(); ssm_step1(ka, l, un, lds, wv); }
            DUP(14) { KA_HERE(); PH_IDS(); TID_HERE(); kv_prep(ka, l, gw, NGWq, lane); }
            wg_global_sync();
            DUP(17) { for (int un = bx; un < 256; un += G) { KA_HERE(); ssm_step2(ka, l, un, lds, wv); } __syncthreads(); }
            DUP(3) { KA_HERE(); PH_IDS(); unsigned char* ws = ka->ws;
              Fft1Order S{Gq, bq, (const char*)(ws + WS_D1), (const char*)(ws + WS_PROJ), (char*)(ws + WS_Z1L), (char*)(ws + WS_Z1C)};
              pg8::EpiBf16 E{1.0f}; pg8::gemm_phase<pg8::EpiBf16, Fft1Order>(lds, wv, 256, INW, S, E); }
            wg_global_sync();
            DUP(18) for (int un = bx; un < 256; un += G) { KA_HERE(); ssm_step3(ka, l, un, lds, wv); }
        }
        SEAM(pb + 2);
        if (IN(pb + 3)) {
            DUP(5) for (int U = bx; U < 512; U += G) {
                KA_HERE(); PH_IDS(); unsigned char* ws = ka->ws; bf16* const PROJ = (bf16*)(ws + WS_PROJ); bf16* const MIX = (bf16*)(ws + WS_MIX);
                const float* qn = ka->in[I_QN] + l * 128; const f32x2* rope = (const f32x2*)(ws + WS_ROPE);
                const int pr = U & 7, idx = U >> 3, b = pr >> 2, kvh = pr & 3, hq = kvh * 4 + (idx >> 4), qb = idx & 15;
                const size_t row0 = (size_t)NCTX + b * 4096 + qb * 256;
                const bf16* ck = (const bf16*)(ws + WS_CK) + ((size_t)(b * 4 + l) * 512) * 512 + kvh * 128;
                const bf16* cv = (const bf16*)(ws + WS_CV) + ((size_t)(b * 4 + l) * 512) * 512 + kvh * 128;
                const bf16* k1 = (const bf16*)(ws + WS_KC) + ((size_t)NCTX + b * 4096) * 512 + kvh * 128; const bf16* v1 = (const bf16*)(ws + WS_VC) + ((size_t)NCTX + b * 4096) * 512 + kvh * 128;
                att::attn_unit(PROJ + row0 * INW + hq * 128, PROJ + row0 * INW + OFF_GA + hq * 128, MIX + row0 * DM + hq * 128,
                               ck, cv, 512, 8, k1, v1, 512, 64, qn, rope, qb * 256, (char*)lds_raw, wv);
            }
            if (bx >= (G >> 1)) {
                const int nB = G - (G >> 1), cB = bx - (G >> 1);
                DUP(6) for (int U = cB; U < 512; U += nB) {
                    KA_HERE(); unsigned char* ws = ka->ws; bf16* const PROJ = (bf16*)(ws + WS_PROJ); bf16* const MIX = (bf16*)(ws + WS_MIX);
                    const float* qn = ka->in[I_QN] + l * 128;
                    const int xx = U & 7, idx = U >> 3, b = xx * 4 + (idx >> 4), hq = idx & 15, kvh = hq >> 2;
                    const size_t row0 = (size_t)b * 256;
                    const bf16* k1 = (const bf16*)(ws + WS_KC) + row0 * 512 + kvh * 128; const bf16* v1 = (const bf16*)(ws + WS_VC) + row0 * 512 + kvh * 128;
                    att::attn_unit(PROJ + row0 * INW + hq * 128, PROJ + row0 * INW + OFF_GA + hq * 128, MIX + row0 * DM + hq * 128,
                                   k1, v1, 512, 0, k1, v1, 512, 4, qn, nullptr, 0, (char*)lds_raw, wv);
                }
                __syncthreads();
                DUP(9) { KA_HERE(); unsigned char* ws = ka->ws; int nBq = nB, cBq = cB; asm volatile("" : "+s"(nBq), "+s"(cBq));
                  pg8::GemmOrder S; S.init(NTOK, 2048, nBq, cBq, ws + WS_YSSM, 1024, ws + WS_WGLU + (size_t)l * 2048 * 1024 * 2, 1024, 1024);
                  pg8::EpiGlu E{(const bf16*)(ws + WS_PROJ), (bf16*)(ws + WS_MIX)}; pg8::gemm_phase<pg8::EpiGlu, pg8::GemmOrder>(lds, wv, 1024, 1024, S, E); }
            } else {
                __syncthreads();
                DUP(7) { KA_HERE(); unsigned char* ws = ka->ws; int nAq = G >> 1, cAq = bx; asm volatile("" : "+s"(nAq), "+s"(cAq));
                  Fft2LOrder S{nAq, cAq, (const char*)(ws + WS_D2L), (const char*)(ws + WS_Z1L), (char*)(ws + WS_MIXED)};
                  pg8::EpiBf16 E{1.0f / 1024.0f}; pg8::gemm_phase<pg8::EpiBf16, Fft2LOrder>(lds, wv, 8192, 8192, S, E); }
                DUP(8) { KA_HERE(); unsigned char* ws = ka->ws; int nAq = G >> 1, cAq = bx; asm volatile("" : "+s"(nAq), "+s"(cAq));
                  Fft2COrder S{nAq, cAq, (const char*)(ws + WS_D2C), (const char*)(ws + WS_Z1C), (char*)(ws + WS_MIXED)};
                  pg8::EpiBf16 E{1.0f / 256.0f}; pg8::gemm_phase<pg8::EpiBf16, Fft2COrder>(lds, wv, 512, 512, S, E); }
            }
        }
        SEAM(pb + 3);
        if (IN(pb + 4)) {
            DUP(10) { KA_HERE(); PH_IDS(); unsigned char* ws = ka->ws;
              pg8::GemmOrder S; S.init(NTOK, 1024, Gq, bq, ws + WS_MIXED, 1024, ws + WS_WFFT + (size_t)l * 1024 * 1024 * 2, 1024, 1024);
              pg8::EpiFftW E{(const bf16*)(ws + WS_PROJ), (bf16*)(ws + WS_MIX)}; pg8::gemm_phase<pg8::EpiFftW, pg8::GemmOrder>(lds, wv, 1024, 1024, S, E); }
        }
        SEAM(pb + 4);
        if (IN(pb + 5)) DUP(11) {
            KA_HERE(); PH_IDS(); unsigned char* ws = ka->ws;
            pg8::GemmOrder S; S.init(NTOK, DM, Gq, bq, ws + WS_MIX, DM, ws + WS_WOUT + (size_t)l * DM * DM * 2, DM, DM);
            pg8::EpiOut E{(bf16*)(ws + ((l & 1) ? WS_DELTA2 : WS_DELTA)), (const float*)(ws + WS_MOD) + (size_t)l * 3 * 12288};
            if (((DUP_MASK) >> 13) & 1) {
                { pg8::SliceOrder<pg8::GemmOrder> S2{S, 0, 2}; pg8::gemm_phase<pg8::EpiOut, pg8::SliceOrder<pg8::GemmOrder>, GEMM1_ALIGN>(lds, wv, DM, DM, S2, E); }
                xcd_barrier(bar, wv);
                { pg8::SliceOrder<pg8::GemmOrder> S2{S, 2, 1000}; pg8::gemm_phase<pg8::EpiOut, pg8::SliceOrder<pg8::GemmOrder>, GEMM1_ALIGN>(lds, wv, DM, DM, S2, E); }
            } else
            pg8::gemm_phase<pg8::EpiOut, pg8::GemmOrder, GEMM1_ALIGN>(lds, wv, DM, DM, S, E);
        }
        SEAM(pb + 5);
    }
    if (IN(25)) DUP(15) { KA_HERE(); PH_IDS(); TID_HERE(); final_norm(ka, gw, NGWq, lane); }
#undef IN
#undef SEAM
}

extern "C" void kernel_launch(void* const* d_in, const int* in_sizes, int n_in, void* d_out, int out_size, void* d_ws, size_t ws_size, hipStream_t stream) {
    static int grid = 0;
    if (grid == 0) {
        if (n_in != 28 || ws_size < WS_END || out_size != 102760448) { fprintf(stderr, "kernel_launch: unexpected shapes (n_in %d, out %d, ws %zu)\n", n_in, out_size, ws_size); grid = -1; return; }
        int dev = 0, cus = 0, per_cu = 0;
        if (hipGetDevice(&dev) != hipSuccess || hipDeviceGetAttribute(&cus, hipDeviceAttributeMultiprocessorCount, dev) != hipSuccess) { grid = -1; return; }
        if (hipFuncSetAttribute((const void*)hymba_fwd, hipFuncAttributeMaxDynamicSharedMemorySize, LDS_BYTES) != hipSuccess) { fprintf(stderr, "kernel_launch: hipFuncSetAttribute failed\n"); grid = -1; return; }
        if (hipOccupancyMaxActiveBlocksPerMultiprocessor(&per_cu, (const void*)hymba_fwd, NWAVES * 64, LDS_BYTES) != hipSuccess || per_cu < 1)
            fprintf(stderr, "kernel_launch: occupancy query reports %d workgroups per CU\n", per_cu);
        (void)hipGetLastError();
        grid = cus;
    }
    if (grid < 0) return;
    (void)hipMemsetAsync((char*)d_ws + WS_CTL, 0, CTL_ZERO_BYTES, stream);
    Args a{};
    for (int i = 0; i < 28; ++i) a.in[i] = (const float*)d_in[i];
    a.out = (float*)d_out; a.ws = (unsigned char*)d_ws;
#if MK_ONE_LAUNCH == 2
    a.ph_lo = 0; a.ph_hi = 1;
    hipLaunchKernelGGL(hymba_fwd, dim3(grid), dim3(NWAVES * 64), LDS_BYTES, stream, a);
    a.ph_lo = 0; a.ph_hi = 26;
    hipLaunchKernelGGL(hymba_fwd, dim3(grid), dim3(NWAVES * 64), LDS_BYTES, stream, a);
#elif MK_ONE_LAUNCH
    a.ph_lo = 0; a.ph_hi = 26;
    hipLaunchKernelGGL(hymba_fwd, dim3(grid), dim3(NWAVES * 64), LDS_BYTES, stream, a);
#else
    for (int ph = 0; ph < 26; ++ph) { a.ph_lo = ph; a.ph_hi = ph + 1; hipLaunchKernelGGL(hymba_fwd, dim3(grid), dim3(NWAVES * 64), LDS_BYTES, stream, a); }
#endif
    const hipError_t le = hipPeekAtLastError();
    if (le != hipSuccess) fprintf(stderr, "kernel_launch: launch failed: %s\n", hipGetErrorName(le));
}
```

```cpp
#include <hip/hip_runtime.h>
#include <cstdio>
#include <cstdint>

#ifndef MK_ONE_LAUNCH
#define MK_ONE_LAUNCH 1
#endif

#ifndef GEMM1_ALIGN
#define GEMM1_ALIGN true
#endif
#ifndef DUP_MASK
#define DUP_MASK 0
#endif
#define DUP(k) for (int rep_ = 0; rep_ < (((DUP_MASK) >> (k)) & 1) + 1; ++rep_)
#define LAS __attribute__((address_space(3)))
#define GAS __attribute__((address_space(1)))
typedef unsigned short bf16;
typedef unsigned v4u __attribute__((ext_vector_type(4)));
typedef unsigned v2u __attribute__((ext_vector_type(2)));
typedef float f32x4 __attribute__((ext_vector_type(4)));
typedef float f32x2 __attribute__((ext_vector_type(2)));
typedef short bf16x8 __attribute__((ext_vector_type(8)));
typedef short s16x4 __attribute__((ext_vector_type(4)));
typedef float f32x16 __attribute__((ext_vector_type(16)));

constexpr int DM = 4096, NTOK = 16384, NCTX = 8192, DEPTH = 4, INW = 9216;
constexpr int OFF_K = 2048, OFF_V = 2560, OFF_GA = 3072, OFF_U = 5120, OFF_GS = 6144, OFF_F = 7168, OFF_GF = 8192;
constexpr float NORM_EPS = 1e-6f;
constexpr size_t OUT_NEWK = 67108864, OUT_NEWV = 83886080, OUT_FRE = 100663296, OUT_FIM = 101187584, OUT_BRE = 101711872, OUT_BIM = 102236160;

constexpr size_t MiB = 1u << 20;
constexpr size_t WS_CTL = 0, CTL_ZERO_BYTES = 1 * MiB;
constexpr size_t WS_MOD = 1 * MiB;
constexpr size_t WS_ROPE = 2 * MiB;
constexpr size_t WS_A16 = 3 * MiB;
constexpr size_t WS_D1 = 4 * MiB;
constexpr size_t WS_D2C = 5 * MiB;
constexpr size_t WS_CK = 6 * MiB;
constexpr size_t WS_CV = 10 * MiB;
constexpr size_t WS_PMAT = 14 * MiB;
constexpr size_t WS_KG = 46 * MiB;
constexpr size_t WS_D2L = 110 * MiB;
constexpr size_t WS_WGLU = 174 * MiB;
constexpr size_t WS_WOUT = 198 * MiB;
constexpr size_t WS_WIN = 326 * MiB;
constexpr size_t WS_H = 614 * MiB;
constexpr size_t WS_PROJ = 742 * MiB;
constexpr size_t WS_MIX = 1030 * MiB;
constexpr size_t WS_A2 = 1158 * MiB;
constexpr size_t WS_SBUF = 1222 * MiB;
constexpr size_t WS_YSSM = 1286 * MiB;
constexpr size_t WS_ZL = 1318 * MiB;
constexpr size_t WS_ZC = 1334 * MiB;
constexpr size_t WS_P = 1350 * MiB;
constexpr size_t WS_WFP = 1386 * MiB;
constexpr int PK = 1152; constexpr size_t ZPART = (size_t)1 << 22;
constexpr size_t WS_DELTA = 1414 * MiB;
constexpr size_t WS_XBF = 1542 * MiB;
constexpr size_t WS_XBF2 = 1702 * MiB;
constexpr size_t WS_KC = 1670 * MiB;
constexpr size_t WS_VC = 1686 * MiB;
constexpr size_t WS_DELTA2 = 1830 * MiB;
constexpr size_t WS_END = 1958 * MiB;
constexpr int CW_BAR = 4096;

constexpr int LDS_BYTES = 147456;
constexpr int MISC_OFF = 143360;
constexpr int NWAVES = 8;

#define LDS_WAIT() asm volatile("s_waitcnt lgkmcnt(0)" ::: "memory")
#define VM_WAIT() asm volatile("s_waitcnt vmcnt(0)" ::: "memory")
#define RLX_AGENT __ATOMIC_RELAXED, __HIP_MEMORY_SCOPE_AGENT

__device__ __forceinline__ int tid_of(int wv) { int t = wv * 64 + (int)__builtin_amdgcn_mbcnt_hi(~0u, __builtin_amdgcn_mbcnt_lo(~0u, 0u)); asm volatile("" : "+v"(t)); return t; }
__device__ __forceinline__ unsigned cvt_pk_bf16(float lo, float hi) { unsigned r; asm volatile("v_cvt_pk_bf16_f32 %0, %1, %2" : "=v"(r) : "v"(lo), "v"(hi)); return r; }
__device__ __forceinline__ float bf_lo(unsigned w) { return __uint_as_float(w << 16); }
__device__ __forceinline__ float bf_hi(unsigned w) { return __uint_as_float(w & 0xffff0000u); }
__device__ __forceinline__ float silu_f(float x) { return x * __builtin_amdgcn_rcpf(1.0f + __expf(-x)); }
__device__ __forceinline__ float sigmoid_f(float x) { return __builtin_amdgcn_rcpf(1.0f + __expf(-x)); }
__device__ __forceinline__ float shflx(float v, int lane, int o) { return __int_as_float(__builtin_amdgcn_ds_bpermute((lane ^ o) << 2, __float_as_int(v))); }
__device__ __forceinline__ float wave_sum(float v, int lane) {
#pragma unroll
    for (int o = 1; o < 64; o <<= 1) v += shflx(v, lane, o);
    return v;
}

namespace pg8 {
constexpr int BM = 256, BK = 64, HALF = 128, HTB = HALF * BK * 2, STAGE_BYTES = 8 * HTB, NXCD = 8, WGM = 8;
__host__ __device__ __forceinline__ int lds_byte(int r, int c) { const int st = (r >> 4) * 2 + (c >> 5), rr = r & 15, cc = c & 31, ob = rr * 64 + cc * 2; return st * 1024 + (ob ^ (((ob >> 9) & 1) << 5)); }
__host__ __device__ __forceinline__ void stage_rc(int b, int& R, int& C) { const int st = b / 1024, sb = b % 1024, swz = sb ^ (((sb >> 9) & 1) << 5); R = (st >> 1) * 16 + swz / 64; C = (st & 1) * 32 + (swz % 64) / 2; }
__host__ __device__ __forceinline__ int perm32(int rho) { const int n = rho >> 4, i = rho & 15; return 8 * (i >> 2) + 4 * n + (i & 3); }

struct Unit { const char* a; const char* b; char* c; int ldc; int pm, pn, z, kt; };

struct GemmOrder {
    int nM, nN, nwg, G, c, kt; const char* A; const char* B; size_t atile, btile;
    __device__ void init(int M, int N, int G_, int c_, const void* A_, int lda, const void* B_, int ldb, int K) { kt = K / BK; nM = M / BM; nN = N / BM; nwg = nM * nN; G = G_; c = c_; A = (const char*)A_; B = (const char*)B_; atile = (size_t)BM * lda * 2; btile = (size_t)BM * ldb * 2; }
    __device__ bool next(int i, Unit& u) const {
        const long L = (long)i * G + c; if (L >= nwg) return false;
        int wgid = (int)L; const int xcd = wgid % NXCD; { const int q = nwg / NXCD, r = nwg % NXCD, off = wgid / NXCD; wgid = (xcd < r ? xcd * (q + 1) : r * (q + 1) + (xcd - r) * q) + off; }
        const int nig = WGM * nN, gid = wgid / nig, fm = gid * WGM, gsz = (nM - fm) < WGM ? (nM - fm) : WGM;
        u.pm = fm + ((wgid % nig) % gsz); u.pn = (wgid % nig) / gsz; u.z = 0; u.c = nullptr; u.ldc = 0; u.kt = kt;
        u.a = A + (size_t)u.pm * atile; u.b = B + (size_t)u.pn * btile; return true;
    }
};
template <class O> struct SliceOrder { O g; int i0, cnt; __device__ bool next(int i, Unit& u) const { if (i >= cnt) return false; return g.next(i0 + i, u); } };
struct OneUnit { Unit u0; __device__ bool next(int i, Unit& u) const { if (i != 0) return false; u = u0; return true; } };

template <class Epi, class Sched, bool ALIGN_EPI = true>
__device__ __forceinline__ void gemm_phase(LAS unsigned char* lds, const int wv, const int lda, const int ldb, const Sched& S, const Epi& E) {
    const int tid = tid_of(wv);
    const int wid = __builtin_amdgcn_readfirstlane(tid >> 6), lane = tid & 63, wr = wid >> 2, wc = wid & 3, fr = lane & 15, fq = lane >> 4;
    unsigned voffA[2], voffB[2];
#pragma unroll
    for (int i = 0; i < 2; ++i) { int R, C; stage_rc(tid * 16 + i * 8192, R, C); const int Rb = Epi::PERM ? ((R & ~31) + perm32(R & 31)) : R;
        voffA[i] = (unsigned)(R * lda + C) * 2u; voffB[i] = (unsigned)(Rb * ldb + C) * 2u; }
    (void)fr; (void)fq;
    const size_t kstep = (size_t)(BK * 2);
    const unsigned hstepA = (unsigned)HALF * lda * 2u, hstepB = (unsigned)HALF * ldb * 2u;
    const unsigned ldsw = (unsigned)wid * 1024u;
    const int aoff = lds_byte(wr * 64 + fr, fq * 8), boff = lds_byte(wc * 32 + fr, fq * 8);
#define PG8_SA(b, h) (((b) * 2 + (h)) * HTB)
#define PG8_SB(b, h) ((4 + (b) * 2 + (h)) * HTB)
#define PG8_STAGE(bufoff, gbase, voff) do { _Pragma("unroll") for (int _i = 0; _i < 2; ++_i) \
        __builtin_amdgcn_global_load_lds((const unsigned*)((const char*)(gbase) + (voff)[_i]), (LAS unsigned*)(lds + (bufoff) + ldsw + _i * 8192), 16, 0, 0); } while (0)
#define PG8_LDA(dst, b, h) do { _Pragma("unroll") for (int m = 0; m < 4; ++m) _Pragma("unroll") for (int k = 0; k < 2; ++k) dst[m][k] = *(const LAS bf16x8*)(lds + PG8_SA(b, h) + aoff + m * 2048 + k * 1024); } while (0)
#define PG8_LDB(dst, b, h) do { _Pragma("unroll") for (int n = 0; n < 2; ++n) _Pragma("unroll") for (int k = 0; k < 2; ++k) dst[n][k] = *(const LAS bf16x8*)(lds + PG8_SB(b, h) + boff + n * 2048 + k * 1024); } while (0)
#define PG8_MMA(ai, bj, At, Bt) do { __builtin_amdgcn_s_setprio(1); _Pragma("unroll") for (int m = 0; m < 4; ++m) _Pragma("unroll") for (int n = 0; n < 2; ++n) _Pragma("unroll") for (int k = 0; k < 2; ++k) \
        acc[ai][bj][m][n] = __builtin_amdgcn_mfma_f32_16x16x32_bf16(Bt[n][k], At[m][k], acc[ai][bj][m][n], 0, 0, 0); __builtin_amdgcn_s_setprio(0); } while (0)
#define PG8_WAIT_V(n) asm volatile("s_waitcnt vmcnt(" #n ")" ::: "memory")
#define PG8_WAIT_L(n) asm volatile("s_waitcnt lgkmcnt(" #n ")" ::: "memory")
#define PG8_BAR __builtin_amdgcn_s_barrier()
#define PG8_SCHED __builtin_amdgcn_sched_barrier(0)
    int ui = 0, nt;
    const char* cA; const char* cB;
    { Unit u0; if (!S.next(0, u0)) return; cA = u0.a; cB = u0.b; nt = u0.kt; }
    f32x4 acc[2][2][4][2];
#pragma unroll
    for (int a = 0; a < 2; ++a)
#pragma unroll
        for (int b = 0; b < 2; ++b)
#pragma unroll
            for (int m = 0; m < 4; ++m)
#pragma unroll
                for (int n = 0; n < 2; ++n) acc[a][b][m][n] = (f32x4){0.f, 0.f, 0.f, 0.f};
    bf16x8 At[4][2], B0[2][2], B1[2][2];
    PG8_STAGE(PG8_SB(0, 0), cB, voffB); PG8_STAGE(PG8_SB(0, 1), cB + hstepB, voffB); PG8_STAGE(PG8_SA(0, 0), cA, voffA); PG8_STAGE(PG8_SA(0, 1), cA + hstepA, voffA);
    if (wr == 1) PG8_BAR;
    PG8_WAIT_V(2); PG8_BAR;
    PG8_STAGE(PG8_SB(1, 0), cB + kstep, voffB); PG8_STAGE(PG8_SA(1, 0), cA + kstep, voffA); PG8_STAGE(PG8_SB(1, 1), cB + hstepB + kstep, voffB);
    PG8_WAIT_V(6); PG8_BAR;
    for (;;) {
        bool has_next; const char* nA; const char* nB; int nnt;
        { Unit nx; has_next = S.next(ui + 1, nx); nA = has_next ? nx.a : cA; nB = has_next ? nx.b : cB; nnt = has_next ? nx.kt : nt; }
        for (int t = 0; t < nt; t += 2) {
            const bool last = (t == nt - 2);
            const char* a1 = cA + (size_t)(t + 1) * kstep;
            const char* a2 = last ? nA : cA + (size_t)(t + 2) * kstep; const char* b2 = last ? nB : cB + (size_t)(t + 2) * kstep;
            const char* a3 = a2 + kstep; const char* b3 = b2 + kstep;
            PG8_LDB(B0, 0, 0); PG8_LDB(B1, 0, 1); PG8_SCHED; PG8_LDA(At, 0, 0); PG8_STAGE(PG8_SA(1, 1), a1 + hstepA, voffA);
            PG8_WAIT_V(8); PG8_WAIT_L(0); PG8_BAR; PG8_MMA(0, 0, At, B0); PG8_MMA(0, 1, At, B1); PG8_BAR; PG8_SCHED;
            PG8_LDA(At, 0, 1); PG8_STAGE(PG8_SB(0, 0), b2, voffB); PG8_STAGE(PG8_SB(0, 1), b2 + hstepB, voffB); PG8_STAGE(PG8_SA(0, 0), a2, voffA);
            PG8_WAIT_V(8); PG8_WAIT_L(0); PG8_BAR; PG8_MMA(1, 0, At, B0); PG8_MMA(1, 1, At, B1); PG8_BAR; PG8_SCHED;
            PG8_LDB(B0, 1, 0); PG8_LDB(B1, 1, 1); PG8_SCHED; PG8_LDA(At, 1, 0); PG8_STAGE(PG8_SA(0, 1), a2 + hstepA, voffA);
            PG8_WAIT_V(8); PG8_WAIT_L(0); PG8_BAR; PG8_MMA(0, 0, At, B0); PG8_MMA(0, 1, At, B1); PG8_BAR; PG8_SCHED;
            PG8_LDA(At, 1, 1); PG8_STAGE(PG8_SB(1, 0), b3, voffB); PG8_STAGE(PG8_SB(1, 1), b3 + hstepB, voffB); PG8_STAGE(PG8_SA(1, 0), a3, voffA);
            PG8_WAIT_V(8); PG8_WAIT_L(0); PG8_BAR; PG8_MMA(1, 0, At, B0); PG8_MMA(1, 1, At, B1); PG8_BAR; PG8_SCHED;
        }
        if constexpr (ALIGN_EPI) { if (wr == 0) PG8_BAR; }
        { Unit cu; (void)S.next(ui, cu); const int t2 = tid_of(wv);
          const int w2 = __builtin_amdgcn_readfirstlane(t2 >> 6); E(acc, cu, w2 >> 2, w2 & 3, t2 & 15, (t2 & 63) >> 4); }
        if (!has_next) break;
#pragma unroll
        for (int a = 0; a < 2; ++a)
#pragma unroll
            for (int b = 0; b < 2; ++b)
#pragma unroll
                for (int m = 0; m < 4; ++m)
#pragma unroll
                    for (int n = 0; n < 2; ++n) acc[a][b][m][n] = (f32x4){0.f, 0.f, 0.f, 0.f};
        cA = nA; cB = nB; nt = nnt; ++ui;
        if constexpr (ALIGN_EPI) { if (wr == 1) PG8_BAR; }
    }
    PG8_WAIT_V(0);
    if constexpr (!ALIGN_EPI) { if (wr == 0) PG8_BAR; }
    PG8_BAR;
#undef PG8_SA
#undef PG8_SB
#undef PG8_STAGE
#undef PG8_LDA
#undef PG8_LDB
#undef PG8_MMA
#undef PG8_WAIT_V
#undef PG8_WAIT_L
#undef PG8_BAR
#undef PG8_SCHED
}

struct EpiProj {
    static constexpr bool PERM = true;
    bf16* proj; bf16* a2;
    __device__ __forceinline__ void operator()(const f32x4 (&acc)[2][2][4][2], const Unit& u, int wr, int wc, int fr, int fq) const {
        const int pn = u.pn; const bool gate = (pn >= 12 && pn < 20) || (pn >= 24 && pn < 28) || (pn >= 32); const bool isu = (pn >= 20 && pn < 24);
        const int row0 = u.pm * BM + wr * 64 + fr, col0 = pn * BM + wc * 32 + 8 * fq;
#pragma unroll
        for (int ai = 0; ai < 2; ++ai)
#pragma unroll
            for (int m = 0; m < 4; ++m) { const int row = row0 + ai * HALF + m * 16;
#pragma unroll
                for (int bj = 0; bj < 2; ++bj) { f32x4 v0 = acc[ai][bj][m][0], v1 = acc[ai][bj][m][1];
                    if (gate) {
#pragma unroll
                        for (int j = 0; j < 4; ++j) { v0[j] = silu_f(v0[j]); v1[j] = silu_f(v1[j]); } }
                    v4u w; w.x = cvt_pk_bf16(v0[0], v0[1]); w.y = cvt_pk_bf16(v0[2], v0[3]); w.z = cvt_pk_bf16(v1[0], v1[1]); w.w = cvt_pk_bf16(v1[2], v1[3]);
                    const int col = col0 + bj * HALF;
                    bf16* dst;
                    if (isu) { const int g = (col - OFF_U) >> 4, c0 = col & 15; dst = a2 + ((size_t)(g * 1024 + (row >> 4)) * 512 + (row & 15) * 16 + c0); }
                    else dst = proj + (size_t)row * INW + col;
                    *(v4u*)dst = w; } }
    }
};
struct EpiBf16 {
    static constexpr bool PERM = true;
    float scale;
    __device__ __forceinline__ void operator()(const f32x4 (&acc)[2][2][4][2], const Unit& u, int wr, int wc, int fr, int fq) const {
        bf16* base = (bf16*)u.c; const int ldc = u.ldc; const int row0 = wr * 64 + fr, col0 = wc * 32 + 8 * fq;
#pragma unroll
        for (int ai = 0; ai < 2; ++ai)
#pragma unroll
            for (int m = 0; m < 4; ++m) { bf16* rowp = base + (size_t)(row0 + ai * HALF + m * 16) * ldc + col0;
#pragma unroll
                for (int bj = 0; bj < 2; ++bj) { const f32x4 v0 = acc[ai][bj][m][0] * scale, v1 = acc[ai][bj][m][1] * scale;
                    v4u w; w.x = cvt_pk_bf16(v0[0], v0[1]); w.y = cvt_pk_bf16(v0[2], v0[3]); w.z = cvt_pk_bf16(v1[0], v1[1]); w.w = cvt_pk_bf16(v1[2], v1[3]);
                    *(v4u*)(rowp + bj * HALF) = w; } }
    }
};
struct EpiBf16X {
    static constexpr bool PERM = true;
    float scale; int aoff, boff;
    __device__ __forceinline__ void operator()(const f32x4 (&acc)[2][2][4][2], const Unit& u, int wr, int wc, int fr, int fq) const {
        bf16* base = (bf16*)u.c; const int ldc = u.ldc; const int row0 = wr * 64 + fr, col0 = wc * 32 + 8 * fq;
#pragma unroll
        for (int ai = 0; ai < 2; ++ai)
#pragma unroll
            for (int m = 0; m < 4; ++m) { bf16* rowp = base + (ai * aoff + (row0 + m * 16) * ldc + col0);
#pragma unroll
                for (int bj = 0; bj < 2; ++bj) { const f32x4 v0 = acc[ai][bj][m][0] * scale, v1 = acc[ai][bj][m][1] * scale;
                    v4u w; w.x = cvt_pk_bf16(v0[0], v0[1]); w.y = cvt_pk_bf16(v0[2], v0[3]); w.z = cvt_pk_bf16(v1[0], v1[1]); w.w = cvt_pk_bf16(v1[2], v1[3]);
                    *(v4u*)(rowp + bj * boff) = w; } }
    }
};
struct EpiF32 {
    static constexpr bool PERM = false;
    __device__ __forceinline__ void operator()(const f32x4 (&acc)[2][2][4][2], const Unit& u, int wr, int wc, int fr, int fq) const {
        float* base = (float*)u.c; const int ldc = u.ldc; const int row0 = wr * 64 + fr, col0 = wc * 32 + 4 * fq;
#pragma unroll
        for (int ai = 0; ai < 2; ++ai)
#pragma unroll
            for (int m = 0; m < 4; ++m) { float* rowp = base + (size_t)(row0 + ai * HALF + m * 16) * ldc + col0;
#pragma unroll
                for (int bj = 0; bj < 2; ++bj)
#pragma unroll
                    for (int n = 0; n < 2; ++n) *(f32x4*)(rowp + bj * HALF + n * 16) = acc[ai][bj][m][n]; }
    }
};
struct EpiSsmY {
    static constexpr bool PERM = true;
    bf16* yssm;
    __device__ __forceinline__ void operator()(const f32x4 (&acc)[2][2][4][2], const Unit& u, int wr, int wc, int fr, int fq) const {
        const int row0 = u.z + wr * 64 + fr, col0 = wc * 32 + 8 * fq, g = u.pn;
#pragma unroll
        for (int ai = 0; ai < 2; ++ai)
#pragma unroll
            for (int m = 0; m < 4; ++m) { const int chunk = row0 + ai * HALF + m * 16;
#pragma unroll
                for (int bj = 0; bj < 2; ++bj) { const f32x4 v0 = acc[ai][bj][m][0], v1 = acc[ai][bj][m][1];
                    v4u w; w.x = cvt_pk_bf16(v0[0], v0[1]); w.y = cvt_pk_bf16(v0[2], v0[3]); w.z = cvt_pk_bf16(v1[0], v1[1]); w.w = cvt_pk_bf16(v1[2], v1[3]);
                    const int col = col0 + bj * HALF, i = col >> 4, c0 = col & 15;
                    *(v4u*)(yssm + (size_t)(chunk * 16 + i) * 1024 + g * 16 + c0) = w; } }
    }
};
struct EpiGlu {
    static constexpr bool PERM = true;
    const bf16* proj; bf16* mix;
    __device__ __forceinline__ void operator()(const f32x4 (&acc)[2][2][4][2], const Unit& u, int wr, int wc, int fr, int fq) const {
        const int row0 = u.pm * BM + wr * 64 + fr, col0 = u.pn * HALF + wc * 32 + 8 * fq;
#pragma unroll
        for (int ai = 0; ai < 2; ++ai)
#pragma unroll
            for (int m = 0; m < 4; ++m) { const int row = row0 + ai * HALF + m * 16;
                const v4u gs = *(const v4u*)(proj + (size_t)row * INW + OFF_GS + col0);
                const f32x4 a0 = acc[ai][0][m][0], a1 = acc[ai][0][m][1], g0 = acc[ai][1][m][0], g1 = acc[ai][1][m][1];
                float o[8];
#pragma unroll
                for (int j = 0; j < 4; ++j) { o[j] = a0[j] * sigmoid_f(g0[j]); o[4 + j] = a1[j] * sigmoid_f(g1[j]); }
                o[0] *= bf_lo(gs.x); o[1] *= bf_hi(gs.x); o[2] *= bf_lo(gs.y); o[3] *= bf_hi(gs.y); o[4] *= bf_lo(gs.z); o[5] *= bf_hi(gs.z); o[6] *= bf_lo(gs.w); o[7] *= bf_hi(gs.w);
                v4u w; w.x = cvt_pk_bf16(o[0], o[1]); w.y = cvt_pk_bf16(o[2], o[3]); w.z = cvt_pk_bf16(o[4], o[5]); w.w = cvt_pk_bf16(o[6], o[7]);
                *(v4u*)(mix + (size_t)row * DM + 2048 + col0) = w; }
    }
};
struct EpiFftW {
    static constexpr bool PERM = true;
    const bf16* proj; bf16* mix;
    __device__ __forceinline__ void operator()(const f32x4 (&acc)[2][2][4][2], const Unit& u, int wr, int wc, int fr, int fq) const {
        const int row0 = u.pm * BM + wr * 64 + fr, col0 = u.pn * BM + wc * 32 + 8 * fq;
#pragma unroll
        for (int ai = 0; ai < 2; ++ai)
#pragma unroll
            for (int m = 0; m < 4; ++m) { const int row = row0 + ai * HALF + m * 16;
#pragma unroll
                for (int bj = 0; bj < 2; ++bj) { const int col = col0 + bj * HALF;
                    const v4u gs = *(const v4u*)(proj + (size_t)row * INW + OFF_GF + col);
                    const f32x4 v0 = acc[ai][bj][m][0], v1 = acc[ai][bj][m][1];
                    v4u w; w.x = cvt_pk_bf16(v0[0] * bf_lo(gs.x), v0[1] * bf_hi(gs.x)); w.y = cvt_pk_bf16(v0[2] * bf_lo(gs.y), v0[3] * bf_hi(gs.y));
                    w.z = cvt_pk_bf16(v1[0] * bf_lo(gs.z), v1[1] * bf_hi(gs.z)); w.w = cvt_pk_bf16(v1[2] * bf_lo(gs.w), v1[3] * bf_hi(gs.w));
                    *(v4u*)(mix + (size_t)row * DM + 3072 + col) = w; } }
    }
};
struct EpiOut {
    static constexpr bool PERM = true;
    bf16* delta; const float* modl;
    __device__ __forceinline__ void operator()(const f32x4 (&acc)[2][2][4][2], const Unit& u, int wr, int wc, int fr, int fq) const {
        const int rt = u.pm * BM; const int v = rt < NCTX ? 0 : (rt < NCTX + 4096 ? 1 : 2);
        const float* gv = modl + v * 12288 + 8192;
        const int row0 = rt + wr * 64 + fr, col0 = u.pn * BM + wc * 32 + 8 * fq;
        f32x4 gt[2][2];
#pragma unroll
        for (int bj = 0; bj < 2; ++bj)
#pragma unroll
            for (int n = 0; n < 2; ++n) gt[bj][n] = *(const f32x4*)(gv + col0 + bj * HALF + n * 4);
#pragma unroll
        for (int ai = 0; ai < 2; ++ai)
#pragma unroll
            for (int m = 0; m < 4; ++m) { bf16* rowp = delta + (size_t)(row0 + ai * HALF + m * 16) * DM + col0;
#pragma unroll
                for (int bj = 0; bj < 2; ++bj) { const f32x4 v0 = acc[ai][bj][m][0] * gt[bj][0], v1 = acc[ai][bj][m][1] * gt[bj][1];
                    v4u w; w.x = cvt_pk_bf16(v0[0], v0[1]); w.y = cvt_pk_bf16(v0[2], v0[3]); w.z = cvt_pk_bf16(v1[0], v1[1]); w.w = cvt_pk_bf16(v1[2], v1[3]);
                    *(v4u*)(rowp + bj * HALF) = w; } }
    }
};
}

namespace att {
constexpr int D = 128, QBLK = 32, KVBLK = 64;
constexpr float SCALE = 0.088388347648318440f;
constexpr float THR = 8.f;
constexpr int SHM_V = KVBLK * D * 2, SHM_K = KVBLK * D * 2;
constexpr int WS_OFF = 2 * SHM_V + 2 * SHM_K, OSTG_OFF = WS_OFF + NWAVES * 64 * 4, OSTG_ROW = 272, OSTG_WAVE = 32 * OSTG_ROW;
static_assert(DEPTH >= 2, "the bf16 stream is first written by layer 1's norm phase");
static_assert(OSTG_OFF + NWAVES * OSTG_WAVE <= MISC_OFF, "attention LDS");
#define KSWZ(row, colB) ((row) * 256 + ((colB) ^ (((row) & 7) << 4)))
#define SBAR() __builtin_amdgcn_sched_barrier(0)
__device__ __forceinline__ int crow(int r, int hi) { return (r & 3) + 8 * (r >> 2) + 4 * hi; }
__device__ __forceinline__ void partialSM(f32x16& p0, f32x16& p1, float& m_reg, float& mn, float& alpha) {
  constexpr float C = SCALE * 1.4426950408889634f;
  float pmax = p0[0]; for (int r = 1; r < 16; ++r) pmax = fmaxf(pmax, p0[r]); for (int r = 0; r < 16; ++r) pmax = fmaxf(pmax, p1[r]);
  { auto rr = __builtin_amdgcn_permlane32_swap(__float_as_uint(pmax), __float_as_uint(pmax), false, false);
    pmax = fmaxf(__uint_as_float(rr[0]), __uint_as_float(rr[1])); }
  if (__builtin_expect(__all(pmax - m_reg <= THR / SCALE), 1)) { mn = m_reg; alpha = 1.f; }
  else { mn = fmaxf(m_reg, pmax); alpha = __builtin_amdgcn_exp2f((m_reg - mn) * C); m_reg = mn; }
  float mnC = -mn * C;
  for (int r = 0; r < 16; ++r) p0[r] = fmaf(p0[r], C, mnC); for (int r = 0; r < 16; ++r) p1[r] = fmaf(p1[r], C, mnC);
  for (int r = 0; r < 16; ++r) p0[r] = __builtin_amdgcn_exp2f(p0[r]);
}
__device__ __forceinline__ void finishSM(f32x16& p0, f32x16& p1, float alpha, float& l_reg, bf16x8& pa0, bf16x8& pa1, bf16x8& pa2, bf16x8& pa3) {
  for (int r = 0; r < 16; ++r) p1[r] = __builtin_amdgcn_exp2f(p1[r]);
  float ps = 0; for (int r = 0; r < 16; ++r) ps += p0[r]; for (int r = 0; r < 16; ++r) ps += p1[r];
  { auto rr = __builtin_amdgcn_permlane32_swap(__float_as_uint(ps), __float_as_uint(ps), false, false);
    ps = __uint_as_float(rr[0]) + __uint_as_float(rr[1]); }
  l_reg = l_reg * alpha + ps;
#define PK4(P, BASE, OUT) do { unsigned a0 = cvt_pk_bf16(P[BASE + 0], P[BASE + 1]), a1 = cvt_pk_bf16(P[BASE + 2], P[BASE + 3]);   \
    unsigned b0 = cvt_pk_bf16(P[BASE + 4], P[BASE + 5]), b1 = cvt_pk_bf16(P[BASE + 6], P[BASE + 7]);                              \
    auto r0 = __builtin_amdgcn_permlane32_swap(a0, b0, false, false); auto r1 = __builtin_amdgcn_permlane32_swap(a1, b1, false, false); \
    v4u w = {r0[0], r1[0], r0[1], r1[1]}; OUT = *reinterpret_cast<bf16x8*>(&w); } while (0)
  PK4(p0, 0, pa0); PK4(p0, 8, pa1); PK4(p1, 0, pa2); PK4(p1, 8, pa3);
#undef PK4
}
__device__ __forceinline__ void qkt(f32x16& p0, f32x16& p1, const char* Ks, const bf16x8* qr, int r32, int hi) {
  p0 = f32x16{}; p1 = f32x16{};
  for (int d0 = 0; d0 < 8; ++d0) { int cb = (d0 * 16 + hi * 8) * 2;
    bf16x8 b0 = *reinterpret_cast<const bf16x8*>(Ks + KSWZ(r32, cb));
    bf16x8 b1 = *reinterpret_cast<const bf16x8*>(Ks + KSWZ(32 + r32, cb));
    p0 = __builtin_amdgcn_mfma_f32_32x32x16_bf16(b0, qr[d0], p0, 0, 0, 0);
    p1 = __builtin_amdgcn_mfma_f32_32x32x16_bf16(b1, qr[d0], p1, 0, 0, 0); }
}
__device__ __forceinline__ int v_st(int k, int c) { const int kk = (k & ~0xC) | ((k & 4) << 1) | ((k & 8) >> 1); return ((kk >> 3) * 4 + (c >> 5)) * 512 + ((kk & 7) * 32 + (c & 31)) * 2; }
__device__ __forceinline__ int v_rd_base(int lane) { return ((lane & 3) << 3) | (((lane >> 2) & 3) << 6) | (((lane >> 4) & 1) << 5) | (((lane >> 5) & 1) << 8); }
constexpr int v_rd_off(int d0, int ks, int half) { return d0 * 512 + ks * 4096 + half * 2048; }
template <int OFF> __device__ __forceinline__ s16x4 tr_read(int vb) {
  s16x4 r; asm volatile("ds_read_b64_tr_b16 %0, %1 offset:%2" : "=&v"(r) : "v"(vb), "i"(OFF) : "memory"); return r;
}
template <int D0> __device__ __forceinline__ void pv_one(f32x16& od, int vb, bf16x8 pa0, bf16x8 pa1, bf16x8 pa2, bf16x8 pa3) {
  const s16x4 l0 = tr_read<v_rd_off(D0, 0, 0)>(vb), h0 = tr_read<v_rd_off(D0, 0, 1)>(vb), l1 = tr_read<v_rd_off(D0, 1, 0)>(vb), h1 = tr_read<v_rd_off(D0, 1, 1)>(vb);
  const s16x4 l2 = tr_read<v_rd_off(D0, 2, 0)>(vb), h2 = tr_read<v_rd_off(D0, 2, 1)>(vb), l3 = tr_read<v_rd_off(D0, 3, 0)>(vb), h3 = tr_read<v_rd_off(D0, 3, 1)>(vb);
  asm volatile("s_waitcnt lgkmcnt(0)" ::: "memory"); SBAR();
#define PK(L, H) (bf16x8){L[0], L[1], L[2], L[3], H[0], H[1], H[2], H[3]}
  od = __builtin_amdgcn_mfma_f32_32x32x16_bf16(pa0, PK(l0, h0), od, 0, 0, 0);
  od = __builtin_amdgcn_mfma_f32_32x32x16_bf16(pa1, PK(l1, h1), od, 0, 0, 0);
  od = __builtin_amdgcn_mfma_f32_32x32x16_bf16(pa2, PK(l2, h2), od, 0, 0, 0);
  od = __builtin_amdgcn_mfma_f32_32x32x16_bf16(pa3, PK(l3, h3), od, 0, 0, 0);
#undef PK
}
__device__ __forceinline__ void pv_d0(f32x16* o, int vb, bf16x8 pa0, bf16x8 pa1, bf16x8 pa2, bf16x8 pa3) {
  pv_one<0>(o[0], vb, pa0, pa1, pa2, pa3); pv_one<1>(o[1], vb, pa0, pa1, pa2, pa3); pv_one<2>(o[2], vb, pa0, pa1, pa2, pa3); pv_one<3>(o[3], vb, pa0, pa1, pa2, pa3);
}

__device__ __forceinline__ void attn_unit(const bf16* __restrict__ Qb, const bf16* __restrict__ Gb, bf16* __restrict__ Ob,
                                          const bf16* __restrict__ K0, const bf16* __restrict__ V0, int ld0, int nt0,
                                          const bf16* __restrict__ K1, const bf16* __restrict__ V1, int ld1, int nt1,
                                          const float* __restrict__ qn, const f32x2* __restrict__ rope, int tok0, char* lds, int wv) {
  const int tid = tid_of(wv);
  const int wid = tid >> 6, lane = tid & 63, r32 = lane & 31, hi = lane >> 5;
  char* V_lds = lds; char* K_lds = lds + 2 * SHM_V;
  float* ws = (float*)(lds + WS_OFF) + wid * 64; float* li_l = ws; float* al_l = ws + 32;
  float m_reg = -1e30f, l_reg = 0; f32x16 o[4] = {}; bf16x8 qr[8];
  const int sr = tid >> 4, sc = (tid & 15) * 8, vst0 = v_st(sr, sc), vst1 = v_st(32 + sr, sc);
  const int vb0 = (int)(uintptr_t)V_lds + v_rd_base(lane);
  struct { bf16x8 vs0, vs1, ks0, ks1; } sr_[2];
#define SLOAD(i, jt) do { const bf16* kb_; const bf16* vb_; long ld_; \
    if ((jt) < nt0) { kb_ = K0 + (long)(jt) * KVBLK * ld0; vb_ = V0 + (long)(jt) * KVBLK * ld0; ld_ = ld0; } else { kb_ = K1 + (long)((jt) - nt0) * KVBLK * ld1; vb_ = V1 + (long)((jt) - nt0) * KVBLK * ld1; ld_ = ld1; } \
    sr_[i].vs0 = *reinterpret_cast<const bf16x8*>(vb_ + (long)sr * ld_ + sc); sr_[i].vs1 = *reinterpret_cast<const bf16x8*>(vb_ + (long)(32 + sr) * ld_ + sc); \
    sr_[i].ks0 = *reinterpret_cast<const bf16x8*>(kb_ + (long)sr * ld_ + sc); sr_[i].ks1 = *reinterpret_cast<const bf16x8*>(kb_ + (long)(32 + sr) * ld_ + sc); } while (0)
  SLOAD(0, 0);
  __syncthreads();
  {
    const bf16* Qw = Qb + (long)(wid * QBLK + r32) * INW + hi * 8;
    float x[8][8]; float ss = 0.f;
#pragma unroll
    for (int d0 = 0; d0 < 8; ++d0) { const v4u raw = *reinterpret_cast<const v4u*>(Qw + d0 * 16);
      x[d0][0] = bf_lo(raw.x); x[d0][1] = bf_hi(raw.x); x[d0][2] = bf_lo(raw.y); x[d0][3] = bf_hi(raw.y); x[d0][4] = bf_lo(raw.z); x[d0][5] = bf_hi(raw.z); x[d0][6] = bf_lo(raw.w); x[d0][7] = bf_hi(raw.w);
#pragma unroll
      for (int j = 0; j < 8; ++j) ss += x[d0][j] * x[d0][j]; }
    { auto rr = __builtin_amdgcn_permlane32_swap(__float_as_uint(ss), __float_as_uint(ss), false, false); ss = __uint_as_float(rr[0]) + __uint_as_float(rr[1]); }
    const float rstd = rsqrtf(ss * (1.0f / 128.0f) + NORM_EPS);
#pragma unroll
    for (int d0 = 0; d0 < 8; ++d0) { const f32x4 w0 = *reinterpret_cast<const f32x4*>(qn + d0 * 16 + hi * 8), w1 = *reinterpret_cast<const f32x4*>(qn + d0 * 16 + hi * 8 + 4);
#pragma unroll
      for (int j = 0; j < 4; ++j) { x[d0][j] *= rstd * w0[j]; x[d0][4 + j] *= rstd * w1[j]; } }
    if (rope) {
      const int t = tok0 + wid * QBLK + r32, prow = t >> 6, pcol = t & 63;
#pragma unroll
      for (int half = 0; half < 2; ++half) { const f32x2* rp = rope + (half ? pcol : prow) * 32;
#pragma unroll
        for (int dd = 0; dd < 2; ++dd) { const int d0 = half * 4 + dd;
#pragma unroll
          for (int j = 0; j < 8; ++j) { const f32x2 cs = rp[dd * 16 + hi * 8 + j]; const float x1 = x[d0][j], x2 = x[d0 + 2][j];
            x[d0][j] = x1 * cs.x - x2 * cs.y; x[d0 + 2][j] = x1 * cs.y + x2 * cs.x; } } }
    }
#pragma unroll
    for (int d0 = 0; d0 < 8; ++d0) { v4u w = {cvt_pk_bf16(x[d0][0], x[d0][1]), cvt_pk_bf16(x[d0][2], x[d0][3]), cvt_pk_bf16(x[d0][4], x[d0][5]), cvt_pk_bf16(x[d0][6], x[d0][7])}; qr[d0] = *reinterpret_cast<bf16x8*>(&w); }
  }
#define SWRITE(b, i) do { *(bf16x8*)(V_lds + (b) * SHM_V + vst0) = sr_[i].vs0;          \
    *(bf16x8*)(V_lds + (b) * SHM_V + vst1) = sr_[i].vs1; int kc = sc * 2;               \
    *(bf16x8*)(K_lds + (b) * SHM_K + KSWZ(sr, kc)) = sr_[i].ks0;                       \
    *(bf16x8*)(K_lds + (b) * SHM_K + KSWZ(32 + sr, kc)) = sr_[i].ks1; } while (0)
#define SWAIT() asm volatile("s_waitcnt vmcnt(4)" ::: "memory")
#define RESC(a) do { if (__any((a) < 1.f)) { if (hi == 0) al_l[r32] = (a); asm volatile("s_waitcnt lgkmcnt(0)" ::: "memory"); \
    for (int d = 0; d < 4; ++d) for (int r = 0; r < 16; ++r) o[d][r] *= al_l[crow(r, hi)]; } } while (0)
  f32x16 pA0, pA1, pB0, pB1; float mnA, mnB, alA, alB; bf16x8 pa0, pa1, pa2, pa3; const int NT = nt0 + nt1;
  constexpr int SE = 0, SO = 1;
  asm volatile("s_waitcnt vmcnt(0)" ::: "memory"); SWRITE(0, SE); __syncthreads();
  qkt(pA0, pA1, K_lds, qr, r32, hi); partialSM(pA0, pA1, m_reg, mnA, alA);
  SLOAD(SO, 1); if (2 < NT) SLOAD(SE, 2);
  SWAIT(); SWRITE(1, SO); __syncthreads();
  for (int j = 1; j + 1 < NT; j += 2) {
    SBAR(); qkt(pB0, pB1, K_lds + SHM_K, qr, r32, hi);
    finishSM(pA0, pA1, alA, l_reg, pa0, pa1, pa2, pa3); SBAR();
    SLOAD(SO, j + 2); SBAR();
    pv_d0(o, vb0, pa0, pa1, pa2, pa3); partialSM(pB0, pB1, m_reg, mnB, alB);
    __syncthreads(); SWAIT(); SWRITE(0, SE);
    RESC(alB); __syncthreads();
    SBAR(); qkt(pA0, pA1, K_lds, qr, r32, hi);
    finishSM(pB0, pB1, alB, l_reg, pa0, pa1, pa2, pa3); SBAR();
    if (j + 3 < NT) SLOAD(SE, j + 3); SBAR();
    pv_d0(o, vb0 + SHM_V, pa0, pa1, pa2, pa3); partialSM(pA0, pA1, m_reg, mnA, alA);
    __syncthreads(); SWAIT(); SWRITE(1, SO);
    RESC(alA); __syncthreads();
  }
  SBAR(); qkt(pB0, pB1, K_lds + SHM_K, qr, r32, hi);
  finishSM(pA0, pA1, alA, l_reg, pa0, pa1, pa2, pa3); SBAR();
  pv_d0(o, vb0, pa0, pa1, pa2, pa3); partialSM(pB0, pB1, m_reg, mnB, alB);
  __syncthreads(); RESC(alB);
  finishSM(pB0, pB1, alB, l_reg, pa0, pa1, pa2, pa3); SBAR();
  pv_d0(o, vb0 + SHM_V, pa0, pa1, pa2, pa3);
  if (hi == 0) li_l[r32] = l_reg; asm volatile("s_waitcnt lgkmcnt(0)" ::: "memory");
  char* stg = lds + OSTG_OFF + wid * OSTG_WAVE;
  v4u gvv[8];
#pragma unroll
  for (int it = 0; it < 8; ++it) gvv[it] = *reinterpret_cast<const v4u*>(Gb + (long)(wid * QBLK + it * 4 + (lane >> 4)) * INW + (lane & 15) * 8);
#pragma unroll
  for (int r = 0; r < 16; ++r) { const int orow = crow(r, hi); const float rl = __builtin_amdgcn_rcpf(li_l[orow]);
#pragma unroll
    for (int d0 = 0; d0 < 4; ++d0) { const unsigned w = cvt_pk_bf16(o[d0][r] * rl, 0.f); *(bf16*)(stg + orow * OSTG_ROW + (d0 * 32 + r32) * 2) = (bf16)(w & 0xffffu); }
    if ((r & 3) == 3) asm volatile("" ::: "memory"); }
  asm volatile("s_waitcnt lgkmcnt(0)" ::: "memory");
#pragma unroll
  for (int it = 0; it < 8; ++it) { const int row = it * 4 + (lane >> 4), cc = (lane & 15) * 8;
    const v4u ov = *(const v4u*)(stg + row * OSTG_ROW + cc * 2);
    const v4u gv = gvv[it];
    v4u w; w.x = cvt_pk_bf16(bf_lo(ov.x) * bf_lo(gv.x), bf_hi(ov.x) * bf_hi(gv.x)); w.y = cvt_pk_bf16(bf_lo(ov.y) * bf_lo(gv.y), bf_hi(ov.y) * bf_hi(gv.y));
    w.z = cvt_pk_bf16(bf_lo(ov.z) * bf_lo(gv.z), bf_hi(ov.z) * bf_hi(gv.z)); w.w = cvt_pk_bf16(bf_lo(ov.w) * bf_lo(gv.w), bf_hi(ov.w) * bf_hi(gv.w));
    *reinterpret_cast<v4u*>(Ob + (long)(wid * QBLK + row) * DM + cc) = w; }
#undef SLOAD
#undef SWRITE
#undef SWAIT
#undef RESC
}
}

#define XB_TMO      128
#define XB_XCNT(j)  (256  + 64 * (j))
#define XB_XSUB(j)  (1280 + 64 * (j))
#define XB_XGEN(j)  (2304 + 64 * (j))
#define XB_TOP      3328
#define XB_TOPGEN   3392
#define XCD_BAR_WORDS 3456
#define XB_SPIN_CAP (1u << 18)
__device__ __forceinline__ unsigned xb_ld(unsigned* p)              { return __hip_atomic_load(p, __ATOMIC_RELAXED, __HIP_MEMORY_SCOPE_AGENT); }
__device__ __forceinline__ unsigned xb_add(unsigned* p, unsigned v) { return __hip_atomic_fetch_add(p, v, __ATOMIC_RELAXED, __HIP_MEMORY_SCOPE_AGENT); }
__device__ __forceinline__ unsigned xb_xcc_id() { return (unsigned)__builtin_amdgcn_s_getreg((3 << 11) | 20) & 0xFu; }
#define XB_SPIN(cond, bar) do { unsigned _sp = 0; while (cond) { __builtin_amdgcn_s_sleep(1); \
    if ((++_sp & 255u) == 0u) { if (xb_ld(&(bar)[XB_TMO])) break; if (_sp > XB_SPIN_CAP) { atomicAdd(&(bar)[XB_TMO], 1u); break; } } } } while (0)
struct XcdBarrier { unsigned* bar; unsigned x; volatile LAS unsigned* st; };
__device__ __forceinline__ XcdBarrier xcd_barrier_post(unsigned* bar, volatile LAS unsigned* st, int tid) {
    XcdBarrier b; b.bar = bar; b.x = xb_xcc_id(); b.st = st;
    if (tid == 0) (void)xb_add(&bar[XB_XCNT(b.x)], 1u);
    return b;
}
__device__ __forceinline__ void xcd_barrier_complete(unsigned* bar, unsigned x, unsigned& nloc, unsigned& nx) {
    const unsigned G = gridDim.x * gridDim.y * gridDim.z;
    unsigned sum, cnt, mine, sp = 0u;
    for (;;) {
        sum = 0u; cnt = 0u; mine = 0u;
#pragma nounroll
        for (unsigned j = 0; j < 16; ++j) { const unsigned c = xb_ld(&bar[XB_XCNT(j)]); sum += c; cnt += (c > 0u) ? 1u : 0u; mine = (j == x) ? c : mine; }
        if (sum == G) break;
        __builtin_amdgcn_s_sleep(1);
        if ((++sp & 255u) == 0u) { if (xb_ld(&bar[XB_TMO])) break; if (sp > XB_SPIN_CAP) { atomicAdd(&bar[XB_TMO], 1u); break; } }
    }
    nloc = mine > 0u ? mine : 1u; nx = cnt > 0u ? cnt : 1u;
}
__device__ __forceinline__ void xcd_barrier(const XcdBarrier& b, int wv) {
    asm volatile("s_waitcnt vmcnt(0)" ::: "memory");
    __syncthreads();
    if (tid_of(wv) == 0) {
        unsigned* bar = b.bar;
        __builtin_amdgcn_s_waitcnt(0);
        unsigned nloc = b.st[0], nx = b.st[1];
        if (nloc == 0u) { xcd_barrier_complete(bar, b.x, nloc, nx); b.st[0] = nloc; b.st[1] = nx; }
        const unsigned old = xb_add(&bar[XB_XSUB(b.x)], 1u);
        const unsigned gen = old / nloc;
        if (old + 1u == (gen + 1u) * nloc) {
            __builtin_amdgcn_fence(__ATOMIC_RELEASE, "agent");
            asm volatile("s_waitcnt vmcnt(0)" ::: "memory");
            const unsigned og = xb_add(&bar[XB_TOP], 1u);
            const unsigned tg = og / nx;
            if (og + 1u == (tg + 1u) * nx) xb_add(&bar[XB_TOPGEN], 1u);
            else XB_SPIN(xb_ld(&bar[XB_TOPGEN]) == tg, bar);
            __builtin_amdgcn_fence(__ATOMIC_ACQUIRE, "agent");
            xb_add(&bar[XB_XGEN(b.x)], 1u);
            asm volatile("s_waitcnt vmcnt(0)" ::: "memory");
        } else {
            XB_SPIN(xb_ld(&bar[XB_XGEN(b.x)]) == gen, bar);
            __builtin_amdgcn_fence(__ATOMIC_ACQUIRE, "agent");
            asm volatile("s_waitcnt vmcnt(0)" ::: "memory");
        }
    }
    __syncthreads();
}
__device__ __forceinline__ void wg_global_sync() {
    asm volatile("s_waitcnt vmcnt(0)" ::: "memory");
    __syncthreads();
    __builtin_amdgcn_fence(__ATOMIC_ACQUIRE, "agent");
    asm volatile("s_waitcnt vmcnt(0)" ::: "memory");
}

struct Args { const float* in[28]; float* out; unsigned char* ws; int ph_lo, ph_hi; };
typedef const __attribute__((address_space(4))) Args* KAP;
#define KA_HERE() KAP ka = (KAP)__builtin_amdgcn_kernarg_segment_ptr(); asm volatile("" : "+s"(ka))
enum { I_XP = 0, I_XS, I_CK, I_CV, I_SFR, I_SFI, I_SBR, I_SBI, I_C, I_CCTX, I_NG, I_WMOD, I_BMOD, I_WIN, I_QN, I_KN, I_LRE, I_LIM, I_LSTEP, I_BRE, I_BIM, I_CRE, I_CIM, I_DSKIP, I_WGLU, I_WFFT, I_WOUT, I_FNG };

__device__ __forceinline__ int glu_row(int n) { return n < 1024 ? ((n >> 7) * 256 + (n & 127)) : (((n - 1024) >> 7) * 256 + 128 + ((n - 1024) & 127)); }
template <bool GLU>
__device__ __forceinline__ void tr_item(const float* __restrict__ W, int K, int N, bf16* __restrict__ WT, LAS float* scr, int item, int lane) {
    const int nblk = N / 64, kb = item / nblk, nb = item % nblk, k0 = 64 * kb, n0 = 64 * nb;
#pragma unroll 8
    for (int i = 0; i < 64; ++i) scr[i * 65 + lane] = W[(size_t)(k0 + i) * N + n0 + lane];
    LDS_WAIT(); asm volatile("" ::: "memory");
    const int c = lane & 7;
#pragma unroll
    for (int j = 0; j < 8; ++j) { const int n = (lane >> 3) + 8 * j; const LAS float* s = scr + (8 * c) * 65 + n;
        v4u o; o.x = cvt_pk_bf16(s[0 * 65], s[1 * 65]); o.y = cvt_pk_bf16(s[2 * 65], s[3 * 65]); o.z = cvt_pk_bf16(s[4 * 65], s[5 * 65]); o.w = cvt_pk_bf16(s[6 * 65], s[7 * 65]);
        int nd = n0 + n; if (GLU) nd = glu_row(nd);
        *(v4u*)(WT + (size_t)nd * K + k0 + 8 * c) = o; }
    LDS_WAIT(); asm volatile("" ::: "memory");
}

__device__ __forceinline__ void ssm_matrices(KAP A, int l, int g, LAS unsigned char* lds, int tid) {
    LAS f32x2* pw = (LAS f32x2*)lds;
    LAS f32x2* bb = pw + 2 * 17 * 64;
    LAS f32x2* cc = bb + 2 * 64 * 16;
    LAS float* kk = (LAS float*)(cc + 2 * 16 * 64);
    if (tid < 128) {
        const int dir = tid >> 6, p = tid & 63, ig = (l * 2 + dir) * 64 + g;
        const float dt = expf(A->in[I_LSTEP][ig]);
        const float lr = A->in[I_LRE][(size_t)ig * 64 + p], li = A->in[I_LIM][(size_t)ig * 64 + p];
        for (int tau = 0; tau <= 16; ++tau) {
            const float mag = expf(lr * dt * (float)tau);
            const double turns = (double)li * (double)dt * (double)tau * 0.15915494309189535;
            const float fr = (float)(turns - rint(turns));
            pw[(dir * 17 + tau) * 64 + p] = (f32x2){mag * cospif(2.f * fr), mag * sinpif(2.f * fr)};
        }
        const f32x2 ab = pw[(dir * 17 + 1) * 64 + p];
        const float nr = ab.x - 1.0f, ni = ab.y, den = lr * lr + li * li;
        const float f_re = (nr * lr + ni * li) / den, f_im = (ni * lr - nr * li) / den;
        for (int c = 0; c < 16; ++c) { const float br = A->in[I_BRE][((size_t)ig * 64 + p) * 16 + c], bi = A->in[I_BIM][((size_t)ig * 64 + p) * 16 + c];
            bb[(dir * 64 + p) * 16 + c] = (f32x2){f_re * br - f_im * bi, f_re * bi + f_im * br}; }
        ((f32x2*)(A->ws + WS_A16))[(size_t)ig * 64 + p] = pw[(dir * 17 + 16) * 64 + p];
    }
    for (int idx = tid; idx < 2048; idx += 512) { const int dir = idx >> 10, c = (idx >> 6) & 15, p = idx & 63; const size_t gi = (((size_t)(l * 2 + dir) * 64 + g) * 16 + c) * 64 + p;
        cc[idx] = (f32x2){A->in[I_CRE][gi], A->in[I_CIM][gi]}; }
    __syncthreads();
    {
        const int dir = tid >> 8, tau = (tid >> 4) & 15, c = tid & 15;
        float accv[16];
#pragma unroll
        for (int j = 0; j < 16; ++j) accv[j] = 0.f;
        for (int p = 0; p < 64; ++p) { const f32x2 cv = cc[(dir * 16 + c) * 64 + p], pv = pw[(dir * 17 + tau) * 64 + p];
            const float wre = cv.x * pv.x - cv.y * pv.y, wim = cv.x * pv.y + cv.y * pv.x;
#pragma unroll
            for (int j = 0; j < 16; ++j) { const f32x2 bv = bb[(dir * 64 + p) * 16 + j]; accv[j] += wre * bv.x - wim * bv.y; } }
#pragma unroll
        for (int j = 0; j < 16; ++j) kk[((dir * 16 + tau) * 16 + c) * 16 + j] = accv[j];
    }
    __syncthreads();
    const int lg = l * 64 + g;
    bf16* Pm = (bf16*)(A->ws + WS_PMAT) + (size_t)lg * 256 * 256;
    for (int q = tid; q < 8192; q += 512) { const int R = q >> 5, col = (q & 31) * 8, s = col >> 4, c0 = col & 15, dir = R >> 7, reim = (R >> 6) & 1, p = R & 63, e = dir ? s : 15 - s;
        const f32x2 pv = pw[(dir * 17 + e) * 64 + p]; float v[8];
#pragma unroll
        for (int j = 0; j < 8; ++j) { const f32x2 bv = bb[(dir * 64 + p) * 16 + c0 + j]; v[j] = reim ? (pv.x * bv.y + pv.y * bv.x) : (pv.x * bv.x - pv.y * bv.y); }
        v4u w; w.x = cvt_pk_bf16(v[0], v[1]); w.y = cvt_pk_bf16(v[2], v[3]); w.z = cvt_pk_bf16(v[4], v[5]); w.w = cvt_pk_bf16(v[6], v[7]);
        *(v4u*)(Pm + (size_t)R * 256 + col) = w; }
    bf16* KGm = (bf16*)(A->ws + WS_KG) + (size_t)lg * 256 * 512;
    for (int q = tid; q < 16384; q += 512) { const int R = q >> 6, col = (q & 63) * 8, i = R >> 4, c = R & 15; float v[8];
        if (col < 256) { const int s = col >> 4, c0 = col & 15;
#pragma unroll
            for (int j = 0; j < 8; ++j) { const int cp = c0 + j; float x;
                if (s < i) x = kk[((0 * 16 + (i - s)) * 16 + c) * 16 + cp];
                else if (s > i) x = kk[((1 * 16 + (s - i)) * 16 + c) * 16 + cp];
                else { x = kk[((0 * 16 + 0) * 16 + c) * 16 + cp] + kk[((1 * 16 + 0) * 16 + c) * 16 + cp]; if (cp == c) x += A->in[I_DSKIP][l * 1024 + g * 16 + c]; }
                v[j] = x; }
        } else { const int k = col - 256, dir = k >> 7, reim = (k >> 6) & 1, p0 = k & 63, e = dir ? 16 - i : i + 1;
#pragma unroll
            for (int j = 0; j < 8; ++j) { const f32x2 cv = cc[(dir * 16 + c) * 64 + p0 + j], pv = pw[(dir * 17 + e) * 64 + p0 + j];
                v[j] = reim ? -(cv.x * pv.y + cv.y * pv.x) : (cv.x * pv.x - cv.y * pv.y); } }
        v4u w; w.x = cvt_pk_bf16(v[0], v[1]); w.y = cvt_pk_bf16(v[2], v[3]); w.z = cvt_pk_bf16(v[4], v[5]); w.w = cvt_pk_bf16(v[6], v[7]);
        *(v4u*)(KGm + (size_t)R * 512 + col) = w; }
    __syncthreads();
}

__device__ __forceinline__ void mod_unit(KAP A, int un, LAS unsigned char* lds, int tid, int wave, int lane) {
    LAS float* sl = (LAS float*)lds;
    LAS float* red = sl + 3 * 4096;
    const int l = un >> 6, nb = un & 63;
    for (int i = tid; i < 3 * 4096; i += 512) { const int v = i >> 12, k = i & 4095; const float x = v == 0 ? A->in[I_CCTX][k] : A->in[I_C][(v - 1) * 4096 + k]; sl[i] = x / (1.0f + expf(-x)); }
    __syncthreads();
    const int ln = lane < 48 ? lane : 47;
    const float* wp = A->in[I_WMOD] + ((size_t)l * 4096 + wave * 512) * 12288 + nb * 192 + ln * 4;
    f32x4 a0 = {0.f, 0.f, 0.f, 0.f}, a1 = a0, a2 = a0;
#pragma unroll 8
    for (int kq = 0; kq < 512; ++kq) { const f32x4 w = *(const f32x4*)(wp + (size_t)kq * 12288); const int k = wave * 512 + kq;
        a0 += sl[k] * w; a1 += sl[4096 + k] * w; a2 += sl[8192 + k] * w; }
    if (lane < 48) {
#pragma unroll
        for (int j = 0; j < 4; ++j) { red[(wave * 3 + 0) * 256 + lane * 4 + j] = a0[j]; red[(wave * 3 + 1) * 256 + lane * 4 + j] = a1[j]; red[(wave * 3 + 2) * 256 + lane * 4 + j] = a2[j]; } }
    __syncthreads();
    for (int i = tid; i < 768; i += 512) { const int v = i >> 8, col = i & 255; if (col < 192) { float s = 0.f;
#pragma unroll
        for (int w = 0; w < 8; ++w) s += red[(w * 3 + v) * 256 + col];
        ((float*)(A->ws + WS_MOD))[(size_t)(l * 3 + v) * 12288 + nb * 192 + col] = s + A->in[I_BMOD][l * 12288 + nb * 192 + col]; } }
    __syncthreads();
}

__device__ __forceinline__ void p0_prologue(KAP A, LAS unsigned char* lds, int G, int bx, int wv) {
    const int tid = tid_of(wv); const int lane = tid & 63, wave = __builtin_amdgcn_readfirstlane(tid >> 6);
    { LAS float* scr = (LAS float*)(lds + wave * 16640);
      const int gw = bx * NWAVES + wave, NGW = G * NWAVES;
      constexpr int I_IN = 64 * 144, I_OUT = 64 * 64, I_GLU = 16 * 32, I_L = I_IN + I_OUT + I_GLU;
      for (int it = gw; it < 4 * I_L; it += NGW) { const int l = it / I_L; int r = it % I_L;
          if (r < I_IN) { tr_item<false>(A->in[I_WIN] + (size_t)l * 4096 * 9216, 4096, 9216, (bf16*)(A->ws + WS_WIN) + (size_t)l * 9216 * 4096, scr, r, lane); continue; } r -= I_IN;
          if (r < I_OUT) { tr_item<false>(A->in[I_WOUT] + (size_t)l * 4096 * 4096, 4096, 4096, (bf16*)(A->ws + WS_WOUT) + (size_t)l * 4096 * 4096, scr, r, lane); continue; } r -= I_OUT;
          tr_item<true>(A->in[I_WGLU] + (size_t)l * 1024 * 2048, 1024, 2048, (bf16*)(A->ws + WS_WGLU) + (size_t)l * 2048 * 1024, scr, r, lane); }
    }
    __syncthreads();
    for (int un = bx; un < 256; un += G) mod_unit(A, un, lds, tid, wave, lane);
    const size_t gt = (size_t)bx * 512 + tid, NGT = (size_t)G * 512;
    { bf16* D2L = (bf16*)(A->ws + WS_D2L);
      LAS bf16* lut = (LAS bf16*)lds;
      for (int i = tid; i < 4096; i += 512) lut[i] = (bf16)(cvt_pk_bf16(cospif((float)i * (1.0f / 2048.0f)), 0.f) & 0xffffu);
      __syncthreads();
      for (size_t q = gt; q < (size_t)4096 * 1024; q += NGT) { const int k = (int)(q >> 10), K0 = (int)(q & 1023) * 8; unsigned h[8];
          const int sh = K0 < 4096 ? 0 : 1024;
#pragma unroll
          for (int j = 0; j < 8; ++j) { const int K = (K0 + j) & 4095; h[j] = lut[(k * K + sh) & 4095]; }
          v4u w; w.x = h[0] | (h[1] << 16); w.y = h[2] | (h[3] << 16); w.z = h[4] | (h[5] << 16); w.w = h[6] | (h[7] << 16);
          *(v4u*)(D2L + (size_t)k * 8192 + K0) = w; }
      __syncthreads(); }
    { bf16* D1 = (bf16*)(A->ws + WS_D1);
      for (size_t q = gt; q < (size_t)256 * 256; q += NGT) { const int mp = (int)(q >> 8), c = (int)(q & 255), m = mp <= 128 ? mp : mp - 128; const float x = (float)((m * c) & 255) * (1.0f / 128.0f);
          const float v = mp <= 128 ? cospif(x) : sinpif(x); D1[q] = (bf16)(cvt_pk_bf16(v, 0.f) & 0xffffu); } }
    { bf16* WFP = (bf16*)(A->ws + WS_WFP);
      for (size_t q = gt; q < (size_t)4 * 144 * 1024; q += NGT) { const int n = (int)(q & 1023), i = (int)((q >> 10) % 144), l = (int)(q / (144 * 1024)); const int kk0 = i * 8;
          const float* W = A->in[I_WFFT] + (size_t)l * 1024 * 1024 + n; float v[8];
          if (kk0 < 1024) { const int g = kk0 >> 8, part = (kk0 >> 7) & 1;
#pragma unroll
              for (int j = 0; j < 8; ++j) { const int m = (kk0 + j) & 127; const float w1 = W[(size_t)(g * 256 + m) * 1024], w2 = W[(size_t)(g * 256 + ((256 - m) & 255)) * 1024];
                  v[j] = part ? (w1 - w2) : (m ? w1 + w2 : w1); } }
          else {
#pragma unroll
              for (int j = 0; j < 8; ++j) v[j] = 0.f;
              if (kk0 == 1024) {
#pragma unroll
                  for (int j = 0; j < 4; ++j) v[j] = W[(size_t)(j * 256 + 128) * 1024]; } }
          v4u w; w.x = cvt_pk_bf16(v[0], v[1]); w.y = cvt_pk_bf16(v[2], v[3]); w.z = cvt_pk_bf16(v[4], v[5]); w.w = cvt_pk_bf16(v[6], v[7]);
          *(v4u*)(WFP + ((size_t)l * 1024 + n) * PK + kk0) = w; }
      bf16* P = (bf16*)(A->ws + WS_P);
      for (size_t q = gt; q < (size_t)NTOK * 31; q += NGT) { const size_t row = q / 31; const int j = (int)(q % 31); *(v2u*)(P + row * PK + 1028 + j * 4) = (v2u){0u, 0u}; } }
    { bf16* D2C = (bf16*)(A->ws + WS_D2C);
      for (size_t q = gt; q < (size_t)256 * 512; q += NGT) { const int k = (int)(q >> 9), K = (int)(q & 511); const float x = (float)((k * (K & 255)) & 255) * (1.0f / 128.0f);
          const float v = K < 256 ? cospif(x) : -sinpif(x); D2C[q] = (bf16)(cvt_pk_bf16(v, 0.f) & 0xffffu); } }
    { f32x2* rope = (f32x2*)(A->ws + WS_ROPE);
      for (size_t q = gt; q < 64 * 32; q += NGT) { const int pos = (int)(q >> 5), i = (int)(q & 31); const float inv = exp2f(-(float)i * (13.287712379549449f / 32.0f));
          const double turns = (double)pos * (double)inv * 0.15915494309189535; const float fr = (float)(turns - rint(turns));
          rope[q] = (f32x2){cospif(2.f * fr), sinpif(2.f * fr)}; } }
    { const size_t n8 = (size_t)2 * 4 * 512 * 512 / 8;
      for (size_t q = gt; q < 2 * n8; q += NGT) { const bool isk = q < n8; const size_t j = isk ? q : q - n8; const float* src = (isk ? A->in[I_CK] : A->in[I_CV]) + j * 8;
          const f32x4 x0 = *(const f32x4*)src, x1 = *(const f32x4*)(src + 4);
          v4u w; w.x = cvt_pk_bf16(x0[0], x0[1]); w.y = cvt_pk_bf16(x0[2], x0[3]); w.z = cvt_pk_bf16(x1[0], x1[1]); w.w = cvt_pk_bf16(x1[2], x1[3]);
          *(v4u*)((bf16*)(A->ws + (isk ? WS_CK : WS_CV)) + j * 8) = w; } }
    __syncthreads();
    for (int lg = bx; lg < 256; lg += G) ssm_matrices(A, lg >> 6, lg & 63, lds, tid);
}

__device__ __forceinline__ f32x4 ldg16(const void* base, unsigned off, int imm) { return *(const f32x4*)(((const char*)base + off) + imm); }
__device__ __forceinline__ void pa_norm(KAP A, int l, int bx, int G, int tid, LAS unsigned char* lds) {
    const float* mod = (const float*)(A->ws + WS_MOD) + (size_t)l * 3 * 12288;
    const f32x4* ng4 = (const f32x4*)(A->in[I_NG] + l * DM);
    bf16* H = (bf16*)(A->ws + WS_H);
    const int lane = tid & 63, wave = __builtin_amdgcn_readfirstlane(tid >> 6);
    const unsigned lo2 = (unsigned)lane * 16u, lo4 = (unsigned)lane * 32u;
    LAS f32x4* avl = (LAS f32x4*)lds; LAS f32x4* svl = avl + 1024;
    for (int rb = bx; rb < NTOK / 64; rb += G) {
        const int m0 = rb * 64; const int v = m0 < NCTX ? 0 : (m0 < NCTX + 4096 ? 1 : 2);
        const f32x4* sh4 = (const f32x4*)(mod + v * 12288); const f32x4* sc4 = (const f32x4*)(mod + v * 12288 + 4096);
        __syncthreads();
        for (int i = tid; i < 1024; i += NWAVES * 64) { const int d = ((i >> 7) * 2 + (i & 1)) * 64 + ((i & 127) >> 1);
            avl[d] = ng4[i] * (sc4[i] + 1.0f); svl[d] = sh4[i]; }
        __syncthreads();
#pragma unroll 2
        for (int r = 0; r < 8; ++r) { const int m = m0 + wave * 8 + r;
            f32x4 x[16]; float ss = 0.f;
            char* xb = (char*)((bf16*)(A->ws + ((l & 1) ? WS_XBF2 : WS_XBF)) + (size_t)m * DM);
            const char* xbi = (const char*)((const bf16*)(A->ws + ((l & 1) ? WS_XBF : WS_XBF2)) + (size_t)m * DM);
            if (l <= 1) { const float* xr = m < NCTX ? A->in[I_XP] + (size_t)m * DM : A->in[I_XS] + (size_t)(m - NCTX) * DM;
#pragma unroll
                for (int j = 0; j < 8; ++j) { x[2 * j] = ldg16(xr, lo4 + (j >> 1) * 4096u, (j & 1) * 2048); x[2 * j + 1] = ldg16(xr, lo4 + (j >> 1) * 4096u, (j & 1) * 2048 + 16); }
            } else {
#pragma unroll
                for (int j = 0; j < 8; ++j) { const v4u d = *(const v4u*)((xbi + (lo2 + (j >> 2) * 4096u)) + (j & 3) * 1024);
                    x[2 * j] = (f32x4){bf_lo(d.x), bf_hi(d.x), bf_lo(d.y), bf_hi(d.y)}; x[2 * j + 1] = (f32x4){bf_lo(d.z), bf_hi(d.z), bf_lo(d.w), bf_hi(d.w)}; }
            }
            if (l > 0) {
                const char* dr = (const char*)((const bf16*)(A->ws + ((l & 1) ? WS_DELTA : WS_DELTA2)) + (size_t)m * DM);
#pragma unroll
                for (int j = 0; j < 8; ++j) { const v4u d = *(const v4u*)((dr + (lo2 + (j >> 2) * 4096u)) + (j & 3) * 1024);
                    x[2 * j] += (f32x4){bf_lo(d.x), bf_hi(d.x), bf_lo(d.y), bf_hi(d.y)}; x[2 * j + 1] += (f32x4){bf_lo(d.z), bf_hi(d.z), bf_lo(d.w), bf_hi(d.w)};
                    v4u w; w.x = cvt_pk_bf16(x[2 * j].x, x[2 * j].y); w.y = cvt_pk_bf16(x[2 * j].z, x[2 * j].w); w.z = cvt_pk_bf16(x[2 * j + 1].x, x[2 * j + 1].y); w.w = cvt_pk_bf16(x[2 * j + 1].z, x[2 * j + 1].w);
                    *(v4u*)((xb + (lo2 + (j >> 2) * 4096u)) + (j & 3) * 1024) = w; }
            }
#pragma unroll
            for (int j = 0; j < 16; ++j) ss += (x[j].x * x[j].x + x[j].y * x[j].y) + (x[j].z * x[j].z + x[j].w * x[j].w);
            const float rstd = rsqrtf(wave_sum(ss, lane) * (1.0f / DM) + NORM_EPS);
            char* orow = (char*)(H + (size_t)m * DM);
#pragma unroll
            for (int j = 0; j < 8; ++j) { const f32x4 y0 = x[2 * j] * rstd * avl[(2 * j) * 64 + lane] + svl[(2 * j) * 64 + lane], y1 = x[2 * j + 1] * rstd * avl[(2 * j + 1) * 64 + lane] + svl[(2 * j + 1) * 64 + lane];
                v4u w; w.x = cvt_pk_bf16(y0.x, y0.y); w.y = cvt_pk_bf16(y0.z, y0.w); w.z = cvt_pk_bf16(y1.x, y1.y); w.w = cvt_pk_bf16(y1.z, y1.w);
                *(v4u*)((orow + (lo2 + (j >> 2) * 4096u)) + (j & 3) * 1024) = w;
                if ((j & 1) == 1) asm volatile("" ::: "memory"); }
        }
    }
    __syncthreads();
}
__device__ __forceinline__ void final_norm(KAP A, int gw, int NGW, int lane) {
    const float* fg = A->in[I_FNG];
    const unsigned lo2 = (unsigned)lane * 16u, lo4 = (unsigned)lane * 32u;
    f32x4 gv[16];
#pragma unroll
    for (int j = 0; j < 8; ++j) { gv[2 * j] = ldg16(fg, lo4 + (j >> 1) * 4096u, (j & 1) * 2048); gv[2 * j + 1] = ldg16(fg, lo4 + (j >> 1) * 4096u, (j & 1) * 2048 + 16); }
    for (int ci = gw; ci < NTOK / 8; ci += NGW) {
#pragma unroll 2
        for (int r = 0; r < 8; ++r) { const int m = ci * 8 + r;
            char* xr = (char*)(A->out + (size_t)m * DM);
            const char* xs = (const char*)((const bf16*)(A->ws + (((DEPTH - 1) & 1) ? WS_XBF2 : WS_XBF)) + (size_t)m * DM);
            const char* dr = (const char*)((const bf16*)(A->ws + (((DEPTH - 1) & 1) ? WS_DELTA2 : WS_DELTA)) + (size_t)m * DM);
            f32x4 x[16]; float ss = 0.f;
#pragma unroll
            for (int j = 0; j < 8; ++j) { const v4u xv = *(const v4u*)((xs + (lo2 + (j >> 2) * 4096u)) + (j & 3) * 1024); const v4u d = *(const v4u*)((dr + (lo2 + (j >> 2) * 4096u)) + (j & 3) * 1024);
                x[2 * j] = (f32x4){bf_lo(xv.x) + bf_lo(d.x), bf_hi(xv.x) + bf_hi(d.x), bf_lo(xv.y) + bf_lo(d.y), bf_hi(xv.y) + bf_hi(d.y)};
                x[2 * j + 1] = (f32x4){bf_lo(xv.z) + bf_lo(d.z), bf_hi(xv.z) + bf_hi(d.z), bf_lo(xv.w) + bf_lo(d.w), bf_hi(xv.w) + bf_hi(d.w)}; }
#pragma unroll
            for (int j = 0; j < 16; ++j) ss += (x[j].x * x[j].x + x[j].y * x[j].y) + (x[j].z * x[j].z + x[j].w * x[j].w);
            const float rstd = rsqrtf(wave_sum(ss, lane) * (1.0f / DM) + NORM_EPS);
#pragma unroll
            for (int j = 0; j < 8; ++j) { *(f32x4*)((xr + (lo4 + (j >> 1) * 4096u)) + (j & 1) * 2048) = x[2 * j] * rstd * gv[2 * j]; *(f32x4*)((xr + (lo4 + (j >> 1) * 4096u)) + (j & 1) * 2048 + 16) = x[2 * j + 1] * rstd * gv[2 * j + 1];
                if ((j & 1) == 1) asm volatile("" ::: "memory"); }
        }
    }
}

__device__ __forceinline__ void kv_prep(KAP A, int l, int gw, int NGW, int lane) {
    const bf16* PROJ = (const bf16*)(A->ws + WS_PROJ);
    const f32x2* rope = (const f32x2*)(A->ws + WS_ROPE);
    const int hl = lane & 15;
    const f32x4 kn0 = *(const f32x4*)(A->in[I_KN] + l * 128 + hl * 8), kn1 = *(const f32x4*)(A->in[I_KN] + l * 128 + hl * 8 + 4);
    for (int ci = gw; ci < NTOK / 4; ci += NGW) {
        const int m0 = ci * 4; const bool ctx = m0 < NCTX;
        v4u kr[4], vr[4];
#pragma unroll
        for (int r = 0; r < 4; ++r) { const bf16* pr = PROJ + (size_t)(m0 + r) * INW; kr[r] = *(const v4u*)(pr + OFF_K + 8 * lane); vr[r] = *(const v4u*)(pr + OFF_V + 8 * lane); }
#pragma unroll
        for (int r = 0; r < 4; ++r) { const int m = m0 + r;
            float k[8] = {bf_lo(kr[r].x), bf_hi(kr[r].x), bf_lo(kr[r].y), bf_hi(kr[r].y), bf_lo(kr[r].z), bf_hi(kr[r].z), bf_lo(kr[r].w), bf_hi(kr[r].w)};
            float ss = 0.f;
#pragma unroll
            for (int j = 0; j < 8; ++j) ss += k[j] * k[j];
            ss += shflx(ss, lane, 1); ss += shflx(ss, lane, 2); ss += shflx(ss, lane, 4); ss += shflx(ss, lane, 8);
            const float rstd = rsqrtf(ss * (1.0f / 128.0f) + NORM_EPS);
#pragma unroll
            for (int j = 0; j < 4; ++j) { k[j] *= rstd * kn0[j]; k[4 + j] *= rstd * kn1[j]; }
            if (ctx) {
                const int b = m >> 8, t = m & 255; const size_t oi = (((size_t)(b * 4 + l) * 256 + t) * 512 + 8 * lane);
                float* ok = A->out + OUT_NEWK + oi; *(f32x4*)ok = (f32x4){k[0], k[1], k[2], k[3]}; *(f32x4*)(ok + 4) = (f32x4){k[4], k[5], k[6], k[7]};
                float* ov = A->out + OUT_NEWV + oi; *(f32x4*)ov = (f32x4){bf_lo(vr[r].x), bf_hi(vr[r].x), bf_lo(vr[r].y), bf_hi(vr[r].y)}; *(f32x4*)(ov + 4) = (f32x4){bf_lo(vr[r].z), bf_hi(vr[r].z), bf_lo(vr[r].w), bf_hi(vr[r].w)};
            } else {
                const int t = (m - NCTX) & 4095, pos = hl < 8 ? (t >> 6) : (t & 63); const f32x2* rp = rope + pos * 32 + (lane & 3) * 8; const bool first = (lane & 4) == 0;
#pragma unroll
                for (int j = 0; j < 8; ++j) { const float other = shflx(k[j], lane, 4); const f32x2 cs = rp[j];
                    k[j] = first ? (k[j] * cs.x - other * cs.y) : (other * cs.y + k[j] * cs.x); }
            }
            v4u w; w.x = cvt_pk_bf16(k[0], k[1]); w.y = cvt_pk_bf16(k[2], k[3]); w.z = cvt_pk_bf16(k[4], k[5]); w.w = cvt_pk_bf16(k[6], k[7]);
            *(v4u*)((bf16*)(A->ws + WS_KC) + (size_t)m * 512 + 8 * lane) = w;
            *(v4u*)((bf16*)(A->ws + WS_VC) + (size_t)m * 512 + 8 * lane) = vr[r];
        }
    }
}

__device__ __forceinline__ void ssm_scan(KAP A, int l, int g, int mt, int tid, LAS unsigned char* lds) {
    const float* S = (const float*)(A->ws + WS_SBUF) + (size_t)g * 1024 * 256;
    bf16* A2 = (bf16*)(A->ws + WS_A2) + (size_t)g * 1024 * 512;
    const int blk = tid >> 5, sub = tid & 31, dir = sub >> 4, p0 = (sub & 15) * 4;
    f32x4 ar, ai;
    { const f32x4* a4 = (const f32x4*)((const float*)(A->ws + WS_A16) + (((size_t)(l * 2 + dir) * 64 + g) * 64 + p0) * 2); const f32x4 t0 = a4[0], t1 = a4[1];
      ar = (f32x4){t0.x, t0.z, t1.x, t1.z}; ai = (f32x4){t0.y, t0.w, t1.y, t1.w}; }
    const int ecol = 256 + dir * 128 + p0, scol = dir * 128 + p0;
    LAS f32x4* T = (LAS f32x4*)lds;
    LAS f32x4* EB = T + 16 * 32 * 2;
    const bool lat = mt >= 2;
    const int rb = mt * 256 + blk * 16;
    f32x4 sr[16], si[16];
#pragma unroll
    for (int i = 0; i < 16; ++i) { const int row = rb + (dir ? 15 - i : i); sr[i] = *(const f32x4*)(S + (size_t)row * 256 + scol); si[i] = *(const f32x4*)(S + (size_t)row * 256 + scol + 64); }
    f32x4 er = {0.f, 0.f, 0.f, 0.f}, ei = er;
    if (lat) {
#pragma unroll
        for (int i = 0; i < 16; ++i) { const f32x4 nr = ar * er - ai * ei + sr[i], ni = ar * ei + ai * er + si[i]; er = nr; ei = ni; }
        T[(blk * 32 + sub) * 2] = er; T[(blk * 32 + sub) * 2 + 1] = ei;
        __syncthreads();
        if (tid < 32) { const int b = mt - 2; const size_t si0 = (((size_t)b * 4 + l) * 64 + g) * 64 + p0;
            f32x4 cr = *(const f32x4*)(A->in[dir ? I_SBR : I_SFR] + si0), ci = *(const f32x4*)(A->in[dir ? I_SBI : I_SFI] + si0);
            f32x4 qr = ar, qi = ai;
#pragma unroll
            for (int k = 0; k < 4; ++k) { const f32x4 t = qr * qr - qi * qi; qi = 2.f * qr * qi; qr = t; }
#pragma unroll 1
            for (int jb = 0; jb < 16; ++jb) { const int bb = dir ? 15 - jb : jb; EB[(bb * 32 + sub) * 2] = cr; EB[(bb * 32 + sub) * 2 + 1] = ci;
                const f32x4 tr = T[(bb * 32 + sub) * 2], ti = T[(bb * 32 + sub) * 2 + 1];
                const f32x4 nr = qr * cr - qi * ci + tr, ni = qr * ci + qi * cr + ti; cr = nr; ci = ni; } }
        __syncthreads();
        er = EB[(blk * 32 + sub) * 2]; ei = EB[(blk * 32 + sub) * 2 + 1];
    }
#pragma unroll
    for (int i = 0; i < 16; ++i) { const int row = rb + (dir ? 15 - i : i);
        v2u wr, wi; wr.x = cvt_pk_bf16(er.x, er.y); wr.y = cvt_pk_bf16(er.z, er.w); wi.x = cvt_pk_bf16(ei.x, ei.y); wi.y = cvt_pk_bf16(ei.z, ei.w);
        *(v2u*)(A2 + (size_t)row * 512 + ecol) = wr; *(v2u*)(A2 + (size_t)row * 512 + ecol + 64) = wi;
        const f32x4 nr = ar * er - ai * ei + sr[i], ni = ar * ei + ai * er + si[i]; er = nr; ei = ni; }
    if (!lat) { const int b = mt * 16 + blk; const size_t oi = (((size_t)b * 4 + l) * 64 + g) * 64 + p0;
        *(f32x4*)(A->out + (dir ? OUT_BRE : OUT_FRE) + oi) = er; *(f32x4*)(A->out + (dir ? OUT_BIM : OUT_FIM) + oi) = ei; }
}
__device__ __forceinline__ void ssm_step1(KAP A, int l, int un, LAS unsigned char* lds, int wv) {
    const int g = un >> 2, mt = un & 3, lg = l * 64 + g;
    pg8::OneUnit S1; S1.u0.a = (const char*)(A->ws + WS_A2) + ((size_t)g * 1024 + mt * 256) * 512 * 2; S1.u0.b = (const char*)(A->ws + WS_PMAT) + (size_t)lg * 256 * 256 * 2;
    S1.u0.c = (char*)(A->ws + WS_SBUF) + ((size_t)g * 1024 + mt * 256) * 256 * 4; S1.u0.ldc = 256; S1.u0.pm = mt; S1.u0.pn = g; S1.u0.z = 0; S1.u0.kt = 4;
    pg8::EpiF32 E; pg8::gemm_phase<pg8::EpiF32, pg8::OneUnit>(lds, wv, 512, 256, S1, E);
}
__device__ __forceinline__ void ssm_step2(KAP A, int l, int un, LAS unsigned char* lds, int wv) {
    const int g = un >> 2, mt = un & 3; const int tid = tid_of(wv); ssm_scan(A, l, g, mt, tid, lds);
}
__device__ __forceinline__ void ssm_step3(KAP A, int l, int un, LAS unsigned char* lds, int wv) {
    const int g = un >> 2, mt = un & 3, lg = l * 64 + g;
    pg8::OneUnit S2; S2.u0.a = (const char*)(A->ws + WS_A2) + ((size_t)g * 1024 + mt * 256) * 512 * 2; S2.u0.b = (const char*)(A->ws + WS_KG) + (size_t)lg * 256 * 512 * 2;
    S2.u0.c = nullptr; S2.u0.ldc = 0; S2.u0.pm = mt; S2.u0.pn = g; S2.u0.z = mt * 256; S2.u0.kt = 8;
    pg8::EpiSsmY E{(bf16*)(A->ws + WS_YSSM)}; pg8::gemm_phase<pg8::EpiSsmY, pg8::OneUnit>(lds, wv, 512, 512, S2, E);
}

struct Fft1Order {
    int G, c; const char* D1; const char* proj; char* zl; char* zc;
    __device__ bool next(int i, pg8::Unit& u) const { const int L = i * G + c; if (L >= 256) return false;
        const int g = L & 3, tt = L >> 2;
        int kt4 = 4; asm volatile("" : "+s"(kt4)); u.kt = kt4;
        u.a = D1; u.b = proj + ((size_t)tt * 256 * INW + OFF_F + g * 256) * 2; u.pm = 0; u.pn = tt; u.z = g;
        if (tt < 32) { u.c = zc + ((size_t)((tt * 4 + g) * 128) * 256) * 2; u.ldc = 256; }
        else { const int b = (tt - 32) >> 4, t0 = ((tt - 32) & 15) * 256; u.c = zl + ((size_t)((b * 4 + g) * 128) * 4096 + t0) * 2; u.ldc = 4096; }
        return true; }
};
struct Fft2LOrder {
    int G, c; const char* D2; const char* z; char* P;
    __device__ bool next(int i, pg8::Unit& u) const { const int L = i * G + c; if (L >= 128) return false;
        const int nt = L & 3, part = (L >> 2) & 1, mt = L >> 3;
        u.kt = 64; u.a = D2 + ((size_t)mt * 256 * 8192 + part * 4096) * 2; u.b = z + (part * ZPART + (size_t)nt * 256 * 4096) * 2; u.pm = mt; u.pn = nt; u.z = part;
        u.c = P + (((size_t)NCTX + (nt >> 1) * 4096 + mt * 256) * PK + (nt & 1) * 512 + part * 128) * 2; u.ldc = PK; return true; }
};
struct Fft2COrder {
    int G, c; const char* D2; const char* z; char* P;
    __device__ bool next(int i, pg8::Unit& u) const { const int L = i * G + c; if (L >= 128) return false;
        const int nt = L & 1, part = (L >> 1) & 1, b = L >> 2;
        u.kt = 4; u.a = D2 + (size_t)part * 256 * 2; u.b = z + (part * ZPART + (size_t)((b * 4 + nt * 2) * 128) * 256) * 2; u.pm = 0; u.pn = nt; u.z = b;
        u.c = P + (((size_t)b * 256) * PK + nt * 512 + part * 128) * 2; u.ldc = PK; return true; }
};
template <int NS, int KS>
__device__ __forceinline__ f32x4 nyq_core(const bf16* arow, size_t lda16, const bf16* bcol, LAS unsigned char* lds, int tid) {
    const int wave = tid >> 6, lane = tid & 63, fq = lane >> 4;
    f32x4 acc[NS];
#pragma unroll
    for (int ns = 0; ns < NS; ++ns) acc[ns] = (f32x4){0.f, 0.f, 0.f, 0.f};
    const int tb = wave * KS * 32 + fq * 8;
#pragma unroll 4
    for (int s2 = 0; s2 < KS; ++s2) { const bf16x8 bv = *(const bf16x8*)(bcol + tb + s2 * 32);
#pragma unroll
        for (int ns = 0; ns < NS; ++ns) { const bf16x8 av = *(const bf16x8*)(arow + ns * lda16 + tb + s2 * 32); acc[ns] = __builtin_amdgcn_mfma_f32_16x16x32_bf16(bv, av, acc[ns], 0, 0, 0); } }
    LAS f32x4* red = (LAS f32x4*)lds;
    __syncthreads();
#pragma unroll
    for (int ns = 0; ns < NS; ++ns) red[(wave * NS + ns) * 64 + lane] = acc[ns];
    __syncthreads();
    f32x4 r = (f32x4){0.f, 0.f, 0.f, 0.f};
    if (tid < NS * 64) {
#pragma unroll
        for (int w = 0; w < 8; ++w) r += red[(w * NS + (tid >> 6)) * 64 + (tid & 63)]; }
    __syncthreads();
    return r;
}
__device__ __forceinline__ void nyq_pass(KAP A, int cA, LAS unsigned char* lds, int wv) {
    const int tid = tid_of(wv); const int fr = tid & 15;
    bf16* P = (bf16*)(A->ws + WS_P);
    {
        const bf16* arow = (const bf16*)(A->ws + WS_D2L) + (size_t)(cA * 32 + fr) * 8192;
        const bf16* bcol = (const bf16*)(A->ws + WS_ZL) + ZPART + (size_t)((fr & 7) * 128) * 4096;
        const f32x4 r = nyq_core<2, 16>(arow, (size_t)16 * 8192, bcol, lds, tid) * (1.0f / 1024.0f);
        const int fq = (tid & 63) >> 4;
        if (tid < 128 && fq < 2) { const int k = cA * 32 + (tid >> 6) * 16 + fr; *(v2u*)(P + ((size_t)NCTX + fq * 4096 + k) * PK + 1024) = (v2u){cvt_pk_bf16(r[0], r[1]), cvt_pk_bf16(r[2], r[3])}; } }
    {
        const int cg = cA & 7, rs = cA >> 3;
        const bf16* arow = (const bf16*)(A->ws + WS_D2C) + (size_t)(rs * 16 + fr) * 512;
        const bf16* bcol = (const bf16*)(A->ws + WS_ZC) + ZPART + (size_t)(((cg * 4 + (fr >> 2)) * 4 + (fr & 3)) * 128) * 256;
        const f32x4 r = nyq_core<1, 1>(arow, 0, bcol, lds, tid) * (1.0f / 256.0f);
        const int fq = (tid & 63) >> 4;
        if (tid < 64) { const int k = rs * 16 + fr, b = cg * 4 + fq; *(v2u*)(P + ((size_t)b * 256 + k) * PK + 1024) = (v2u){cvt_pk_bf16(r[0], r[1]), cvt_pk_bf16(r[2], r[3])}; } }
}

__global__ void __launch_bounds__(NWAVES * 64, 2) hymba_fwd(Args args) {
    extern __shared__ __attribute__((aligned(16))) unsigned char lds_raw[];
    LAS unsigned char* lds = (LAS unsigned char*)lds_raw;
    volatile LAS unsigned* MISC = (volatile LAS unsigned*)(lds + MISC_OFF);
    const int G = gridDim.x, bx = blockIdx.x;
    const int wv = __builtin_amdgcn_readfirstlane(threadIdx.x >> 6);
#define TID_HERE() const int tid = tid_of(wv); const int lane = tid & 63, wave = __builtin_amdgcn_readfirstlane(tid >> 6), gw = bq * NWAVES + wave, NGWq = Gq * NWAVES; (void)lane; (void)gw; (void)NGWq
#define PH_IDS() int Gq = G, bq = bx; asm volatile("" : "+s"(Gq), "+s"(bq))
    for (int u = tid_of(wv); u < (LDS_BYTES - MISC_OFF) / 4; u += NWAVES * 64) ((LAS unsigned*)(lds + MISC_OFF))[u] = 0u;
    __syncthreads();
    int lo, hi; XcdBarrier bar;
    { KA_HERE(); PH_IDS(); lo = ka->ph_lo; hi = ka->ph_hi; unsigned* ctl = (unsigned*)(ka->ws + WS_CTL);
      bar.bar = ctl + CW_BAR; bar.x = 0; bar.st = nullptr;
      if (hi - lo > 1) bar = xcd_barrier_post(ctl + CW_BAR, MISC + 8, tid_of(wv)); }
#define IN(k) (lo <= (k) && (k) < hi)
#define SEAM(k) do { if (IN(k) && IN((k) + 1)) { xcd_barrier(bar, wv); if (((DUP_MASK) >> 12) & 1) xcd_barrier(bar, wv); } } while (0)

    if (IN(0)) DUP(0) { KA_HERE(); PH_IDS(); p0_prologue(ka, lds, Gq, bq, wv); }
    SEAM(0);

    for (int l = 0; l < DEPTH; ++l) for (int lrep_ = 0; lrep_ < 1 + (((DUP_MASK) >> 19) & 1); ++lrep_) {
        const int pb = 1 + 6 * l;
        if (IN(pb)) DUP(1) { KA_HERE(); PH_IDS(); TID_HERE(); pa_norm(ka, l, bq, Gq, tid, lds);
        }
        SEAM(pb);
        if (IN(pb + 1)) DUP(2) {
            KA_HERE(); PH_IDS(); unsigned char* ws = ka->ws;
            pg8::GemmOrder S; S.init(NTOK, INW, Gq, bq, ws + WS_H, DM, ws + WS_WIN + (size_t)l * INW * DM * 2, DM, DM);
            pg8::EpiProj E{(bf16*)(ws + WS_PROJ), (bf16*)(ws + WS_A2)};
            pg8::gemm_phase<pg8::EpiProj, pg8::GemmOrder, GEMM1_ALIGN>(lds, wv, DM, DM, S, E);
        }
        SEAM(pb + 1);
        if (IN(pb + 2)) {
            DUP(16) for (int un = bx; un < 256; un += G) { KA_HERE(); ssm_step1(ka, l, un, lds, wv); }
            DUP(14) { KA_HERE(); PH_IDS(); TID_HERE(); kv_prep(ka, l, gw, NGWq, lane); }
            wg_global_sync();
            DUP(17) { for (int un = bx; un < 256; un += G) { KA_HERE(); ssm_step2(ka, l, un, lds, wv); } __syncthreads(); }
            DUP(3) { KA_HERE(); PH_IDS(); unsigned char* ws = ka->ws;
              Fft1Order S{Gq, bq, (const char*)(ws + WS_D1), (const char*)(ws + WS_PROJ), (char*)(ws + WS_ZL), (char*)(ws + WS_ZC)};
              pg8::EpiBf16X E{1.0f, (int)ZPART, 128}; pg8::gemm_phase<pg8::EpiBf16X, Fft1Order>(lds, wv, 256, INW, S, E); }
            wg_global_sync();
            DUP(18) for (int un = bx; un < 256; un += G) { KA_HERE(); ssm_step3(ka, l, un, lds, wv); }
        }
        SEAM(pb + 2);
        if (IN(pb + 3)) {
            DUP(5) for (int U = bx; U < 512; U += G) {
                KA_HERE(); PH_IDS(); unsigned char* ws = ka->ws; bf16* const PROJ = (bf16*)(ws + WS_PROJ); bf16* const MIX = (bf16*)(ws + WS_MIX);
                const float* qn = ka->in[I_QN] + l * 128; const f32x2* rope = (const f32x2*)(ws + WS_ROPE);
                const int pr = U & 7, idx = U >> 3, b = pr >> 2, kvh = pr & 3, hq = kvh * 4 + (idx >> 4), qb = idx & 15;
                const size_t row0 = (size_t)NCTX + b * 4096 + qb * 256;
                const bf16* ck = (const bf16*)(ws + WS_CK) + ((size_t)(b * 4 + l) * 512) * 512 + kvh * 128;
                const bf16* cv = (const bf16*)(ws + WS_CV) + ((size_t)(b * 4 + l) * 512) * 512 + kvh * 128;
                const bf16* k1 = (const bf16*)(ws + WS_KC) + ((size_t)NCTX + b * 4096) * 512 + kvh * 128; const bf16* v1 = (const bf16*)(ws + WS_VC) + ((size_t)NCTX + b * 4096) * 512 + kvh * 128;
                att::attn_unit(PROJ + row0 * INW + hq * 128, PROJ + row0 * INW + OFF_GA + hq * 128, MIX + row0 * DM + hq * 128,
                               ck, cv, 512, 8, k1, v1, 512, 64, qn, rope, qb * 256, (char*)lds_raw, wv);
            }
            if (bx >= (G >> 1)) {
                const int nB = G - (G >> 1), cB = bx - (G >> 1);
                DUP(6) for (int U = cB; U < 512; U += nB) {
                    KA_HERE(); unsigned char* ws = ka->ws; bf16* const PROJ = (bf16*)(ws + WS_PROJ); bf16* const MIX = (bf16*)(ws + WS_MIX);
                    const float* qn = ka->in[I_QN] + l * 128;
                    const int xx = U & 7, idx = U >> 3, b = xx * 4 + (idx >> 4), hq = idx & 15, kvh = hq >> 2;
                    const size_t row0 = (size_t)b * 256;
                    const bf16* k1 = (const bf16*)(ws + WS_KC) + row0 * 512 + kvh * 128; const bf16* v1 = (const bf16*)(ws + WS_VC) + row0 * 512 + kvh * 128;
                    att::attn_unit(PROJ + row0 * INW + hq * 128, PROJ + row0 * INW + OFF_GA + hq * 128, MIX + row0 * DM + hq * 128,
                                   k1, v1, 512, 0, k1, v1, 512, 4, qn, nullptr, 0, (char*)lds_raw, wv);
                }
                __syncthreads();
                DUP(9) { KA_HERE(); unsigned char* ws = ka->ws; int nBq = nB, cBq = cB; asm volatile("" : "+s"(nBq), "+s"(cBq));
                  pg8::GemmOrder S; S.init(NTOK, 2048, nBq, cBq, ws + WS_YSSM, 1024, ws + WS_WGLU + (size_t)l * 2048 * 1024 * 2, 1024, 1024);
                  pg8::EpiGlu E{(const bf16*)(ws + WS_PROJ), (bf16*)(ws + WS_MIX)}; pg8::gemm_phase<pg8::EpiGlu, pg8::GemmOrder>(lds, wv, 1024, 1024, S, E); }
            } else {
                __syncthreads();
                DUP(7) { KA_HERE(); unsigned char* ws = ka->ws; int nAq = G >> 1, cAq = bx; asm volatile("" : "+s"(nAq), "+s"(cAq));
                  Fft2LOrder S{nAq, cAq, (const char*)(ws + WS_D2L), (const char*)(ws + WS_ZL), (char*)(ws + WS_P)};
                  pg8::EpiBf16X E{1.0f / 1024.0f, 128 * PK, 256}; pg8::gemm_phase<pg8::EpiBf16X, Fft2LOrder>(lds, wv, 8192, 4096, S, E); }
                DUP(8) { KA_HERE(); unsigned char* ws = ka->ws; int nAq = G >> 1, cAq = bx; asm volatile("" : "+s"(nAq), "+s"(cAq));
                  Fft2COrder S{nAq, cAq, (const char*)(ws + WS_D2C), (const char*)(ws + WS_ZC), (char*)(ws + WS_P)};
                  pg8::EpiBf16X E{1.0f / 256.0f, 128 * PK, 256}; pg8::gemm_phase<pg8::EpiBf16X, Fft2COrder>(lds, wv, 512, 256, S, E); }
                DUP(8) { KA_HERE(); for (int it = bx; it < 128; it += (G >> 1)) nyq_pass(ka, it, lds, wv); }
            }
        }
        SEAM(pb + 3);
        if (IN(pb + 4)) {
            DUP(10) { KA_HERE(); PH_IDS(); unsigned char* ws = ka->ws;
              pg8::GemmOrder S; S.init(NTOK, 1024, Gq, bq, ws + WS_P, PK, ws + WS_WFP + (size_t)l * 1024 * PK * 2, PK, PK);
              pg8::EpiFftW E{(const bf16*)(ws + WS_PROJ), (bf16*)(ws + WS_MIX)}; pg8::gemm_phase<pg8::EpiFftW, pg8::GemmOrder>(lds, wv, PK, PK, S, E); }
        }
        SEAM(pb + 4);
        if (IN(pb + 5)) DUP(11) {
            KA_HERE(); PH_IDS(); unsigned char* ws = ka->ws;
            pg8::GemmOrder S; S.init(NTOK, DM, Gq, bq, ws + WS_MIX, DM, ws + WS_WOUT + (size_t)l * DM * DM * 2, DM, DM);
            pg8::EpiOut E{(bf16*)(ws + ((l & 1) ? WS_DELTA2 : WS_DELTA)), (const float*)(ws + WS_MOD) + (size_t)l * 3 * 12288};
            if (((DUP_MASK) >> 13) & 1) {
                { pg8::SliceOrder<pg8::GemmOrder> S2{S, 0, 2}; pg8::gemm_phase<pg8::EpiOut, pg8::SliceOrder<pg8::GemmOrder>, GEMM1_ALIGN>(lds, wv, DM, DM, S2, E); }
                xcd_barrier(bar, wv);
                { pg8::SliceOrder<pg8::GemmOrder> S2{S, 2, 1000}; pg8::gemm_phase<pg8::EpiOut, pg8::SliceOrder<pg8::GemmOrder>, GEMM1_ALIGN>(lds, wv, DM, DM, S2, E); }
            } else
            pg8::gemm_phase<pg8::EpiOut, pg8::GemmOrder, GEMM1_ALIGN>(lds, wv, DM, DM, S, E);
        }
        SEAM(pb + 5);
    }
    if (IN(25)) DUP(15) { KA_HERE(); PH_IDS(); TID_HERE(); final_norm(ka, gw, NGWq, lane); }
#undef IN
#undef SEAM
}

extern "C" void kernel_launch(void* const* d_in, const int* in_sizes, int n_in, void* d_out, int out_size, void* d_ws, size_t ws_size, hipStream_t stream) {
    static int grid = 0;
    if (grid == 0) {
        if (n_in != 28 || ws_size < WS_END || out_size != 102760448) { fprintf(stderr, "kernel_launch: unexpected shapes (n_in %d, out %d, ws %zu)\n", n_in, out_size, ws_size); grid = -1; return; }
        int dev = 0, cus = 0, per_cu = 0;
        if (hipGetDevice(&dev) != hipSuccess || hipDeviceGetAttribute(&cus, hipDeviceAttributeMultiprocessorCount, dev) != hipSuccess) { grid = -1; return; }
        if (hipFuncSetAttribute((const void*)hymba_fwd, hipFuncAttributeMaxDynamicSharedMemorySize, LDS_BYTES) != hipSuccess) { fprintf(stderr, "kernel_launch: hipFuncSetAttribute failed\n"); grid = -1; return; }
        if (hipOccupancyMaxActiveBlocksPerMultiprocessor(&per_cu, (const void*)hymba_fwd, NWAVES * 64, LDS_BYTES) != hipSuccess || per_cu < 1)
            fprintf(stderr, "kernel_launch: occupancy query reports %d workgroups per CU\n", per_cu);
        (void)hipGetLastError();
        grid = cus;
    }
    if (grid < 0) return;
    (void)hipMemsetAsync((char*)d_ws + WS_CTL, 0, CTL_ZERO_BYTES, stream);
    Args a{};
    for (int i = 0; i < 28; ++i) a.in[i] = (const float*)d_in[i];
    a.out = (float*)d_out; a.ws = (unsigned char*)d_ws;
#if MK_ONE_LAUNCH == 2
    a.ph_lo = 0; a.ph_hi = 1;
    hipLaunchKernelGGL(hymba_fwd, dim3(grid), dim3(NWAVES * 64), LDS_BYTES, stream, a);
    a.ph_lo = 0; a.ph_hi = 26;
    hipLaunchKernelGGL(hymba_fwd, dim3(grid), dim3(NWAVES * 64), LDS_BYTES, stream, a);
#elif MK_ONE_LAUNCH
    a.ph_lo = 0; a.ph_hi = 26;
    hipLaunchKernelGGL(hymba_fwd, dim3(grid), dim3(NWAVES * 64), LDS_BYTES, stream, a);
#else
    for (int ph = 0; ph < 26; ++ph) { a.ph_lo = ph; a.ph_hi = ph + 1; hipLaunchKernelGGL(hymba_fwd, dim3(grid), dim3(NWAVES * 64), LDS_BYTES, stream, a); }
#endif
    const hipError_t le = hipPeekAtLastError();
    if (le != hipSuccess) fprintf(stderr, "kernel_launch: launch failed: %s\n", hipGetErrorName(le));
}
```

```cpp
#include <hip/hip_runtime.h>
#include <cstdio>
#include <cstdint>

#ifndef MK_ONE_LAUNCH
#define MK_ONE_LAUNCH 1
#endif

#ifndef GEMM1_ALIGN
#define GEMM1_ALIGN true
#endif
#ifndef DUP_MASK
#define DUP_MASK 0
#endif
#define DUP(k) for (int rep_ = 0; rep_ < (((DUP_MASK) >> (k)) & 1) + 1; ++rep_)
#define LAS __attribute__((address_space(3)))
#define GAS __attribute__((address_space(1)))
typedef unsigned short bf16;
typedef unsigned v4u __attribute__((ext_vector_type(4)));
typedef unsigned v2u __attribute__((ext_vector_type(2)));
typedef float f32x4 __attribute__((ext_vector_type(4)));
typedef float f32x2 __attribute__((ext_vector_type(2)));
typedef short bf16x8 __attribute__((ext_vector_type(8)));
typedef short s16x4 __attribute__((ext_vector_type(4)));
typedef float f32x16 __attribute__((ext_vector_type(16)));

constexpr int DM = 4096, NTOK = 16384, NCTX = 8192, DEPTH = 4, INW = 9216;
constexpr int OFF_K = 2048, OFF_V = 2560, OFF_GA = 3072, OFF_U = 5120, OFF_GS = 6144, OFF_F = 7168, OFF_GF = 8192;
constexpr float NORM_EPS = 1e-6f;
constexpr size_t OUT_NEWK = 67108864, OUT_NEWV = 83886080, OUT_FRE = 100663296, OUT_FIM = 101187584, OUT_BRE = 101711872, OUT_BIM = 102236160;

constexpr size_t MiB = 1u << 20;
constexpr size_t WS_CTL = 0, CTL_ZERO_BYTES = 1 * MiB;
constexpr size_t WS_MOD = 1 * MiB;
constexpr size_t WS_ROPE = 2 * MiB;
constexpr size_t WS_A16 = 3 * MiB;
constexpr size_t WS_D1 = 4 * MiB;
constexpr size_t WS_D2C = 5 * MiB;
constexpr size_t WS_CK = 6 * MiB;
constexpr size_t WS_CV = 10 * MiB;
constexpr size_t WS_PMAT = 14 * MiB;
constexpr size_t WS_KG = 46 * MiB;
constexpr size_t WS_D2L = 110 * MiB;
constexpr size_t WS_WGLU = 174 * MiB;
constexpr size_t WS_WOUT = 198 * MiB;
constexpr size_t WS_WIN = 326 * MiB;
constexpr size_t WS_H = 614 * MiB;
constexpr size_t WS_PROJ = 742 * MiB;
constexpr size_t WS_MIX = 1030 * MiB;
constexpr size_t WS_A2 = 1158 * MiB;
constexpr size_t WS_SBUF = 1222 * MiB;
constexpr size_t WS_YSSM = 1286 * MiB;
constexpr size_t WS_ZL = 1318 * MiB;
constexpr size_t WS_ZC = 1334 * MiB;
constexpr size_t WS_P = 1350 * MiB;
constexpr size_t WS_WFP = 1386 * MiB;
constexpr int PK = 1152; constexpr size_t ZPART = (size_t)1 << 22;
constexpr size_t WS_DELTA = 1414 * MiB;
constexpr size_t WS_XBF = 1542 * MiB;
constexpr size_t WS_XBF2 = 1702 * MiB;
constexpr size_t WS_KC = 1670 * MiB;
constexpr size_t WS_VC = 1686 * MiB;
constexpr size_t WS_DELTA2 = 1830 * MiB;
constexpr size_t WS_END = 1958 * MiB;
constexpr int CW_BAR = 4096;

constexpr int LDS_BYTES = 147456;
constexpr int MISC_OFF = 143360;
constexpr int NWAVES = 8;

#define LDS_WAIT() asm volatile("s_waitcnt lgkmcnt(0)" ::: "memory")
#define VM_WAIT() asm volatile("s_waitcnt vmcnt(0)" ::: "memory")
#define RLX_AGENT __ATOMIC_RELAXED, __HIP_MEMORY_SCOPE_AGENT

__device__ __forceinline__ int tid_of(int wv) { int t = wv * 64 + (int)__builtin_amdgcn_mbcnt_hi(~0u, __builtin_amdgcn_mbcnt_lo(~0u, 0u)); asm volatile("" : "+v"(t)); return t; }
__device__ __forceinline__ unsigned cvt_pk_bf16(float lo, float hi) { unsigned r; asm volatile("v_cvt_pk_bf16_f32 %0, %1, %2" : "=v"(r) : "v"(lo), "v"(hi)); return r; }
__device__ __forceinline__ float bf_lo(unsigned w) { return __uint_as_float(w << 16); }
__device__ __forceinline__ float bf_hi(unsigned w) { return __uint_as_float(w & 0xffff0000u); }
__device__ __forceinline__ float silu_f(float x) { return x * __builtin_amdgcn_rcpf(1.0f + __expf(-x)); }
__device__ __forceinline__ float sigmoid_f(float x) { return __builtin_amdgcn_rcpf(1.0f + __expf(-x)); }
__device__ __forceinline__ float shflx(float v, int lane, int o) { return __int_as_float(__builtin_amdgcn_ds_bpermute((lane ^ o) << 2, __float_as_int(v))); }
__device__ __forceinline__ float wave_sum(float v, int lane) {
#pragma unroll
    for (int o = 1; o < 64; o <<= 1) v += shflx(v, lane, o);
    return v;
}

namespace pg8 {
constexpr int BM = 256, BK = 64, HALF = 128, HTB = HALF * BK * 2, STAGE_BYTES = 8 * HTB, NXCD = 8, WGM = 8;
__host__ __device__ __forceinline__ int lds_byte(int r, int c) { const int st = (r >> 4) * 2 + (c >> 5), rr = r & 15, cc = c & 31, ob = rr * 64 + cc * 2; return st * 1024 + (ob ^ (((ob >> 9) & 1) << 5)); }
__host__ __device__ __forceinline__ void stage_rc(int b, int& R, int& C) { const int st = b / 1024, sb = b % 1024, swz = sb ^ (((sb >> 9) & 1) << 5); R = (st >> 1) * 16 + swz / 64; C = (st & 1) * 32 + (swz % 64) / 2; }
__host__ __device__ __forceinline__ int perm32(int rho) { const int n = rho >> 4, i = rho & 15; return 8 * (i >> 2) + 4 * n + (i & 3); }

struct Unit { const char* a; const char* b; char* c; int ldc; int pm, pn, z, kt; };

struct GemmOrder {
    int nM, nN, nwg, G, c, kt; const char* A; const char* B; size_t atile, btile;
    __device__ void init(int M, int N, int G_, int c_, const void* A_, int lda, const void* B_, int ldb, int K) { kt = K / BK; nM = M / BM; nN = N / BM; nwg = nM * nN; G = G_; c = c_; A = (const char*)A_; B = (const char*)B_; atile = (size_t)BM * lda * 2; btile = (size_t)BM * ldb * 2; }
    __device__ bool next(int i, Unit& u) const {
        const long L = (long)i * G + c; if (L >= nwg) return false;
        int wgid = (int)L; const int xcd = wgid % NXCD; { const int q = nwg / NXCD, r = nwg % NXCD, off = wgid / NXCD; wgid = (xcd < r ? xcd * (q + 1) : r * (q + 1) + (xcd - r) * q) + off; }
        const int nig = WGM * nN, gid = wgid / nig, fm = gid * WGM, gsz = (nM - fm) < WGM ? (nM - fm) : WGM;
        u.pm = fm + ((wgid % nig) % gsz); u.pn = (wgid % nig) / gsz; u.z = 0; u.c = nullptr; u.ldc = 0; u.kt = kt;
        u.a = A + (size_t)u.pm * atile; u.b = B + (size_t)u.pn * btile; return true;
    }
};
template <class O> struct SliceOrder { O g; int i0, cnt; __device__ bool next(int i, Unit& u) const { if (i >= cnt) return false; return g.next(i0 + i, u); } };
struct OneUnit { Unit u0; __device__ bool next(int i, Unit& u) const { if (i != 0) return false; u = u0; return true; } };

template <class Epi, class Sched, bool ALIGN_EPI = true>
__device__ __forceinline__ void gemm_phase(LAS unsigned char* lds, const int wv, const int lda, const int ldb, const Sched& S, const Epi& E) {
    const int tid = tid_of(wv);
    const int wid = __builtin_amdgcn_readfirstlane(tid >> 6), lane = tid & 63, wr = wid >> 2, wc = wid & 3, fr = lane & 15, fq = lane >> 4;
    unsigned voffA[2], voffB[2];
#pragma unroll
    for (int i = 0; i < 2; ++i) { int R, C; stage_rc(tid * 16 + i * 8192, R, C); const int Rb = Epi::PERM ? ((R & ~31) + perm32(R & 31)) : R;
        voffA[i] = (unsigned)(R * lda + C) * 2u; voffB[i] = (unsigned)(Rb * ldb + C) * 2u; }
    (void)fr; (void)fq;
    const size_t kstep = (size_t)(BK * 2);
    const unsigned hstepA = (unsigned)HALF * lda * 2u, hstepB = (unsigned)HALF * ldb * 2u;
    const unsigned ldsw = (unsigned)wid * 1024u;
    const int aoff = lds_byte(wr * 64 + fr, fq * 8), boff = lds_byte(wc * 32 + fr, fq * 8);
#define PG8_SA(b, h) (((b) * 2 + (h)) * HTB)
#define PG8_SB(b, h) ((4 + (b) * 2 + (h)) * HTB)
#define PG8_STAGE(bufoff, gbase, voff) do { _Pragma("unroll") for (int _i = 0; _i < 2; ++_i) \
        __builtin_amdgcn_global_load_lds((const unsigned*)((const char*)(gbase) + (voff)[_i]), (LAS unsigned*)(lds + (bufoff) + ldsw + _i * 8192), 16, 0, 0); } while (0)
#define PG8_LDA(dst, b, h) do { _Pragma("unroll") for (int m = 0; m < 4; ++m) _Pragma("unroll") for (int k = 0; k < 2; ++k) dst[m][k] = *(const LAS bf16x8*)(lds + PG8_SA(b, h) + aoff + m * 2048 + k * 1024); } while (0)
#define PG8_LDB(dst, b, h) do { _Pragma("unroll") for (int n = 0; n < 2; ++n) _Pragma("unroll") for (int k = 0; k < 2; ++k) dst[n][k] = *(const LAS bf16x8*)(lds + PG8_SB(b, h) + boff + n * 2048 + k * 1024); } while (0)
#define PG8_MMA(ai, bj, At, Bt) do { __builtin_amdgcn_s_setprio(1); _Pragma("unroll") for (int m = 0; m < 4; ++m) _Pragma("unroll") for (int n = 0; n < 2; ++n) _Pragma("unroll") for (int k = 0; k < 2; ++k) \
        acc[ai][bj][m][n] = __builtin_amdgcn_mfma_f32_16x16x32_bf16(Bt[n][k], At[m][k], acc[ai][bj][m][n], 0, 0, 0); __builtin_amdgcn_s_setprio(0); } while (0)
#define PG8_WAIT_V(n) asm volatile("s_waitcnt vmcnt(" #n ")" ::: "memory")
#define PG8_WAIT_L(n) asm volatile("s_waitcnt lgkmcnt(" #n ")" ::: "memory")
#define PG8_BAR __builtin_amdgcn_s_barrier()
#define PG8_SCHED __builtin_amdgcn_sched_barrier(0)
    int ui = 0, nt;
    const char* cA; const char* cB;
    { Unit u0; if (!S.next(0, u0)) return; cA = u0.a; cB = u0.b; nt = u0.kt; }
    f32x4 acc[2][2][4][2];
#pragma unroll
    for (int a = 0; a < 2; ++a)
#pragma unroll
        for (int b = 0; b < 2; ++b)
#pragma unroll
            for (int m = 0; m < 4; ++m)
#pragma unroll
                for (int n = 0; n < 2; ++n) acc[a][b][m][n] = (f32x4){0.f, 0.f, 0.f, 0.f};
    bf16x8 At[4][2], B0[2][2], B1[2][2];
    PG8_STAGE(PG8_SB(0, 0), cB, voffB); PG8_STAGE(PG8_SB(0, 1), cB + hstepB, voffB); PG8_STAGE(PG8_SA(0, 0), cA, voffA); PG8_STAGE(PG8_SA(0, 1), cA + hstepA, voffA);
    if (wr == 1) PG8_BAR;
    PG8_WAIT_V(2); PG8_BAR;
    PG8_STAGE(PG8_SB(1, 0), cB + kstep, voffB); PG8_STAGE(PG8_SA(1, 0), cA + kstep, voffA); PG8_STAGE(PG8_SB(1, 1), cB + hstepB + kstep, voffB);
    PG8_WAIT_V(6); PG8_BAR;
    for (;;) {
        bool has_next; const char* nA; const char* nB; int nnt;
        { Unit nx; has_next = S.next(ui + 1, nx); nA = has_next ? nx.a : cA; nB = has_next ? nx.b : cB; nnt = has_next ? nx.kt : nt; }
        for (int t = 0; t < nt; t += 2) {
            const bool last = (t == nt - 2);
            const char* a1 = cA + (size_t)(t + 1) * kstep;
            const char* a2 = last ? nA : cA + (size_t)(t + 2) * kstep; const char* b2 = last ? nB : cB + (size_t)(t + 2) * kstep;
            const char* a3 = a2 + kstep; const char* b3 = b2 + kstep;
            PG8_LDB(B0, 0, 0); PG8_LDB(B1, 0, 1); PG8_SCHED; PG8_LDA(At, 0, 0); PG8_STAGE(PG8_SA(1, 1), a1 + hstepA, voffA);
            PG8_WAIT_V(8); PG8_WAIT_L(0); PG8_BAR; PG8_MMA(0, 0, At, B0); PG8_MMA(0, 1, At, B1); PG8_BAR; PG8_SCHED;
            PG8_LDA(At, 0, 1); PG8_STAGE(PG8_SB(0, 0), b2, voffB); PG8_STAGE(PG8_SB(0, 1), b2 + hstepB, voffB); PG8_STAGE(PG8_SA(0, 0), a2, voffA);
            PG8_WAIT_V(8); PG8_WAIT_L(0); PG8_BAR; PG8_MMA(1, 0, At, B0); PG8_MMA(1, 1, At, B1); PG8_BAR; PG8_SCHED;
            PG8_LDB(B0, 1, 0); PG8_LDB(B1, 1, 1); PG8_SCHED; PG8_LDA(At, 1, 0); PG8_STAGE(PG8_SA(0, 1), a2 + hstepA, voffA);
            PG8_WAIT_V(8); PG8_WAIT_L(0); PG8_BAR; PG8_MMA(0, 0, At, B0); PG8_MMA(0, 1, At, B1); PG8_BAR; PG8_SCHED;
            PG8_LDA(At, 1, 1); PG8_STAGE(PG8_SB(1, 0), b3, voffB); PG8_STAGE(PG8_SB(1, 1), b3 + hstepB, voffB); PG8_STAGE(PG8_SA(1, 0), a3, voffA);
            PG8_WAIT_V(8); PG8_WAIT_L(0); PG8_BAR; PG8_MMA(1, 0, At, B0); PG8_MMA(1, 1, At, B1); PG8_BAR; PG8_SCHED;
        }
        if constexpr (ALIGN_EPI) { if (wr == 0) PG8_BAR; }
        { Unit cu; (void)S.next(ui, cu); const int t2 = tid_of(wv);
          const int w2 = __builtin_amdgcn_readfirstlane(t2 >> 6); E(acc, cu, w2 >> 2, w2 & 3, t2 & 15, (t2 & 63) >> 4); }
        if (!has_next) break;
#pragma unroll
        for (int a = 0; a < 2; ++a)
#pragma unroll
            for (int b = 0; b < 2; ++b)
#pragma unroll
                for (int m = 0; m < 4; ++m)
#pragma unroll
                    for (int n = 0; n < 2; ++n) acc[a][b][m][n] = (f32x4){0.f, 0.f, 0.f, 0.f};
        cA = nA; cB = nB; nt = nnt; ++ui;
        if constexpr (ALIGN_EPI) { if (wr == 1) PG8_BAR; }
    }
    PG8_WAIT_V(0);
    if constexpr (!ALIGN_EPI) { if (wr == 0) PG8_BAR; }
    PG8_BAR;
#undef PG8_SA
#undef PG8_SB
#undef PG8_STAGE
#undef PG8_LDA
#undef PG8_LDB
#undef PG8_MMA
#undef PG8_WAIT_V
#undef PG8_WAIT_L
#undef PG8_BAR
#undef PG8_SCHED
}

struct EpiProj {
    static constexpr bool PERM = true;
    bf16* proj; bf16* a2;
    __device__ __forceinline__ void operator()(const f32x4 (&acc)[2][2][4][2], const Unit& u, int wr, int wc, int fr, int fq) const {
        const int pn = u.pn; const bool gate = (pn >= 12 && pn < 20) || (pn >= 24 && pn < 28) || (pn >= 32); const bool isu = (pn >= 20 && pn < 24);
        const int row0 = u.pm * BM + wr * 64 + fr, col0 = pn * BM + wc * 32 + 8 * fq;
#pragma unroll
        for (int ai = 0; ai < 2; ++ai)
#pragma unroll
            for (int m = 0; m < 4; ++m) { const int row = row0 + ai * HALF + m * 16;
#pragma unroll
                for (int bj = 0; bj < 2; ++bj) { f32x4 v0 = acc[ai][bj][m][0], v1 = acc[ai][bj][m][1];
                    if (gate) {
#pragma unroll
                        for (int j = 0; j < 4; ++j) { v0[j] = silu_f(v0[j]); v1[j] = silu_f(v1[j]); } }
                    v4u w; w.x = cvt_pk_bf16(v0[0], v0[1]); w.y = cvt_pk_bf16(v0[2], v0[3]); w.z = cvt_pk_bf16(v1[0], v1[1]); w.w = cvt_pk_bf16(v1[2], v1[3]);
                    const int col = col0 + bj * HALF;
                    bf16* dst;
                    if (isu) { const int g = (col - OFF_U) >> 4, c0 = col & 15; dst = a2 + ((size_t)(g * 1024 + (row >> 4)) * 512 + (row & 15) * 16 + c0); }
                    else dst = proj + (size_t)row * INW + col;
                    *(v4u*)dst = w; } }
    }
};
struct EpiBf16 {
    static constexpr bool PERM = true;
    float scale;
    __device__ __forceinline__ void operator()(const f32x4 (&acc)[2][2][4][2], const Unit& u, int wr, int wc, int fr, int fq) const {
        bf16* base = (bf16*)u.c; const int ldc = u.ldc; const int row0 = wr * 64 + fr, col0 = wc * 32 + 8 * fq;
#pragma unroll
        for (int ai = 0; ai < 2; ++ai)
#pragma unroll
            for (int m = 0; m < 4; ++m) { bf16* rowp = base + (size_t)(row0 + ai * HALF + m * 16) * ldc + col0;
#pragma unroll
                for (int bj = 0; bj < 2; ++bj) { const f32x4 v0 = acc[ai][bj][m][0] * scale, v1 = acc[ai][bj][m][1] * scale;
                    v4u w; w.x = cvt_pk_bf16(v0[0], v0[1]); w.y = cvt_pk_bf16(v0[2], v0[3]); w.z = cvt_pk_bf16(v1[0], v1[1]); w.w = cvt_pk_bf16(v1[2], v1[3]);
                    *(v4u*)(rowp + bj * HALF) = w; } }
    }
};
struct EpiBf16X {
    static constexpr bool PERM = true;
    float scale; int aoff, boff;
    __device__ __forceinline__ void operator()(const f32x4 (&acc)[2][2][4][2], const Unit& u, int wr, int wc, int fr, int fq) const {
        bf16* base = (bf16*)u.c; const int ldc = u.ldc; const int row0 = wr * 64 + fr, col0 = wc * 32 + 8 * fq;
#pragma unroll
        for (int ai = 0; ai < 2; ++ai)
#pragma unroll
            for (int m = 0; m < 4; ++m) { bf16* rowp = base + (ai * aoff + (row0 + m * 16) * ldc + col0);
#pragma unroll
                for (int bj = 0; bj < 2; ++bj) { const f32x4 v0 = acc[ai][bj][m][0] * scale, v1 = acc[ai][bj][m][1] * scale;
                    v4u w; w.x = cvt_pk_bf16(v0[0], v0[1]); w.y = cvt_pk_bf16(v0[2], v0[3]); w.z = cvt_pk_bf16(v1[0], v1[1]); w.w = cvt_pk_bf16(v1[2], v1[3]);
                    *(v4u*)(rowp + bj * boff) = w; } }
    }
};
struct EpiF32 {
    static constexpr bool PERM = false;
    __device__ __forceinline__ void operator()(const f32x4 (&acc)[2][2][4][2], const Unit& u, int wr, int wc, int fr, int fq) const {
        float* base = (float*)u.c; const int ldc = u.ldc; const int row0 = wr * 64 + fr, col0 = wc * 32 + 4 * fq;
#pragma unroll
        for (int ai = 0; ai < 2; ++ai)
#pragma unroll
            for (int m = 0; m < 4; ++m) { float* rowp = base + (size_t)(row0 + ai * HALF + m * 16) * ldc + col0;
#pragma unroll
                for (int bj = 0; bj < 2; ++bj)
#pragma unroll
                    for (int n = 0; n < 2; ++n) *(f32x4*)(rowp + bj * HALF + n * 16) = acc[ai][bj][m][n]; }
    }
};
struct EpiSsmY {
    static constexpr bool PERM = true;
    bf16* yssm;
    __device__ __forceinline__ void operator()(const f32x4 (&acc)[2][2][4][2], const Unit& u, int wr, int wc, int fr, int fq) const {
        const int row0 = u.z + wr * 64 + fr, col0 = wc * 32 + 8 * fq, g = u.pn;
#pragma unroll
        for (int ai = 0; ai < 2; ++ai)
#pragma unroll
            for (int m = 0; m < 4; ++m) { const int chunk = row0 + ai * HALF + m * 16;
#pragma unroll
                for (int bj = 0; bj < 2; ++bj) { const f32x4 v0 = acc[ai][bj][m][0], v1 = acc[ai][bj][m][1];
                    v4u w; w.x = cvt_pk_bf16(v0[0], v0[1]); w.y = cvt_pk_bf16(v0[2], v0[3]); w.z = cvt_pk_bf16(v1[0], v1[1]); w.w = cvt_pk_bf16(v1[2], v1[3]);
                    const int col = col0 + bj * HALF, i = col >> 4, c0 = col & 15;
                    *(v4u*)(yssm + (size_t)(chunk * 16 + i) * 1024 + g * 16 + c0) = w; } }
    }
};
struct EpiGlu {
    static constexpr bool PERM = true;
    const bf16* proj; bf16* mix;
    __device__ __forceinline__ void operator()(const f32x4 (&acc)[2][2][4][2], const Unit& u, int wr, int wc, int fr, int fq) const {
        const int row0 = u.pm * BM + wr * 64 + fr, col0 = u.pn * HALF + wc * 32 + 8 * fq;
#pragma unroll
        for (int ai = 0; ai < 2; ++ai)
#pragma unroll
            for (int m = 0; m < 4; ++m) { const int row = row0 + ai * HALF + m * 16;
                const v4u gs = *(const v4u*)(proj + (size_t)row * INW + OFF_GS + col0);
                const f32x4 a0 = acc[ai][0][m][0], a1 = acc[ai][0][m][1], g0 = acc[ai][1][m][0], g1 = acc[ai][1][m][1];
                float o[8];
#pragma unroll
                for (int j = 0; j < 4; ++j) { o[j] = a0[j] * sigmoid_f(g0[j]); o[4 + j] = a1[j] * sigmoid_f(g1[j]); }
                o[0] *= bf_lo(gs.x); o[1] *= bf_hi(gs.x); o[2] *= bf_lo(gs.y); o[3] *= bf_hi(gs.y); o[4] *= bf_lo(gs.z); o[5] *= bf_hi(gs.z); o[6] *= bf_lo(gs.w); o[7] *= bf_hi(gs.w);
                v4u w; w.x = cvt_pk_bf16(o[0], o[1]); w.y = cvt_pk_bf16(o[2], o[3]); w.z = cvt_pk_bf16(o[4], o[5]); w.w = cvt_pk_bf16(o[6], o[7]);
                *(v4u*)(mix + (size_t)row * DM + 2048 + col0) = w; }
    }
};
struct EpiFftW {
    static constexpr bool PERM = true;
    const bf16* proj; bf16* mix;
    __device__ __forceinline__ void operator()(const f32x4 (&acc)[2][2][4][2], const Unit& u, int wr, int wc, int fr, int fq) const {
        const int row0 = u.pm * BM + wr * 64 + fr, col0 = u.pn * BM + wc * 32 + 8 * fq;
#pragma unroll
        for (int ai = 0; ai < 2; ++ai)
#pragma unroll
            for (int m = 0; m < 4; ++m) { const int row = row0 + ai * HALF + m * 16;
#pragma unroll
                for (int bj = 0; bj < 2; ++bj) { const int col = col0 + bj * HALF;
                    const v4u gs = *(const v4u*)(proj + (size_t)row * INW + OFF_GF + col);
                    const f32x4 v0 = acc[ai][bj][m][0], v1 = acc[ai][bj][m][1];
                    v4u w; w.x = cvt_pk_bf16(v0[0] * bf_lo(gs.x), v0[1] * bf_hi(gs.x)); w.y = cvt_pk_bf16(v0[2] * bf_lo(gs.y), v0[3] * bf_hi(gs.y));
                    w.z = cvt_pk_bf16(v1[0] * bf_lo(gs.z), v1[1] * bf_hi(gs.z)); w.w = cvt_pk_bf16(v1[2] * bf_lo(gs.w), v1[3] * bf_hi(gs.w));
                    *(v4u*)(mix + (size_t)row * DM + 3072 + col) = w; } }
    }
};
struct EpiOut {
    static constexpr bool PERM = true;
    bf16* delta; const float* modl;
    __device__ __forceinline__ void operator()(const f32x4 (&acc)[2][2][4][2], const Unit& u, int wr, int wc, int fr, int fq) const {
        const int rt = u.pm * BM; const int v = rt < NCTX ? 0 : (rt < NCTX + 4096 ? 1 : 2);
        const float* gv = modl + v * 12288 + 8192;
        const int row0 = rt + wr * 64 + fr, col0 = u.pn * BM + wc * 32 + 8 * fq;
        f32x4 gt[2][2];
#pragma unroll
        for (int bj = 0; bj < 2; ++bj)
#pragma unroll
            for (int n = 0; n < 2; ++n) gt[bj][n] = *(const f32x4*)(gv + col0 + bj * HALF + n * 4);
#pragma unroll
        for (int ai = 0; ai < 2; ++ai)
#pragma unroll
            for (int m = 0; m < 4; ++m) { bf16* rowp = delta + (size_t)(row0 + ai * HALF + m * 16) * DM + col0;
#pragma unroll
                for (int bj = 0; bj < 2; ++bj) { const f32x4 v0 = acc[ai][bj][m][0] * gt[bj][0], v1 = acc[ai][bj][m][1] * gt[bj][1];
                    v4u w; w.x = cvt_pk_bf16(v0[0], v0[1]); w.y = cvt_pk_bf16(v0[2], v0[3]); w.z = cvt_pk_bf16(v1[0], v1[1]); w.w = cvt_pk_bf16(v1[2], v1[3]);
                    *(v4u*)(rowp + bj * HALF) = w; } }
    }
};
}

namespace att {
constexpr int D = 128, QBLK = 32, KVBLK = 64;
constexpr float SCALE = 0.088388347648318440f;
constexpr float THR = 8.f;
constexpr int SHM_V = KVBLK * D * 2, SHM_K = KVBLK * D * 2;
constexpr int WS_OFF = 2 * SHM_V + 2 * SHM_K, OSTG_OFF = WS_OFF + NWAVES * 64 * 4, OSTG_ROW = 272, OSTG_WAVE = 32 * OSTG_ROW;
static_assert(DEPTH >= 2, "the bf16 stream is first written by layer 1's norm phase");
static_assert(OSTG_OFF + NWAVES * OSTG_WAVE <= MISC_OFF, "attention LDS");
#define KSWZ(row, colB) ((row) * 256 + ((colB) ^ (((row) & 7) << 4)))
#define SBAR() __builtin_amdgcn_sched_barrier(0)
__device__ __forceinline__ int crow(int r, int hi) { return (r & 3) + 8 * (r >> 2) + 4 * hi; }
__device__ __forceinline__ void partialSM(f32x16& p0, f32x16& p1, float& m_reg, float& mn, float& alpha) {
  constexpr float C = SCALE * 1.4426950408889634f;
  float pmax = p0[0]; for (int r = 1; r < 16; ++r) pmax = fmaxf(pmax, p0[r]); for (int r = 0; r < 16; ++r) pmax = fmaxf(pmax, p1[r]);
  { auto rr = __builtin_amdgcn_permlane32_swap(__float_as_uint(pmax), __float_as_uint(pmax), false, false);
    pmax = fmaxf(__uint_as_float(rr[0]), __uint_as_float(rr[1])); }
  if (__builtin_expect(__all(pmax - m_reg <= THR / SCALE), 1)) { mn = m_reg; alpha = 1.f; }
  else { mn = fmaxf(m_reg, pmax); alpha = __builtin_amdgcn_exp2f((m_reg - mn) * C); m_reg = mn; }
  float mnC = -mn * C;
  for (int r = 0; r < 16; ++r) p0[r] = fmaf(p0[r], C, mnC); for (int r = 0; r < 16; ++r) p1[r] = fmaf(p1[r], C, mnC);
  for (int r = 0; r < 16; ++r) p0[r] = __builtin_amdgcn_exp2f(p0[r]);
}
__device__ __forceinline__ void finishSM(f32x16& p0, f32x16& p1, float alpha, float& l_reg, bf16x8& pa0, bf16x8& pa1, bf16x8& pa2, bf16x8& pa3) {
  for (int r = 0; r < 16; ++r) p1[r] = __builtin_amdgcn_exp2f(p1[r]);
  float ps = 0; for (int r = 0; r < 16; ++r) ps += p0[r]; for (int r = 0; r < 16; ++r) ps += p1[r];
  { auto rr = __builtin_amdgcn_permlane32_swap(__float_as_uint(ps), __float_as_uint(ps), false, false);
    ps = __uint_as_float(rr[0]) + __uint_as_float(rr[1]); }
  l_reg = l_reg * alpha + ps;
#define PK4(P, BASE, OUT) do { unsigned a0 = cvt_pk_bf16(P[BASE + 0], P[BASE + 1]), a1 = cvt_pk_bf16(P[BASE + 2], P[BASE + 3]);   \
    unsigned b0 = cvt_pk_bf16(P[BASE + 4], P[BASE + 5]), b1 = cvt_pk_bf16(P[BASE + 6], P[BASE + 7]);                              \
    auto r0 = __builtin_amdgcn_permlane32_swap(a0, b0, false, false); auto r1 = __builtin_amdgcn_permlane32_swap(a1, b1, false, false); \
    v4u w = {r0[0], r1[0], r0[1], r1[1]}; OUT = *reinterpret_cast<bf16x8*>(&w); } while (0)
  PK4(p0, 0, pa0); PK4(p0, 8, pa1); PK4(p1, 0, pa2); PK4(p1, 8, pa3);
#undef PK4
}
__device__ __forceinline__ void qkt(f32x16& p0, f32x16& p1, const char* Ks, const bf16x8* qr, int r32, int hi) {
  p0 = f32x16{}; p1 = f32x16{};
  for (int d0 = 0; d0 < 8; ++d0) { int cb = (d0 * 16 + hi * 8) * 2;
    bf16x8 b0 = *reinterpret_cast<const bf16x8*>(Ks + KSWZ(r32, cb));
    bf16x8 b1 = *reinterpret_cast<const bf16x8*>(Ks + KSWZ(32 + r32, cb));
    p0 = __builtin_amdgcn_mfma_f32_32x32x16_bf16(b0, qr[d0], p0, 0, 0, 0);
    p1 = __builtin_amdgcn_mfma_f32_32x32x16_bf16(b1, qr[d0], p1, 0, 0, 0); }
}
__device__ __forceinline__ int v_st(int k, int c) { const int kk = (k & ~0xC) | ((k & 4) << 1) | ((k & 8) >> 1); return ((kk >> 3) * 4 + (c >> 5)) * 512 + ((kk & 7) * 32 + (c & 31)) * 2; }
__device__ __forceinline__ int v_rd_base(int lane) { return ((lane & 3) << 3) | (((lane >> 2) & 3) << 6) | (((lane >> 4) & 1) << 5) | (((lane >> 5) & 1) << 8); }
constexpr int v_rd_off(int d0, int ks, int half) { return d0 * 512 + ks * 4096 + half * 2048; }
template <int OFF> __device__ __forceinline__ s16x4 tr_read(int vb) {
  s16x4 r; asm volatile("ds_read_b64_tr_b16 %0, %1 offset:%2" : "=&v"(r) : "v"(vb), "i"(OFF) : "memory"); return r;
}
template <int D0> __device__ __forceinline__ void pv_one(f32x16& od, int vb, bf16x8 pa0, bf16x8 pa1, bf16x8 pa2, bf16x8 pa3) {
  const s16x4 l0 = tr_read<v_rd_off(D0, 0, 0)>(vb), h0 = tr_read<v_rd_off(D0, 0, 1)>(vb), l1 = tr_read<v_rd_off(D0, 1, 0)>(vb), h1 = tr_read<v_rd_off(D0, 1, 1)>(vb);
  const s16x4 l2 = tr_read<v_rd_off(D0, 2, 0)>(vb), h2 = tr_read<v_rd_off(D0, 2, 1)>(vb), l3 = tr_read<v_rd_off(D0, 3, 0)>(vb), h3 = tr_read<v_rd_off(D0, 3, 1)>(vb);
  asm volatile("s_waitcnt lgkmcnt(0)" ::: "memory"); SBAR();
#define PK(L, H) (bf16x8){L[0], L[1], L[2], L[3], H[0], H[1], H[2], H[3]}
  od = __builtin_amdgcn_mfma_f32_32x32x16_bf16(pa0, PK(l0, h0), od, 0, 0, 0);
  od = __builtin_amdgcn_mfma_f32_32x32x16_bf16(pa1, PK(l1, h1), od, 0, 0, 0);
  od = __builtin_amdgcn_mfma_f32_32x32x16_bf16(pa2, PK(l2, h2), od, 0, 0, 0);
  od = __builtin_amdgcn_mfma_f32_32x32x16_bf16(pa3, PK(l3, h3), od, 0, 0, 0);
#undef PK
}
__device__ __forceinline__ void pv_d0(f32x16* o, int vb, bf16x8 pa0, bf16x8 pa1, bf16x8 pa2, bf16x8 pa3) {
  pv_one<0>(o[0], vb, pa0, pa1, pa2, pa3); pv_one<1>(o[1], vb, pa0, pa1, pa2, pa3); pv_one<2>(o[2], vb, pa0, pa1, pa2, pa3); pv_one<3>(o[3], vb, pa0, pa1, pa2, pa3);
}

__device__ __forceinline__ void attn_unit(const bf16* __restrict__ Qb, const bf16* __restrict__ Gb, bf16* __restrict__ Ob,
                                          const bf16* __restrict__ K0, const bf16* __restrict__ V0, int ld0, int nt0,
                                          const bf16* __restrict__ K1, const bf16* __restrict__ V1, int ld1, int nt1,
                                          const float* __restrict__ qn, const f32x2* __restrict__ rope, int tok0, char* lds, int wv) {
  const int tid = tid_of(wv);
  const int wid = tid >> 6, lane = tid & 63, r32 = lane & 31, hi = lane >> 5;
  char* V_lds = lds; char* K_lds = lds + 2 * SHM_V;
  float* ws = (float*)(lds + WS_OFF) + wid * 64; float* li_l = ws; float* al_l = ws + 32;
  float m_reg = -1e30f, l_reg = 0; f32x16 o[4] = {}; bf16x8 qr[8];
  const int sr = tid >> 4, sc = (tid & 15) * 8, vst0 = v_st(sr, sc), vst1 = v_st(32 + sr, sc);
  const int vb0 = (int)(uintptr_t)V_lds + v_rd_base(lane);
  struct { bf16x8 vs0, vs1, ks0, ks1; } sr_[2];
#define SLOAD(i, jt) do { const bf16* kb_; const bf16* vb_; long ld_; \
    if ((jt) < nt0) { kb_ = K0 + (long)(jt) * KVBLK * ld0; vb_ = V0 + (long)(jt) * KVBLK * ld0; ld_ = ld0; } else { kb_ = K1 + (long)((jt) - nt0) * KVBLK * ld1; vb_ = V1 + (long)((jt) - nt0) * KVBLK * ld1; ld_ = ld1; } \
    sr_[i].vs0 = *reinterpret_cast<const bf16x8*>(vb_ + (long)sr * ld_ + sc); sr_[i].vs1 = *reinterpret_cast<const bf16x8*>(vb_ + (long)(32 + sr) * ld_ + sc); \
    sr_[i].ks0 = *reinterpret_cast<const bf16x8*>(kb_ + (long)sr * ld_ + sc); sr_[i].ks1 = *reinterpret_cast<const bf16x8*>(kb_ + (long)(32 + sr) * ld_ + sc); } while (0)
  SLOAD(0, 0);
  __syncthreads();
  {
    const bf16* Qw = Qb + (long)(wid * QBLK + r32) * INW + hi * 8;
    float x[8][8]; float ss = 0.f;
#pragma unroll
    for (int d0 = 0; d0 < 8; ++d0) { const v4u raw = *reinterpret_cast<const v4u*>(Qw + d0 * 16);
      x[d0][0] = bf_lo(raw.x); x[d0][1] = bf_hi(raw.x); x[d0][2] = bf_lo(raw.y); x[d0][3] = bf_hi(raw.y); x[d0][4] = bf_lo(raw.z); x[d0][5] = bf_hi(raw.z); x[d0][6] = bf_lo(raw.w); x[d0][7] = bf_hi(raw.w);
#pragma unroll
      for (int j = 0; j < 8; ++j) ss += x[d0][j] * x[d0][j]; }
    { auto rr = __builtin_amdgcn_permlane32_swap(__float_as_uint(ss), __float_as_uint(ss), false, false); ss = __uint_as_float(rr[0]) + __uint_as_float(rr[1]); }
    const float rstd = rsqrtf(ss * (1.0f / 128.0f) + NORM_EPS);
#pragma unroll
    for (int d0 = 0; d0 < 8; ++d0) { const f32x4 w0 = *reinterpret_cast<const f32x4*>(qn + d0 * 16 + hi * 8), w1 = *reinterpret_cast<const f32x4*>(qn + d0 * 16 + hi * 8 + 4);
#pragma unroll
      for (int j = 0; j < 4; ++j) { x[d0][j] *= rstd * w0[j]; x[d0][4 + j] *= rstd * w1[j]; } }
    if (rope) {
      const int t = tok0 + wid * QBLK + r32, prow = t >> 6, pcol = t & 63;
#pragma unroll
      for (int half = 0; half < 2; ++half) { const f32x2* rp = rope + (half ? pcol : prow) * 32;
#pragma unroll
        for (int dd = 0; dd < 2; ++dd) { const int d0 = half * 4 + dd;
#pragma unroll
          for (int j = 0; j < 8; ++j) { const f32x2 cs = rp[dd * 16 + hi * 8 + j]; const float x1 = x[d0][j], x2 = x[d0 + 2][j];
            x[d0][j] = x1 * cs.x - x2 * cs.y; x[d0 + 2][j] = x1 * cs.y + x2 * cs.x; } } }
    }
#pragma unroll
    for (int d0 = 0; d0 < 8; ++d0) { v4u w = {cvt_pk_bf16(x[d0][0], x[d0][1]), cvt_pk_bf16(x[d0][2], x[d0][3]), cvt_pk_bf16(x[d0][4], x[d0][5]), cvt_pk_bf16(x[d0][6], x[d0][7])}; qr[d0] = *reinterpret_cast<bf16x8*>(&w); }
  }
#define SWRITE(b, i) do { *(bf16x8*)(V_lds + (b) * SHM_V + vst0) = sr_[i].vs0;          \
    *(bf16x8*)(V_lds + (b) * SHM_V + vst1) = sr_[i].vs1; int kc = sc * 2;               \
    *(bf16x8*)(K_lds + (b) * SHM_K + KSWZ(sr, kc)) = sr_[i].ks0;                       \
    *(bf16x8*)(K_lds + (b) * SHM_K + KSWZ(32 + sr, kc)) = sr_[i].ks1; } while (0)
#define SWAIT() asm volatile("s_waitcnt vmcnt(4)" ::: "memory")
#define RESC(a) do { if (__any((a) < 1.f)) { if (hi == 0) al_l[r32] = (a); asm volatile("s_waitcnt lgkmcnt(0)" ::: "memory"); \
    for (int d = 0; d < 4; ++d) for (int r = 0; r < 16; ++r) o[d][r] *= al_l[crow(r, hi)]; } } while (0)
  f32x16 pA0, pA1, pB0, pB1; float mnA, mnB, alA, alB; bf16x8 pa0, pa1, pa2, pa3; const int NT = nt0 + nt1;
  constexpr int SE = 0, SO = 1;
  asm volatile("s_waitcnt vmcnt(0)" ::: "memory"); SWRITE(0, SE); __syncthreads();
  qkt(pA0, pA1, K_lds, qr, r32, hi); partialSM(pA0, pA1, m_reg, mnA, alA);
  SLOAD(SO, 1); if (2 < NT) SLOAD(SE, 2);
  SWAIT(); SWRITE(1, SO); __syncthreads();
  for (int j = 1; j + 1 < NT; j += 2) {
    SBAR(); qkt(pB0, pB1, K_lds + SHM_K, qr, r32, hi);
    finishSM(pA0, pA1, alA, l_reg, pa0, pa1, pa2, pa3); SBAR();
    SLOAD(SO, j + 2); SBAR();
    pv_d0(o, vb0, pa0, pa1, pa2, pa3); partialSM(pB0, pB1, m_reg, mnB, alB);
    __syncthreads(); SWAIT(); SWRITE(0, SE);
    RESC(alB); __syncthreads();
    SBAR(); qkt(pA0, pA1, K_lds, qr, r32, hi);
    finishSM(pB0, pB1, alB, l_reg, pa0, pa1, pa2, pa3); SBAR();
    if (j + 3 < NT) SLOAD(SE, j + 3); SBAR();
    pv_d0(o, vb0 + SHM_V, pa0, pa1, pa2, pa3); partialSM(pA0, pA1, m_reg, mnA, alA);
    __syncthreads(); SWAIT(); SWRITE(1, SO);
    RESC(alA); __syncthreads();
  }
  SBAR(); qkt(pB0, pB1, K_lds + SHM_K, qr, r32, hi);
  finishSM(pA0, pA1, alA, l_reg, pa0, pa1, pa2, pa3); SBAR();
  pv_d0(o, vb0, pa0, pa1, pa2, pa3); partialSM(pB0, pB1, m_reg, mnB, alB);
  __syncthreads(); RESC(alB);
  finishSM(pB0, pB1, alB, l_reg, pa0, pa1, pa2, pa3); SBAR();
  pv_d0(o, vb0 + SHM_V, pa0, pa1, pa2, pa3);
  if (hi == 0) li_l[r32] = l_reg; asm volatile("s_waitcnt lgkmcnt(0)" ::: "memory");
  char* stg = lds + OSTG_OFF + wid * OSTG_WAVE;
  v4u gvv[8];
#pragma unroll
  for (int it = 0; it < 8; ++it) gvv[it] = *reinterpret_cast<const v4u*>(Gb + (long)(wid * QBLK + it * 4 + (lane >> 4)) * INW + (lane & 15) * 8);
#pragma unroll
  for (int r = 0; r < 16; ++r) { const int orow = crow(r, hi); const float rl = __builtin_amdgcn_rcpf(li_l[orow]);
#pragma unroll
    for (int d0 = 0; d0 < 4; ++d0) { const unsigned w = cvt_pk_bf16(o[d0][r] * rl, 0.f); *(bf16*)(stg + orow * OSTG_ROW + (d0 * 32 + r32) * 2) = (bf16)(w & 0xffffu); }
    if ((r & 3) == 3) asm volatile("" ::: "memory"); }
  asm volatile("s_waitcnt lgkmcnt(0)" ::: "memory");
#pragma unroll
  for (int it = 0; it < 8; ++it) { const int row = it * 4 + (lane >> 4), cc = (lane & 15) * 8;
    const v4u ov = *(const v4u*)(stg + row * OSTG_ROW + cc * 2);
    const v4u gv = gvv[it];
    v4u w; w.x = cvt_pk_bf16(bf_lo(ov.x) * bf_lo(gv.x), bf_hi(ov.x) * bf_hi(gv.x)); w.y = cvt_pk_bf16(bf_lo(ov.y) * bf_lo(gv.y), bf_hi(ov.y) * bf_hi(gv.y));
    w.z = cvt_pk_bf16(bf_lo(ov.z) * bf_lo(gv.z), bf_hi(ov.z) * bf_hi(gv.z)); w.w = cvt_pk_bf16(bf_lo(ov.w) * bf_lo(gv.w), bf_hi(ov.w) * bf_hi(gv.w));
    *reinterpret_cast<v4u*>(Ob + (long)(wid * QBLK + row) * DM + cc) = w; }
#undef SLOAD
#undef SWRITE
#undef SWAIT
#undef RESC
}
}

#define XB_TMO      128
#define XB_XCNT(j)  (256  + 64 * (j))
#define XB_XSUB(j)  (1280 + 64 * (j))
#define XB_XGEN(j)  (2304 + 64 * (j))
#define XB_TOP      3328
#define XB_TOPGEN   3392
#define XCD_BAR_WORDS 3456
#define XB_SPIN_CAP (1u << 18)
__device__ __forceinline__ unsigned xb_ld(unsigned* p)              { return __hip_atomic_load(p, __ATOMIC_RELAXED, __HIP_MEMORY_SCOPE_AGENT); }
__device__ __forceinline__ unsigned xb_add(unsigned* p, unsigned v) { return __hip_atomic_fetch_add(p, v, __ATOMIC_RELAXED, __HIP_MEMORY_SCOPE_AGENT); }
__device__ __forceinline__ unsigned xb_xcc_id() { return (unsigned)__builtin_amdgcn_s_getreg((3 << 11) | 20) & 0xFu; }
#define XB_SPIN(cond, bar) do { unsigned _sp = 0; while (cond) { __builtin_amdgcn_s_sleep(1); \
    if ((++_sp & 255u) == 0u) { if (xb_ld(&(bar)[XB_TMO])) break; if (_sp > XB_SPIN_CAP) { atomicAdd(&(bar)[XB_TMO], 1u); break; } } } } while (0)
struct XcdBarrier { unsigned* bar; unsigned x; volatile LAS unsigned* st; };
__device__ __forceinline__ XcdBarrier xcd_barrier_post(unsigned* bar, volatile LAS unsigned* st, int tid) {
    XcdBarrier b; b.bar = bar; b.x = xb_xcc_id(); b.st = st;
    if (tid == 0) (void)xb_add(&bar[XB_XCNT(b.x)], 1u);
    return b;
}
__device__ __forceinline__ void xcd_barrier_complete(unsigned* bar, unsigned x, unsigned& nloc, unsigned& nx) {
    const unsigned G = gridDim.x * gridDim.y * gridDim.z;
    unsigned sum, cnt, mine, sp = 0u;
    for (;;) {
        sum = 0u; cnt = 0u; mine = 0u;
#pragma nounroll
        for (unsigned j = 0; j < 16; ++j) { const unsigned c = xb_ld(&bar[XB_XCNT(j)]); sum += c; cnt += (c > 0u) ? 1u : 0u; mine = (j == x) ? c : mine; }
        if (sum == G) break;
        __builtin_amdgcn_s_sleep(1);
        if ((++sp & 255u) == 0u) { if (xb_ld(&bar[XB_TMO])) break; if (sp > XB_SPIN_CAP) { atomicAdd(&bar[XB_TMO], 1u); break; } }
    }
    nloc = mine > 0u ? mine : 1u; nx = cnt > 0u ? cnt : 1u;
}
__device__ __forceinline__ void xcd_barrier(const XcdBarrier& b, int wv) {
    asm volatile("s_waitcnt vmcnt(0)" ::: "memory");
    __syncthreads();
    if (tid_of(wv) == 0) {
        unsigned* bar = b.bar;
        __builtin_amdgcn_s_waitcnt(0);
        unsigned nloc = b.st[0], nx = b.st[1];
        if (nloc == 0u) { xcd_barrier_complete(bar, b.x, nloc, nx); b.st[0] = nloc; b.st[1] = nx; }
        const unsigned old = xb_add(&bar[XB_XSUB(b.x)], 1u);
        const unsigned gen = old / nloc;
        if (old + 1u == (gen + 1u) * nloc) {
            __builtin_amdgcn_fence(__ATOMIC_RELEASE, "agent");
            asm volatile("s_waitcnt vmcnt(0)" ::: "memory");
            const unsigned og = xb_add(&bar[XB_TOP], 1u);
            const unsigned tg = og / nx;
            if (og + 1u == (tg + 1u) * nx) xb_add(&bar[XB_TOPGEN], 1u);
            else XB_SPIN(xb_ld(&bar[XB_TOPGEN]) == tg, bar);
            __builtin_amdgcn_fence(__ATOMIC_ACQUIRE, "agent");
            xb_add(&bar[XB_XGEN(b.x)], 1u);
            asm volatile("s_waitcnt vmcnt(0)" ::: "memory");
        } else {
            XB_SPIN(xb_ld(&bar[XB_XGEN(b.x)]) == gen, bar);
            __builtin_amdgcn_fence(__ATOMIC_ACQUIRE, "agent");
            asm volatile("s_waitcnt vmcnt(0)" ::: "memory");
        }
    }
    __syncthreads();
}
__device__ __forceinline__ void wg_global_sync() {
    asm volatile("s_waitcnt vmcnt(0)" ::: "memory");
    __syncthreads();
    __builtin_amdgcn_fence(__ATOMIC_ACQUIRE, "agent");
    asm volatile("s_waitcnt vmcnt(0)" ::: "memory");
}

struct Args { const float* in[28]; float* out; unsigned char* ws; int ph_lo, ph_hi; };
typedef const __attribute__((address_space(4))) Args* KAP;
#define KA_HERE() KAP ka = (KAP)__builtin_amdgcn_kernarg_segment_ptr(); asm volatile("" : "+s"(ka))
enum { I_XP = 0, I_XS, I_CK, I_CV, I_SFR, I_SFI, I_SBR, I_SBI, I_C, I_CCTX, I_NG, I_WMOD, I_BMOD, I_WIN, I_QN, I_KN, I_LRE, I_LIM, I_LSTEP, I_BRE, I_BIM, I_CRE, I_CIM, I_DSKIP, I_WGLU, I_WFFT, I_WOUT, I_FNG };

__device__ __forceinline__ int glu_row(int n) { return n < 1024 ? ((n >> 7) * 256 + (n & 127)) : (((n - 1024) >> 7) * 256 + 128 + ((n - 1024) & 127)); }
template <bool GLU>
__device__ __forceinline__ void tr_item(const float* __restrict__ W, int K, int N, bf16* __restrict__ WT, LAS float* scr, int item, int lane) {
    const int nblk = N / 64, kb = item / nblk, nb = item % nblk, k0 = 64 * kb, n0 = 64 * nb;
#pragma unroll 8
    for (int i = 0; i < 64; ++i) scr[i * 65 + lane] = W[(size_t)(k0 + i) * N + n0 + lane];
    LDS_WAIT(); asm volatile("" ::: "memory");
    const int c = lane & 7;
#pragma unroll
    for (int j = 0; j < 8; ++j) { const int n = (lane >> 3) + 8 * j; const LAS float* s = scr + (8 * c) * 65 + n;
        v4u o; o.x = cvt_pk_bf16(s[0 * 65], s[1 * 65]); o.y = cvt_pk_bf16(s[2 * 65], s[3 * 65]); o.z = cvt_pk_bf16(s[4 * 65], s[5 * 65]); o.w = cvt_pk_bf16(s[6 * 65], s[7 * 65]);
        int nd = n0 + n; if (GLU) nd = glu_row(nd);
        *(v4u*)(WT + (size_t)nd * K + k0 + 8 * c) = o; }
    LDS_WAIT(); asm volatile("" ::: "memory");
}

__device__ __forceinline__ void ssm_matrices(KAP A, int l, int g, LAS unsigned char* lds, int tid) {
    LAS f32x2* pw = (LAS f32x2*)lds;
    LAS f32x2* bb = pw + 2 * 17 * 64;
    LAS f32x2* cc = bb + 2 * 64 * 16;
    LAS float* kk = (LAS float*)(cc + 2 * 16 * 64);
    if (tid < 128) {
        const int dir = tid >> 6, p = tid & 63, ig = (l * 2 + dir) * 64 + g;
        const float dt = expf(A->in[I_LSTEP][ig]);
        const float lr = A->in[I_LRE][(size_t)ig * 64 + p], li = A->in[I_LIM][(size_t)ig * 64 + p];
        for (int tau = 0; tau <= 16; ++tau) {
            const float mag = expf(lr * dt * (float)tau);
            const double turns = (double)li * (double)dt * (double)tau * 0.15915494309189535;
            const float fr = (float)(turns - rint(turns));
            pw[(dir * 17 + tau) * 64 + p] = (f32x2){mag * cospif(2.f * fr), mag * sinpif(2.f * fr)};
        }
        const f32x2 ab = pw[(dir * 17 + 1) * 64 + p];
        const float nr = ab.x - 1.0f, ni = ab.y, den = lr * lr + li * li;
        const float f_re = (nr * lr + ni * li) / den, f_im = (ni * lr - nr * li) / den;
        for (int c = 0; c < 16; ++c) { const float br = A->in[I_BRE][((size_t)ig * 64 + p) * 16 + c], bi = A->in[I_BIM][((size_t)ig * 64 + p) * 16 + c];
            bb[(dir * 64 + p) * 16 + c] = (f32x2){f_re * br - f_im * bi, f_re * bi + f_im * br}; }
        ((f32x2*)(A->ws + WS_A16))[(size_t)ig * 64 + p] = pw[(dir * 17 + 16) * 64 + p];
    }
    for (int idx = tid; idx < 2048; idx += 512) { const int dir = idx >> 10, c = (idx >> 6) & 15, p = idx & 63; const size_t gi = (((size_t)(l * 2 + dir) * 64 + g) * 16 + c) * 64 + p;
        cc[idx] = (f32x2){A->in[I_CRE][gi], A->in[I_CIM][gi]}; }
    __syncthreads();
    {
        const int dir = tid >> 8, tau = (tid >> 4) & 15, c = tid & 15;
        float accv[16];
#pragma unroll
        for (int j = 0; j < 16; ++j) accv[j] = 0.f;
        for (int p = 0; p < 64; ++p) { const f32x2 cv = cc[(dir * 16 + c) * 64 + p], pv = pw[(dir * 17 + tau) * 64 + p];
            const float wre = cv.x * pv.x - cv.y * pv.y, wim = cv.x * pv.y + cv.y * pv.x;
#pragma unroll
            for (int j = 0; j < 16; ++j) { const f32x2 bv = bb[(dir * 64 + p) * 16 + j]; accv[j] += wre * bv.x - wim * bv.y; } }
#pragma unroll
        for (int j = 0; j < 16; ++j) kk[((dir * 16 + tau) * 16 + c) * 16 + j] = accv[j];
    }
    __syncthreads();
    const int lg = l * 64 + g;
    bf16* Pm = (bf16*)(A->ws + WS_PMAT) + (size_t)lg * 256 * 256;
    for (int q = tid; q < 8192; q += 512) { const int R = q >> 5, col = (q & 31) * 8, s = col >> 4, c0 = col & 15, dir = R >> 7, reim = (R >> 6) & 1, p = R & 63, e = dir ? s : 15 - s;
        const f32x2 pv = pw[(dir * 17 + e) * 64 + p]; float v[8];
#pragma unroll
        for (int j = 0; j < 8; ++j) { const f32x2 bv = bb[(dir * 64 + p) * 16 + c0 + j]; v[j] = reim ? (pv.x * bv.y + pv.y * bv.x) : (pv.x * bv.x - pv.y * bv.y); }
        v4u w; w.x = cvt_pk_bf16(v[0], v[1]); w.y = cvt_pk_bf16(v[2], v[3]); w.z = cvt_pk_bf16(v[4], v[5]); w.w = cvt_pk_bf16(v[6], v[7]);
        *(v4u*)(Pm + (size_t)R * 256 + col) = w; }
    bf16* KGm = (bf16*)(A->ws + WS_KG) + (size_t)lg * 256 * 512;
    for (int q = tid; q < 16384; q += 512) { const int R = q >> 6, col = (q & 63) * 8, i = R >> 4, c = R & 15; float v[8];
        if (col < 256) { const int s = col >> 4, c0 = col & 15;
#pragma unroll
            for (int j = 0; j < 8; ++j) { const int cp = c0 + j; float x;
                if (s < i) x = kk[((0 * 16 + (i - s)) * 16 + c) * 16 + cp];
                else if (s > i) x = kk[((1 * 16 + (s - i)) * 16 + c) * 16 + cp];
                else { x = kk[((0 * 16 + 0) * 16 + c) * 16 + cp] + kk[((1 * 16 + 0) * 16 + c) * 16 + cp]; if (cp == c) x += A->in[I_DSKIP][l * 1024 + g * 16 + c]; }
                v[j] = x; }
        } else { const int k = col - 256, dir = k >> 7, reim = (k >> 6) & 1, p0 = k & 63, e = dir ? 16 - i : i + 1;
#pragma unroll
            for (int j = 0; j < 8; ++j) { const f32x2 cv = cc[(dir * 16 + c) * 64 + p0 + j], pv = pw[(dir * 17 + e) * 64 + p0 + j];
                v[j] = reim ? -(cv.x * pv.y + cv.y * pv.x) : (cv.x * pv.x - cv.y * pv.y); } }
        v4u w; w.x = cvt_pk_bf16(v[0], v[1]); w.y = cvt_pk_bf16(v[2], v[3]); w.z = cvt_pk_bf16(v[4], v[5]); w.w = cvt_pk_bf16(v[6], v[7]);
        *(v4u*)(KGm + (size_t)R * 512 + col) = w; }
    __syncthreads();
}

__device__ __forceinline__ void mod_unit(KAP A, int un, LAS unsigned char* lds, int tid, int wave, int lane) {
    LAS float* sl = (LAS float*)lds;
    LAS float* red = sl + 3 * 4096;
    const int l = un >> 6, nb = un & 63;
    for (int i = tid; i < 3 * 4096; i += 512) { const int v = i >> 12, k = i & 4095; const float x = v == 0 ? A->in[I_CCTX][k] : A->in[I_C][(v - 1) * 4096 + k]; sl[i] = x / (1.0f + expf(-x)); }
    __syncthreads();
    const int ln = lane < 48 ? lane : 47;
    const float* wp = A->in[I_WMOD] + ((size_t)l * 4096 + wave * 512) * 12288 + nb * 192 + ln * 4;
    f32x4 a0 = {0.f, 0.f, 0.f, 0.f}, a1 = a0, a2 = a0;
#pragma unroll 8
    for (int kq = 0; kq < 512; ++kq) { const f32x4 w = *(const f32x4*)(wp + (size_t)kq * 12288); const int k = wave * 512 + kq;
        a0 += sl[k] * w; a1 += sl[4096 + k] * w; a2 += sl[8192 + k] * w; }
    if (lane < 48) {
#pragma unroll
        for (int j = 0; j < 4; ++j) { red[(wave * 3 + 0) * 256 + lane * 4 + j] = a0[j]; red[(wave * 3 + 1) * 256 + lane * 4 + j] = a1[j]; red[(wave * 3 + 2) * 256 + lane * 4 + j] = a2[j]; } }
    __syncthreads();
    for (int i = tid; i < 768; i += 512) { const int v = i >> 8, col = i & 255; if (col < 192) { float s = 0.f;
#pragma unroll
        for (int w = 0; w < 8; ++w) s += red[(w * 3 + v) * 256 + col];
        ((float*)(A->ws + WS_MOD))[(size_t)(l * 3 + v) * 12288 + nb * 192 + col] = s + A->in[I_BMOD][l * 12288 + nb * 192 + col]; } }
    __syncthreads();
}

__device__ __forceinline__ void p0_prologue(KAP A, LAS unsigned char* lds, int G, int bx, int wv) {
    const int tid = tid_of(wv); const int lane = tid & 63, wave = __builtin_amdgcn_readfirstlane(tid >> 6);
    { LAS float* scr = (LAS float*)(lds + wave * 16640);
      const int gw = bx * NWAVES + wave, NGW = G * NWAVES;
      constexpr int I_IN = 64 * 144, I_OUT = 64 * 64, I_GLU = 16 * 32, I_L = I_IN + I_OUT + I_GLU;
      for (int it = gw; it < 4 * I_L; it += NGW) { const int l = it / I_L; int r = it % I_L;
          if (r < I_IN) { tr_item<false>(A->in[I_WIN] + (size_t)l * 4096 * 9216, 4096, 9216, (bf16*)(A->ws + WS_WIN) + (size_t)l * 9216 * 4096, scr, r, lane); continue; } r -= I_IN;
          if (r < I_OUT) { tr_item<false>(A->in[I_WOUT] + (size_t)l * 4096 * 4096, 4096, 4096, (bf16*)(A->ws + WS_WOUT) + (size_t)l * 4096 * 4096, scr, r, lane); continue; } r -= I_OUT;
          tr_item<true>(A->in[I_WGLU] + (size_t)l * 1024 * 2048, 1024, 2048, (bf16*)(A->ws + WS_WGLU) + (size_t)l * 2048 * 1024, scr, r, lane); }
    }
    __syncthreads();
    for (int un = bx; un < 256; un += G) mod_unit(A, un, lds, tid, wave, lane);
    const size_t gt = (size_t)bx * 512 + tid, NGT = (size_t)G * 512;
    { bf16* D2L = (bf16*)(A->ws + WS_D2L);
      LAS bf16* lut = (LAS bf16*)lds;
      for (int i = tid; i < 4096; i += 512) lut[i] = (bf16)(cvt_pk_bf16(cospif((float)i * (1.0f / 2048.0f)), 0.f) & 0xffffu);
      __syncthreads();
      for (size_t q = gt; q < (size_t)4096 * 1024; q += NGT) { const int k = (int)(q >> 10), K0 = (int)(q & 1023) * 8; unsigned h[8];
          const int sh = K0 < 4096 ? 0 : 1024;
#pragma unroll
          for (int j = 0; j < 8; ++j) { const int K = (K0 + j) & 4095; h[j] = lut[(k * K + sh) & 4095]; }
          v4u w; w.x = h[0] | (h[1] << 16); w.y = h[2] | (h[3] << 16); w.z = h[4] | (h[5] << 16); w.w = h[6] | (h[7] << 16);
          *(v4u*)(D2L + (size_t)k * 8192 + K0) = w; }
      __syncthreads(); }
    { bf16* D1 = (bf16*)(A->ws + WS_D1);
      for (size_t q = gt; q < (size_t)256 * 256; q += NGT) { const int mp = (int)(q >> 8), c = (int)(q & 255), m = mp <= 128 ? mp : mp - 128; const float x = (float)((m * c) & 255) * (1.0f / 128.0f);
          const float v = mp <= 128 ? cospif(x) : sinpif(x); D1[q] = (bf16)(cvt_pk_bf16(v, 0.f) & 0xffffu); } }
    { bf16* WFP = (bf16*)(A->ws + WS_WFP);
      for (size_t q = gt; q < (size_t)4 * 144 * 1024; q += NGT) { const int n = (int)(q & 1023), i = (int)((q >> 10) % 144), l = (int)(q / (144 * 1024)); const int kk0 = i * 8;
          const float* W = A->in[I_WFFT] + (size_t)l * 1024 * 1024 + n; float v[8];
          if (kk0 < 1024) { const int g = kk0 >> 8, part = (kk0 >> 7) & 1;
#pragma unroll
              for (int j = 0; j < 8; ++j) { const int m = (kk0 + j) & 127; const float w1 = W[(size_t)(g * 256 + m) * 1024], w2 = W[(size_t)(g * 256 + ((256 - m) & 255)) * 1024];
                  v[j] = part ? (w1 - w2) : (m ? w1 + w2 : w1); } }
          else {
#pragma unroll
              for (int j = 0; j < 8; ++j) v[j] = 0.f;
              if (kk0 == 1024) {
#pragma unroll
                  for (int j = 0; j < 4; ++j) v[j] = W[(size_t)(j * 256 + 128) * 1024]; } }
          v4u w; w.x = cvt_pk_bf16(v[0], v[1]); w.y = cvt_pk_bf16(v[2], v[3]); w.z = cvt_pk_bf16(v[4], v[5]); w.w = cvt_pk_bf16(v[6], v[7]);
          *(v4u*)(WFP + ((size_t)l * 1024 + n) * PK + kk0) = w; }
      bf16* P = (bf16*)(A->ws + WS_P);
      for (size_t q = gt; q < (size_t)NTOK * 31; q += NGT) { const size_t row = q / 31; const int j = (int)(q % 31); *(v2u*)(P + row * PK + 1028 + j * 4) = (v2u){0u, 0u}; } }
    { bf16* D2C = (bf16*)(A->ws + WS_D2C);
      for (size_t q = gt; q < (size_t)256 * 512; q += NGT) { const int k = (int)(q >> 9), K = (int)(q & 511); const float x = (float)((k * (K & 255)) & 255) * (1.0f / 128.0f);
          const float v = K < 256 ? cospif(x) : -sinpif(x); D2C[q] = (bf16)(cvt_pk_bf16(v, 0.f) & 0xffffu); } }
    { f32x2* rope = (f32x2*)(A->ws + WS_ROPE);
      for (size_t q = gt; q < 64 * 32; q += NGT) { const int pos = (int)(q >> 5), i = (int)(q & 31); const float inv = exp2f(-(float)i * (13.287712379549449f / 32.0f));
          const double turns = (double)pos * (double)inv * 0.15915494309189535; const float fr = (float)(turns - rint(turns));
          rope[q] = (f32x2){cospif(2.f * fr), sinpif(2.f * fr)}; } }
    { const size_t n8 = (size_t)2 * 4 * 512 * 512 / 8;
      for (size_t q = gt; q < 2 * n8; q += NGT) { const bool isk = q < n8; const size_t j = isk ? q : q - n8; const float* src = (isk ? A->in[I_CK] : A->in[I_CV]) + j * 8;
          const f32x4 x0 = *(const f32x4*)src, x1 = *(const f32x4*)(src + 4);
          v4u w; w.x = cvt_pk_bf16(x0[0], x0[1]); w.y = cvt_pk_bf16(x0[2], x0[3]); w.z = cvt_pk_bf16(x1[0], x1[1]); w.w = cvt_pk_bf16(x1[2], x1[3]);
          *(v4u*)((bf16*)(A->ws + (isk ? WS_CK : WS_CV)) + j * 8) = w; } }
    __syncthreads();
    for (int lg = bx; lg < 256; lg += G) ssm_matrices(A, lg >> 6, lg & 63, lds, tid);
}

__device__ __forceinline__ f32x4 ldg16(const void* base, unsigned off, int imm) { return *(const f32x4*)(((const char*)base + off) + imm); }
__device__ __forceinline__ void pa_norm(KAP A, int l, int bx, int G, int tid, LAS unsigned char* lds) {
    const float* mod = (const float*)(A->ws + WS_MOD) + (size_t)l * 3 * 12288;
    const f32x4* ng4 = (const f32x4*)(A->in[I_NG] + l * DM);
    bf16* H = (bf16*)(A->ws + WS_H);
    const int lane = tid & 63, wave = __builtin_amdgcn_readfirstlane(tid >> 6);
    const unsigned lo2 = (unsigned)lane * 16u, lo4 = (unsigned)lane * 32u;
    LAS f32x4* avl = (LAS f32x4*)lds; LAS f32x4* svl = avl + 1024;
    for (int rb = bx; rb < NTOK / 64; rb += G) {
        const int m0 = rb * 64; const int v = m0 < NCTX ? 0 : (m0 < NCTX + 4096 ? 1 : 2);
        const f32x4* sh4 = (const f32x4*)(mod + v * 12288); const f32x4* sc4 = (const f32x4*)(mod + v * 12288 + 4096);
        __syncthreads();
        for (int i = tid; i < 1024; i += NWAVES * 64) { const int d = ((i >> 7) * 2 + (i & 1)) * 64 + ((i & 127) >> 1);
            avl[d] = ng4[i] * (sc4[i] + 1.0f); svl[d] = sh4[i]; }
        __syncthreads();
#pragma unroll 2
        for (int r = 0; r < 8; ++r) { const int m = m0 + wave * 8 + r;
            f32x4 x[16]; float ss = 0.f;
            char* xb = (char*)((bf16*)(A->ws + ((l & 1) ? WS_XBF2 : WS_XBF)) + (size_t)m * DM);
            const char* xbi = (const char*)((const bf16*)(A->ws + ((l & 1) ? WS_XBF : WS_XBF2)) + (size_t)m * DM);
            if (l <= 1) { const float* xr = m < NCTX ? A->in[I_XP] + (size_t)m * DM : A->in[I_XS] + (size_t)(m - NCTX) * DM;
#pragma unroll
                for (int j = 0; j < 8; ++j) { x[2 * j] = ldg16(xr, lo4 + (j >> 1) * 4096u, (j & 1) * 2048); x[2 * j + 1] = ldg16(xr, lo4 + (j >> 1) * 4096u, (j & 1) * 2048 + 16); }
            } else {
#pragma unroll
                for (int j = 0; j < 8; ++j) { const v4u d = *(const v4u*)((xbi + (lo2 + (j >> 2) * 4096u)) + (j & 3) * 1024);
                    x[2 * j] = (f32x4){bf_lo(d.x), bf_hi(d.x), bf_lo(d.y), bf_hi(d.y)}; x[2 * j + 1] = (f32x4){bf_lo(d.z), bf_hi(d.z), bf_lo(d.w), bf_hi(d.w)}; }
            }
            if (l > 0) {
                const char* dr = (const char*)((const bf16*)(A->ws + ((l & 1) ? WS_DELTA : WS_DELTA2)) + (size_t)m * DM);
#pragma unroll
                for (int j = 0; j < 8; ++j) { const v4u d = *(const v4u*)((dr + (lo2 + (j >> 2) * 4096u)) + (j & 3) * 1024);
                    x[2 * j] += (f32x4){bf_lo(d.x), bf_hi(d.x), bf_lo(d.y), bf_hi(d.y)}; x[2 * j + 1] += (f32x4){bf_lo(d.z), bf_hi(d.z), bf_lo(d.w), bf_hi(d.w)};
                    v4u w; w.x = cvt_pk_bf16(x[2 * j].x, x[2 * j].y); w.y = cvt_pk_bf16(x[2 * j].z, x[2 * j].w); w.z = cvt_pk_bf16(x[2 * j + 1].x, x[2 * j + 1].y); w.w = cvt_pk_bf16(x[2 * j + 1].z, x[2 * j + 1].w);
                    *(v4u*)((xb + (lo2 + (j >> 2) * 4096u)) + (j & 3) * 1024) = w; }
            }
#pragma unroll
            for (int j = 0; j < 16; ++j) ss += (x[j].x * x[j].x + x[j].y * x[j].y) + (x[j].z * x[j].z + x[j].w * x[j].w);
            const float rstd = rsqrtf(wave_sum(ss, lane) * (1.0f / DM) + NORM_EPS);
            char* orow = (char*)(H + (size_t)m * DM);
#pragma unroll
            for (int j = 0; j < 8; ++j) { const f32x4 y0 = x[2 * j] * rstd * avl[(2 * j) * 64 + lane] + svl[(2 * j) * 64 + lane], y1 = x[2 * j + 1] * rstd * avl[(2 * j + 1) * 64 + lane] + svl[(2 * j + 1) * 64 + lane];
                v4u w; w.x = cvt_pk_bf16(y0.x, y0.y); w.y = cvt_pk_bf16(y0.z, y0.w); w.z = cvt_pk_bf16(y1.x, y1.y); w.w = cvt_pk_bf16(y1.z, y1.w);
                *(v4u*)((orow + (lo2 + (j >> 2) * 4096u)) + (j & 3) * 1024) = w;
                if ((j & 1) == 1) asm volatile("" ::: "memory"); }
        }
    }
    __syncthreads();
}
__device__ __forceinline__ void final_norm(KAP A, int gw, int NGW, int lane) {
    const float* fg = A->in[I_FNG];
    const unsigned lo2 = (unsigned)lane * 16u, lo4 = (unsigned)lane * 32u;
    f32x4 gv[16];
#pragma unroll
    for (int j = 0; j < 8; ++j) { gv[2 * j] = ldg16(fg, lo4 + (j >> 1) * 4096u, (j & 1) * 2048); gv[2 * j + 1] = ldg16(fg, lo4 + (j >> 1) * 4096u, (j & 1) * 2048 + 16); }
    for (int ci = gw; ci < NTOK / 8; ci += NGW) {
#pragma unroll 2
        for (int r = 0; r < 8; ++r) { const int m = ci * 8 + r;
            char* xr = (char*)(A->out + (size_t)m * DM);
            const char* xs = (const char*)((const bf16*)(A->ws + (((DEPTH - 1) & 1) ? WS_XBF2 : WS_XBF)) + (size_t)m * DM);
            const char* dr = (const char*)((const bf16*)(A->ws + (((DEPTH - 1) & 1) ? WS_DELTA2 : WS_DELTA)) + (size_t)m * DM);
            f32x4 x[16]; float ss = 0.f;
#pragma unroll
            for (int j = 0; j < 8; ++j) { const v4u xv = *(const v4u*)((xs + (lo2 + (j >> 2) * 4096u)) + (j & 3) * 1024); const v4u d = *(const v4u*)((dr + (lo2 + (j >> 2) * 4096u)) + (j & 3) * 1024);
                x[2 * j] = (f32x4){bf_lo(xv.x) + bf_lo(d.x), bf_hi(xv.x) + bf_hi(d.x), bf_lo(xv.y) + bf_lo(d.y), bf_hi(xv.y) + bf_hi(d.y)};
                x[2 * j + 1] = (f32x4){bf_lo(xv.z) + bf_lo(d.z), bf_hi(xv.z) + bf_hi(d.z), bf_lo(xv.w) + bf_lo(d.w), bf_hi(xv.w) + bf_hi(d.w)}; }
#pragma unroll
            for (int j = 0; j < 16; ++j) ss += (x[j].x * x[j].x + x[j].y * x[j].y) + (x[j].z * x[j].z + x[j].w * x[j].w);
            const float rstd = rsqrtf(wave_sum(ss, lane) * (1.0f / DM) + NORM_EPS);
#pragma unroll
            for (int j = 0; j < 8; ++j) { *(f32x4*)((xr + (lo4 + (j >> 1) * 4096u)) + (j & 1) * 2048) = x[2 * j] * rstd * gv[2 * j]; *(f32x4*)((xr + (lo4 + (j >> 1) * 4096u)) + (j & 1) * 2048 + 16) = x[2 * j + 1] * rstd * gv[2 * j + 1];
                if ((j & 1) == 1) asm volatile("" ::: "memory"); }
        }
    }
}

__device__ __forceinline__ void kv_prep(KAP A, int l, int gw, int NGW, int lane) {
    const bf16* PROJ = (const bf16*)(A->ws + WS_PROJ);
    const f32x2* rope = (const f32x2*)(A->ws + WS_ROPE);
    const int hl = lane & 15;
    const f32x4 kn0 = *(const f32x4*)(A->in[I_KN] + l * 128 + hl * 8), kn1 = *(const f32x4*)(A->in[I_KN] + l * 128 + hl * 8 + 4);
    for (int ci = gw; ci < NTOK / 4; ci += NGW) {
        const int m0 = ci * 4; const bool ctx = m0 < NCTX;
        v4u kr[4], vr[4];
#pragma unroll
        for (int r = 0; r < 4; ++r) { const bf16* pr = PROJ + (size_t)(m0 + r) * INW; kr[r] = *(const v4u*)(pr + OFF_K + 8 * lane); vr[r] = *(const v4u*)(pr + OFF_V + 8 * lane); }
#pragma unroll
        for (int r = 0; r < 4; ++r) { const int m = m0 + r;
            float k[8] = {bf_lo(kr[r].x), bf_hi(kr[r].x), bf_lo(kr[r].y), bf_hi(kr[r].y), bf_lo(kr[r].z), bf_hi(kr[r].z), bf_lo(kr[r].w), bf_hi(kr[r].w)};
            float ss = 0.f;
#pragma unroll
            for (int j = 0; j < 8; ++j) ss += k[j] * k[j];
            ss += shflx(ss, lane, 1); ss += shflx(ss, lane, 2); ss += shflx(ss, lane, 4); ss += shflx(ss, lane, 8);
            const float rstd = rsqrtf(ss * (1.0f / 128.0f) + NORM_EPS);
#pragma unroll
            for (int j = 0; j < 4; ++j) { k[j] *= rstd * kn0[j]; k[4 + j] *= rstd * kn1[j]; }
            if (ctx) {
                const int b = m >> 8, t = m & 255; const size_t oi = (((size_t)(b * 4 + l) * 256 + t) * 512 + 8 * lane);
                float* ok = A->out + OUT_NEWK + oi; *(f32x4*)ok = (f32x4){k[0], k[1], k[2], k[3]}; *(f32x4*)(ok + 4) = (f32x4){k[4], k[5], k[6], k[7]};
                float* ov = A->out + OUT_NEWV + oi; *(f32x4*)ov = (f32x4){bf_lo(vr[r].x), bf_hi(vr[r].x), bf_lo(vr[r].y), bf_hi(vr[r].y)}; *(f32x4*)(ov + 4) = (f32x4){bf_lo(vr[r].z), bf_hi(vr[r].z), bf_lo(vr[r].w), bf_hi(vr[r].w)};
            } else {
                const int t = (m - NCTX) & 4095, pos = hl < 8 ? (t >> 6) : (t & 63); const f32x2* rp = rope + pos * 32 + (lane & 3) * 8; const bool first = (lane & 4) == 0;
#pragma unroll
                for (int j = 0; j < 8; ++j) { const float other = shflx(k[j], lane, 4); const f32x2 cs = rp[j];
                    k[j] = first ? (k[j] * cs.x - other * cs.y) : (other * cs.y + k[j] * cs.x); }
            }
            v4u w; w.x = cvt_pk_bf16(k[0], k[1]); w.y = cvt_pk_bf16(k[2], k[3]); w.z = cvt_pk_bf16(k[4], k[5]); w.w = cvt_pk_bf16(k[6], k[7]);
            *(v4u*)((bf16*)(A->ws + WS_KC) + (size_t)m * 512 + 8 * lane) = w;
            *(v4u*)((bf16*)(A->ws + WS_VC) + (size_t)m * 512 + 8 * lane) = vr[r];
        }
    }
}

__device__ __forceinline__ void ssm_scan(KAP A, int l, int g, int mt, int tid, LAS unsigned char* lds) {
    const float* S = (const float*)(A->ws + WS_SBUF) + (size_t)g * 1024 * 256;
    bf16* A2 = (bf16*)(A->ws + WS_A2) + (size_t)g * 1024 * 512;
    const int blk = tid >> 5, sub = tid & 31, dir = sub >> 4, p0 = (sub & 15) * 4;
    f32x4 ar, ai;
    { const f32x4* a4 = (const f32x4*)((const float*)(A->ws + WS_A16) + (((size_t)(l * 2 + dir) * 64 + g) * 64 + p0) * 2); const f32x4 t0 = a4[0], t1 = a4[1];
      ar = (f32x4){t0.x, t0.z, t1.x, t1.z}; ai = (f32x4){t0.y, t0.w, t1.y, t1.w}; }
    const int ecol = 256 + dir * 128 + p0, scol = dir * 128 + p0;
    LAS f32x4* T = (LAS f32x4*)lds;
    LAS f32x4* EB = T + 16 * 32 * 2;
    const bool lat = mt >= 2;
    const int rb = mt * 256 + blk * 16;
    f32x4 sr[16], si[16];
#pragma unroll
    for (int i = 0; i < 16; ++i) { const int row = rb + (dir ? 15 - i : i); sr[i] = *(const f32x4*)(S + (size_t)row * 256 + scol); si[i] = *(const f32x4*)(S + (size_t)row * 256 + scol + 64); }
    f32x4 er = {0.f, 0.f, 0.f, 0.f}, ei = er;
    if (lat) {
#pragma unroll
        for (int i = 0; i < 16; ++i) { const f32x4 nr = ar * er - ai * ei + sr[i], ni = ar * ei + ai * er + si[i]; er = nr; ei = ni; }
        T[(blk * 32 + sub) * 2] = er; T[(blk * 32 + sub) * 2 + 1] = ei;
        __syncthreads();
        if (tid < 32) { const int b = mt - 2; const size_t si0 = (((size_t)b * 4 + l) * 64 + g) * 64 + p0;
            f32x4 cr = *(const f32x4*)(A->in[dir ? I_SBR : I_SFR] + si0), ci = *(const f32x4*)(A->in[dir ? I_SBI : I_SFI] + si0);
            f32x4 qr = ar, qi = ai;
#pragma unroll
            for (int k = 0; k < 4; ++k) { const f32x4 t = qr * qr - qi * qi; qi = 2.f * qr * qi; qr = t; }
#pragma unroll 1
            for (int jb = 0; jb < 16; ++jb) { const int bb = dir ? 15 - jb : jb; EB[(bb * 32 + sub) * 2] = cr; EB[(bb * 32 + sub) * 2 + 1] = ci;
                const f32x4 tr = T[(bb * 32 + sub) * 2], ti = T[(bb * 32 + sub) * 2 + 1];
                const f32x4 nr = qr * cr - qi * ci + tr, ni = qr * ci + qi * cr + ti; cr = nr; ci = ni; } }
        __syncthreads();
        er = EB[(blk * 32 + sub) * 2]; ei = EB[(blk * 32 + sub) * 2 + 1];
    }
#pragma unroll
    for (int i = 0; i < 16; ++i) { const int row = rb + (dir ? 15 - i : i);
        v2u wr, wi; wr.x = cvt_pk_bf16(er.x, er.y); wr.y = cvt_pk_bf16(er.z, er.w); wi.x = cvt_pk_bf16(ei.x, ei.y); wi.y = cvt_pk_bf16(ei.z, ei.w);
        *(v2u*)(A2 + (size_t)row * 512 + ecol) = wr; *(v2u*)(A2 + (size_t)row * 512 + ecol + 64) = wi;
        const f32x4 nr = ar * er - ai * ei + sr[i], ni = ar * ei + ai * er + si[i]; er = nr; ei = ni; }
    if (!lat) { const int b = mt * 16 + blk; const size_t oi = (((size_t)b * 4 + l) * 64 + g) * 64 + p0;
        *(f32x4*)(A->out + (dir ? OUT_BRE : OUT_FRE) + oi) = er; *(f32x4*)(A->out + (dir ? OUT_BIM : OUT_FIM) + oi) = ei; }
}
__device__ __forceinline__ void ssm_step1(KAP A, int l, int un, LAS unsigned char* lds, int wv) {
    const int g = un >> 2, mt = un & 3, lg = l * 64 + g;
    pg8::OneUnit S1; S1.u0.a = (const char*)(A->ws + WS_A2) + ((size_t)g * 1024 + mt * 256) * 512 * 2; S1.u0.b = (const char*)(A->ws + WS_PMAT) + (size_t)lg * 256 * 256 * 2;
    S1.u0.c = (char*)(A->ws + WS_SBUF) + ((size_t)g * 1024 + mt * 256) * 256 * 4; S1.u0.ldc = 256; S1.u0.pm = mt; S1.u0.pn = g; S1.u0.z = 0; S1.u0.kt = 4;
    pg8::EpiF32 E; pg8::gemm_phase<pg8::EpiF32, pg8::OneUnit>(lds, wv, 512, 256, S1, E);
}
__device__ __forceinline__ void ssm_step2(KAP A, int l, int un, LAS unsigned char* lds, int wv) {
    const int g = un >> 2, mt = un & 3; const int tid = tid_of(wv); ssm_scan(A, l, g, mt, tid, lds);
}
__device__ __forceinline__ void ssm_step3(KAP A, int l, int un, LAS unsigned char* lds, int wv) {
    const int g = un >> 2, mt = un & 3, lg = l * 64 + g;
    pg8::OneUnit S2; S2.u0.a = (const char*)(A->ws + WS_A2) + ((size_t)g * 1024 + mt * 256) * 512 * 2; S2.u0.b = (const char*)(A->ws + WS_KG) + (size_t)lg * 256 * 512 * 2;
    S2.u0.c = nullptr; S2.u0.ldc = 0; S2.u0.pm = mt; S2.u0.pn = g; S2.u0.z = mt * 256; S2.u0.kt = 8;
    pg8::EpiSsmY E{(bf16*)(A->ws + WS_YSSM)}; pg8::gemm_phase<pg8::EpiSsmY, pg8::OneUnit>(lds, wv, 512, 512, S2, E);
}

struct Fft1Order {
    int G, c; const char* D1; const char* proj; char* zl; char* zc;
    __device__ bool next(int i, pg8::Unit& u) const { const int L = i * G + c; if (L >= 256) return false;
        const int g = L & 3, tt = L >> 2;
        int kt4 = 4; asm volatile("" : "+s"(kt4)); u.kt = kt4;
        u.a = D1; u.b = proj + ((size_t)tt * 256 * INW + OFF_F + g * 256) * 2; u.pm = 0; u.pn = tt; u.z = g;
        if (tt < 32) { u.c = zc + ((size_t)((tt * 4 + g) * 128) * 256) * 2; u.ldc = 256; }
        else { const int b = (tt - 32) >> 4, t0 = ((tt - 32) & 15) * 256; u.c = zl + ((size_t)((b * 4 + g) * 128) * 4096 + t0) * 2; u.ldc = 4096; }
        return true; }
};
struct Fft2LOrder {
    int G, c; const char* D2; const char* z; char* P;
    __device__ bool next(int i, pg8::Unit& u) const { const int L = i * G + c; if (L >= 128) return false;
        const int nt = L & 3, part = (L >> 2) & 1, mt = L >> 3;
        u.kt = 64; u.a = D2 + ((size_t)mt * 256 * 8192 + part * 4096) * 2; u.b = z + (part * ZPART + (size_t)nt * 256 * 4096) * 2; u.pm = mt; u.pn = nt; u.z = part;
        u.c = P + (((size_t)NCTX + (nt >> 1) * 4096 + mt * 256) * PK + (nt & 1) * 512 + part * 128) * 2; u.ldc = PK; return true; }
};
struct Fft2COrder {
    int G, c; const char* D2; const char* z; char* P;
    __device__ bool next(int i, pg8::Unit& u) const { const int L = i * G + c; if (L >= 128) return false;
        const int nt = L & 1, part = (L >> 1) & 1, b = L >> 2;
        u.kt = 4; u.a = D2 + (size_t)part * 256 * 2; u.b = z + (part * ZPART + (size_t)((b * 4 + nt * 2) * 128) * 256) * 2; u.pm = 0; u.pn = nt; u.z = b;
        u.c = P + (((size_t)b * 256) * PK + nt * 512 + part * 128) * 2; u.ldc = PK; return true; }
};
template <int NS, int KS>
__device__ __forceinline__ f32x4 nyq_core(const bf16* arow, size_t lda16, const bf16* bcol, LAS unsigned char* lds, int tid) {
    const int wave = tid >> 6, lane = tid & 63, fq = lane >> 4;
    f32x4 acc[NS];
#pragma unroll
    for (int ns = 0; ns < NS; ++ns) acc[ns] = (f32x4){0.f, 0.f, 0.f, 0.f};
    const int tb = wave * KS * 32 + fq * 8;
#pragma unroll 4
    for (int s2 = 0; s2 < KS; ++s2) { const bf16x8 bv = *(const bf16x8*)(bcol + tb + s2 * 32);
#pragma unroll
        for (int ns = 0; ns < NS; ++ns) { const bf16x8 av = *(const bf16x8*)(arow + ns * lda16 + tb + s2 * 32); acc[ns] = __builtin_amdgcn_mfma_f32_16x16x32_bf16(bv, av, acc[ns], 0, 0, 0); } }
    LAS f32x4* red = (LAS f32x4*)lds;
    __syncthreads();
#pragma unroll
    for (int ns = 0; ns < NS; ++ns) red[(wave * NS + ns) * 64 + lane] = acc[ns];
    __syncthreads();
    f32x4 r = (f32x4){0.f, 0.f, 0.f, 0.f};
    if (tid < NS * 64) {
#pragma unroll
        for (int w = 0; w < 8; ++w) r += red[(w * NS + (tid >> 6)) * 64 + (tid & 63)]; }
    __syncthreads();
    return r;
}
__device__ __forceinline__ void nyq_pass(KAP A, int cA, LAS unsigned char* lds, int wv) {
    const int tid = tid_of(wv); const int fr = tid & 15;
    bf16* P = (bf16*)(A->ws + WS_P);
    {
        const bf16* arow = (const bf16*)(A->ws + WS_D2L) + (size_t)(cA * 32 + fr) * 8192;
        const bf16* bcol = (const bf16*)(A->ws + WS_ZL) + ZPART + (size_t)((fr & 7) * 128) * 4096;
        const f32x4 r = nyq_core<2, 16>(arow, (size_t)16 * 8192, bcol, lds, tid) * (1.0f / 1024.0f);
        const int fq = (tid & 63) >> 4;
        if (tid < 128 && fq < 2) { const int k = cA * 32 + (tid >> 6) * 16 + fr; *(v2u*)(P + ((size_t)NCTX + fq * 4096 + k) * PK + 1024) = (v2u){cvt_pk_bf16(r[0], r[1]), cvt_pk_bf16(r[2], r[3])}; } }
    {
        const int cg = cA & 7, rs = cA >> 3;
        const bf16* arow = (const bf16*)(A->ws + WS_D2C) + (size_t)(rs * 16 + fr) * 512;
        const bf16* bcol = (const bf16*)(A->ws + WS_ZC) + ZPART + (size_t)(((cg * 4 + (fr >> 2)) * 4 + (fr & 3)) * 128) * 256;
        const f32x4 r = nyq_core<1, 1>(arow, 0, bcol, lds, tid) * (1.0f / 256.0f);
        const int fq = (tid & 63) >> 4;
        if (tid < 64) { const int k = rs * 16 + fr, b = cg * 4 + fq; *(v2u*)(P + ((size_t)b * 256 + k) * PK + 1024) = (v2u){cvt_pk_bf16(r[0], r[1]), cvt_pk_bf16(r[2], r[3])}; } }
}

__global__ void __launch_bounds__(NWAVES * 64, 2) hymba_fwd(Args args) {
    extern __shared__ __attribute__((aligned(16))) unsigned char lds_raw[];
    LAS unsigned char* lds = (LAS unsigned char*)lds_raw;
    volatile LAS unsigned* MISC = (volatile LAS unsigned*)(lds + MISC_OFF);
    const int G = gridDim.x, bx = blockIdx.x;
    const int wv = __builtin_amdgcn_readfirstlane(threadIdx.x >> 6);
#define TID_HERE() const int tid = tid_of(wv); const int lane = tid & 63, wave = __builtin_amdgcn_readfirstlane(tid >> 6), gw = bq * NWAVES + wave, NGWq = Gq * NWAVES; (void)lane; (void)gw; (void)NGWq
#define PH_IDS() int Gq = G, bq = bx; asm volatile("" : "+s"(Gq), "+s"(bq))
    for (int u = tid_of(wv); u < (LDS_BYTES - MISC_OFF) / 4; u += NWAVES * 64) ((LAS unsigned*)(lds + MISC_OFF))[u] = 0u;
    __syncthreads();
    int lo, hi; XcdBarrier bar;
    { KA_HERE(); PH_IDS(); lo = ka->ph_lo; hi = ka->ph_hi; unsigned* ctl = (unsigned*)(ka->ws + WS_CTL);
      bar.bar = ctl + CW_BAR; bar.x = 0; bar.st = nullptr;
      if (hi - lo > 1) bar = xcd_barrier_post(ctl + CW_BAR, MISC + 8, tid_of(wv)); }
#define IN(k) (lo <= (k) && (k) < hi)
#define SEAM(k) do { if (IN(k) && IN((k) + 1)) { xcd_barrier(bar, wv); if (((DUP_MASK) >> 12) & 1) xcd_barrier(bar, wv); } } while (0)

    if (IN(0)) DUP(0) { KA_HERE(); PH_IDS(); p0_prologue(ka, lds, Gq, bq, wv); }
    SEAM(0);

    for (int l = 0; l < DEPTH; ++l) for (int lrep_ = 0; lrep_ < 1 + (((DUP_MASK) >> 19) & 1); ++lrep_) {
        const int pb = 1 + 6 * l;
        if (IN(pb)) DUP(1) { KA_HERE(); PH_IDS(); TID_HERE(); pa_norm(ka, l, bq, Gq, tid, lds);
        }
        SEAM(pb);
        if (IN(pb + 1)) DUP(2) {
            KA_HERE(); PH_IDS(); unsigned char* ws = ka->ws;
            pg8::GemmOrder S; S.init(NTOK, INW, Gq, bq, ws + WS_H, DM, ws + WS_WIN + (size_t)l * INW * DM * 2, DM, DM);
            pg8::EpiProj E{(bf16*)(ws + WS_PROJ), (bf16*)(ws + WS_A2)};
            pg8::gemm_phase<pg8::EpiProj, pg8::GemmOrder, GEMM1_ALIGN>(lds, wv, DM, DM, S, E);
        }
        SEAM(pb + 1);
        if (IN(pb + 2)) {
            DUP(16) for (int un = bx; un < 256; un += G) { KA_HERE(); ssm_step1(ka, l, un, lds, wv); }
            DUP(14) { KA_HERE(); PH_IDS(); TID_HERE(); kv_prep(ka, l, gw, NGWq, lane); }
            wg_global_sync();
            DUP(17) { for (int un = bx; un < 256; un += G) { KA_HERE(); ssm_step2(ka, l, un, lds, wv); } __syncthreads(); }
            DUP(3) { KA_HERE(); PH_IDS(); unsigned char* ws = ka->ws;
              Fft1Order S{Gq, bq, (const char*)(ws + WS_D1), (const char*)(ws + WS_PROJ), (char*)(ws + WS_ZL), (char*)(ws + WS_ZC)};
              pg8::EpiBf16X E{1.0f, (int)ZPART, 128}; pg8::gemm_phase<pg8::EpiBf16X, Fft1Order>(lds, wv, 256, INW, S, E); }
            wg_global_sync();
            DUP(18) for (int un = bx; un < 256; un += G) { KA_HERE(); ssm_step3(ka, l, un, lds, wv); }
        }
        SEAM(pb + 2);
        if (IN(pb + 3)) {
            DUP(5) for (int U = bx; U < 512; U += G) {
                KA_HERE(); PH_IDS(); unsigned char* ws = ka->ws; bf16* const PROJ = (bf16*)(ws + WS_PROJ); bf16* const MIX = (bf16*)(ws + WS_MIX);
                const float* qn = ka->in[I_QN] + l * 128; const f32x2* rope = (const f32x2*)(ws + WS_ROPE);
                const int pr = U & 7, idx = U >> 3, b = pr >> 2, kvh = pr & 3, hq = kvh * 4 + (idx >> 4), qb = idx & 15;
                const size_t row0 = (size_t)NCTX + b * 4096 + qb * 256;
                const bf16* ck = (const bf16*)(ws + WS_CK) + ((size_t)(b * 4 + l) * 512) * 512 + kvh * 128;
                const bf16* cv = (const bf16*)(ws + WS_CV) + ((size_t)(b * 4 + l) * 512) * 512 + kvh * 128;
                const bf16* k1 = (const bf16*)(ws + WS_KC) + ((size_t)NCTX + b * 4096) * 512 + kvh * 128; const bf16* v1 = (const bf16*)(ws + WS_VC) + ((size_t)NCTX + b * 4096) * 512 + kvh * 128;
                att::attn_unit(PROJ + row0 * INW + hq * 128, PROJ + row0 * INW + OFF_GA + hq * 128, MIX + row0 * DM + hq * 128,
                               ck, cv, 512, 8, k1, v1, 512, 64, qn, rope, qb * 256, (char*)lds_raw, wv);
            }
            {
                const int nH = G >> 1, hb = bx >= nH ? 1 : 0, cH = bx - hb * nH, Uend = hb ? 512 : 256;
                DUP(6) for (int U = hb * 256 + cH; U < Uend; U += (hb ? G - nH : nH)) {
                    KA_HERE(); unsigned char* ws = ka->ws; bf16* const PROJ = (bf16*)(ws + WS_PROJ); bf16* const MIX = (bf16*)(ws + WS_MIX);
                    const float* qn = ka->in[I_QN] + l * 128;
                    const int xx = U & 7, idx = U >> 3, b = xx * 4 + (idx >> 4), hq = idx & 15, kvh = hq >> 2;
                    const size_t row0 = (size_t)b * 256;
                    const bf16* k1 = (const bf16*)(ws + WS_KC) + row0 * 512 + kvh * 128; const bf16* v1 = (const bf16*)(ws + WS_VC) + row0 * 512 + kvh * 128;
                    att::attn_unit(PROJ + row0 * INW + hq * 128, PROJ + row0 * INW + OFF_GA + hq * 128, MIX + row0 * DM + hq * 128,
                                   k1, v1, 512, 0, k1, v1, 512, 4, qn, nullptr, 0, (char*)lds_raw, wv);
                }
            }
            if (bx >= (G >> 1)) {
                const int nB = G - (G >> 1), cB = bx - (G >> 1);
                __syncthreads();
                DUP(9) { KA_HERE(); unsigned char* ws = ka->ws; int nBq = nB, cBq = cB; asm volatile("" : "+s"(nBq), "+s"(cBq));
                  pg8::GemmOrder S; S.init(NTOK, 2048, nBq, cBq, ws + WS_YSSM, 1024, ws + WS_WGLU + (size_t)l * 2048 * 1024 * 2, 1024, 1024);
                  pg8::EpiGlu E{(const bf16*)(ws + WS_PROJ), (bf16*)(ws + WS_MIX)}; pg8::gemm_phase<pg8::EpiGlu, pg8::GemmOrder>(lds, wv, 1024, 1024, S, E); }
            } else {
                __syncthreads();
                DUP(7) { KA_HERE(); unsigned char* ws = ka->ws; int nAq = G >> 1, cAq = bx; asm volatile("" : "+s"(nAq), "+s"(cAq));
                  Fft2LOrder S{nAq, cAq, (const char*)(ws + WS_D2L), (const char*)(ws + WS_ZL), (char*)(ws + WS_P)};
                  pg8::EpiBf16X E{1.0f / 1024.0f, 128 * PK, 256}; pg8::gemm_phase<pg8::EpiBf16X, Fft2LOrder>(lds, wv, 8192, 4096, S, E); }
                DUP(8) { KA_HERE(); unsigned char* ws = ka->ws; int nAq = G >> 1, cAq = bx; asm volatile("" : "+s"(nAq), "+s"(cAq));
                  Fft2COrder S{nAq, cAq, (const char*)(ws + WS_D2C), (const char*)(ws + WS_ZC), (char*)(ws + WS_P)};
                  pg8::EpiBf16X E{1.0f / 256.0f, 128 * PK, 256}; pg8::gemm_phase<pg8::EpiBf16X, Fft2COrder>(lds, wv, 512, 256, S, E); }
                DUP(8) { KA_HERE(); for (int it = bx; it < 128; it += (G >> 1)) nyq_pass(ka, it, lds, wv); }
            }
        }
        SEAM(pb + 3);
        if (IN(pb + 4)) {
            DUP(10) { KA_HERE(); PH_IDS(); unsigned char* ws = ka->ws;
              pg8::GemmOrder S; S.init(NTOK, 1024, Gq, bq, ws + WS_P, PK, ws + WS_WFP + (size_t)l * 1024 * PK * 2, PK, PK);
              pg8::EpiFftW E{(const bf16*)(ws + WS_PROJ), (bf16*)(ws + WS_MIX)}; pg8::gemm_phase<pg8::EpiFftW, pg8::GemmOrder>(lds, wv, PK, PK, S, E); }
        }
        SEAM(pb + 4);
        if (IN(pb + 5)) DUP(11) {
            KA_HERE(); PH_IDS(); unsigned char* ws = ka->ws;
            pg8::GemmOrder S; S.init(NTOK, DM, Gq, bq, ws + WS_MIX, DM, ws + WS_WOUT + (size_t)l * DM * DM * 2, DM, DM);
            pg8::EpiOut E{(bf16*)(ws + ((l & 1) ? WS_DELTA2 : WS_DELTA)), (const float*)(ws + WS_MOD) + (size_t)l * 3 * 12288};
            if (((DUP_MASK) >> 13) & 1) {
                { pg8::SliceOrder<pg8::GemmOrder> S2{S, 0, 2}; pg8::gemm_phase<pg8::EpiOut, pg8::SliceOrder<pg8::GemmOrder>, GEMM1_ALIGN>(lds, wv, DM, DM, S2, E); }
                xcd_barrier(bar, wv);
                { pg8::SliceOrder<pg8::GemmOrder> S2{S, 2, 1000}; pg8::gemm_phase<pg8::EpiOut, pg8::SliceOrder<pg8::GemmOrder>, GEMM1_ALIGN>(lds, wv, DM, DM, S2, E); }
            } else
            pg8::gemm_phase<pg8::EpiOut, pg8::GemmOrder, GEMM1_ALIGN>(lds, wv, DM, DM, S, E);
        }
        SEAM(pb + 5);
    }
    if (IN(25)) DUP(15) { KA_HERE(); PH_IDS(); TID_HERE(); final_norm(ka, gw, NGWq, lane); }
#undef IN
#undef SEAM
}

extern "C" void kernel_launch(void* const* d_in, const int* in_sizes, int n_in, void* d_out, int out_size, void* d_ws, size_t ws_size, hipStream_t stream) {
    static int grid = 0;
    if (grid == 0) {
        if (n_in != 28 || ws_size < WS_END || out_size != 102760448) { fprintf(stderr, "kernel_launch: unexpected shapes (n_in %d, out %d, ws %zu)\n", n_in, out_size, ws_size); grid = -1; return; }
        int dev = 0, cus = 0, per_cu = 0;
        if (hipGetDevice(&dev) != hipSuccess || hipDeviceGetAttribute(&cus, hipDeviceAttributeMultiprocessorCount, dev) != hipSuccess) { grid = -1; return; }
        if (hipFuncSetAttribute((const void*)hymba_fwd, hipFuncAttributeMaxDynamicSharedMemorySize, LDS_BYTES) != hipSuccess) { fprintf(stderr, "kernel_launch: hipFuncSetAttribute failed\n"); grid = -1; return; }
        if (hipOccupancyMaxActiveBlocksPerMultiprocessor(&per_cu, (const void*)hymba_fwd, NWAVES * 64, LDS_BYTES) != hipSuccess || per_cu < 1)
            fprintf(stderr, "kernel_launch: occupancy query reports %d workgroups per CU\n", per_cu);
        (void)hipGetLastError();
        grid = cus;
    }
    if (grid < 0) return;
    (void)hipMemsetAsync((char*)d_ws + WS_CTL, 0, CTL_ZERO_BYTES, stream);
    Args a{};
    for (int i = 0; i < 28; ++i) a.in[i] = (const float*)d_in[i];
    a.out = (float*)d_out; a.ws = (unsigned char*)d_ws;
#if MK_ONE_LAUNCH == 2
    a.ph_lo = 0; a.ph_hi = 1;
    hipLaunchKernelGGL(hymba_fwd, dim3(grid), dim3(NWAVES * 64), LDS_BYTES, stream, a);
    a.ph_lo = 0; a.ph_hi = 26;
    hipLaunchKernelGGL(hymba_fwd, dim3(grid), dim3(NWAVES * 64), LDS_BYTES, stream, a);
#elif MK_ONE_LAUNCH
    a.ph_lo = 0; a.ph_hi = 26;
    hipLaunchKernelGGL(hymba_fwd, dim3(grid), dim3(NWAVES * 64), LDS_BYTES, stream, a);
#else
    for (int ph = 0; ph < 26; ++ph) { a.ph_lo = ph; a.ph_hi = ph + 1; hipLaunchKernelGGL(hymba_fwd, dim3(grid), dim3(NWAVES * 64), LDS_BYTES, stream, a); }
#endif
    const hipError_t le = hipPeekAtLastError();
    if (le != hipSuccess) fprintf(stderr, "kernel_launch: launch failed: %s\n", hipGetErrorName(le));
}
```

```cpp
#include <hip/hip_runtime.h>
#include <cstdio>
#include <cstdint>

#ifndef MK_ONE_LAUNCH
#define MK_ONE_LAUNCH 1
#endif

#ifndef GEMM1_ALIGN
#define GEMM1_ALIGN true
#endif
#ifndef DUP_MASK
#define DUP_MASK 0
#endif
#define DUP(k) for (int rep_ = 0; rep_ < (((DUP_MASK) >> (k)) & 1) + 1; ++rep_)
#define LAS __attribute__((address_space(3)))
#define GAS __attribute__((address_space(1)))
typedef unsigned short bf16;
typedef unsigned v4u __attribute__((ext_vector_type(4)));
typedef unsigned v2u __attribute__((ext_vector_type(2)));
typedef float f32x4 __attribute__((ext_vector_type(4)));
typedef float f32x2 __attribute__((ext_vector_type(2)));
typedef short bf16x8 __attribute__((ext_vector_type(8)));
typedef short s16x4 __attribute__((ext_vector_type(4)));
typedef float f32x16 __attribute__((ext_vector_type(16)));

constexpr int DM = 4096, NTOK = 16384, NCTX = 8192, DEPTH = 4, INW = 9216;
constexpr int OFF_K = 2048, OFF_V = 2560, OFF_GA = 3072, OFF_U = 5120, OFF_GS = 6144, OFF_F = 7168, OFF_GF = 8192;
constexpr float NORM_EPS = 1e-6f;
constexpr size_t OUT_NEWK = 67108864, OUT_NEWV = 83886080, OUT_FRE = 100663296, OUT_FIM = 101187584, OUT_BRE = 101711872, OUT_BIM = 102236160;

constexpr size_t MiB = 1u << 20;
constexpr size_t WS_CTL = 0, CTL_ZERO_BYTES = 1 * MiB;
constexpr size_t WS_MOD = 1 * MiB;
constexpr size_t WS_ROPE = 2 * MiB;
constexpr size_t WS_A16 = 3 * MiB;
constexpr size_t WS_D1 = 4 * MiB;
constexpr size_t WS_D2C = 5 * MiB;
constexpr size_t WS_CK = 6 * MiB;
constexpr size_t WS_CV = 10 * MiB;
constexpr size_t WS_PMAT = 14 * MiB;
constexpr size_t WS_KG = 46 * MiB;
constexpr size_t WS_D2L = 110 * MiB;
constexpr size_t WS_WGLU = 174 * MiB;
constexpr size_t WS_WOUT = 198 * MiB;
constexpr size_t WS_WIN = 326 * MiB;
constexpr size_t WS_H = 614 * MiB;
constexpr size_t WS_PROJ = 742 * MiB;
constexpr size_t WS_MIX = 1030 * MiB;
constexpr size_t WS_A2 = 1158 * MiB;
constexpr size_t WS_SBUF = 1222 * MiB;
constexpr size_t WS_YSSM = 1286 * MiB;
constexpr size_t WS_ZL = 1318 * MiB;
constexpr size_t WS_ZC = 1334 * MiB;
constexpr size_t WS_P = 1350 * MiB;
constexpr size_t WS_WFP = 1386 * MiB;
constexpr int PK = 1152; constexpr size_t ZPART = (size_t)1 << 22;
constexpr size_t WS_DELTA = 1414 * MiB;
constexpr size_t WS_XBF = 1542 * MiB;
constexpr size_t WS_XBF2 = 1702 * MiB;
constexpr size_t WS_KC = 1670 * MiB;
constexpr size_t WS_VC = 1686 * MiB;
constexpr size_t WS_DELTA2 = 1830 * MiB;
constexpr size_t WS_END = 1958 * MiB;
constexpr int CW_BAR = 4096;

constexpr int LDS_BYTES = 147456;
constexpr int MISC_OFF = 143360;
constexpr int NWAVES = 8;

#define LDS_WAIT() asm volatile("s_waitcnt lgkmcnt(0)" ::: "memory")
#define VM_WAIT() asm volatile("s_waitcnt vmcnt(0)" ::: "memory")
#define RLX_AGENT __ATOMIC_RELAXED, __HIP_MEMORY_SCOPE_AGENT

__device__ __forceinline__ int tid_of(int wv) { int t = wv * 64 + (int)__builtin_amdgcn_mbcnt_hi(~0u, __builtin_amdgcn_mbcnt_lo(~0u, 0u)); asm volatile("" : "+v"(t)); return t; }
__device__ __forceinline__ unsigned cvt_pk_bf16(float lo, float hi) { unsigned r; asm volatile("v_cvt_pk_bf16_f32 %0, %1, %2" : "=v"(r) : "v"(lo), "v"(hi)); return r; }
__device__ __forceinline__ float bf_lo(unsigned w) { return __uint_as_float(w << 16); }
__device__ __forceinline__ float bf_hi(unsigned w) { return __uint_as_float(w & 0xffff0000u); }
__device__ __forceinline__ float silu_f(float x) { return x * __builtin_amdgcn_rcpf(1.0f + __expf(-x)); }
__device__ __forceinline__ float sigmoid_f(float x) { return __builtin_amdgcn_rcpf(1.0f + __expf(-x)); }
__device__ __forceinline__ float shflx(float v, int lane, int o) { return __int_as_float(__builtin_amdgcn_ds_bpermute((lane ^ o) << 2, __float_as_int(v))); }
__device__ __forceinline__ float wave_sum(float v, int lane) {
#pragma unroll
    for (int o = 1; o < 64; o <<= 1) v += shflx(v, lane, o);
    return v;
}

namespace pg8 {
constexpr int BM = 256, BK = 64, HALF = 128, HTB = HALF * BK * 2, STAGE_BYTES = 8 * HTB, NXCD = 8, WGM = 8;
__host__ __device__ __forceinline__ int lds_byte(int r, int c) { const int st = (r >> 4) * 2 + (c >> 5), rr = r & 15, cc = c & 31, ob = rr * 64 + cc * 2; return st * 1024 + (ob ^ (((ob >> 9) & 1) << 5)); }
__host__ __device__ __forceinline__ void stage_rc(int b, int& R, int& C) { const int st = b / 1024, sb = b % 1024, swz = sb ^ (((sb >> 9) & 1) << 5); R = (st >> 1) * 16 + swz / 64; C = (st & 1) * 32 + (swz % 64) / 2; }
__host__ __device__ __forceinline__ int perm32(int rho) { const int n = rho >> 4, i = rho & 15; return 8 * (i >> 2) + 4 * n + (i & 3); }

struct Unit { const char* a; const char* b; char* c; int ldc; int pm, pn, z, kt; };

struct GemmOrder {
    int nM, nN, nwg, G, c, kt; const char* A; const char* B; size_t atile, btile;
    __device__ void init(int M, int N, int G_, int c_, const void* A_, int lda, const void* B_, int ldb, int K) { kt = K / BK; nM = M / BM; nN = N / BM; nwg = nM * nN; G = G_; c = c_; A = (const char*)A_; B = (const char*)B_; atile = (size_t)BM * lda * 2; btile = (size_t)BM * ldb * 2; }
    __device__ bool next(int i, Unit& u) const {
        const long L = (long)i * G + c; if (L >= nwg) return false;
        int wgid = (int)L; const int xcd = wgid % NXCD; { const int q = nwg / NXCD, r = nwg % NXCD, off = wgid / NXCD; wgid = (xcd < r ? xcd * (q + 1) : r * (q + 1) + (xcd - r) * q) + off; }
        const int nig = WGM * nN, gid = wgid / nig, fm = gid * WGM, gsz = (nM - fm) < WGM ? (nM - fm) : WGM;
        u.pm = fm + ((wgid % nig) % gsz); u.pn = (wgid % nig) / gsz; u.z = 0; u.c = nullptr; u.ldc = 0; u.kt = kt;
        u.a = A + (size_t)u.pm * atile; u.b = B + (size_t)u.pn * btile; return true;
    }
};
template <class O> struct SliceOrder { O g; int i0, cnt; __device__ bool next(int i, Unit& u) const { if (i >= cnt) return false; return g.next(i0 + i, u); } };
struct OneUnit { Unit u0; __device__ bool next(int i, Unit& u) const { if (i != 0) return false; u = u0; return true; } };

template <class Epi, class Sched, bool ALIGN_EPI = true>
__device__ __forceinline__ void gemm_phase(LAS unsigned char* lds, const int wv, const int lda, const int ldb, const Sched& S, const Epi& E) {
    const int tid = tid_of(wv);
    const int wid = __builtin_amdgcn_readfirstlane(tid >> 6), lane = tid & 63, wr = wid >> 2, wc = wid & 3, fr = lane & 15, fq = lane >> 4;
    unsigned voffA[2], voffB[2];
#pragma unroll
    for (int i = 0; i < 2; ++i) { int R, C; stage_rc(tid * 16 + i * 8192, R, C); const int Rb = Epi::PERM ? ((R & ~31) + perm32(R & 31)) : R;
        voffA[i] = (unsigned)(R * lda + C) * 2u; voffB[i] = (unsigned)(Rb * ldb + C) * 2u; }
    (void)fr; (void)fq;
    const size_t kstep = (size_t)(BK * 2);
    const unsigned hstepA = (unsigned)HALF * lda * 2u, hstepB = (unsigned)HALF * ldb * 2u;
    const unsigned ldsw = (unsigned)wid * 1024u;
    const int aoff = lds_byte(wr * 64 + fr, fq * 8), boff = lds_byte(wc * 32 + fr, fq * 8);
#define PG8_SA(b, h) (((b) * 2 + (h)) * HTB)
#define PG8_SB(b, h) ((4 + (b) * 2 + (h)) * HTB)
#define PG8_STAGE(bufoff, gbase, voff) do { _Pragma("unroll") for (int _i = 0; _i < 2; ++_i) \
        __builtin_amdgcn_global_load_lds((const unsigned*)((const char*)(gbase) + (voff)[_i]), (LAS unsigned*)(lds + (bufoff) + ldsw + _i * 8192), 16, 0, 0); } while (0)
#define PG8_LDA(dst, b, h) do { _Pragma("unroll") for (int m = 0; m < 4; ++m) _Pragma("unroll") for (int k = 0; k < 2; ++k) dst[m][k] = *(const LAS bf16x8*)(lds + PG8_SA(b, h) + aoff + m * 2048 + k * 1024); } while (0)
#define PG8_LDB(dst, b, h) do { _Pragma("unroll") for (int n = 0; n < 2; ++n) _Pragma("unroll") for (int k = 0; k < 2; ++k) dst[n][k] = *(const LAS bf16x8*)(lds + PG8_SB(b, h) + boff + n * 2048 + k * 1024); } while (0)
#define PG8_MMA(ai, bj, At, Bt) do { __builtin_amdgcn_s_setprio(1); _Pragma("unroll") for (int m = 0; m < 4; ++m) _Pragma("unroll") for (int n = 0; n < 2; ++n) _Pragma("unroll") for (int k = 0; k < 2; ++k) \
        acc[ai][bj][m][n] = __builtin_amdgcn_mfma_f32_16x16x32_bf16(Bt[n][k], At[m][k], acc[ai][bj][m][n], 0, 0, 0); __builtin_amdgcn_s_setprio(0); } while (0)
#define PG8_WAIT_V(n) asm volatile("s_waitcnt vmcnt(" #n ")" ::: "memory")
#define PG8_WAIT_L(n) asm volatile("s_waitcnt lgkmcnt(" #n ")" ::: "memory")
#define PG8_BAR __builtin_amdgcn_s_barrier()
#define PG8_SCHED __builtin_amdgcn_sched_barrier(0)
    int ui = 0, nt;
    const char* cA; const char* cB;
    { Unit u0; if (!S.next(0, u0)) return; cA = u0.a; cB = u0.b; nt = u0.kt; }
    f32x4 acc[2][2][4][2];
#pragma unroll
    for (int a = 0; a < 2; ++a)
#pragma unroll
        for (int b = 0; b < 2; ++b)
#pragma unroll
            for (int m = 0; m < 4; ++m)
#pragma unroll
                for (int n = 0; n < 2; ++n) acc[a][b][m][n] = (f32x4){0.f, 0.f, 0.f, 0.f};
    bf16x8 At[4][2], B0[2][2], B1[2][2];
    PG8_STAGE(PG8_SB(0, 0), cB, voffB); PG8_STAGE(PG8_SB(0, 1), cB + hstepB, voffB); PG8_STAGE(PG8_SA(0, 0), cA, voffA); PG8_STAGE(PG8_SA(0, 1), cA + hstepA, voffA);
    if (wr == 1) PG8_BAR;
    PG8_WAIT_V(2); PG8_BAR;
    PG8_STAGE(PG8_SB(1, 0), cB + kstep, voffB); PG8_STAGE(PG8_SA(1, 0), cA + kstep, voffA); PG8_STAGE(PG8_SB(1, 1), cB + hstepB + kstep, voffB);
    PG8_WAIT_V(6); PG8_BAR;
    for (;;) {
        bool has_next; const char* nA; const char* nB; int nnt;
        { Unit nx; has_next = S.next(ui + 1, nx); nA = has_next ? nx.a : cA; nB = has_next ? nx.b : cB; nnt = has_next ? nx.kt : nt; }
        for (int t = 0; t < nt; t += 2) {
            const bool last = (t == nt - 2);
            const char* a1 = cA + (size_t)(t + 1) * kstep;
            const char* a2 = last ? nA : cA + (size_t)(t + 2) * kstep; const char* b2 = last ? nB : cB + (size_t)(t + 2) * kstep;
            const char* a3 = a2 + kstep; const char* b3 = b2 + kstep;
            PG8_LDB(B0, 0, 0); PG8_LDB(B1, 0, 1); PG8_SCHED; PG8_LDA(At, 0, 0); PG8_STAGE(PG8_SA(1, 1), a1 + hstepA, voffA);
            PG8_WAIT_V(8); PG8_WAIT_L(0); PG8_BAR; PG8_MMA(0, 0, At, B0); PG8_MMA(0, 1, At, B1); PG8_BAR; PG8_SCHED;
            PG8_LDA(At, 0, 1); PG8_STAGE(PG8_SB(0, 0), b2, voffB); PG8_STAGE(PG8_SB(0, 1), b2 + hstepB, voffB); PG8_STAGE(PG8_SA(0, 0), a2, voffA);
            PG8_WAIT_V(8); PG8_WAIT_L(0); PG8_BAR; PG8_MMA(1, 0, At, B0); PG8_MMA(1, 1, At, B1); PG8_BAR; PG8_SCHED;
            PG8_LDB(B0, 1, 0); PG8_LDB(B1, 1, 1); PG8_SCHED; PG8_LDA(At, 1, 0); PG8_STAGE(PG8_SA(0, 1), a2 + hstepA, voffA);
            PG8_WAIT_V(8); PG8_WAIT_L(0); PG8_BAR; PG8_MMA(0, 0, At, B0); PG8_MMA(0, 1, At, B1); PG8_BAR; PG8_SCHED;
            PG8_LDA(At, 1, 1); PG8_STAGE(PG8_SB(1, 0), b3, voffB); PG8_STAGE(PG8_SB(1, 1), b3 + hstepB, voffB); PG8_STAGE(PG8_SA(1, 0), a3, voffA);
            PG8_WAIT_V(8); PG8_WAIT_L(0); PG8_BAR; PG8_MMA(1, 0, At, B0); PG8_MMA(1, 1, At, B1); PG8_BAR; PG8_SCHED;
        }
        if constexpr (ALIGN_EPI) { if (wr == 0) PG8_BAR; }
        { Unit cu; (void)S.next(ui, cu); const int t2 = tid_of(wv);
          const int w2 = __builtin_amdgcn_readfirstlane(t2 >> 6); E(acc, cu, w2 >> 2, w2 & 3, t2 & 15, (t2 & 63) >> 4); }
        if (!has_next) break;
#pragma unroll
        for (int a = 0; a < 2; ++a)
#pragma unroll
            for (int b = 0; b < 2; ++b)
#pragma unroll
                for (int m = 0; m < 4; ++m)
#pragma unroll
                    for (int n = 0; n < 2; ++n) acc[a][b][m][n] = (f32x4){0.f, 0.f, 0.f, 0.f};
        cA = nA; cB = nB; nt = nnt; ++ui;
        if constexpr (ALIGN_EPI) { if (wr == 1) PG8_BAR; }
    }
    PG8_WAIT_V(0);
    if constexpr (!ALIGN_EPI) { if (wr == 0) PG8_BAR; }
    PG8_BAR;
#undef PG8_SA
#undef PG8_SB
#undef PG8_STAGE
#undef PG8_LDA
#undef PG8_LDB
#undef PG8_MMA
#undef PG8_WAIT_V
#undef PG8_WAIT_L
#undef PG8_BAR
#undef PG8_SCHED
}

struct EpiProj {
    static constexpr bool PERM = true;
    bf16* proj; bf16* a2;
    __device__ __forceinline__ void operator()(const f32x4 (&acc)[2][2][4][2], const Unit& u, int wr, int wc, int fr, int fq) const {
        const int pn = u.pn; const bool gate = (pn >= 12 && pn < 20) || (pn >= 24 && pn < 28) || (pn >= 32); const bool isu = (pn >= 20 && pn < 24);
        const int row0 = u.pm * BM + wr * 64 + fr, col0 = pn * BM + wc * 32 + 8 * fq;
#pragma unroll
        for (int ai = 0; ai < 2; ++ai)
#pragma unroll
            for (int m = 0; m < 4; ++m) { const int row = row0 + ai * HALF + m * 16;
#pragma unroll
                for (int bj = 0; bj < 2; ++bj) { f32x4 v0 = acc[ai][bj][m][0], v1 = acc[ai][bj][m][1];
                    if (gate) {
#pragma unroll
                        for (int j = 0; j < 4; ++j) { v0[j] = silu_f(v0[j]); v1[j] = silu_f(v1[j]); } }
                    v4u w; w.x = cvt_pk_bf16(v0[0], v0[1]); w.y = cvt_pk_bf16(v0[2], v0[3]); w.z = cvt_pk_bf16(v1[0], v1[1]); w.w = cvt_pk_bf16(v1[2], v1[3]);
                    const int col = col0 + bj * HALF;
                    bf16* dst;
                    if (isu) { const int g = (col - OFF_U) >> 4, c0 = col & 15; dst = a2 + ((size_t)(g * 1024 + (row >> 4)) * 512 + (row & 15) * 16 + c0); }
                    else dst = proj + (size_t)row * INW + col;
                    *(v4u*)dst = w; } }
    }
};
struct EpiBf16 {
    static constexpr bool PERM = true;
    float scale;
    __device__ __forceinline__ void operator()(const f32x4 (&acc)[2][2][4][2], const Unit& u, int wr, int wc, int fr, int fq) const {
        bf16* base = (bf16*)u.c; const int ldc = u.ldc; const int row0 = wr * 64 + fr, col0 = wc * 32 + 8 * fq;
#pragma unroll
        for (int ai = 0; ai < 2; ++ai)
#pragma unroll
            for (int m = 0; m < 4; ++m) { bf16* rowp = base + (size_t)(row0 + ai * HALF + m * 16) * ldc + col0;
#pragma unroll
                for (int bj = 0; bj < 2; ++bj) { const f32x4 v0 = acc[ai][bj][m][0] * scale, v1 = acc[ai][bj][m][1] * scale;
                    v4u w; w.x = cvt_pk_bf16(v0[0], v0[1]); w.y = cvt_pk_bf16(v0[2], v0[3]); w.z = cvt_pk_bf16(v1[0], v1[1]); w.w = cvt_pk_bf16(v1[2], v1[3]);
                    *(v4u*)(rowp + bj * HALF) = w; } }
    }
};
struct EpiBf16X {
    static constexpr bool PERM = true;
    float scale; int aoff, boff;
    __device__ __forceinline__ void operator()(const f32x4 (&acc)[2][2][4][2], const Unit& u, int wr, int wc, int fr, int fq) const {
        bf16* base = (bf16*)u.c; const int ldc = u.ldc; const int row0 = wr * 64 + fr, col0 = wc * 32 + 8 * fq;
#pragma unroll
        for (int ai = 0; ai < 2; ++ai)
#pragma unroll
            for (int m = 0; m < 4; ++m) { bf16* rowp = base + (ai * aoff + (row0 + m * 16) * ldc + col0);
#pragma unroll
                for (int bj = 0; bj < 2; ++bj) { const f32x4 v0 = acc[ai][bj][m][0] * scale, v1 = acc[ai][bj][m][1] * scale;
                    v4u w; w.x = cvt_pk_bf16(v0[0], v0[1]); w.y = cvt_pk_bf16(v0[2], v0[3]); w.z = cvt_pk_bf16(v1[0], v1[1]); w.w = cvt_pk_bf16(v1[2], v1[3]);
                    *(v4u*)(rowp + bj * boff) = w; } }
    }
};
struct EpiF32 {
    static constexpr bool PERM = false;
    __device__ __forceinline__ void operator()(const f32x4 (&acc)[2][2][4][2], const Unit& u, int wr, int wc, int fr, int fq) const {
        float* base = (float*)u.c; const int ldc = u.ldc; const int row0 = wr * 64 + fr, col0 = wc * 32 + 4 * fq;
#pragma unroll
        for (int ai = 0; ai < 2; ++ai)
#pragma unroll
            for (int m = 0; m < 4; ++m) { float* rowp = base + (size_t)(row0 + ai * HALF + m * 16) * ldc + col0;
#pragma unroll
                for (int bj = 0; bj < 2; ++bj)
#pragma unroll
                    for (int n = 0; n < 2; ++n) *(f32x4*)(rowp + bj * HALF + n * 16) = acc[ai][bj][m][n]; }
    }
};
struct EpiSsmY {
    static constexpr bool PERM = true;
    bf16* yssm;
    __device__ __forceinline__ void operator()(const f32x4 (&acc)[2][2][4][2], const Unit& u, int wr, int wc, int fr, int fq) const {
        const int row0 = u.z + wr * 64 + fr, col0 = wc * 32 + 8 * fq, g = u.pn;
#pragma unroll
        for (int ai = 0; ai < 2; ++ai)
#pragma unroll
            for (int m = 0; m < 4; ++m) { const int chunk = row0 + ai * HALF + m * 16;
#pragma unroll
                for (int bj = 0; bj < 2; ++bj) { const f32x4 v0 = acc[ai][bj][m][0], v1 = acc[ai][bj][m][1];
                    v4u w; w.x = cvt_pk_bf16(v0[0], v0[1]); w.y = cvt_pk_bf16(v0[2], v0[3]); w.z = cvt_pk_bf16(v1[0], v1[1]); w.w = cvt_pk_bf16(v1[2], v1[3]);
                    const int col = col0 + bj * HALF, i = col >> 4, c0 = col & 15;
                    *(v4u*)(yssm + (size_t)(chunk * 16 + i) * 1024 + g * 16 + c0) = w; } }
    }
};
struct EpiGlu {
    static constexpr bool PERM = true;
    const bf16* proj; bf16* mix;
    __device__ __forceinline__ void operator()(const f32x4 (&acc)[2][2][4][2], const Unit& u, int wr, int wc, int fr, int fq) const {
        const int row0 = u.pm * BM + wr * 64 + fr, col0 = u.pn * HALF + wc * 32 + 8 * fq;
#pragma unroll
        for (int ai = 0; ai < 2; ++ai)
#pragma unroll
            for (int m = 0; m < 4; ++m) { const int row = row0 + ai * HALF + m * 16;
                const v4u gs = *(const v4u*)(proj + (size_t)row * INW + OFF_GS + col0);
                const f32x4 a0 = acc[ai][0][m][0], a1 = acc[ai][0][m][1], g0 = acc[ai][1][m][0], g1 = acc[ai][1][m][1];
                float o[8];
#pragma unroll
                for (int j = 0; j < 4; ++j) { o[j] = a0[j] * sigmoid_f(g0[j]); o[4 + j] = a1[j] * sigmoid_f(g1[j]); }
                o[0] *= bf_lo(gs.x); o[1] *= bf_hi(gs.x); o[2] *= bf_lo(gs.y); o[3] *= bf_hi(gs.y); o[4] *= bf_lo(gs.z); o[5] *= bf_hi(gs.z); o[6] *= bf_lo(gs.w); o[7] *= bf_hi(gs.w);
                v4u w; w.x = cvt_pk_bf16(o[0], o[1]); w.y = cvt_pk_bf16(o[2], o[3]); w.z = cvt_pk_bf16(o[4], o[5]); w.w = cvt_pk_bf16(o[6], o[7]);
                *(v4u*)(mix + (size_t)row * DM + 2048 + col0) = w; }
    }
};
struct EpiFftW {
    static constexpr bool PERM = true;
    const bf16* proj; bf16* mix;
    __device__ __forceinline__ void operator()(const f32x4 (&acc)[2][2][4][2], const Unit& u, int wr, int wc, int fr, int fq) const {
        const int row0 = u.pm * BM + wr * 64 + fr, col0 = u.pn * BM + wc * 32 + 8 * fq;
#pragma unroll
        for (int ai = 0; ai < 2; ++ai)
#pragma unroll
            for (int m = 0; m < 4; ++m) { const int row = row0 + ai * HALF + m * 16;
#pragma unroll
                for (int bj = 0; bj < 2; ++bj) { const int col = col0 + bj * HALF;
                    const v4u gs = *(const v4u*)(proj + (size_t)row * INW + OFF_GF + col);
                    const f32x4 v0 = acc[ai][bj][m][0], v1 = acc[ai][bj][m][1];
                    v4u w; w.x = cvt_pk_bf16(v0[0] * bf_lo(gs.x), v0[1] * bf_hi(gs.x)); w.y = cvt_pk_bf16(v0[2] * bf_lo(gs.y), v0[3] * bf_hi(gs.y));
                    w.z = cvt_pk_bf16(v1[0] * bf_lo(gs.z), v1[1] * bf_hi(gs.z)); w.w = cvt_pk_bf16(v1[2] * bf_lo(gs.w), v1[3] * bf_hi(gs.w));
                    *(v4u*)(mix + (size_t)row * DM + 3072 + col) = w; } }
    }
};
struct EpiOut {
    static constexpr bool PERM = true;
    bf16* delta; const float* modl;
    __device__ __forceinline__ void operator()(const f32x4 (&acc)[2][2][4][2], const Unit& u, int wr, int wc, int fr, int fq) const {
        const int rt = u.pm * BM; const int v = rt < NCTX ? 0 : (rt < NCTX + 4096 ? 1 : 2);
        const float* gv = modl + v * 12288 + 8192;
        const int row0 = rt + wr * 64 + fr, col0 = u.pn * BM + wc * 32 + 8 * fq;
        f32x4 gt[2][2];
#pragma unroll
        for (int bj = 0; bj < 2; ++bj)
#pragma unroll
            for (int n = 0; n < 2; ++n) gt[bj][n] = *(const f32x4*)(gv + col0 + bj * HALF + n * 4);
#pragma unroll
        for (int ai = 0; ai < 2; ++ai)
#pragma unroll
            for (int m = 0; m < 4; ++m) { bf16* rowp = delta + (size_t)(row0 + ai * HALF + m * 16) * DM + col0;
#pragma unroll
                for (int bj = 0; bj < 2; ++bj) { const f32x4 v0 = acc[ai][bj][m][0] * gt[bj][0], v1 = acc[ai][bj][m][1] * gt[bj][1];
                    v4u w; w.x = cvt_pk_bf16(v0[0], v0[1]); w.y = cvt_pk_bf16(v0[2], v0[3]); w.z = cvt_pk_bf16(v1[0], v1[1]); w.w = cvt_pk_bf16(v1[2], v1[3]);
                    *(v4u*)(rowp + bj * HALF) = w; } }
    }
};
}

namespace att {
constexpr int D = 128, QBLK = 32, KVBLK = 64;
constexpr float SCALE = 0.088388347648318440f;
constexpr float THR = 8.f;
constexpr int SHM_V = KVBLK * D * 2, SHM_K = KVBLK * D * 2;
constexpr int WS_OFF = 2 * SHM_V + 2 * SHM_K, OSTG_OFF = WS_OFF + NWAVES * 64 * 4, OSTG_ROW = 272, OSTG_WAVE = 32 * OSTG_ROW;
static_assert(DEPTH >= 2, "the bf16 stream is first written by layer 1's norm phase");
static_assert(OSTG_OFF + NWAVES * OSTG_WAVE <= MISC_OFF, "attention LDS");
#define KSWZ(row, colB) ((row) * 256 + ((colB) ^ (((row) & 7) << 4)))
#define SBAR() __builtin_amdgcn_sched_barrier(0)
__device__ __forceinline__ int crow(int r, int hi) { return (r & 3) + 8 * (r >> 2) + 4 * hi; }
__device__ __forceinline__ void partialSM(f32x16& p0, f32x16& p1, float& m_reg, float& mn, float& alpha) {
  constexpr float C = SCALE * 1.4426950408889634f;
  float pmax = p0[0]; for (int r = 1; r < 16; ++r) pmax = fmaxf(pmax, p0[r]); for (int r = 0; r < 16; ++r) pmax = fmaxf(pmax, p1[r]);
  { auto rr = __builtin_amdgcn_permlane32_swap(__float_as_uint(pmax), __float_as_uint(pmax), false, false);
    pmax = fmaxf(__uint_as_float(rr[0]), __uint_as_float(rr[1])); }
  if (__builtin_expect(__all(pmax - m_reg <= THR / SCALE), 1)) { mn = m_reg; alpha = 1.f; }
  else { mn = fmaxf(m_reg, pmax); alpha = __builtin_amdgcn_exp2f((m_reg - mn) * C); m_reg = mn; }
  float mnC = -mn * C;
  for (int r = 0; r < 16; ++r) p0[r] = fmaf(p0[r], C, mnC); for (int r = 0; r < 16; ++r) p1[r] = fmaf(p1[r], C, mnC);
  for (int r = 0; r < 16; ++r) p0[r] = __builtin_amdgcn_exp2f(p0[r]);
}
__device__ __forceinline__ void finishSM(f32x16& p0, f32x16& p1, float alpha, float& l_reg, bf16x8& pa0, bf16x8& pa1, bf16x8& pa2, bf16x8& pa3) {
  for (int r = 0; r < 16; ++r) p1[r] = __builtin_amdgcn_exp2f(p1[r]);
  float ps = 0; for (int r = 0; r < 16; ++r) ps += p0[r]; for (int r = 0; r < 16; ++r) ps += p1[r];
  { auto rr = __builtin_amdgcn_permlane32_swap(__float_as_uint(ps), __float_as_uint(ps), false, false);
    ps = __uint_as_float(rr[0]) + __uint_as_float(rr[1]); }
  l_reg = l_reg * alpha + ps;
#define PK4(P, BASE, OUT) do { unsigned a0 = cvt_pk_bf16(P[BASE + 0], P[BASE + 1]), a1 = cvt_pk_bf16(P[BASE + 2], P[BASE + 3]);   \
    unsigned b0 = cvt_pk_bf16(P[BASE + 4], P[BASE + 5]), b1 = cvt_pk_bf16(P[BASE + 6], P[BASE + 7]);                              \
    auto r0 = __builtin_amdgcn_permlane32_swap(a0, b0, false, false); auto r1 = __builtin_amdgcn_permlane32_swap(a1, b1, false, false); \
    v4u w = {r0[0], r1[0], r0[1], r1[1]}; OUT = *reinterpret_cast<bf16x8*>(&w); } while (0)
  PK4(p0, 0, pa0); PK4(p0, 8, pa1); PK4(p1, 0, pa2); PK4(p1, 8, pa3);
#undef PK4
}
__device__ __forceinline__ void qkt(f32x16& p0, f32x16& p1, const char* Ks, const bf16x8* qr, int r32, int hi) {
  p0 = f32x16{}; p1 = f32x16{};
  for (int d0 = 0; d0 < 8; ++d0) { int cb = (d0 * 16 + hi * 8) * 2;
    bf16x8 b0 = *reinterpret_cast<const bf16x8*>(Ks + KSWZ(r32, cb));
    bf16x8 b1 = *reinterpret_cast<const bf16x8*>(Ks + KSWZ(32 + r32, cb));
    p0 = __builtin_amdgcn_mfma_f32_32x32x16_bf16(b0, qr[d0], p0, 0, 0, 0);
    p1 = __builtin_amdgcn_mfma_f32_32x32x16_bf16(b1, qr[d0], p1, 0, 0, 0); }
}
__device__ __forceinline__ int v_st(int k, int c) { const int kk = (k & ~0xC) | ((k & 4) << 1) | ((k & 8) >> 1); return ((kk >> 3) * 4 + (c >> 5)) * 512 + ((kk & 7) * 32 + (c & 31)) * 2; }
__device__ __forceinline__ int v_rd_base(int lane) { return ((lane & 3) << 3) | (((lane >> 2) & 3) << 6) | (((lane >> 4) & 1) << 5) | (((lane >> 5) & 1) << 8); }
constexpr int v_rd_off(int d0, int ks, int half) { return d0 * 512 + ks * 4096 + half * 2048; }
template <int OFF> __device__ __forceinline__ s16x4 tr_read(int vb) {
  s16x4 r; asm volatile("ds_read_b64_tr_b16 %0, %1 offset:%2" : "=&v"(r) : "v"(vb), "i"(OFF) : "memory"); return r;
}
template <int D0> __device__ __forceinline__ void pv_one(f32x16& od, int vb, bf16x8 pa0, bf16x8 pa1, bf16x8 pa2, bf16x8 pa3) {
  const s16x4 l0 = tr_read<v_rd_off(D0, 0, 0)>(vb), h0 = tr_read<v_rd_off(D0, 0, 1)>(vb), l1 = tr_read<v_rd_off(D0, 1, 0)>(vb), h1 = tr_read<v_rd_off(D0, 1, 1)>(vb);
  const s16x4 l2 = tr_read<v_rd_off(D0, 2, 0)>(vb), h2 = tr_read<v_rd_off(D0, 2, 1)>(vb), l3 = tr_read<v_rd_off(D0, 3, 0)>(vb), h3 = tr_read<v_rd_off(D0, 3, 1)>(vb);
  asm volatile("s_waitcnt lgkmcnt(0)" ::: "memory"); SBAR();
#define PK(L, H) (bf16x8){L[0], L[1], L[2], L[3], H[0], H[1], H[2], H[3]}
  od = __builtin_amdgcn_mfma_f32_32x32x16_bf16(pa0, PK(l0, h0), od, 0, 0, 0);
  od = __builtin_amdgcn_mfma_f32_32x32x16_bf16(pa1, PK(l1, h1), od, 0, 0, 0);
  od = __builtin_amdgcn_mfma_f32_32x32x16_bf16(pa2, PK(l2, h2), od, 0, 0, 0);
  od = __builtin_amdgcn_mfma_f32_32x32x16_bf16(pa3, PK(l3, h3), od, 0, 0, 0);
#undef PK
}
__device__ __forceinline__ void pv_d0(f32x16* o, int vb, bf16x8 pa0, bf16x8 pa1, bf16x8 pa2, bf16x8 pa3) {
  pv_one<0>(o[0], vb, pa0, pa1, pa2, pa3); pv_one<1>(o[1], vb, pa0, pa1, pa2, pa3); pv_one<2>(o[2], vb, pa0, pa1, pa2, pa3); pv_one<3>(o[3], vb, pa0, pa1, pa2, pa3);
}

__device__ __forceinline__ void attn_unit(const bf16* __restrict__ Qb, const bf16* __restrict__ Gb, bf16* __restrict__ Ob,
                                          const bf16* __restrict__ K0, const bf16* __restrict__ V0, int ld0, int nt0,
                                          const bf16* __restrict__ K1, const bf16* __restrict__ V1, int ld1, int nt1,
                                          const float* __restrict__ qn, const f32x2* __restrict__ rope, int tok0, char* lds, int wv) {
  const int tid = tid_of(wv);
  const int wid = tid >> 6, lane = tid & 63, r32 = lane & 31, hi = lane >> 5;
  char* V_lds = lds; char* K_lds = lds + 2 * SHM_V;
  float* ws = (float*)(lds + WS_OFF) + wid * 64; float* li_l = ws; float* al_l = ws + 32;
  float m_reg = -1e30f, l_reg = 0; f32x16 o[4] = {}; bf16x8 qr[8];
  const int sr = tid >> 4, sc = (tid & 15) * 8, vst0 = v_st(sr, sc), vst1 = v_st(32 + sr, sc);
  const int vb0 = (int)(uintptr_t)V_lds + v_rd_base(lane);
  struct { bf16x8 vs0, vs1, ks0, ks1; } sr_[2];
#define SLOAD(i, jt) do { const bf16* kb_; const bf16* vb_; long ld_; \
    if ((jt) < nt0) { kb_ = K0 + (long)(jt) * KVBLK * ld0; vb_ = V0 + (long)(jt) * KVBLK * ld0; ld_ = ld0; } else { kb_ = K1 + (long)((jt) - nt0) * KVBLK * ld1; vb_ = V1 + (long)((jt) - nt0) * KVBLK * ld1; ld_ = ld1; } \
    sr_[i].vs0 = *reinterpret_cast<const bf16x8*>(vb_ + (long)sr * ld_ + sc); sr_[i].vs1 = *reinterpret_cast<const bf16x8*>(vb_ + (long)(32 + sr) * ld_ + sc); \
    sr_[i].ks0 = *reinterpret_cast<const bf16x8*>(kb_ + (long)sr * ld_ + sc); sr_[i].ks1 = *reinterpret_cast<const bf16x8*>(kb_ + (long)(32 + sr) * ld_ + sc); } while (0)
  SLOAD(0, 0);
  __syncthreads();
  {
    const bf16* Qw = Qb + (long)(wid * QBLK + r32) * INW + hi * 8;
    float x[8][8]; float ss = 0.f;
#pragma unroll
    for (int d0 = 0; d0 < 8; ++d0) { const v4u raw = *reinterpret_cast<const v4u*>(Qw + d0 * 16);
      x[d0][0] = bf_lo(raw.x); x[d0][1] = bf_hi(raw.x); x[d0][2] = bf_lo(raw.y); x[d0][3] = bf_hi(raw.y); x[d0][4] = bf_lo(raw.z); x[d0][5] = bf_hi(raw.z); x[d0][6] = bf_lo(raw.w); x[d0][7] = bf_hi(raw.w);
#pragma unroll
      for (int j = 0; j < 8; ++j) ss += x[d0][j] * x[d0][j]; }
    { auto rr = __builtin_amdgcn_permlane32_swap(__float_as_uint(ss), __float_as_uint(ss), false, false); ss = __uint_as_float(rr[0]) + __uint_as_float(rr[1]); }
    const float rstd = rsqrtf(ss * (1.0f / 128.0f) + NORM_EPS);
#pragma unroll
    for (int d0 = 0; d0 < 8; ++d0) { const f32x4 w0 = *reinterpret_cast<const f32x4*>(qn + d0 * 16 + hi * 8), w1 = *reinterpret_cast<const f32x4*>(qn + d0 * 16 + hi * 8 + 4);
#pragma unroll
      for (int j = 0; j < 4; ++j) { x[d0][j] *= rstd * w0[j]; x[d0][4 + j] *= rstd * w1[j]; } }
    if (rope) {
      const int t = tok0 + wid * QBLK + r32, prow = t >> 6, pcol = t & 63;
#pragma unroll
      for (int half = 0; half < 2; ++half) { const f32x2* rp = rope + (half ? pcol : prow) * 32;
#pragma unroll
        for (int dd = 0; dd < 2; ++dd) { const int d0 = half * 4 + dd;
#pragma unroll
          for (int j = 0; j < 8; ++j) { const f32x2 cs = rp[dd * 16 + hi * 8 + j]; const float x1 = x[d0][j], x2 = x[d0 + 2][j];
            x[d0][j] = x1 * cs.x - x2 * cs.y; x[d0 + 2][j] = x1 * cs.y + x2 * cs.x; } } }
    }
#pragma unroll
    for (int d0 = 0; d0 < 8; ++d0) { v4u w = {cvt_pk_bf16(x[d0][0], x[d0][1]), cvt_pk_bf16(x[d0][2], x[d0][3]), cvt_pk_bf16(x[d0][4], x[d0][5]), cvt_pk_bf16(x[d0][6], x[d0][7])}; qr[d0] = *reinterpret_cast<bf16x8*>(&w); }
  }
#define SWRITE(b, i) do { *(bf16x8*)(V_lds + (b) * SHM_V + vst0) = sr_[i].vs0;          \
    *(bf16x8*)(V_lds + (b) * SHM_V + vst1) = sr_[i].vs1; int kc = sc * 2;               \
    *(bf16x8*)(K_lds + (b) * SHM_K + KSWZ(sr, kc)) = sr_[i].ks0;                       \
    *(bf16x8*)(K_lds + (b) * SHM_K + KSWZ(32 + sr, kc)) = sr_[i].ks1; } while (0)
#define SWAIT() asm volatile("s_waitcnt vmcnt(4)" ::: "memory")
#define RESC(a) do { if (__any((a) < 1.f)) { if (hi == 0) al_l[r32] = (a); asm volatile("s_waitcnt lgkmcnt(0)" ::: "memory"); \
    for (int d = 0; d < 4; ++d) for (int r = 0; r < 16; ++r) o[d][r] *= al_l[crow(r, hi)]; } } while (0)
  f32x16 pA0, pA1, pB0, pB1; float mnA, mnB, alA, alB; bf16x8 pa0, pa1, pa2, pa3; const int NT = nt0 + nt1;
  constexpr int SE = 0, SO = 1;
  asm volatile("s_waitcnt vmcnt(0)" ::: "memory"); SWRITE(0, SE); __syncthreads();
  qkt(pA0, pA1, K_lds, qr, r32, hi); partialSM(pA0, pA1, m_reg, mnA, alA);
  SLOAD(SO, 1); if (2 < NT) SLOAD(SE, 2);
  SWAIT(); SWRITE(1, SO); __syncthreads();
  for (int j = 1; j + 1 < NT; j += 2) {
    SBAR(); qkt(pB0, pB1, K_lds + SHM_K, qr, r32, hi);
    finishSM(pA0, pA1, alA, l_reg, pa0, pa1, pa2, pa3); SBAR();
    SLOAD(SO, j + 2); SBAR();
    pv_d0(o, vb0, pa0, pa1, pa2, pa3); partialSM(pB0, pB1, m_reg, mnB, alB);
    __syncthreads(); SWAIT(); SWRITE(0, SE);
    RESC(alB); __syncthreads();
    SBAR(); qkt(pA0, pA1, K_lds, qr, r32, hi);
    finishSM(pB0, pB1, alB, l_reg, pa0, pa1, pa2, pa3); SBAR();
    if (j + 3 < NT) SLOAD(SE, j + 3); SBAR();
    pv_d0(o, vb0 + SHM_V, pa0, pa1, pa2, pa3); partialSM(pA0, pA1, m_reg, mnA, alA);
    __syncthreads(); SWAIT(); SWRITE(1, SO);
    RESC(alA); __syncthreads();
  }
  SBAR(); qkt(pB0, pB1, K_lds + SHM_K, qr, r32, hi);
  finishSM(pA0, pA1, alA, l_reg, pa0, pa1, pa2, pa3); SBAR();
  pv_d0(o, vb0, pa0, pa1, pa2, pa3); partialSM(pB0, pB1, m_reg, mnB, alB);
  __syncthreads(); RESC(alB);
  finishSM(pB0, pB1, alB, l_reg, pa0, pa1, pa2, pa3); SBAR();
  pv_d0(o, vb0 + SHM_V, pa0, pa1, pa2, pa3);
  if (hi == 0) li_l[r32] = l_reg; asm volatile("s_waitcnt lgkmcnt(0)" ::: "memory");
  char* stg = lds + OSTG_OFF + wid * OSTG_WAVE;
  v4u gvv[8];
#pragma unroll
  for (int it = 0; it < 8; ++it) gvv[it] = *reinterpret_cast<const v4u*>(Gb + (long)(wid * QBLK + it * 4 + (lane >> 4)) * INW + (lane & 15) * 8);
#pragma unroll
  for (int r = 0; r < 16; ++r) { const int orow = crow(r, hi); const float rl = __builtin_amdgcn_rcpf(li_l[orow]);
#pragma unroll
    for (int d0 = 0; d0 < 4; ++d0) { const unsigned w = cvt_pk_bf16(o[d0][r] * rl, 0.f); *(bf16*)(stg + orow * OSTG_ROW + (d0 * 32 + r32) * 2) = (bf16)(w & 0xffffu); }
    if ((r & 3) == 3) asm volatile("" ::: "memory"); }
  asm volatile("s_waitcnt lgkmcnt(0)" ::: "memory");
#pragma unroll
  for (int it = 0; it < 8; ++it) { const int row = it * 4 + (lane >> 4), cc = (lane & 15) * 8;
    const v4u ov = *(const v4u*)(stg + row * OSTG_ROW + cc * 2);
    const v4u gv = gvv[it];
    v4u w; w.x = cvt_pk_bf16(bf_lo(ov.x) * bf_lo(gv.x), bf_hi(ov.x) * bf_hi(gv.x)); w.y = cvt_pk_bf16(bf_lo(ov.y) * bf_lo(gv.y), bf_hi(ov.y) * bf_hi(gv.y));
    w.z = cvt_pk_bf16(bf_lo(ov.z) * bf_lo(gv.z), bf_hi(ov.z) * bf_hi(gv.z)); w.w = cvt_pk_bf16(bf_lo(ov.w) * bf_lo(gv.w), bf_hi(ov.w) * bf_hi(gv.w));
    *reinterpret_cast<v4u*>(Ob + (long)(wid * QBLK + row) * DM + cc) = w; }
#undef SLOAD
#undef SWRITE
#undef SWAIT
#undef RESC
}
}

#define XB_TMO      128
#define XB_XCNT(j)  (256  + 64 * (j))
#define XB_XSUB(j)  (1280 + 64 * (j))
#define XB_XGEN(j)  (2304 + 64 * (j))
#define XB_TOP      3328
#define XB_TOPGEN   3392
#define XCD_BAR_WORDS 3456
#define XB_SPIN_CAP (1u << 18)
__device__ __forceinline__ unsigned xb_ld(unsigned* p)              { return __hip_atomic_load(p, __ATOMIC_RELAXED, __HIP_MEMORY_SCOPE_AGENT); }
__device__ __forceinline__ unsigned xb_add(unsigned* p, unsigned v) { return __hip_atomic_fetch_add(p, v, __ATOMIC_RELAXED, __HIP_MEMORY_SCOPE_AGENT); }
__device__ __forceinline__ unsigned xb_xcc_id() { return (unsigned)__builtin_amdgcn_s_getreg((3 << 11) | 20) & 0xFu; }
#define XB_SPIN(cond, bar) do { unsigned _sp = 0; while (cond) { __builtin_amdgcn_s_sleep(1); \
    if ((++_sp & 255u) == 0u) { if (xb_ld(&(bar)[XB_TMO])) break; if (_sp > XB_SPIN_CAP) { atomicAdd(&(bar)[XB_TMO], 1u); break; } } } } while (0)
struct XcdBarrier { unsigned* bar; unsigned x; volatile LAS unsigned* st; };
__device__ __forceinline__ XcdBarrier xcd_barrier_post(unsigned* bar, volatile LAS unsigned* st, int tid) {
    XcdBarrier b; b.bar = bar; b.x = xb_xcc_id(); b.st = st;
    if (tid == 0) (void)xb_add(&bar[XB_XCNT(b.x)], 1u);
    return b;
}
__device__ __forceinline__ void xcd_barrier_complete(unsigned* bar, unsigned x, unsigned& nloc, unsigned& nx) {
    const unsigned G = gridDim.x * gridDim.y * gridDim.z;
    unsigned sum, cnt, mine, sp = 0u;
    for (;;) {
        sum = 0u; cnt = 0u; mine = 0u;
#pragma nounroll
        for (unsigned j = 0; j < 16; ++j) { const unsigned c = xb_ld(&bar[XB_XCNT(j)]); sum += c; cnt += (c > 0u) ? 1u : 0u; mine = (j == x) ? c : mine; }
        if (sum == G) break;
        __builtin_amdgcn_s_sleep(1);
        if ((++sp & 255u) == 0u) { if (xb_ld(&bar[XB_TMO])) break; if (sp > XB_SPIN_CAP) { atomicAdd(&bar[XB_TMO], 1u); break; } }
    }
    nloc = mine > 0u ? mine : 1u; nx = cnt > 0u ? cnt : 1u;
}
__device__ __forceinline__ void xcd_barrier(const XcdBarrier& b, int wv) {
    asm volatile("s_waitcnt vmcnt(0)" ::: "memory");
    __syncthreads();
    if (tid_of(wv) == 0) {
        unsigned* bar = b.bar;
        __builtin_amdgcn_s_waitcnt(0);
        unsigned nloc = b.st[0], nx = b.st[1];
        if (nloc == 0u) { xcd_barrier_complete(bar, b.x, nloc, nx); b.st[0] = nloc; b.st[1] = nx; }
        const unsigned old = xb_add(&bar[XB_XSUB(b.x)], 1u);
        const unsigned gen = old / nloc;
        if (old + 1u == (gen + 1u) * nloc) {
            __builtin_amdgcn_fence(__ATOMIC_RELEASE, "agent");
            asm volatile("s_waitcnt vmcnt(0)" ::: "memory");
            const unsigned og = xb_add(&bar[XB_TOP], 1u);
            const unsigned tg = og / nx;
            if (og + 1u == (tg + 1u) * nx) xb_add(&bar[XB_TOPGEN], 1u);
            else XB_SPIN(xb_ld(&bar[XB_TOPGEN]) == tg, bar);
            __builtin_amdgcn_fence(__ATOMIC_ACQUIRE, "agent");
            xb_add(&bar[XB_XGEN(b.x)], 1u);
            asm volatile("s_waitcnt vmcnt(0)" ::: "memory");
        } else {
            XB_SPIN(xb_ld(&bar[XB_XGEN(b.x)]) == gen, bar);
            __builtin_amdgcn_fence(__ATOMIC_ACQUIRE, "agent");
            asm volatile("s_waitcnt vmcnt(0)" ::: "memory");
        }
    }
    __syncthreads();
}
__device__ __forceinline__ void wg_global_sync() {
    asm volatile("s_waitcnt vmcnt(0)" ::: "memory");
    __syncthreads();
    __builtin_amdgcn_fence(__ATOMIC_ACQUIRE, "agent");
    asm volatile("s_waitcnt vmcnt(0)" ::: "memory");
}

struct Args { const float* in[28]; float* out; unsigned char* ws; int ph_lo, ph_hi; };
typedef const __attribute__((address_space(4))) Args* KAP;
#define KA_HERE() KAP ka = (KAP)__builtin_amdgcn_kernarg_segment_ptr(); asm volatile("" : "+s"(ka))
enum { I_XP = 0, I_XS, I_CK, I_CV, I_SFR, I_SFI, I_SBR, I_SBI, I_C, I_CCTX, I_NG, I_WMOD, I_BMOD, I_WIN, I_QN, I_KN, I_LRE, I_LIM, I_LSTEP, I_BRE, I_BIM, I_CRE, I_CIM, I_DSKIP, I_WGLU, I_WFFT, I_WOUT, I_FNG };

__device__ __forceinline__ int glu_row(int n) { return n < 1024 ? ((n >> 7) * 256 + (n & 127)) : (((n - 1024) >> 7) * 256 + 128 + ((n - 1024) & 127)); }
template <bool GLU>
__device__ __forceinline__ void tr_item(const float* __restrict__ W, int K, int N, bf16* __restrict__ WT, LAS float* scr, int item, int lane) {
    const int nblk = N / 64, kb = item / nblk, nb = item % nblk, k0 = 64 * kb, n0 = 64 * nb;
#pragma unroll 8
    for (int i = 0; i < 64; ++i) scr[i * 65 + lane] = W[(size_t)(k0 + i) * N + n0 + lane];
    LDS_WAIT(); asm volatile("" ::: "memory");
    const int c = lane & 7;
#pragma unroll
    for (int j = 0; j < 8; ++j) { const int n = (lane >> 3) + 8 * j; const LAS float* s = scr + (8 * c) * 65 + n;
        v4u o; o.x = cvt_pk_bf16(s[0 * 65], s[1 * 65]); o.y = cvt_pk_bf16(s[2 * 65], s[3 * 65]); o.z = cvt_pk_bf16(s[4 * 65], s[5 * 65]); o.w = cvt_pk_bf16(s[6 * 65], s[7 * 65]);
        int nd = n0 + n; if (GLU) nd = glu_row(nd);
        *(v4u*)(WT + (size_t)nd * K + k0 + 8 * c) = o; }
    LDS_WAIT(); asm volatile("" ::: "memory");
}

__device__ __forceinline__ void ssm_matrices(KAP A, int l, int g, LAS unsigned char* lds, int tid) {
    LAS f32x2* pw = (LAS f32x2*)lds;
    LAS f32x2* bb = pw + 2 * 17 * 64;
    LAS f32x2* cc = bb + 2 * 64 * 16;
    LAS float* kk = (LAS float*)(cc + 2 * 16 * 64);
    if (tid < 128) {
        const int dir = tid >> 6, p = tid & 63, ig = (l * 2 + dir) * 64 + g;
        const float dt = expf(A->in[I_LSTEP][ig]);
        const float lr = A->in[I_LRE][(size_t)ig * 64 + p], li = A->in[I_LIM][(size_t)ig * 64 + p];
        for (int tau = 0; tau <= 16; ++tau) {
            const float mag = expf(lr * dt * (float)tau);
            const double turns = (double)li * (double)dt * (double)tau * 0.15915494309189535;
            const float fr = (float)(turns - rint(turns));
            pw[(dir * 17 + tau) * 64 + p] = (f32x2){mag * cospif(2.f * fr), mag * sinpif(2.f * fr)};
        }
        const f32x2 ab = pw[(dir * 17 + 1) * 64 + p];
        const float nr = ab.x - 1.0f, ni = ab.y, den = lr * lr + li * li;
        const float f_re = (nr * lr + ni * li) / den, f_im = (ni * lr - nr * li) / den;
        for (int c = 0; c < 16; ++c) { const float br = A->in[I_BRE][((size_t)ig * 64 + p) * 16 + c], bi = A->in[I_BIM][((size_t)ig * 64 + p) * 16 + c];
            bb[(dir * 64 + p) * 16 + c] = (f32x2){f_re * br - f_im * bi, f_re * bi + f_im * br}; }
        ((f32x2*)(A->ws + WS_A16))[(size_t)ig * 64 + p] = pw[(dir * 17 + 16) * 64 + p];
    }
    for (int idx = tid; idx < 2048; idx += 512) { const int dir = idx >> 10, c = (idx >> 6) & 15, p = idx & 63; const size_t gi = (((size_t)(l * 2 + dir) * 64 + g) * 16 + c) * 64 + p;
        cc[idx] = (f32x2){A->in[I_CRE][gi], A->in[I_CIM][gi]}; }
    __syncthreads();
    {
        const int dir = tid >> 8, tau = (tid >> 4) & 15, c = tid & 15;
        float accv[16];
#pragma unroll
        for (int j = 0; j < 16; ++j) accv[j] = 0.f;
        for (int p = 0; p < 64; ++p) { const f32x2 cv = cc[(dir * 16 + c) * 64 + p], pv = pw[(dir * 17 + tau) * 64 + p];
            const float wre = cv.x * pv.x - cv.y * pv.y, wim = cv.x * pv.y + cv.y * pv.x;
#pragma unroll
            for (int j = 0; j < 16; ++j) { const f32x2 bv = bb[(dir * 64 + p) * 16 + j]; accv[j] += wre * bv.x - wim * bv.y; } }
#pragma unroll
        for (int j = 0; j < 16; ++j) kk[((dir * 16 + tau) * 16 + c) * 16 + j] = accv[j];
    }
    __syncthreads();
    const int lg = l * 64 + g;
    bf16* Pm = (bf16*)(A->ws + WS_PMAT) + (size_t)lg * 256 * 256;
    for (int q = tid; q < 8192; q += 512) { const int R = q >> 5, col = (q & 31) * 8, s = col >> 4, c0 = col & 15, dir = R >> 7, reim = (R >> 6) & 1, p = R & 63, e = dir ? s : 15 - s;
        const f32x2 pv = pw[(dir * 17 + e) * 64 + p]; float v[8];
#pragma unroll
        for (int j = 0; j < 8; ++j) { const f32x2 bv = bb[(dir * 64 + p) * 16 + c0 + j]; v[j] = reim ? (pv.x * bv.y + pv.y * bv.x) : (pv.x * bv.x - pv.y * bv.y); }
        v4u w; w.x = cvt_pk_bf16(v[0], v[1]); w.y = cvt_pk_bf16(v[2], v[3]); w.z = cvt_pk_bf16(v[4], v[5]); w.w = cvt_pk_bf16(v[6], v[7]);
        *(v4u*)(Pm + (size_t)R * 256 + col) = w; }
    bf16* KGm = (bf16*)(A->ws + WS_KG) + (size_t)lg * 256 * 512;
    for (int q = tid; q < 16384; q += 512) { const int R = q >> 6, col = (q & 63) * 8, i = R >> 4, c = R & 15; float v[8];
        if (col < 256) { const int s = col >> 4, c0 = col & 15;
#pragma unroll
            for (int j = 0; j < 8; ++j) { const int cp = c0 + j; float x;
                if (s < i) x = kk[((0 * 16 + (i - s)) * 16 + c) * 16 + cp];
                else if (s > i) x = kk[((1 * 16 + (s - i)) * 16 + c) * 16 + cp];
                else { x = kk[((0 * 16 + 0) * 16 + c) * 16 + cp] + kk[((1 * 16 + 0) * 16 + c) * 16 + cp]; if (cp == c) x += A->in[I_DSKIP][l * 1024 + g * 16 + c]; }
                v[j] = x; }
        } else { const int k = col - 256, dir = k >> 7, reim = (k >> 6) & 1, p0 = k & 63, e = dir ? 16 - i : i + 1;
#pragma unroll
            for (int j = 0; j < 8; ++j) { const f32x2 cv = cc[(dir * 16 + c) * 64 + p0 + j], pv = pw[(dir * 17 + e) * 64 + p0 + j];
                v[j] = reim ? -(cv.x * pv.y + cv.y * pv.x) : (cv.x * pv.x - cv.y * pv.y); } }
        v4u w; w.x = cvt_pk_bf16(v[0], v[1]); w.y = cvt_pk_bf16(v[2], v[3]); w.z = cvt_pk_bf16(v[4], v[5]); w.w = cvt_pk_bf16(v[6], v[7]);
        *(v4u*)(KGm + (size_t)R * 512 + col) = w; }
    __syncthreads();
}

__device__ __forceinline__ void mod_unit(KAP A, int un, LAS unsigned char* lds, int tid, int wave, int lane) {
    LAS float* sl = (LAS float*)lds;
    LAS float* red = sl + 3 * 4096;
    const int l = un >> 6, nb = un & 63;
    for (int i = tid; i < 3 * 4096; i += 512) { const int v = i >> 12, k = i & 4095; const float x = v == 0 ? A->in[I_CCTX][k] : A->in[I_C][(v - 1) * 4096 + k]; sl[i] = x / (1.0f + expf(-x)); }
    __syncthreads();
    const int ln = lane < 48 ? lane : 47;
    const float* wp = A->in[I_WMOD] + ((size_t)l * 4096 + wave * 512) * 12288 + nb * 192 + ln * 4;
    f32x4 a0 = {0.f, 0.f, 0.f, 0.f}, a1 = a0, a2 = a0;
#pragma unroll 8
    for (int kq = 0; kq < 512; ++kq) { const f32x4 w = *(const f32x4*)(wp + (size_t)kq * 12288); const int k = wave * 512 + kq;
        a0 += sl[k] * w; a1 += sl[4096 + k] * w; a2 += sl[8192 + k] * w; }
    if (lane < 48) {
#pragma unroll
        for (int j = 0; j < 4; ++j) { red[(wave * 3 + 0) * 256 + lane * 4 + j] = a0[j]; red[(wave * 3 + 1) * 256 + lane * 4 + j] = a1[j]; red[(wave * 3 + 2) * 256 + lane * 4 + j] = a2[j]; } }
    __syncthreads();
    for (int i = tid; i < 768; i += 512) { const int v = i >> 8, col = i & 255; if (col < 192) { float s = 0.f;
#pragma unroll
        for (int w = 0; w < 8; ++w) s += red[(w * 3 + v) * 256 + col];
        ((float*)(A->ws + WS_MOD))[(size_t)(l * 3 + v) * 12288 + nb * 192 + col] = s + A->in[I_BMOD][l * 12288 + nb * 192 + col]; } }
    __syncthreads();
}

__device__ __forceinline__ void p0_prologue(KAP A, LAS unsigned char* lds, int G, int bx, int wv) {
    const int tid = tid_of(wv); const int lane = tid & 63, wave = __builtin_amdgcn_readfirstlane(tid >> 6);
    { LAS float* scr = (LAS float*)(lds + wave * 16640);
      const int gw = bx * NWAVES + wave, NGW = G * NWAVES;
      constexpr int I_IN = 64 * 144, I_OUT = 64 * 64, I_GLU = 16 * 32, I_L = I_IN + I_OUT + I_GLU;
      for (int it = gw; it < 4 * I_L; it += NGW) { const int l = it / I_L; int r = it % I_L;
          if (r < I_IN) { tr_item<false>(A->in[I_WIN] + (size_t)l * 4096 * 9216, 4096, 9216, (bf16*)(A->ws + WS_WIN) + (size_t)l * 9216 * 4096, scr, r, lane); continue; } r -= I_IN;
          if (r < I_OUT) { tr_item<false>(A->in[I_WOUT] + (size_t)l * 4096 * 4096, 4096, 4096, (bf16*)(A->ws + WS_WOUT) + (size_t)l * 4096 * 4096, scr, r, lane); continue; } r -= I_OUT;
          tr_item<true>(A->in[I_WGLU] + (size_t)l * 1024 * 2048, 1024, 2048, (bf16*)(A->ws + WS_WGLU) + (size_t)l * 2048 * 1024, scr, r, lane); }
    }
    __syncthreads();
    for (int un = bx; un < 256; un += G) mod_unit(A, un, lds, tid, wave, lane);
    const size_t gt = (size_t)bx * 512 + tid, NGT = (size_t)G * 512;
    { bf16* D2L = (bf16*)(A->ws + WS_D2L);
      LAS bf16* lut = (LAS bf16*)lds;
      for (int i = tid; i < 4096; i += 512) lut[i] = (bf16)(cvt_pk_bf16(cospif((float)i * (1.0f / 2048.0f)), 0.f) & 0xffffu);
      __syncthreads();
      for (size_t q = gt; q < (size_t)4096 * 1024; q += NGT) { const int k = (int)(q >> 10), K0 = (int)(q & 1023) * 8; unsigned h[8];
          const int sh = K0 < 4096 ? 0 : 1024;
#pragma unroll
          for (int j = 0; j < 8; ++j) { const int K = (K0 + j) & 4095; h[j] = lut[(k * K + sh) & 4095]; }
          v4u w; w.x = h[0] | (h[1] << 16); w.y = h[2] | (h[3] << 16); w.z = h[4] | (h[5] << 16); w.w = h[6] | (h[7] << 16);
          *(v4u*)(D2L + (size_t)k * 8192 + K0) = w; }
      __syncthreads(); }
    { bf16* D1 = (bf16*)(A->ws + WS_D1);
      for (size_t q = gt; q < (size_t)256 * 256; q += NGT) { const int mp = (int)(q >> 8), c = (int)(q & 255), m = mp <= 128 ? mp : mp - 128; const float x = (float)((m * c) & 255) * (1.0f / 128.0f);
          const float v = mp <= 128 ? cospif(x) : sinpif(x); D1[q] = (bf16)(cvt_pk_bf16(v, 0.f) & 0xffffu); } }
    { bf16* WFP = (bf16*)(A->ws + WS_WFP);
      for (size_t q = gt; q < (size_t)4 * 144 * 1024; q += NGT) { const int n = (int)(q & 1023), i = (int)((q >> 10) % 144), l = (int)(q / (144 * 1024)); const int kk0 = i * 8;
          const float* W = A->in[I_WFFT] + (size_t)l * 1024 * 1024 + n; float v[8];
          if (kk0 < 1024) { const int g = kk0 >> 8, part = (kk0 >> 7) & 1;
#pragma unroll
              for (int j = 0; j < 8; ++j) { const int m = (kk0 + j) & 127; const float w1 = W[(size_t)(g * 256 + m) * 1024], w2 = W[(size_t)(g * 256 + ((256 - m) & 255)) * 1024];
                  v[j] = part ? (w1 - w2) : (m ? w1 + w2 : w1); } }
          else {
#pragma unroll
              for (int j = 0; j < 8; ++j) v[j] = 0.f;
              if (kk0 == 1024) {
#pragma unroll
                  for (int j = 0; j < 4; ++j) v[j] = W[(size_t)(j * 256 + 128) * 1024]; } }
          v4u w; w.x = cvt_pk_bf16(v[0], v[1]); w.y = cvt_pk_bf16(v[2], v[3]); w.z = cvt_pk_bf16(v[4], v[5]); w.w = cvt_pk_bf16(v[6], v[7]);
          *(v4u*)(WFP + ((size_t)l * 1024 + n) * PK + kk0) = w; }
      bf16* P = (bf16*)(A->ws + WS_P);
      for (size_t q = gt; q < (size_t)NTOK * 31; q += NGT) { const size_t row = q / 31; const int j = (int)(q % 31); *(v2u*)(P + row * PK + 1028 + j * 4) = (v2u){0u, 0u}; } }
    { bf16* D2C = (bf16*)(A->ws + WS_D2C);
      for (size_t q = gt; q < (size_t)256 * 512; q += NGT) { const int k = (int)(q >> 9), K = (int)(q & 511); const float x = (float)((k * (K & 255)) & 255) * (1.0f / 128.0f);
          const float v = K < 256 ? cospif(x) : -sinpif(x); D2C[q] = (bf16)(cvt_pk_bf16(v, 0.f) & 0xffffu); } }
    { f32x2* rope = (f32x2*)(A->ws + WS_ROPE);
      for (size_t q = gt; q < 64 * 32; q += NGT) { const int pos = (int)(q >> 5), i = (int)(q & 31); const float inv = exp2f(-(float)i * (13.287712379549449f / 32.0f));
          const double turns = (double)pos * (double)inv * 0.15915494309189535; const float fr = (float)(turns - rint(turns));
          rope[q] = (f32x2){cospif(2.f * fr), sinpif(2.f * fr)}; } }
    { const size_t n8 = (size_t)2 * 4 * 512 * 512 / 8;
      for (size_t q = gt; q < 2 * n8; q += NGT) { const bool isk = q < n8; const size_t j = isk ? q : q - n8; const float* src = (isk ? A->in[I_CK] : A->in[I_CV]) + j * 8;
          const f32x4 x0 = *(const f32x4*)src, x1 = *(const f32x4*)(src + 4);
          v4u w; w.x = cvt_pk_bf16(x0[0], x0[1]); w.y = cvt_pk_bf16(x0[2], x0[3]); w.z = cvt_pk_bf16(x1[0], x1[1]); w.w = cvt_pk_bf16(x1[2], x1[3]);
          *(v4u*)((bf16*)(A->ws + (isk ? WS_CK : WS_CV)) + j * 8) = w; } }
    __syncthreads();
    for (int lg = bx; lg < 256; lg += G) ssm_matrices(A, lg >> 6, lg & 63, lds, tid);
}

__device__ __forceinline__ f32x4 ldg16(const void* base, unsigned off, int imm) { return *(const f32x4*)(((const char*)base + off) + imm); }
__device__ __forceinline__ void pa_norm(KAP A, int l, int bx, int G, int tid, LAS unsigned char* lds) {
    const float* mod = (const float*)(A->ws + WS_MOD) + (size_t)l * 3 * 12288;
    const f32x4* ng4 = (const f32x4*)(A->in[I_NG] + l * DM);
    bf16* H = (bf16*)(A->ws + WS_H);
    const int lane = tid & 63, wave = __builtin_amdgcn_readfirstlane(tid >> 6);
    const unsigned lo2 = (unsigned)lane * 16u, lo4 = (unsigned)lane * 32u;
    LAS f32x4* avl = (LAS f32x4*)lds; LAS f32x4* svl = avl + 1024;
    for (int rb = bx; rb < NTOK / 64; rb += G) {
        const int m0 = rb * 64; const int v = m0 < NCTX ? 0 : (m0 < NCTX + 4096 ? 1 : 2);
        const f32x4* sh4 = (const f32x4*)(mod + v * 12288); const f32x4* sc4 = (const f32x4*)(mod + v * 12288 + 4096);
        __syncthreads();
        for (int i = tid; i < 1024; i += NWAVES * 64) { const int d = ((i >> 7) * 2 + (i & 1)) * 64 + ((i & 127) >> 1);
            avl[d] = ng4[i] * (sc4[i] + 1.0f); svl[d] = sh4[i]; }
        __syncthreads();
#pragma unroll 2
        for (int r = 0; r < 8; ++r) { const int m = m0 + wave * 8 + r;
            f32x4 x[16]; float ss = 0.f;
            char* xb = (char*)((bf16*)(A->ws + ((l & 1) ? WS_XBF2 : WS_XBF)) + (size_t)m * DM);
            const char* xbi = (const char*)((const bf16*)(A->ws + ((l & 1) ? WS_XBF : WS_XBF2)) + (size_t)m * DM);
            if (l <= 1) { const float* xr = m < NCTX ? A->in[I_XP] + (size_t)m * DM : A->in[I_XS] + (size_t)(m - NCTX) * DM;
#pragma unroll
                for (int j = 0; j < 8; ++j) { x[2 * j] = ldg16(xr, lo4 + (j >> 1) * 4096u, (j & 1) * 2048); x[2 * j + 1] = ldg16(xr, lo4 + (j >> 1) * 4096u, (j & 1) * 2048 + 16); }
            } else {
#pragma unroll
                for (int j = 0; j < 8; ++j) { const v4u d = *(const v4u*)((xbi + (lo2 + (j >> 2) * 4096u)) + (j & 3) * 1024);
                    x[2 * j] = (f32x4){bf_lo(d.x), bf_hi(d.x), bf_lo(d.y), bf_hi(d.y)}; x[2 * j + 1] = (f32x4){bf_lo(d.z), bf_hi(d.z), bf_lo(d.w), bf_hi(d.w)}; }
            }
            if (l > 0) {
                const char* dr = (const char*)((const bf16*)(A->ws + ((l & 1) ? WS_DELTA : WS_DELTA2)) + (size_t)m * DM);
#pragma unroll
                for (int j = 0; j < 8; ++j) { const v4u d = *(const v4u*)((dr + (lo2 + (j >> 2) * 4096u)) + (j & 3) * 1024);
                    x[2 * j] += (f32x4){bf_lo(d.x), bf_hi(d.x), bf_lo(d.y), bf_hi(d.y)}; x[2 * j + 1] += (f32x4){bf_lo(d.z), bf_hi(d.z), bf_lo(d.w), bf_hi(d.w)};
                    v4u w; w.x = cvt_pk_bf16(x[2 * j].x, x[2 * j].y); w.y = cvt_pk_bf16(x[2 * j].z, x[2 * j].w); w.z = cvt_pk_bf16(x[2 * j + 1].x, x[2 * j + 1].y); w.w = cvt_pk_bf16(x[2 * j + 1].z, x[2 * j + 1].w);
                    *(v4u*)((xb + (lo2 + (j >> 2) * 4096u)) + (j & 3) * 1024) = w; }
            }
#pragma unroll
            for (int j = 0; j < 16; ++j) ss += (x[j].x * x[j].x + x[j].y * x[j].y) + (x[j].z * x[j].z + x[j].w * x[j].w);
            const float rstd = rsqrtf(wave_sum(ss, lane) * (1.0f / DM) + NORM_EPS);
            char* orow = (char*)(H + (size_t)m * DM);
#pragma unroll
            for (int j = 0; j < 8; ++j) { const f32x4 y0 = x[2 * j] * rstd * avl[(2 * j) * 64 + lane] + svl[(2 * j) * 64 + lane], y1 = x[2 * j + 1] * rstd * avl[(2 * j + 1) * 64 + lane] + svl[(2 * j + 1) * 64 + lane];
                v4u w; w.x = cvt_pk_bf16(y0.x, y0.y); w.y = cvt_pk_bf16(y0.z, y0.w); w.z = cvt_pk_bf16(y1.x, y1.y); w.w = cvt_pk_bf16(y1.z, y1.w);
                *(v4u*)((orow + (lo2 + (j >> 2) * 4096u)) + (j & 3) * 1024) = w;
                if ((j & 1) == 1) asm volatile("" ::: "memory"); }
        }
    }
    __syncthreads();
}
__device__ __forceinline__ void final_norm(KAP A, int gw, int NGW, int lane) {
    const float* fg = A->in[I_FNG];
    const unsigned lo2 = (unsigned)lane * 16u, lo4 = (unsigned)lane * 32u;
    f32x4 gv[16];
#pragma unroll
    for (int j = 0; j < 8; ++j) { gv[2 * j] = ldg16(fg, lo4 + (j >> 1) * 4096u, (j & 1) * 2048); gv[2 * j + 1] = ldg16(fg, lo4 + (j >> 1) * 4096u, (j & 1) * 2048 + 16); }
    for (int ci = gw; ci < NTOK / 8; ci += NGW) {
#pragma unroll 2
        for (int r = 0; r < 8; ++r) { const int m = ci * 8 + r;
            char* xr = (char*)(A->out + (size_t)m * DM);
            const char* xs = (const char*)((const bf16*)(A->ws + (((DEPTH - 1) & 1) ? WS_XBF2 : WS_XBF)) + (size_t)m * DM);
            const char* dr = (const char*)((const bf16*)(A->ws + (((DEPTH - 1) & 1) ? WS_DELTA2 : WS_DELTA)) + (size_t)m * DM);
            f32x4 x[16]; float ss = 0.f;
#pragma unroll
            for (int j = 0; j < 8; ++j) { const v4u xv = *(const v4u*)((xs + (lo2 + (j >> 2) * 4096u)) + (j & 3) * 1024); const v4u d = *(const v4u*)((dr + (lo2 + (j >> 2) * 4096u)) + (j & 3) * 1024);
                x[2 * j] = (f32x4){bf_lo(xv.x) + bf_lo(d.x), bf_hi(xv.x) + bf_hi(d.x), bf_lo(xv.y) + bf_lo(d.y), bf_hi(xv.y) + bf_hi(d.y)};
                x[2 * j + 1] = (f32x4){bf_lo(xv.z) + bf_lo(d.z), bf_hi(xv.z) + bf_hi(d.z), bf_lo(xv.w) + bf_lo(d.w), bf_hi(xv.w) + bf_hi(d.w)}; }
#pragma unroll
            for (int j = 0; j < 16; ++j) ss += (x[j].x * x[j].x + x[j].y * x[j].y) + (x[j].z * x[j].z + x[j].w * x[j].w);
            const float rstd = rsqrtf(wave_sum(ss, lane) * (1.0f / DM) + NORM_EPS);
#pragma unroll
            for (int j = 0; j < 8; ++j) { *(f32x4*)((xr + (lo4 + (j >> 1) * 4096u)) + (j & 1) * 2048) = x[2 * j] * rstd * gv[2 * j]; *(f32x4*)((xr + (lo4 + (j >> 1) * 4096u)) + (j & 1) * 2048 + 16) = x[2 * j + 1] * rstd * gv[2 * j + 1];
                if ((j & 1) == 1) asm volatile("" ::: "memory"); }
        }
    }
}

__device__ __forceinline__ void kv_prep(KAP A, int l, int gw, int NGW, int lane) {
    const bf16* PROJ = (const bf16*)(A->ws + WS_PROJ);
    const f32x2* rope = (const f32x2*)(A->ws + WS_ROPE);
    const int hl = lane & 15;
    const f32x4 kn0 = *(const f32x4*)(A->in[I_KN] + l * 128 + hl * 8), kn1 = *(const f32x4*)(A->in[I_KN] + l * 128 + hl * 8 + 4);
    for (int ci = gw; ci < NTOK / 4; ci += NGW) {
        const int m0 = ci * 4; const bool ctx = m0 < NCTX;
        v4u kr[4], vr[4];
#pragma unroll
        for (int r = 0; r < 4; ++r) { const bf16* pr = PROJ + (size_t)(m0 + r) * INW; kr[r] = *(const v4u*)(pr + OFF_K + 8 * lane); vr[r] = *(const v4u*)(pr + OFF_V + 8 * lane); }
#pragma unroll
        for (int r = 0; r < 4; ++r) { const int m = m0 + r;
            float k[8] = {bf_lo(kr[r].x), bf_hi(kr[r].x), bf_lo(kr[r].y), bf_hi(kr[r].y), bf_lo(kr[r].z), bf_hi(kr[r].z), bf_lo(kr[r].w), bf_hi(kr[r].w)};
            float ss = 0.f;
#pragma unroll
            for (int j = 0; j < 8; ++j) ss += k[j] * k[j];
            ss += shflx(ss, lane, 1); ss += shflx(ss, lane, 2); ss += shflx(ss, lane, 4); ss += shflx(ss, lane, 8);
            const float rstd = rsqrtf(ss * (1.0f / 128.0f) + NORM_EPS);
#pragma unroll
            for (int j = 0; j < 4; ++j) { k[j] *= rstd * kn0[j]; k[4 + j] *= rstd * kn1[j]; }
            if (ctx) {
                const int b = m >> 8, t = m & 255; const size_t oi = (((size_t)(b * 4 + l) * 256 + t) * 512 + 8 * lane);
                float* ok = A->out + OUT_NEWK + oi; *(f32x4*)ok = (f32x4){k[0], k[1], k[2], k[3]}; *(f32x4*)(ok + 4) = (f32x4){k[4], k[5], k[6], k[7]};
                float* ov = A->out + OUT_NEWV + oi; *(f32x4*)ov = (f32x4){bf_lo(vr[r].x), bf_hi(vr[r].x), bf_lo(vr[r].y), bf_hi(vr[r].y)}; *(f32x4*)(ov + 4) = (f32x4){bf_lo(vr[r].z), bf_hi(vr[r].z), bf_lo(vr[r].w), bf_hi(vr[r].w)};
            } else {
                const int t = (m - NCTX) & 4095, pos = hl < 8 ? (t >> 6) : (t & 63); const f32x2* rp = rope + pos * 32 + (lane & 3) * 8; const bool first = (lane & 4) == 0;
#pragma unroll
                for (int j = 0; j < 8; ++j) { const float other = shflx(k[j], lane, 4); const f32x2 cs = rp[j];
                    k[j] = first ? (k[j] * cs.x - other * cs.y) : (other * cs.y + k[j] * cs.x); }
            }
            v4u w; w.x = cvt_pk_bf16(k[0], k[1]); w.y = cvt_pk_bf16(k[2], k[3]); w.z = cvt_pk_bf16(k[4], k[5]); w.w = cvt_pk_bf16(k[6], k[7]);
            *(v4u*)((bf16*)(A->ws + WS_KC) + (size_t)m * 512 + 8 * lane) = w;
            *(v4u*)((bf16*)(A->ws + WS_VC) + (size_t)m * 512 + 8 * lane) = vr[r];
        }
    }
}

__device__ __forceinline__ void ssm_scan(KAP A, int l, int g, int mt, int tid, LAS unsigned char* lds) {
    const float* S = (const float*)(A->ws + WS_SBUF) + (size_t)g * 1024 * 256;
    bf16* A2 = (bf16*)(A->ws + WS_A2) + (size_t)g * 1024 * 512;
    const int blk = tid >> 5, sub = tid & 31, dir = sub >> 4, p0 = (sub & 15) * 4;
    f32x4 ar, ai;
    { const f32x4* a4 = (const f32x4*)((const float*)(A->ws + WS_A16) + (((size_t)(l * 2 + dir) * 64 + g) * 64 + p0) * 2); const f32x4 t0 = a4[0], t1 = a4[1];
      ar = (f32x4){t0.x, t0.z, t1.x, t1.z}; ai = (f32x4){t0.y, t0.w, t1.y, t1.w}; }
    const int ecol = 256 + dir * 128 + p0, scol = dir * 128 + p0;
    LAS f32x4* T = (LAS f32x4*)lds;
    LAS f32x4* EB = T + 16 * 32 * 2;
    const bool lat = mt >= 2;
    const int rb = mt * 256 + blk * 16;
    f32x4 sr[16], si[16];
#pragma unroll
    for (int i = 0; i < 16; ++i) { const int row = rb + (dir ? 15 - i : i); sr[i] = *(const f32x4*)(S + (size_t)row * 256 + scol); si[i] = *(const f32x4*)(S + (size_t)row * 256 + scol + 64); }
    f32x4 er = {0.f, 0.f, 0.f, 0.f}, ei = er;
    if (lat) {
#pragma unroll
        for (int i = 0; i < 16; ++i) { const f32x4 nr = ar * er - ai * ei + sr[i], ni = ar * ei + ai * er + si[i]; er = nr; ei = ni; }
        T[(blk * 32 + sub) * 2] = er; T[(blk * 32 + sub) * 2 + 1] = ei;
        __syncthreads();
        if (tid < 32) { const int b = mt - 2; const size_t si0 = (((size_t)b * 4 + l) * 64 + g) * 64 + p0;
            f32x4 cr = *(const f32x4*)(A->in[dir ? I_SBR : I_SFR] + si0), ci = *(const f32x4*)(A->in[dir ? I_SBI : I_SFI] + si0);
            f32x4 qr = ar, qi = ai;
#pragma unroll
            for (int k = 0; k < 4; ++k) { const f32x4 t = qr * qr - qi * qi; qi = 2.f * qr * qi; qr = t; }
#pragma unroll 1
            for (int jb = 0; jb < 16; ++jb) { const int bb = dir ? 15 - jb : jb; EB[(bb * 32 + sub) * 2] = cr; EB[(bb * 32 + sub) * 2 + 1] = ci;
                const f32x4 tr = T[(bb * 32 + sub) * 2], ti = T[(bb * 32 + sub) * 2 + 1];
                const f32x4 nr = qr * cr - qi * ci + tr, ni = qr * ci + qi * cr + ti; cr = nr; ci = ni; } }
        __syncthreads();
        er = EB[(blk * 32 + sub) * 2]; ei = EB[(blk * 32 + sub) * 2 + 1];
    }
#pragma unroll
    for (int i = 0; i < 16; ++i) { const int row = rb + (dir ? 15 - i : i);
        v2u wr, wi; wr.x = cvt_pk_bf16(er.x, er.y); wr.y = cvt_pk_bf16(er.z, er.w); wi.x = cvt_pk_bf16(ei.x, ei.y); wi.y = cvt_pk_bf16(ei.z, ei.w);
        *(v2u*)(A2 + (size_t)row * 512 + ecol) = wr; *(v2u*)(A2 + (size_t)row * 512 + ecol + 64) = wi;
        const f32x4 nr = ar * er - ai * ei + sr[i], ni = ar * ei + ai * er + si[i]; er = nr; ei = ni; }
    if (!lat) { const int b = mt * 16 + blk; const size_t oi = (((size_t)b * 4 + l) * 64 + g) * 64 + p0;
        *(f32x4*)(A->out + (dir ? OUT_BRE : OUT_FRE) + oi) = er; *(f32x4*)(A->out + (dir ? OUT_BIM : OUT_FIM) + oi) = ei; }
}
__device__ __forceinline__ void ssm_step1(KAP A, int l, int un, LAS unsigned char* lds, int wv) {
    const int g = un >> 2, mt = un & 3, lg = l * 64 + g;
    pg8::OneUnit S1; S1.u0.a = (const char*)(A->ws + WS_A2) + ((size_t)g * 1024 + mt * 256) * 512 * 2; S1.u0.b = (const char*)(A->ws + WS_PMAT) + (size_t)lg * 256 * 256 * 2;
    S1.u0.c = (char*)(A->ws + WS_SBUF) + ((size_t)g * 1024 + mt * 256) * 256 * 4; S1.u0.ldc = 256; S1.u0.pm = mt; S1.u0.pn = g; S1.u0.z = 0; S1.u0.kt = 4;
    pg8::EpiF32 E; pg8::gemm_phase<pg8::EpiF32, pg8::OneUnit>(lds, wv, 512, 256, S1, E);
}
__device__ __forceinline__ void ssm_step2(KAP A, int l, int un, LAS unsigned char* lds, int wv) {
    const int g = un >> 2, mt = un & 3; const int tid = tid_of(wv); ssm_scan(A, l, g, mt, tid, lds);
}
__device__ __forceinline__ void ssm_step3(KAP A, int l, int un, LAS unsigned char* lds, int wv) {
    const int g = un >> 2, mt = un & 3, lg = l * 64 + g;
    pg8::OneUnit S2; S2.u0.a = (const char*)(A->ws + WS_A2) + ((size_t)g * 1024 + mt * 256) * 512 * 2; S2.u0.b = (const char*)(A->ws + WS_KG) + (size_t)lg * 256 * 512 * 2;
    S2.u0.c = nullptr; S2.u0.ldc = 0; S2.u0.pm = mt; S2.u0.pn = g; S2.u0.z = mt * 256; S2.u0.kt = 8;
    pg8::EpiSsmY E{(bf16*)(A->ws + WS_YSSM)}; pg8::gemm_phase<pg8::EpiSsmY, pg8::OneUnit>(lds, wv, 512, 512, S2, E);
}

struct Fft1Order {
    int G, c; const char* D1; const char* proj; char* zl; char* zc;
    __device__ bool next(int i, pg8::Unit& u) const { const int L = i * G + c; if (L >= 256) return false;
        const int g = L & 3, tt = L >> 2;
        int kt4 = 4; asm volatile("" : "+s"(kt4)); u.kt = kt4;
        u.a = D1; u.b = proj + ((size_t)tt * 256 * INW + OFF_F + g * 256) * 2; u.pm = 0; u.pn = tt; u.z = g;
        if (tt < 32) { u.c = zc + ((size_t)((tt * 4 + g) * 128) * 256) * 2; u.ldc = 256; }
        else { const int b = (tt - 32) >> 4, t0 = ((tt - 32) & 15) * 256; u.c = zl + ((size_t)((b * 4 + g) * 128) * 4096 + t0) * 2; u.ldc = 4096; }
        return true; }
};
struct Fft2LOrder {
    int G, c; const char* D2; const char* z; char* P;
    __device__ bool next(int i, pg8::Unit& u) const { const int L = i * G + c; if (L >= 128) return false;
        const int nt = L & 3, part = (L >> 2) & 1, mt = L >> 3;
        u.kt = 64; u.a = D2 + ((size_t)mt * 256 * 8192 + part * 4096) * 2; u.b = z + (part * ZPART + (size_t)nt * 256 * 4096) * 2; u.pm = mt; u.pn = nt; u.z = part;
        u.c = P + (((size_t)NCTX + (nt >> 1) * 4096 + mt * 256) * PK + (nt & 1) * 512 + part * 128) * 2; u.ldc = PK; return true; }
};
struct Fft2COrder {
    int G, c; const char* D2; const char* z; char* P;
    __device__ bool next(int i, pg8::Unit& u) const { const int L = i * G + c; if (L >= 128) return false;
        const int nt = L & 1, part = (L >> 1) & 1, b = L >> 2;
        u.kt = 4; u.a = D2 + (size_t)part * 256 * 2; u.b = z + (part * ZPART + (size_t)((b * 4 + nt * 2) * 128) * 256) * 2; u.pm = 0; u.pn = nt; u.z = b;
        u.c = P + (((size_t)b * 256) * PK + nt * 512 + part * 128) * 2; u.ldc = PK; return true; }
};
template <int NS, int KS>
__device__ __forceinline__ f32x4 nyq_core(const bf16* arow, size_t lda16, const bf16* bcol, LAS unsigned char* lds, int tid) {
    const int wave = tid >> 6, lane = tid & 63, fq = lane >> 4;
    f32x4 acc[NS];
#pragma unroll
    for (int ns = 0; ns < NS; ++ns) acc[ns] = (f32x4){0.f, 0.f, 0.f, 0.f};
    const int tb = wave * KS * 32 + fq * 8;
#pragma unroll 4
    for (int s2 = 0; s2 < KS; ++s2) { const bf16x8 bv = *(const bf16x8*)(bcol + tb + s2 * 32);
#pragma unroll
        for (int ns = 0; ns < NS; ++ns) { const bf16x8 av = *(const bf16x8*)(arow + ns * lda16 + tb + s2 * 32); acc[ns] = __builtin_amdgcn_mfma_f32_16x16x32_bf16(bv, av, acc[ns], 0, 0, 0); } }
    LAS f32x4* red = (LAS f32x4*)lds;
    __syncthreads();
#pragma unroll
    for (int ns = 0; ns < NS; ++ns) red[(wave * NS + ns) * 64 + lane] = acc[ns];
    __syncthreads();
    f32x4 r = (f32x4){0.f, 0.f, 0.f, 0.f};
    if (tid < NS * 64) {
#pragma unroll
        for (int w = 0; w < 8; ++w) r += red[(w * NS + (tid >> 6)) * 64 + (tid & 63)]; }
    __syncthreads();
    return r;
}
__device__ __forceinline__ void nyq_pass(KAP A, int cA, LAS unsigned char* lds, int wv) {
    const int tid = tid_of(wv); const int fr = tid & 15;
    bf16* P = (bf16*)(A->ws + WS_P);
    {
        const bf16* arow = (const bf16*)(A->ws + WS_D2L) + (size_t)(cA * 32 + fr) * 8192;
        const bf16* bcol = (const bf16*)(A->ws + WS_ZL) + ZPART + (size_t)((fr & 7) * 128) * 4096;
        const f32x4 r = nyq_core<2, 16>(arow, (size_t)16 * 8192, bcol, lds, tid) * (1.0f / 1024.0f);
        const int fq = (tid & 63) >> 4;
        if (tid < 128 && fq < 2) { const int k = cA * 32 + (tid >> 6) * 16 + fr; *(v2u*)(P + ((size_t)NCTX + fq * 4096 + k) * PK + 1024) = (v2u){cvt_pk_bf16(r[0], r[1]), cvt_pk_bf16(r[2], r[3])}; } }
    {
        const int cg = cA & 7, rs = cA >> 3;
        const bf16* arow = (const bf16*)(A->ws + WS_D2C) + (size_t)(rs * 16 + fr) * 512;
        const bf16* bcol = (const bf16*)(A->ws + WS_ZC) + ZPART + (size_t)(((cg * 4 + (fr >> 2)) * 4 + (fr & 3)) * 128) * 256;
        const f32x4 r = nyq_core<1, 1>(arow, 0, bcol, lds, tid) * (1.0f / 256.0f);
        const int fq = (tid & 63) >> 4;
        if (tid < 64) { const int k = rs * 16 + fr, b = cg * 4 + fq; *(v2u*)(P + ((size_t)b * 256 + k) * PK + 1024) = (v2u){cvt_pk_bf16(r[0], r[1]), cvt_pk_bf16(r[2], r[3])}; } }
}

__global__ void __launch_bounds__(NWAVES * 64, 2) hymba_fwd(Args args) {
    extern __shared__ __attribute__((aligned(16))) unsigned char lds_raw[];
    LAS unsigned char* lds = (LAS unsigned char*)lds_raw;
    volatile LAS unsigned* MISC = (volatile LAS unsigned*)(lds + MISC_OFF);
    const int G = gridDim.x, bx = blockIdx.x;
    const int wv = __builtin_amdgcn_readfirstlane(threadIdx.x >> 6);
#define TID_HERE() const int tid = tid_of(wv); const int lane = tid & 63, wave = __builtin_amdgcn_readfirstlane(tid >> 6), gw = bq * NWAVES + wave, NGWq = Gq * NWAVES; (void)lane; (void)gw; (void)NGWq
#define PH_IDS() int Gq = G, bq = bx; asm volatile("" : "+s"(Gq), "+s"(bq))
    for (int u = tid_of(wv); u < (LDS_BYTES - MISC_OFF) / 4; u += NWAVES * 64) ((LAS unsigned*)(lds + MISC_OFF))[u] = 0u;
    __syncthreads();
    int lo, hi; XcdBarrier bar;
    { KA_HERE(); PH_IDS(); lo = ka->ph_lo; hi = ka->ph_hi; unsigned* ctl = (unsigned*)(ka->ws + WS_CTL);
      bar.bar = ctl + CW_BAR; bar.x = 0; bar.st = nullptr;
      if (hi - lo > 1) bar = xcd_barrier_post(ctl + CW_BAR, MISC + 8, tid_of(wv)); }
#define IN(k) (lo <= (k) && (k) < hi)
#define SEAM(k) do { if (IN(k) && IN((k) + 1)) { xcd_barrier(bar, wv); if (((DUP_MASK) >> 12) & 1) xcd_barrier(bar, wv); } } while (0)

    if (IN(0)) DUP(0) { KA_HERE(); PH_IDS(); p0_prologue(ka, lds, Gq, bq, wv); }
    SEAM(0);

    for (int l = 0; l < DEPTH; ++l) for (int lrep_ = 0; lrep_ < 1 + (((DUP_MASK) >> 19) & 1); ++lrep_) {
        const int pb = 1 + 6 * l;
        if (IN(pb)) DUP(1) { KA_HERE(); PH_IDS(); TID_HERE(); pa_norm(ka, l, bq, Gq, tid, lds);
        }
        SEAM(pb);
        if (IN(pb + 1)) DUP(2) {
            KA_HERE(); PH_IDS(); unsigned char* ws = ka->ws;
            pg8::GemmOrder S; S.init(NTOK, INW, Gq, bq, ws + WS_H, DM, ws + WS_WIN + (size_t)l * INW * DM * 2, DM, DM);
            pg8::EpiProj E{(bf16*)(ws + WS_PROJ), (bf16*)(ws + WS_A2)};
            pg8::gemm_phase<pg8::EpiProj, pg8::GemmOrder, GEMM1_ALIGN>(lds, wv, DM, DM, S, E);
        }
        SEAM(pb + 1);
        if (IN(pb + 2)) {
            DUP(16) for (int un = bx; un < 256; un += G) { KA_HERE(); ssm_step1(ka, l, un, lds, wv); }
            DUP(14) { KA_HERE(); PH_IDS(); TID_HERE(); kv_prep(ka, l, gw, NGWq, lane); }
            wg_global_sync();
            DUP(17) { for (int un = bx; un < 256; un += G) { KA_HERE(); ssm_step2(ka, l, un, lds, wv); } __syncthreads(); }
            DUP(3) { KA_HERE(); PH_IDS(); unsigned char* ws = ka->ws;
              Fft1Order S{Gq, bq, (const char*)(ws + WS_D1), (const char*)(ws + WS_PROJ), (char*)(ws + WS_ZL), (char*)(ws + WS_ZC)};
              pg8::EpiBf16X E{1.0f, (int)ZPART, 128}; pg8::gemm_phase<pg8::EpiBf16X, Fft1Order>(lds, wv, 256, INW, S, E); }
            wg_global_sync();
            DUP(18) for (int un = bx; un < 256; un += G) { KA_HERE(); ssm_step3(ka, l, un, lds, wv); }
        }
        SEAM(pb + 2);
        if (IN(pb + 3)) {
            if (bx < (G >> 1)) {
                __syncthreads();
                DUP(7) { KA_HERE(); unsigned char* ws = ka->ws; int nAq = G >> 1, cAq = bx; asm volatile("" : "+s"(nAq), "+s"(cAq));
                  Fft2LOrder S{nAq, cAq, (const char*)(ws + WS_D2L), (const char*)(ws + WS_ZL), (char*)(ws + WS_P)};
                  pg8::EpiBf16X E{1.0f / 1024.0f, 128 * PK, 256}; pg8::gemm_phase<pg8::EpiBf16X, Fft2LOrder>(lds, wv, 8192, 4096, S, E); }
                DUP(8) { KA_HERE(); unsigned char* ws = ka->ws; int nAq = G >> 1, cAq = bx; asm volatile("" : "+s"(nAq), "+s"(cAq));
                  Fft2COrder S{nAq, cAq, (const char*)(ws + WS_D2C), (const char*)(ws + WS_ZC), (char*)(ws + WS_P)};
                  pg8::EpiBf16X E{1.0f / 256.0f, 128 * PK, 256}; pg8::gemm_phase<pg8::EpiBf16X, Fft2COrder>(lds, wv, 512, 256, S, E); }
                DUP(8) { KA_HERE(); for (int it = bx; it < 128; it += (G >> 1)) nyq_pass(ka, it, lds, wv); }
                __syncthreads();
            }
            DUP(5) for (int U = bx; U < 512; U += G) {
                KA_HERE(); PH_IDS(); unsigned char* ws = ka->ws; bf16* const PROJ = (bf16*)(ws + WS_PROJ); bf16* const MIX = (bf16*)(ws + WS_MIX);
                const float* qn = ka->in[I_QN] + l * 128; const f32x2* rope = (const f32x2*)(ws + WS_ROPE);
                const int pr = U & 7, idx = U >> 3, b = pr >> 2, kvh = pr & 3, hq = kvh * 4 + (idx >> 4), qb = idx & 15;
                const size_t row0 = (size_t)NCTX + b * 4096 + qb * 256;
                const bf16* ck = (const bf16*)(ws + WS_CK) + ((size_t)(b * 4 + l) * 512) * 512 + kvh * 128;
                const bf16* cv = (const bf16*)(ws + WS_CV) + ((size_t)(b * 4 + l) * 512) * 512 + kvh * 128;
                const bf16* k1 = (const bf16*)(ws + WS_KC) + ((size_t)NCTX + b * 4096) * 512 + kvh * 128; const bf16* v1 = (const bf16*)(ws + WS_VC) + ((size_t)NCTX + b * 4096) * 512 + kvh * 128;
                att::attn_unit(PROJ + row0 * INW + hq * 128, PROJ + row0 * INW + OFF_GA + hq * 128, MIX + row0 * DM + hq * 128,
                               ck, cv, 512, 8, k1, v1, 512, 64, qn, rope, qb * 256, (char*)lds_raw, wv);
            }
            {
                const int nH = G >> 1, hb = bx >= nH ? 1 : 0, cH = bx - hb * nH, Uend = hb ? 512 : 256;
                DUP(6) for (int U = hb * 256 + cH; U < Uend; U += (hb ? G - nH : nH)) {
                    KA_HERE(); unsigned char* ws = ka->ws; bf16* const PROJ = (bf16*)(ws + WS_PROJ); bf16* const MIX = (bf16*)(ws + WS_MIX);
                    const float* qn = ka->in[I_QN] + l * 128;
                    const int xx = U & 7, idx = U >> 3, b = xx * 4 + (idx >> 4), hq = idx & 15, kvh = hq >> 2;
                    const size_t row0 = (size_t)b * 256;
                    const bf16* k1 = (const bf16*)(ws + WS_KC) + row0 * 512 + kvh * 128; const bf16* v1 = (const bf16*)(ws + WS_VC) + row0 * 512 + kvh * 128;
                    att::attn_unit(PROJ + row0 * INW + hq * 128, PROJ + row0 * INW + OFF_GA + hq * 128, MIX + row0 * DM + hq * 128,
                                   k1, v1, 512, 0, k1, v1, 512, 4, qn, nullptr, 0, (char*)lds_raw, wv);
                }
            }
            if (bx >= (G >> 1)) {
                const int nB = G - (G >> 1), cB = bx - (G >> 1);
                __syncthreads();
                DUP(9) { KA_HERE(); unsigned char* ws = ka->ws; int nBq = nB, cBq = cB; asm volatile("" : "+s"(nBq), "+s"(cBq));
                  pg8::GemmOrder S; S.init(NTOK, 2048, nBq, cBq, ws + WS_YSSM, 1024, ws + WS_WGLU + (size_t)l * 2048 * 1024 * 2, 1024, 1024);
                  pg8::EpiGlu E{(const bf16*)(ws + WS_PROJ), (bf16*)(ws + WS_MIX)}; pg8::gemm_phase<pg8::EpiGlu, pg8::GemmOrder>(lds, wv, 1024, 1024, S, E); }
            }
        }
        SEAM(pb + 3);
        if (IN(pb + 4)) {
            DUP(10) { KA_HERE(); PH_IDS(); unsigned char* ws = ka->ws;
              pg8::GemmOrder S; S.init(NTOK, 1024, Gq, bq, ws + WS_P, PK, ws + WS_WFP + (size_t)l * 1024 * PK * 2, PK, PK);
              pg8::EpiFftW E{(const bf16*)(ws + WS_PROJ), (bf16*)(ws + WS_MIX)}; pg8::gemm_phase<pg8::EpiFftW, pg8::GemmOrder>(lds, wv, PK, PK, S, E); }
        }
        SEAM(pb + 4);
        if (IN(pb + 5)) DUP(11) {
            KA_HERE(); PH_IDS(); unsigned char* ws = ka->ws;
            pg8::GemmOrder S; S.init(NTOK, DM, Gq, bq, ws + WS_MIX, DM, ws + WS_WOUT + (size_t)l * DM * DM * 2, DM, DM);
            pg8::EpiOut E{(bf16*)(ws + ((l & 1) ? WS_DELTA2 : WS_DELTA)), (const float*)(ws + WS_MOD) + (size_t)l * 3 * 12288};
            if (((DUP_MASK) >> 13) & 1) {
                { pg8::SliceOrder<pg8::GemmOrder> S2{S, 0, 2}; pg8::gemm_phase<pg8::EpiOut, pg8::SliceOrder<pg8::GemmOrder>, GEMM1_ALIGN>(lds, wv, DM, DM, S2, E); }
                xcd_barrier(bar, wv);
                { pg8::SliceOrder<pg8::GemmOrder> S2{S, 2, 1000}; pg8::gemm_phase<pg8::EpiOut, pg8::SliceOrder<pg8::GemmOrder>, GEMM1_ALIGN>(lds, wv, DM, DM, S2, E); }
            } else
            pg8::gemm_phase<pg8::EpiOut, pg8::GemmOrder, GEMM1_ALIGN>(lds, wv, DM, DM, S, E);
        }
        SEAM(pb + 5);
    }
    if (IN(25)) DUP(15) { KA_HERE(); PH_IDS(); TID_HERE(); final_norm(ka, gw, NGWq, lane); }
#undef IN
#undef SEAM
}

extern "C" void kernel_launch(void* const* d_in, const int* in_sizes, int n_in, void* d_out, int out_size, void* d_ws, size_t ws_size, hipStream_t stream) {
    static int grid = 0;
    if (grid == 0) {
        if (n_in != 28 || ws_size < WS_END || out_size != 102760448) { fprintf(stderr, "kernel_launch: unexpected shapes (n_in %d, out %d, ws %zu)\n", n_in, out_size, ws_size); grid = -1; return; }
        int dev = 0, cus = 0, per_cu = 0;
        if (hipGetDevice(&dev) != hipSuccess || hipDeviceGetAttribute(&cus, hipDeviceAttributeMultiprocessorCount, dev) != hipSuccess) { grid = -1; return; }
        if (hipFuncSetAttribute((const void*)hymba_fwd, hipFuncAttributeMaxDynamicSharedMemorySize, LDS_BYTES) != hipSuccess) { fprintf(stderr, "kernel_launch: hipFuncSetAttribute failed\n"); grid = -1; return; }
        if (hipOccupancyMaxActiveBlocksPerMultiprocessor(&per_cu, (const void*)hymba_fwd, NWAVES * 64, LDS_BYTES) != hipSuccess || per_cu < 1)
            fprintf(stderr, "kernel_launch: occupancy query reports %d workgroups per CU\n", per_cu);
        (void)hipGetLastError();
        grid = cus;
    }
    if (grid < 0) return;
    (void)hipMemsetAsync((char*)d_ws + WS_CTL, 0, CTL_ZERO_BYTES, stream);
    Args a{};
    for (int i = 0; i < 28; ++i) a.in[i] = (const float*)d_in[i];
    a.out = (float*)d_out; a.ws = (unsigned char*)d_ws;
#if MK_ONE_LAUNCH == 2
    a.ph_lo = 0; a.ph_hi = 1;
    hipLaunchKernelGGL(hymba_fwd, dim3(grid), dim3(NWAVES * 64), LDS_BYTES, stream, a);
    a.ph_lo = 0; a.ph_hi = 26;
    hipLaunchKernelGGL(hymba_fwd, dim3(grid), dim3(NWAVES * 64), LDS_BYTES, stream, a);
#elif MK_ONE_LAUNCH
    a.ph_lo = 0; a.ph_hi = 26;
    hipLaunchKernelGGL(hymba_fwd, dim3(grid), dim3(NWAVES * 64), LDS_BYTES, stream, a);
#else
    for (int ph = 0; ph < 26; ++ph) { a.ph_lo = ph; a.ph_hi = ph + 1; hipLaunchKernelGGL(hymba_fwd, dim3(grid), dim3(NWAVES * 64), LDS_BYTES, stream, a); }
#endif
    const hipError_t le = hipPeekAtLastError();
    if (le != hipSuccess) fprintf(stderr, "kernel_launch: launch failed: %s\n", hipGetErrorName(le));
}
```

```cpp
#include <hip/hip_runtime.h>
#include <cstdio>
#include <cstdint>

#ifndef MK_ONE_LAUNCH
#define MK_ONE_LAUNCH 1
#endif

#ifndef GEMM1_ALIGN
#define GEMM1_ALIGN true
#endif
#ifndef DUP_MASK
#define DUP_MASK 0
#endif
#define DUP(k) for (int rep_ = 0; rep_ < (((DUP_MASK) >> (k)) & 1) + 1; ++rep_)
#define LAS __attribute__((address_space(3)))
#define GAS __attribute__((address_space(1)))
typedef unsigned short bf16;
typedef unsigned v4u __attribute__((ext_vector_type(4)));
typedef unsigned v2u __attribute__((ext_vector_type(2)));
typedef float f32x4 __attribute__((ext_vector_type(4)));
typedef float f32x2 __attribute__((ext_vector_type(2)));
typedef short bf16x8 __attribute__((ext_vector_type(8)));
typedef short s16x4 __attribute__((ext_vector_type(4)));
typedef float f32x16 __attribute__((ext_vector_type(16)));

constexpr int DM = 4096, NTOK = 16384, NCTX = 8192, DEPTH = 4, INW = 9216;
constexpr int OFF_K = 2048, OFF_V = 2560, OFF_GA = 3072, OFF_U = 5120, OFF_GS = 6144, OFF_F = 7168, OFF_GF = 8192;
constexpr float NORM_EPS = 1e-6f;
constexpr size_t OUT_NEWK = 67108864, OUT_NEWV = 83886080, OUT_FRE = 100663296, OUT_FIM = 101187584, OUT_BRE = 101711872, OUT_BIM = 102236160;

constexpr size_t MiB = 1u << 20;
constexpr size_t WS_CTL = 0, CTL_ZERO_BYTES = 1 * MiB;
constexpr size_t WS_MOD = 1 * MiB;
constexpr size_t WS_ROPE = 2 * MiB;
constexpr size_t WS_A16 = 3 * MiB;
constexpr size_t WS_D1 = 4 * MiB;
constexpr size_t WS_D2C = 5 * MiB;
constexpr size_t WS_CK = 6 * MiB;
constexpr size_t WS_CV = 10 * MiB;
constexpr size_t WS_PMAT = 14 * MiB;
constexpr size_t WS_KG = 46 * MiB;
constexpr size_t WS_D2L = 110 * MiB;
constexpr size_t WS_WGLU = 174 * MiB;
constexpr size_t WS_WOUT = 198 * MiB;
constexpr size_t WS_WIN = 326 * MiB;
constexpr size_t WS_H = 614 * MiB;
constexpr size_t WS_PROJ = 742 * MiB;
constexpr size_t WS_MIX = 1030 * MiB;
constexpr size_t WS_A2 = 1158 * MiB;
constexpr size_t WS_SBUF = 1222 * MiB;
constexpr size_t WS_YSSM = 1286 * MiB;
constexpr size_t WS_ZL = 1318 * MiB;
constexpr size_t WS_ZC = 1334 * MiB;
constexpr size_t WS_P = 1350 * MiB;
constexpr size_t WS_WFP = 1386 * MiB;
constexpr int PK = 1152; constexpr size_t ZPART = (size_t)1 << 22;
constexpr size_t WS_DELTA = 1414 * MiB;
constexpr size_t WS_XBF = 1542 * MiB;
constexpr size_t WS_XBF2 = 1702 * MiB;
constexpr size_t WS_KC = 1670 * MiB;
constexpr size_t WS_VC = 1686 * MiB;
constexpr size_t WS_DELTA2 = 1830 * MiB;
constexpr size_t WS_END = 1958 * MiB;
constexpr int CW_BAR = 4096;

constexpr int LDS_BYTES = 147456;
constexpr int MISC_OFF = 143360;
constexpr int NWAVES = 8;

#define LDS_WAIT() asm volatile("s_waitcnt lgkmcnt(0)" ::: "memory")
#define VM_WAIT() asm volatile("s_waitcnt vmcnt(0)" ::: "memory")
#define RLX_AGENT __ATOMIC_RELAXED, __HIP_MEMORY_SCOPE_AGENT

__device__ __forceinline__ int tid_of(int wv) { int t = wv * 64 + (int)__builtin_amdgcn_mbcnt_hi(~0u, __builtin_amdgcn_mbcnt_lo(~0u, 0u)); asm volatile("" : "+v"(t)); return t; }
__device__ __forceinline__ unsigned cvt_pk_bf16(float lo, float hi) { unsigned r; asm volatile("v_cvt_pk_bf16_f32 %0, %1, %2" : "=v"(r) : "v"(lo), "v"(hi)); return r; }
__device__ __forceinline__ float bf_lo(unsigned w) { return __uint_as_float(w << 16); }
__device__ __forceinline__ float bf_hi(unsigned w) { return __uint_as_float(w & 0xffff0000u); }
__device__ __forceinline__ float silu_f(float x) { return x * __builtin_amdgcn_rcpf(1.0f + __expf(-x)); }
__device__ __forceinline__ float sigmoid_f(float x) { return __builtin_amdgcn_rcpf(1.0f + __expf(-x)); }
__device__ __forceinline__ float shflx(float v, int lane, int o) { return __int_as_float(__builtin_amdgcn_ds_bpermute((lane ^ o) << 2, __float_as_int(v))); }
__device__ __forceinline__ float wave_sum(float v, int lane) {
#pragma unroll
    for (int o = 1; o < 64; o <<= 1) v += shflx(v, lane, o);
    return v;
}

namespace pg8 {
constexpr int BM = 256, BK = 64, HALF = 128, HTB = HALF * BK * 2, STAGE_BYTES = 8 * HTB, NXCD = 8, WGM = 8;
__host__ __device__ __forceinline__ int lds_byte(int r, int c) { const int st = (r >> 4) * 2 + (c >> 5), rr = r & 15, cc = c & 31, ob = rr * 64 + cc * 2; return st * 1024 + (ob ^ (((ob >> 9) & 1) << 5)); }
__host__ __device__ __forceinline__ void stage_rc(int b, int& R, int& C) { const int st = b / 1024, sb = b % 1024, swz = sb ^ (((sb >> 9) & 1) << 5); R = (st >> 1) * 16 + swz / 64; C = (st & 1) * 32 + (swz % 64) / 2; }
__host__ __device__ __forceinline__ int perm32(int rho) { const int n = rho >> 4, i = rho & 15; return 8 * (i >> 2) + 4 * n + (i & 3); }

struct Unit { const char* a; const char* b; char* c; int ldc; int pm, pn, z, kt; };

struct GemmOrder {
    int nM, nN, nwg, G, c, kt; const char* A; const char* B; size_t atile, btile;
    __device__ void init(int M, int N, int G_, int c_, const void* A_, int lda, const void* B_, int ldb, int K) { kt = K / BK; nM = M / BM; nN = N / BM; nwg = nM * nN; G = G_; c = c_; A = (const char*)A_; B = (const char*)B_; atile = (size_t)BM * lda * 2; btile = (size_t)BM * ldb * 2; }
    __device__ bool next(int i, Unit& u) const {
        const long L = (long)i * G + c; if (L >= nwg) return false;
        int wgid = (int)L; const int xcd = wgid % NXCD; { const int q = nwg / NXCD, r = nwg % NXCD, off = wgid / NXCD; wgid = (xcd < r ? xcd * (q + 1) : r * (q + 1) + (xcd - r) * q) + off; }
        const int nig = WGM * nN, gid = wgid / nig, fm = gid * WGM, gsz = (nM - fm) < WGM ? (nM - fm) : WGM;
        u.pm = fm + ((wgid % nig) % gsz); u.pn = (wgid % nig) / gsz; u.z = 0; u.c = nullptr; u.ldc = 0; u.kt = kt;
        u.a = A + (size_t)u.pm * atile; u.b = B + (size_t)u.pn * btile; return true;
    }
};
template <class O> struct SliceOrder { O g; int i0, cnt; __device__ bool next(int i, Unit& u) const { if (i >= cnt) return false; return g.next(i0 + i, u); } };
struct OneUnit { Unit u0; __device__ bool next(int i, Unit& u) const { if (i != 0) return false; u = u0; return true; } };

template <class Epi, class Sched, bool ALIGN_EPI = true>
__device__ __forceinline__ void gemm_phase(LAS unsigned char* lds, const int wv, const int lda, const int ldb, const Sched& S, const Epi& E) {
    const int tid = tid_of(wv);
    const int wid = __builtin_amdgcn_readfirstlane(tid >> 6), lane = tid & 63, wr = wid >> 2, wc = wid & 3, fr = lane & 15, fq = lane >> 4;
    unsigned voffA[2], voffB[2];
#pragma unroll
    for (int i = 0; i < 2; ++i) { int R, C; stage_rc(tid * 16 + i * 8192, R, C); const int Rb = Epi::PERM ? ((R & ~31) + perm32(R & 31)) : R;
        voffA[i] = (unsigned)(R * lda + C) * 2u; voffB[i] = (unsigned)(Rb * ldb + C) * 2u; }
    (void)fr; (void)fq;
    const size_t kstep = (size_t)(BK * 2);
    const unsigned hstepA = (unsigned)HALF * lda * 2u, hstepB = (unsigned)HALF * ldb * 2u;
    const unsigned ldsw = (unsigned)wid * 1024u;
    const int aoff = lds_byte(wr * 64 + fr, fq * 8), boff = lds_byte(wc * 32 + fr, fq * 8);
#define PG8_SA(b, h) (((b) * 2 + (h)) * HTB)
#define PG8_SB(b, h) ((4 + (b) * 2 + (h)) * HTB)
#define PG8_STAGE(bufoff, gbase, voff) do { _Pragma("unroll") for (int _i = 0; _i < 2; ++_i) \
        __builtin_amdgcn_global_load_lds((const unsigned*)((const char*)(gbase) + (voff)[_i]), (LAS unsigned*)(lds + (bufoff) + ldsw + _i * 8192), 16, 0, 0); } while (0)
#define PG8_LDA(dst, b, h) do { _Pragma("unroll") for (int m = 0; m < 4; ++m) _Pragma("unroll") for (int k = 0; k < 2; ++k) dst[m][k] = *(const LAS bf16x8*)(lds + PG8_SA(b, h) + aoff + m * 2048 + k * 1024); } while (0)
#define PG8_LDB(dst, b, h) do { _Pragma("unroll") for (int n = 0; n < 2; ++n) _Pragma("unroll") for (int k = 0; k < 2; ++k) dst[n][k] = *(const LAS bf16x8*)(lds + PG8_SB(b, h) + boff + n * 2048 + k * 1024); } while (0)
#define PG8_MMA(ai, bj, At, Bt) do { __builtin_amdgcn_s_setprio(1); _Pragma("unroll") for (int m = 0; m < 4; ++m) _Pragma("unroll") for (int n = 0; n < 2; ++n) _Pragma("unroll") for (int k = 0; k < 2; ++k) \
        acc[ai][bj][m][n] = __builtin_amdgcn_mfma_f32_16x16x32_bf16(Bt[n][k], At[m][k], acc[ai][bj][m][n], 0, 0, 0); __builtin_amdgcn_s_setprio(0); } while (0)
#define PG8_WAIT_V(n) asm volatile("s_waitcnt vmcnt(" #n ")" ::: "memory")
#define PG8_WAIT_L(n) asm volatile("s_waitcnt lgkmcnt(" #n ")" ::: "memory")
#define PG8_BAR __builtin_amdgcn_s_barrier()
#define PG8_SCHED __builtin_amdgcn_sched_barrier(0)
    int ui = 0, nt;
    const char* cA; const char* cB;
    { Unit u0; if (!S.next(0, u0)) return; cA = u0.a; cB = u0.b; nt = u0.kt; }
    f32x4 acc[2][2][4][2];
#pragma unroll
    for (int a = 0; a < 2; ++a)
#pragma unroll
        for (int b = 0; b < 2; ++b)
#pragma unroll
            for (int m = 0; m < 4; ++m)
#pragma unroll
                for (int n = 0; n < 2; ++n) acc[a][b][m][n] = (f32x4){0.f, 0.f, 0.f, 0.f};
    bf16x8 At[4][2], B0[2][2], B1[2][2];
    PG8_STAGE(PG8_SB(0, 0), cB, voffB); PG8_STAGE(PG8_SB(0, 1), cB + hstepB, voffB); PG8_STAGE(PG8_SA(0, 0), cA, voffA); PG8_STAGE(PG8_SA(0, 1), cA + hstepA, voffA);
    if (wr == 1) PG8_BAR;
    PG8_WAIT_V(2); PG8_BAR;
    PG8_STAGE(PG8_SB(1, 0), cB + kstep, voffB); PG8_STAGE(PG8_SA(1, 0), cA + kstep, voffA); PG8_STAGE(PG8_SB(1, 1), cB + hstepB + kstep, voffB);
    PG8_WAIT_V(6); PG8_BAR;
    for (;;) {
        bool has_next; const char* nA; const char* nB; int nnt;
        { Unit nx; has_next = S.next(ui + 1, nx); nA = has_next ? nx.a : cA; nB = has_next ? nx.b : cB; nnt = has_next ? nx.kt : nt; }
        for (int t = 0; t < nt; t += 2) {
            const bool last = (t == nt - 2);
            const char* a1 = cA + (size_t)(t + 1) * kstep;
            const char* a2 = last ? nA : cA + (size_t)(t + 2) * kstep; const char* b2 = last ? nB : cB + (size_t)(t + 2) * kstep;
            const char* a3 = a2 + kstep; const char* b3 = b2 + kstep;
            PG8_LDB(B0, 0, 0); PG8_LDB(B1, 0, 1); PG8_SCHED; PG8_LDA(At, 0, 0); PG8_STAGE(PG8_SA(1, 1), a1 + hstepA, voffA);
            PG8_WAIT_V(8); PG8_WAIT_L(0); PG8_BAR; PG8_MMA(0, 0, At, B0); PG8_MMA(0, 1, At, B1); PG8_BAR; PG8_SCHED;
            PG8_LDA(At, 0, 1); PG8_STAGE(PG8_SB(0, 0), b2, voffB); PG8_STAGE(PG8_SB(0, 1), b2 + hstepB, voffB); PG8_STAGE(PG8_SA(0, 0), a2, voffA);
            PG8_WAIT_V(8); PG8_WAIT_L(0); PG8_BAR; PG8_MMA(1, 0, At, B0); PG8_MMA(1, 1, At, B1); PG8_BAR; PG8_SCHED;
            PG8_LDB(B0, 1, 0); PG8_LDB(B1, 1, 1); PG8_SCHED; PG8_LDA(At, 1, 0); PG8_STAGE(PG8_SA(0, 1), a2 + hstepA, voffA);
            PG8_WAIT_V(8); PG8_WAIT_L(0); PG8_BAR; PG8_MMA(0, 0, At, B0); PG8_MMA(0, 1, At, B1); PG8_BAR; PG8_SCHED;
            PG8_LDA(At, 1, 1); PG8_STAGE(PG8_SB(1, 0), b3, voffB); PG8_STAGE(PG8_SB(1, 1), b3 + hstepB, voffB); PG8_STAGE(PG8_SA(1, 0), a3, voffA);
            PG8_WAIT_V(8); PG8_WAIT_L(0); PG8_BAR; PG8_MMA(1, 0, At, B0); PG8_MMA(1, 1, At, B1); PG8_BAR; PG8_SCHED;
        }
        if constexpr (ALIGN_EPI) { if (wr == 0) PG8_BAR; }
        { Unit cu; (void)S.next(ui, cu); const int t2 = tid_of(wv);
          const int w2 = __builtin_amdgcn_readfirstlane(t2 >> 6); E(acc, cu, w2 >> 2, w2 & 3, t2 & 15, (t2 & 63) >> 4); }
        if (!has_next) break;
#pragma unroll
        for (int a = 0; a < 2; ++a)
#pragma unroll
            for (int b = 0; b < 2; ++b)
#pragma unroll
                for (int m = 0; m < 4; ++m)
#pragma unroll
                    for (int n = 0; n < 2; ++n) acc[a][b][m][n] = (f32x4){0.f, 0.f, 0.f, 0.f};
        cA = nA; cB = nB; nt = nnt; ++ui;
        if constexpr (ALIGN_EPI) { if (wr == 1) PG8_BAR; }
    }
    PG8_WAIT_V(0);
    if constexpr (!ALIGN_EPI) { if (wr == 0) PG8_BAR; }
    PG8_BAR;
#undef PG8_SA
#undef PG8_SB
#undef PG8_STAGE
#undef PG8_LDA
#undef PG8_LDB
#undef PG8_MMA
#undef PG8_WAIT_V
#undef PG8_WAIT_L
#undef PG8_BAR
#undef PG8_SCHED
}

struct EpiProj {
    static constexpr bool PERM = true;
    bf16* proj; bf16* a2;
    __device__ __forceinline__ void operator()(const f32x4 (&acc)[2][2][4][2], const Unit& u, int wr, int wc, int fr, int fq) const {
        const int pn = u.pn; const bool gate = (pn >= 12 && pn < 20) || (pn >= 24 && pn < 28) || (pn >= 32); const bool isu = (pn >= 20 && pn < 24);
        const int row0 = u.pm * BM + wr * 64 + fr, col0 = pn * BM + wc * 32 + 8 * fq;
#pragma unroll
        for (int ai = 0; ai < 2; ++ai)
#pragma unroll
            for (int m = 0; m < 4; ++m) { const int row = row0 + ai * HALF + m * 16;
#pragma unroll
                for (int bj = 0; bj < 2; ++bj) { f32x4 v0 = acc[ai][bj][m][0], v1 = acc[ai][bj][m][1];
                    if (gate) {
#pragma unroll
                        for (int j = 0; j < 4; ++j) { v0[j] = silu_f(v0[j]); v1[j] = silu_f(v1[j]); } }
                    v4u w; w.x = cvt_pk_bf16(v0[0], v0[1]); w.y = cvt_pk_bf16(v0[2], v0[3]); w.z = cvt_pk_bf16(v1[0], v1[1]); w.w = cvt_pk_bf16(v1[2], v1[3]);
                    const int col = col0 + bj * HALF;
                    bf16* dst;
                    if (isu) { const int g = (col - OFF_U) >> 4, c0 = col & 15; dst = a2 + ((size_t)(g * 1024 + (row >> 4)) * 512 + (row & 15) * 16 + c0); }
                    else dst = proj + (size_t)row * INW + col;
                    *(v4u*)dst = w; } }
    }
};
struct EpiBf16 {
    static constexpr bool PERM = true;
    float scale;
    __device__ __forceinline__ void operator()(const f32x4 (&acc)[2][2][4][2], const Unit& u, int wr, int wc, int fr, int fq) const {
        bf16* base = (bf16*)u.c; const int ldc = u.ldc; const int row0 = wr * 64 + fr, col0 = wc * 32 + 8 * fq;
#pragma unroll
        for (int ai = 0; ai < 2; ++ai)
#pragma unroll
            for (int m = 0; m < 4; ++m) { bf16* rowp = base + (size_t)(row0 + ai * HALF + m * 16) * ldc + col0;
#pragma unroll
                for (int bj = 0; bj < 2; ++bj) { const f32x4 v0 = acc[ai][bj][m][0] * scale, v1 = acc[ai][bj][m][1] * scale;
                    v4u w; w.x = cvt_pk_bf16(v0[0], v0[1]); w.y = cvt_pk_bf16(v0[2], v0[3]); w.z = cvt_pk_bf16(v1[0], v1[1]); w.w = cvt_pk_bf16(v1[2], v1[3]);
                    *(v4u*)(rowp + bj * HALF) = w; } }
    }
};
struct EpiBf16X {
    static constexpr bool PERM = true;
    float scale; int aoff, boff;
    __device__ __forceinline__ void operator()(const f32x4 (&acc)[2][2][4][2], const Unit& u, int wr, int wc, int fr, int fq) const {
        bf16* base = (bf16*)u.c; const int ldc = u.ldc; const int row0 = wr * 64 + fr, col0 = wc * 32 + 8 * fq;
#pragma unroll
        for (int ai = 0; ai < 2; ++ai)
#pragma unroll
            for (int m = 0; m < 4; ++m) { bf16* rowp = base + (ai * aoff + (row0 + m * 16) * ldc + col0);
#pragma unroll
                for (int bj = 0; bj < 2; ++bj) { const f32x4 v0 = acc[ai][bj][m][0] * scale, v1 = acc[ai][bj][m][1] * scale;
                    v4u w; w.x = cvt_pk_bf16(v0[0], v0[1]); w.y = cvt_pk_bf16(v0[2], v0[3]); w.z = cvt_pk_bf16(v1[0], v1[1]); w.w = cvt_pk_bf16(v1[2], v1[3]);
                    *(v4u*)(rowp + bj * boff) = w; } }
    }
};
struct EpiF32 {
    static constexpr bool PERM = false;
    __device__ __forceinline__ void operator()(const f32x4 (&acc)[2][2][4][2], const Unit& u, int wr, int wc, int fr, int fq) const {
        float* base = (float*)u.c; const int ldc = u.ldc; const int row0 = wr * 64 + fr, col0 = wc * 32 + 4 * fq;
#pragma unroll
        for (int ai = 0; ai < 2; ++ai)
#pragma unroll
            for (int m = 0; m < 4; ++m) { float* rowp = base + (size_t)(row0 + ai * HALF + m * 16) * ldc + col0;
#pragma unroll
                for (int bj = 0; bj < 2; ++bj)
#pragma unroll
                    for (int n = 0; n < 2; ++n) *(f32x4*)(rowp + bj * HALF + n * 16) = acc[ai][bj][m][n]; }
    }
};
struct EpiLdsS {
    static constexpr bool PERM = true;
    LAS unsigned char* lds;
    __device__ __forceinline__ void operator()(const f32x4 (&acc)[2][2][4][2], const Unit& u, int wr, int wc, int fr, int fq) const {
        asm volatile("s_waitcnt vmcnt(0)" ::: "memory"); __builtin_amdgcn_s_barrier();
        const int row0 = wr * 64 + fr, ch0 = wc * 4 + fq; (void)u;
#pragma unroll
        for (int ai = 0; ai < 2; ++ai)
#pragma unroll
            for (int m = 0; m < 4; ++m) { const int r = row0 + ai * HALF + m * 16;
#pragma unroll
                for (int bj = 0; bj < 2; ++bj) { const f32x4 v0 = acc[ai][bj][m][0], v1 = acc[ai][bj][m][1];
                    v4u w; w.x = cvt_pk_bf16(v0[0], v0[1]); w.y = cvt_pk_bf16(v0[2], v0[3]); w.z = cvt_pk_bf16(v1[0], v1[1]); w.w = cvt_pk_bf16(v1[2], v1[3]);
                    *(LAS v4u*)(lds + r * 512 + (((ch0 + bj * 16) ^ fr) << 4)) = w; } }
    }
};
struct EpiSsmY {
    static constexpr bool PERM = true;
    bf16* yssm;
    __device__ __forceinline__ void operator()(const f32x4 (&acc)[2][2][4][2], const Unit& u, int wr, int wc, int fr, int fq) const {
        const int row0 = u.z + wr * 64 + fr, col0 = wc * 32 + 8 * fq, g = u.pn;
#pragma unroll
        for (int ai = 0; ai < 2; ++ai)
#pragma unroll
            for (int m = 0; m < 4; ++m) { const int chunk = row0 + ai * HALF + m * 16;
#pragma unroll
                for (int bj = 0; bj < 2; ++bj) { const f32x4 v0 = acc[ai][bj][m][0], v1 = acc[ai][bj][m][1];
                    v4u w; w.x = cvt_pk_bf16(v0[0], v0[1]); w.y = cvt_pk_bf16(v0[2], v0[3]); w.z = cvt_pk_bf16(v1[0], v1[1]); w.w = cvt_pk_bf16(v1[2], v1[3]);
                    const int col = col0 + bj * HALF, i = col >> 4, c0 = col & 15;
                    *(v4u*)(yssm + (size_t)(chunk * 16 + i) * 1024 + g * 16 + c0) = w; } }
    }
};
struct EpiGlu {
    static constexpr bool PERM = true;
    const bf16* proj; bf16* mix;
    __device__ __forceinline__ void operator()(const f32x4 (&acc)[2][2][4][2], const Unit& u, int wr, int wc, int fr, int fq) const {
        const int row0 = u.pm * BM + wr * 64 + fr, col0 = u.pn * HALF + wc * 32 + 8 * fq;
#pragma unroll
        for (int ai = 0; ai < 2; ++ai)
#pragma unroll
            for (int m = 0; m < 4; ++m) { const int row = row0 + ai * HALF + m * 16;
                const v4u gs = *(const v4u*)(proj + (size_t)row * INW + OFF_GS + col0);
                const f32x4 a0 = acc[ai][0][m][0], a1 = acc[ai][0][m][1], g0 = acc[ai][1][m][0], g1 = acc[ai][1][m][1];
                float o[8];
#pragma unroll
                for (int j = 0; j < 4; ++j) { o[j] = a0[j] * sigmoid_f(g0[j]); o[4 + j] = a1[j] * sigmoid_f(g1[j]); }
                o[0] *= bf_lo(gs.x); o[1] *= bf_hi(gs.x); o[2] *= bf_lo(gs.y); o[3] *= bf_hi(gs.y); o[4] *= bf_lo(gs.z); o[5] *= bf_hi(gs.z); o[6] *= bf_lo(gs.w); o[7] *= bf_hi(gs.w);
                v4u w; w.x = cvt_pk_bf16(o[0], o[1]); w.y = cvt_pk_bf16(o[2], o[3]); w.z = cvt_pk_bf16(o[4], o[5]); w.w = cvt_pk_bf16(o[6], o[7]);
                *(v4u*)(mix + (size_t)row * DM + 2048 + col0) = w; }
    }
};
struct EpiFftW {
    static constexpr bool PERM = true;
    const bf16* proj; bf16* mix;
    __device__ __forceinline__ void operator()(const f32x4 (&acc)[2][2][4][2], const Unit& u, int wr, int wc, int fr, int fq) const {
        const int row0 = u.pm * BM + wr * 64 + fr, col0 = u.pn * BM + wc * 32 + 8 * fq;
#pragma unroll
        for (int ai = 0; ai < 2; ++ai)
#pragma unroll
            for (int m = 0; m < 4; ++m) { const int row = row0 + ai * HALF + m * 16;
#pragma unroll
                for (int bj = 0; bj < 2; ++bj) { const int col = col0 + bj * HALF;
                    const v4u gs = *(const v4u*)(proj + (size_t)row * INW + OFF_GF + col);
                    const f32x4 v0 = acc[ai][bj][m][0], v1 = acc[ai][bj][m][1];
                    v4u w; w.x = cvt_pk_bf16(v0[0] * bf_lo(gs.x), v0[1] * bf_hi(gs.x)); w.y = cvt_pk_bf16(v0[2] * bf_lo(gs.y), v0[3] * bf_hi(gs.y));
                    w.z = cvt_pk_bf16(v1[0] * bf_lo(gs.z), v1[1] * bf_hi(gs.z)); w.w = cvt_pk_bf16(v1[2] * bf_lo(gs.w), v1[3] * bf_hi(gs.w));
                    *(v4u*)(mix + (size_t)row * DM + 3072 + col) = w; } }
    }
};
struct EpiOut {
    static constexpr bool PERM = true;
    bf16* delta; const float* modl;
    __device__ __forceinline__ void operator()(const f32x4 (&acc)[2][2][4][2], const Unit& u, int wr, int wc, int fr, int fq) const {
        const int rt = u.pm * BM; const int v = rt < NCTX ? 0 : (rt < NCTX + 4096 ? 1 : 2);
        const float* gv = modl + v * 12288 + 8192;
        const int row0 = rt + wr * 64 + fr, col0 = u.pn * BM + wc * 32 + 8 * fq;
        f32x4 gt[2][2];
#pragma unroll
        for (int bj = 0; bj < 2; ++bj)
#pragma unroll
            for (int n = 0; n < 2; ++n) gt[bj][n] = *(const f32x4*)(gv + col0 + bj * HALF + n * 4);
#pragma unroll
        for (int ai = 0; ai < 2; ++ai)
#pragma unroll
            for (int m = 0; m < 4; ++m) { bf16* rowp = delta + (size_t)(row0 + ai * HALF + m * 16) * DM + col0;
#pragma unroll
                for (int bj = 0; bj < 2; ++bj) { const f32x4 v0 = acc[ai][bj][m][0] * gt[bj][0], v1 = acc[ai][bj][m][1] * gt[bj][1];
                    v4u w; w.x = cvt_pk_bf16(v0[0], v0[1]); w.y = cvt_pk_bf16(v0[2], v0[3]); w.z = cvt_pk_bf16(v1[0], v1[1]); w.w = cvt_pk_bf16(v1[2], v1[3]);
                    *(v4u*)(rowp + bj * HALF) = w; } }
    }
};
}

namespace att {
constexpr int D = 128, QBLK = 32, KVBLK = 64;
constexpr float SCALE = 0.088388347648318440f;
constexpr float THR = 8.f;
constexpr int SHM_V = KVBLK * D * 2, SHM_K = KVBLK * D * 2;
constexpr int WS_OFF = 2 * SHM_V + 2 * SHM_K, OSTG_OFF = WS_OFF + NWAVES * 64 * 4, OSTG_ROW = 272, OSTG_WAVE = 32 * OSTG_ROW;
static_assert(DEPTH >= 2, "the bf16 stream is first written by layer 1's norm phase");
static_assert(OSTG_OFF + NWAVES * OSTG_WAVE <= MISC_OFF, "attention LDS");
#define KSWZ(row, colB) ((row) * 256 + ((colB) ^ (((row) & 7) << 4)))
#define SBAR() __builtin_amdgcn_sched_barrier(0)
__device__ __forceinline__ int crow(int r, int hi) { return (r & 3) + 8 * (r >> 2) + 4 * hi; }
__device__ __forceinline__ void partialSM(f32x16& p0, f32x16& p1, float& m_reg, float& mn, float& alpha) {
  constexpr float C = SCALE * 1.4426950408889634f;
  float pmax = p0[0]; for (int r = 1; r < 16; ++r) pmax = fmaxf(pmax, p0[r]); for (int r = 0; r < 16; ++r) pmax = fmaxf(pmax, p1[r]);
  { auto rr = __builtin_amdgcn_permlane32_swap(__float_as_uint(pmax), __float_as_uint(pmax), false, false);
    pmax = fmaxf(__uint_as_float(rr[0]), __uint_as_float(rr[1])); }
  if (__builtin_expect(__all(pmax - m_reg <= THR / SCALE), 1)) { mn = m_reg; alpha = 1.f; }
  else { mn = fmaxf(m_reg, pmax); alpha = __builtin_amdgcn_exp2f((m_reg - mn) * C); m_reg = mn; }
  float mnC = -mn * C;
  for (int r = 0; r < 16; ++r) p0[r] = fmaf(p0[r], C, mnC); for (int r = 0; r < 16; ++r) p1[r] = fmaf(p1[r], C, mnC);
  for (int r = 0; r < 16; ++r) p0[r] = __builtin_amdgcn_exp2f(p0[r]);
}
__device__ __forceinline__ void finishSM(f32x16& p0, f32x16& p1, float alpha, float& l_reg, bf16x8& pa0, bf16x8& pa1, bf16x8& pa2, bf16x8& pa3) {
  for (int r = 0; r < 16; ++r) p1[r] = __builtin_amdgcn_exp2f(p1[r]);
  float ps = 0; for (int r = 0; r < 16; ++r) ps += p0[r]; for (int r = 0; r < 16; ++r) ps += p1[r];
  { auto rr = __builtin_amdgcn_permlane32_swap(__float_as_uint(ps), __float_as_uint(ps), false, false);
    ps = __uint_as_float(rr[0]) + __uint_as_float(rr[1]); }
  l_reg = l_reg * alpha + ps;
#define PK4(P, BASE, OUT) do { unsigned a0 = cvt_pk_bf16(P[BASE + 0], P[BASE + 1]), a1 = cvt_pk_bf16(P[BASE + 2], P[BASE + 3]);   \
    unsigned b0 = cvt_pk_bf16(P[BASE + 4], P[BASE + 5]), b1 = cvt_pk_bf16(P[BASE + 6], P[BASE + 7]);                              \
    auto r0 = __builtin_amdgcn_permlane32_swap(a0, b0, false, false); auto r1 = __builtin_amdgcn_permlane32_swap(a1, b1, false, false); \
    v4u w = {r0[0], r1[0], r0[1], r1[1]}; OUT = *reinterpret_cast<bf16x8*>(&w); } while (0)
  PK4(p0, 0, pa0); PK4(p0, 8, pa1); PK4(p1, 0, pa2); PK4(p1, 8, pa3);
#undef PK4
}
__device__ __forceinline__ void qkt(f32x16& p0, f32x16& p1, const char* Ks, const bf16x8* qr, int r32, int hi) {
  p0 = f32x16{}; p1 = f32x16{};
  for (int d0 = 0; d0 < 8; ++d0) { int cb = (d0 * 16 + hi * 8) * 2;
    bf16x8 b0 = *reinterpret_cast<const bf16x8*>(Ks + KSWZ(r32, cb));
    bf16x8 b1 = *reinterpret_cast<const bf16x8*>(Ks + KSWZ(32 + r32, cb));
    p0 = __builtin_amdgcn_mfma_f32_32x32x16_bf16(b0, qr[d0], p0, 0, 0, 0);
    p1 = __builtin_amdgcn_mfma_f32_32x32x16_bf16(b1, qr[d0], p1, 0, 0, 0); }
}
__device__ __forceinline__ int v_st(int k, int c) { const int kk = (k & ~0xC) | ((k & 4) << 1) | ((k & 8) >> 1); return ((kk >> 3) * 4 + (c >> 5)) * 512 + ((kk & 7) * 32 + (c & 31)) * 2; }
__device__ __forceinline__ int v_rd_base(int lane) { return ((lane & 3) << 3) | (((lane >> 2) & 3) << 6) | (((lane >> 4) & 1) << 5) | (((lane >> 5) & 1) << 8); }
constexpr int v_rd_off(int d0, int ks, int half) { return d0 * 512 + ks * 4096 + half * 2048; }
template <int OFF> __device__ __forceinline__ s16x4 tr_read(int vb) {
  s16x4 r; asm volatile("ds_read_b64_tr_b16 %0, %1 offset:%2" : "=&v"(r) : "v"(vb), "i"(OFF) : "memory"); return r;
}
template <int D0> __device__ __forceinline__ void pv_one(f32x16& od, int vb, bf16x8 pa0, bf16x8 pa1, bf16x8 pa2, bf16x8 pa3) {
  const s16x4 l0 = tr_read<v_rd_off(D0, 0, 0)>(vb), h0 = tr_read<v_rd_off(D0, 0, 1)>(vb), l1 = tr_read<v_rd_off(D0, 1, 0)>(vb), h1 = tr_read<v_rd_off(D0, 1, 1)>(vb);
  const s16x4 l2 = tr_read<v_rd_off(D0, 2, 0)>(vb), h2 = tr_read<v_rd_off(D0, 2, 1)>(vb), l3 = tr_read<v_rd_off(D0, 3, 0)>(vb), h3 = tr_read<v_rd_off(D0, 3, 1)>(vb);
  asm volatile("s_waitcnt lgkmcnt(0)" ::: "memory"); SBAR();
#define PK(L, H) (bf16x8){L[0], L[1], L[2], L[3], H[0], H[1], H[2], H[3]}
  od = __builtin_amdgcn_mfma_f32_32x32x16_bf16(pa0, PK(l0, h0), od, 0, 0, 0);
  od = __builtin_amdgcn_mfma_f32_32x32x16_bf16(pa1, PK(l1, h1), od, 0, 0, 0);
  od = __builtin_amdgcn_mfma_f32_32x32x16_bf16(pa2, PK(l2, h2), od, 0, 0, 0);
  od = __builtin_amdgcn_mfma_f32_32x32x16_bf16(pa3, PK(l3, h3), od, 0, 0, 0);
#undef PK
}
__device__ __forceinline__ void pv_d0(f32x16* o, int vb, bf16x8 pa0, bf16x8 pa1, bf16x8 pa2, bf16x8 pa3) {
  pv_one<0>(o[0], vb, pa0, pa1, pa2, pa3); pv_one<1>(o[1], vb, pa0, pa1, pa2, pa3); pv_one<2>(o[2], vb, pa0, pa1, pa2, pa3); pv_one<3>(o[3], vb, pa0, pa1, pa2, pa3);
}

__device__ __forceinline__ void attn_unit(const bf16* __restrict__ Qb, const bf16* __restrict__ Gb, bf16* __restrict__ Ob,
                                          const bf16* __restrict__ K0, const bf16* __restrict__ V0, int ld0, int nt0,
                                          const bf16* __restrict__ K1, const bf16* __restrict__ V1, int ld1, int nt1,
                                          const float* __restrict__ qn, const f32x2* __restrict__ rope, int tok0, char* lds, int wv) {
  const int tid = tid_of(wv);
  const int wid = tid >> 6, lane = tid & 63, r32 = lane & 31, hi = lane >> 5;
  char* V_lds = lds; char* K_lds = lds + 2 * SHM_V;
  float* ws = (float*)(lds + WS_OFF) + wid * 64; float* li_l = ws; float* al_l = ws + 32;
  float m_reg = -1e30f, l_reg = 0; f32x16 o[4] = {}; bf16x8 qr[8];
  const int sr = tid >> 4, sc = (tid & 15) * 8, vst0 = v_st(sr, sc), vst1 = v_st(32 + sr, sc);
  const int vb0 = (int)(uintptr_t)V_lds + v_rd_base(lane);
  struct { bf16x8 vs0, vs1, ks0, ks1; } sr_[2];
#define SLOAD(i, jt) do { const bf16* kb_; const bf16* vb_; long ld_; \
    if ((jt) < nt0) { kb_ = K0 + (long)(jt) * KVBLK * ld0; vb_ = V0 + (long)(jt) * KVBLK * ld0; ld_ = ld0; } else { kb_ = K1 + (long)((jt) - nt0) * KVBLK * ld1; vb_ = V1 + (long)((jt) - nt0) * KVBLK * ld1; ld_ = ld1; } \
    sr_[i].vs0 = *reinterpret_cast<const bf16x8*>(vb_ + (long)sr * ld_ + sc); sr_[i].vs1 = *reinterpret_cast<const bf16x8*>(vb_ + (long)(32 + sr) * ld_ + sc); \
    sr_[i].ks0 = *reinterpret_cast<const bf16x8*>(kb_ + (long)sr * ld_ + sc); sr_[i].ks1 = *reinterpret_cast<const bf16x8*>(kb_ + (long)(32 + sr) * ld_ + sc); } while (0)
  SLOAD(0, 0);
  __syncthreads();
  {
    const bf16* Qw = Qb + (long)(wid * QBLK + r32) * INW + hi * 8;
    float x[8][8]; float ss = 0.f;
#pragma unroll
    for (int d0 = 0; d0 < 8; ++d0) { const v4u raw = *reinterpret_cast<const v4u*>(Qw + d0 * 16);
      x[d0][0] = bf_lo(raw.x); x[d0][1] = bf_hi(raw.x); x[d0][2] = bf_lo(raw.y); x[d0][3] = bf_hi(raw.y); x[d0][4] = bf_lo(raw.z); x[d0][5] = bf_hi(raw.z); x[d0][6] = bf_lo(raw.w); x[d0][7] = bf_hi(raw.w);
#pragma unroll
      for (int j = 0; j < 8; ++j) ss += x[d0][j] * x[d0][j]; }
    { auto rr = __builtin_amdgcn_permlane32_swap(__float_as_uint(ss), __float_as_uint(ss), false, false); ss = __uint_as_float(rr[0]) + __uint_as_float(rr[1]); }
    const float rstd = rsqrtf(ss * (1.0f / 128.0f) + NORM_EPS);
#pragma unroll
    for (int d0 = 0; d0 < 8; ++d0) { const f32x4 w0 = *reinterpret_cast<const f32x4*>(qn + d0 * 16 + hi * 8), w1 = *reinterpret_cast<const f32x4*>(qn + d0 * 16 + hi * 8 + 4);
#pragma unroll
      for (int j = 0; j < 4; ++j) { x[d0][j] *= rstd * w0[j]; x[d0][4 + j] *= rstd * w1[j]; } }
    if (rope) {
      const int t = tok0 + wid * QBLK + r32, prow = t >> 6, pcol = t & 63;
#pragma unroll
      for (int half = 0; half < 2; ++half) { const f32x2* rp = rope + (half ? pcol : prow) * 32;
#pragma unroll
        for (int dd = 0; dd < 2; ++dd) { const int d0 = half * 4 + dd;
#pragma unroll
          for (int j = 0; j < 8; ++j) { const f32x2 cs = rp[dd * 16 + hi * 8 + j]; const float x1 = x[d0][j], x2 = x[d0 + 2][j];
            x[d0][j] = x1 * cs.x - x2 * cs.y; x[d0 + 2][j] = x1 * cs.y + x2 * cs.x; } } }
    }
#pragma unroll
    for (int d0 = 0; d0 < 8; ++d0) { v4u w = {cvt_pk_bf16(x[d0][0], x[d0][1]), cvt_pk_bf16(x[d0][2], x[d0][3]), cvt_pk_bf16(x[d0][4], x[d0][5]), cvt_pk_bf16(x[d0][6], x[d0][7])}; qr[d0] = *reinterpret_cast<bf16x8*>(&w); }
  }
#define SWRITE(b, i) do { *(bf16x8*)(V_lds + (b) * SHM_V + vst0) = sr_[i].vs0;          \
    *(bf16x8*)(V_lds + (b) * SHM_V + vst1) = sr_[i].vs1; int kc = sc * 2;               \
    *(bf16x8*)(K_lds + (b) * SHM_K + KSWZ(sr, kc)) = sr_[i].ks0;                       \
    *(bf16x8*)(K_lds + (b) * SHM_K + KSWZ(32 + sr, kc)) = sr_[i].ks1; } while (0)
#define SWAIT() asm volatile("s_waitcnt vmcnt(4)" ::: "memory")
#define RESC(a) do { if (__any((a) < 1.f)) { if (hi == 0) al_l[r32] = (a); asm volatile("s_waitcnt lgkmcnt(0)" ::: "memory"); \
    for (int d = 0; d < 4; ++d) for (int r = 0; r < 16; ++r) o[d][r] *= al_l[crow(r, hi)]; } } while (0)
  f32x16 pA0, pA1, pB0, pB1; float mnA, mnB, alA, alB; bf16x8 pa0, pa1, pa2, pa3; const int NT = nt0 + nt1;
  constexpr int SE = 0, SO = 1;
  asm volatile("s_waitcnt vmcnt(0)" ::: "memory"); SWRITE(0, SE); __syncthreads();
  qkt(pA0, pA1, K_lds, qr, r32, hi); partialSM(pA0, pA1, m_reg, mnA, alA);
  SLOAD(SO, 1); if (2 < NT) SLOAD(SE, 2);
  SWAIT(); SWRITE(1, SO); __syncthreads();
  for (int j = 1; j + 1 < NT; j += 2) {
    SBAR(); qkt(pB0, pB1, K_lds + SHM_K, qr, r32, hi);
    finishSM(pA0, pA1, alA, l_reg, pa0, pa1, pa2, pa3); SBAR();
    SLOAD(SO, j + 2); SBAR();
    pv_d0(o, vb0, pa0, pa1, pa2, pa3); partialSM(pB0, pB1, m_reg, mnB, alB);
    __syncthreads(); SWAIT(); SWRITE(0, SE);
    RESC(alB); __syncthreads();
    SBAR(); qkt(pA0, pA1, K_lds, qr, r32, hi);
    finishSM(pB0, pB1, alB, l_reg, pa0, pa1, pa2, pa3); SBAR();
    if (j + 3 < NT) SLOAD(SE, j + 3); SBAR();
    pv_d0(o, vb0 + SHM_V, pa0, pa1, pa2, pa3); partialSM(pA0, pA1, m_reg, mnA, alA);
    __syncthreads(); SWAIT(); SWRITE(1, SO);
    RESC(alA); __syncthreads();
  }
  SBAR(); qkt(pB0, pB1, K_lds + SHM_K, qr, r32, hi);
  finishSM(pA0, pA1, alA, l_reg, pa0, pa1, pa2, pa3); SBAR();
  pv_d0(o, vb0, pa0, pa1, pa2, pa3); partialSM(pB0, pB1, m_reg, mnB, alB);
  __syncthreads(); RESC(alB);
  finishSM(pB0, pB1, alB, l_reg, pa0, pa1, pa2, pa3); SBAR();
  pv_d0(o, vb0 + SHM_V, pa0, pa1, pa2, pa3);
  if (hi == 0) li_l[r32] = l_reg; asm volatile("s_waitcnt lgkmcnt(0)" ::: "memory");
  char* stg = lds + OSTG_OFF + wid * OSTG_WAVE;
  v4u gvv[8];
#pragma unroll
  for (int it = 0; it < 8; ++it) gvv[it] = *reinterpret_cast<const v4u*>(Gb + (long)(wid * QBLK + it * 4 + (lane >> 4)) * INW + (lane & 15) * 8);
#pragma unroll
  for (int r = 0; r < 16; ++r) { const int orow = crow(r, hi); const float rl = __builtin_amdgcn_rcpf(li_l[orow]);
#pragma unroll
    for (int d0 = 0; d0 < 4; ++d0) { const unsigned w = cvt_pk_bf16(o[d0][r] * rl, 0.f); *(bf16*)(stg + orow * OSTG_ROW + (d0 * 32 + r32) * 2) = (bf16)(w & 0xffffu); }
    if ((r & 3) == 3) asm volatile("" ::: "memory"); }
  asm volatile("s_waitcnt lgkmcnt(0)" ::: "memory");
#pragma unroll
  for (int it = 0; it < 8; ++it) { const int row = it * 4 + (lane >> 4), cc = (lane & 15) * 8;
    const v4u ov = *(const v4u*)(stg + row * OSTG_ROW + cc * 2);
    const v4u gv = gvv[it];
    v4u w; w.x = cvt_pk_bf16(bf_lo(ov.x) * bf_lo(gv.x), bf_hi(ov.x) * bf_hi(gv.x)); w.y = cvt_pk_bf16(bf_lo(ov.y) * bf_lo(gv.y), bf_hi(ov.y) * bf_hi(gv.y));
    w.z = cvt_pk_bf16(bf_lo(ov.z) * bf_lo(gv.z), bf_hi(ov.z) * bf_hi(gv.z)); w.w = cvt_pk_bf16(bf_lo(ov.w) * bf_lo(gv.w), bf_hi(ov.w) * bf_hi(gv.w));
    *reinterpret_cast<v4u*>(Ob + (long)(wid * QBLK + row) * DM + cc) = w; }
#undef SLOAD
#undef SWRITE
#undef SWAIT
#undef RESC
}
}

#define XB_TMO      128
#define XB_XCNT(j)  (256  + 64 * (j))
#define XB_XSUB(j)  (1280 + 64 * (j))
#define XB_XGEN(j)  (2304 + 64 * (j))
#define XB_TOP      3328
#define XB_TOPGEN   3392
#define XCD_BAR_WORDS 3456
#define XB_SPIN_CAP (1u << 18)
__device__ __forceinline__ unsigned xb_ld(unsigned* p)              { return __hip_atomic_load(p, __ATOMIC_RELAXED, __HIP_MEMORY_SCOPE_AGENT); }
__device__ __forceinline__ unsigned xb_add(unsigned* p, unsigned v) { return __hip_atomic_fetch_add(p, v, __ATOMIC_RELAXED, __HIP_MEMORY_SCOPE_AGENT); }
__device__ __forceinline__ unsigned xb_xcc_id() { return (unsigned)__builtin_amdgcn_s_getreg((3 << 11) | 20) & 0xFu; }
#define XB_SPIN(cond, bar) do { unsigned _sp = 0; while (cond) { __builtin_amdgcn_s_sleep(1); \
    if ((++_sp & 255u) == 0u) { if (xb_ld(&(bar)[XB_TMO])) break; if (_sp > XB_SPIN_CAP) { atomicAdd(&(bar)[XB_TMO], 1u); break; } } } } while (0)
struct XcdBarrier { unsigned* bar; unsigned x; volatile LAS unsigned* st; };
__device__ __forceinline__ XcdBarrier xcd_barrier_post(unsigned* bar, volatile LAS unsigned* st, int tid) {
    XcdBarrier b; b.bar = bar; b.x = xb_xcc_id(); b.st = st;
    if (tid == 0) (void)xb_add(&bar[XB_XCNT(b.x)], 1u);
    return b;
}
__device__ __forceinline__ void xcd_barrier_complete(unsigned* bar, unsigned x, unsigned& nloc, unsigned& nx) {
    const unsigned G = gridDim.x * gridDim.y * gridDim.z;
    unsigned sum, cnt, mine, sp = 0u;
    for (;;) {
        sum = 0u; cnt = 0u; mine = 0u;
#pragma nounroll
        for (unsigned j = 0; j < 16; ++j) { const unsigned c = xb_ld(&bar[XB_XCNT(j)]); sum += c; cnt += (c > 0u) ? 1u : 0u; mine = (j == x) ? c : mine; }
        if (sum == G) break;
        __builtin_amdgcn_s_sleep(1);
        if ((++sp & 255u) == 0u) { if (xb_ld(&bar[XB_TMO])) break; if (sp > XB_SPIN_CAP) { atomicAdd(&bar[XB_TMO], 1u); break; } }
    }
    nloc = mine > 0u ? mine : 1u; nx = cnt > 0u ? cnt : 1u;
}
__device__ __forceinline__ void xcd_barrier(const XcdBarrier& b, int wv) {
    asm volatile("s_waitcnt vmcnt(0)" ::: "memory");
    __syncthreads();
    if (tid_of(wv) == 0) {
        unsigned* bar = b.bar;
        __builtin_amdgcn_s_waitcnt(0);
        unsigned nloc = b.st[0], nx = b.st[1];
        if (nloc == 0u) { xcd_barrier_complete(bar, b.x, nloc, nx); b.st[0] = nloc; b.st[1] = nx; }
        const unsigned old = xb_add(&bar[XB_XSUB(b.x)], 1u);
        const unsigned gen = old / nloc;
        if (old + 1u == (gen + 1u) * nloc) {
            __builtin_amdgcn_fence(__ATOMIC_RELEASE, "agent");
            asm volatile("s_waitcnt vmcnt(0)" ::: "memory");
            const unsigned og = xb_add(&bar[XB_TOP], 1u);
            const unsigned tg = og / nx;
            if (og + 1u == (tg + 1u) * nx) xb_add(&bar[XB_TOPGEN], 1u);
            else XB_SPIN(xb_ld(&bar[XB_TOPGEN]) == tg, bar);
            __builtin_amdgcn_fence(__ATOMIC_ACQUIRE, "agent");
            xb_add(&bar[XB_XGEN(b.x)], 1u);
            asm volatile("s_waitcnt vmcnt(0)" ::: "memory");
        } else {
            XB_SPIN(xb_ld(&bar[XB_XGEN(b.x)]) == gen, bar);
            __builtin_amdgcn_fence(__ATOMIC_ACQUIRE, "agent");
            asm volatile("s_waitcnt vmcnt(0)" ::: "memory");
        }
    }
    __syncthreads();
}
__device__ __forceinline__ void wg_global_sync() {
    asm volatile("s_waitcnt vmcnt(0)" ::: "memory");
    __syncthreads();
    __builtin_amdgcn_fence(__ATOMIC_ACQUIRE, "agent");
    asm volatile("s_waitcnt vmcnt(0)" ::: "memory");
}

struct Args { const float* in[28]; float* out; unsigned char* ws; int ph_lo, ph_hi; };
typedef const __attribute__((address_space(4))) Args* KAP;
#define KA_HERE() KAP ka = (KAP)__builtin_amdgcn_kernarg_segment_ptr(); asm volatile("" : "+s"(ka))
enum { I_XP = 0, I_XS, I_CK, I_CV, I_SFR, I_SFI, I_SBR, I_SBI, I_C, I_CCTX, I_NG, I_WMOD, I_BMOD, I_WIN, I_QN, I_KN, I_LRE, I_LIM, I_LSTEP, I_BRE, I_BIM, I_CRE, I_CIM, I_DSKIP, I_WGLU, I_WFFT, I_WOUT, I_FNG };

__device__ __forceinline__ int glu_row(int n) { return n < 1024 ? ((n >> 7) * 256 + (n & 127)) : (((n - 1024) >> 7) * 256 + 128 + ((n - 1024) & 127)); }
template <bool GLU>
__device__ __forceinline__ void tr_item(const float* __restrict__ W, int K, int N, bf16* __restrict__ WT, LAS float* scr, int item, int lane) {
    const int nblk = N / 64, kb = item / nblk, nb = item % nblk, k0 = 64 * kb, n0 = 64 * nb;
#pragma unroll 8
    for (int i = 0; i < 64; ++i) scr[i * 65 + lane] = W[(size_t)(k0 + i) * N + n0 + lane];
    LDS_WAIT(); asm volatile("" ::: "memory");
    const int c = lane & 7;
#pragma unroll
    for (int j = 0; j < 8; ++j) { const int n = (lane >> 3) + 8 * j; const LAS float* s = scr + (8 * c) * 65 + n;
        v4u o; o.x = cvt_pk_bf16(s[0 * 65], s[1 * 65]); o.y = cvt_pk_bf16(s[2 * 65], s[3 * 65]); o.z = cvt_pk_bf16(s[4 * 65], s[5 * 65]); o.w = cvt_pk_bf16(s[6 * 65], s[7 * 65]);
        int nd = n0 + n; if (GLU) nd = glu_row(nd);
        *(v4u*)(WT + (size_t)nd * K + k0 + 8 * c) = o; }
    LDS_WAIT(); asm volatile("" ::: "memory");
}

__device__ __forceinline__ void ssm_matrices(KAP A, int l, int g, LAS unsigned char* lds, int tid) {
    LAS f32x2* pw = (LAS f32x2*)lds;
    LAS f32x2* bb = pw + 2 * 17 * 64;
    LAS f32x2* cc = bb + 2 * 64 * 16;
    LAS float* kk = (LAS float*)(cc + 2 * 16 * 64);
    if (tid < 128) {
        const int dir = tid >> 6, p = tid & 63, ig = (l * 2 + dir) * 64 + g;
        const float dt = expf(A->in[I_LSTEP][ig]);
        const float lr = A->in[I_LRE][(size_t)ig * 64 + p], li = A->in[I_LIM][(size_t)ig * 64 + p];
        for (int tau = 0; tau <= 16; ++tau) {
            const float mag = expf(lr * dt * (float)tau);
            const double turns = (double)li * (double)dt * (double)tau * 0.15915494309189535;
            const float fr = (float)(turns - rint(turns));
            pw[(dir * 17 + tau) * 64 + p] = (f32x2){mag * cospif(2.f * fr), mag * sinpif(2.f * fr)};
        }
        const f32x2 ab = pw[(dir * 17 + 1) * 64 + p];
        const float nr = ab.x - 1.0f, ni = ab.y, den = lr * lr + li * li;
        const float f_re = (nr * lr + ni * li) / den, f_im = (ni * lr - nr * li) / den;
        for (int c = 0; c < 16; ++c) { const float br = A->in[I_BRE][((size_t)ig * 64 + p) * 16 + c], bi = A->in[I_BIM][((size_t)ig * 64 + p) * 16 + c];
            bb[(dir * 64 + p) * 16 + c] = (f32x2){f_re * br - f_im * bi, f_re * bi + f_im * br}; }
        ((f32x2*)(A->ws + WS_A16))[(size_t)ig * 64 + p] = pw[(dir * 17 + 16) * 64 + p];
    }
    for (int idx = tid; idx < 2048; idx += 512) { const int dir = idx >> 10, c = (idx >> 6) & 15, p = idx & 63; const size_t gi = (((size_t)(l * 2 + dir) * 64 + g) * 16 + c) * 64 + p;
        cc[idx] = (f32x2){A->in[I_CRE][gi], A->in[I_CIM][gi]}; }
    __syncthreads();
    {
        const int dir = tid >> 8, tau = (tid >> 4) & 15, c = tid & 15;
        float accv[16];
#pragma unroll
        for (int j = 0; j < 16; ++j) accv[j] = 0.f;
        for (int p = 0; p < 64; ++p) { const f32x2 cv = cc[(dir * 16 + c) * 64 + p], pv = pw[(dir * 17 + tau) * 64 + p];
            const float wre = cv.x * pv.x - cv.y * pv.y, wim = cv.x * pv.y + cv.y * pv.x;
#pragma unroll
            for (int j = 0; j < 16; ++j) { const f32x2 bv = bb[(dir * 64 + p) * 16 + j]; accv[j] += wre * bv.x - wim * bv.y; } }
#pragma unroll
        for (int j = 0; j < 16; ++j) kk[((dir * 16 + tau) * 16 + c) * 16 + j] = accv[j];
    }
    __syncthreads();
    const int lg = l * 64 + g;
    bf16* Pm = (bf16*)(A->ws + WS_PMAT) + (size_t)lg * 256 * 256;
    for (int q = tid; q < 8192; q += 512) { const int R = q >> 5, col = (q & 31) * 8, s = col >> 4, c0 = col & 15, dir = R >> 7, reim = (R >> 6) & 1, p = R & 63, e = dir ? s : 15 - s;
        const f32x2 pv = pw[(dir * 17 + e) * 64 + p]; float v[8];
#pragma unroll
        for (int j = 0; j < 8; ++j) { const f32x2 bv = bb[(dir * 64 + p) * 16 + c0 + j]; v[j] = reim ? (pv.x * bv.y + pv.y * bv.x) : (pv.x * bv.x - pv.y * bv.y); }
        v4u w; w.x = cvt_pk_bf16(v[0], v[1]); w.y = cvt_pk_bf16(v[2], v[3]); w.z = cvt_pk_bf16(v[4], v[5]); w.w = cvt_pk_bf16(v[6], v[7]);
        *(v4u*)(Pm + (size_t)R * 256 + col) = w; }
    bf16* KGm = (bf16*)(A->ws + WS_KG) + (size_t)lg * 256 * 512;
    for (int q = tid; q < 16384; q += 512) { const int R = q >> 6, col = (q & 63) * 8, i = R >> 4, c = R & 15; float v[8];
        if (col < 256) { const int s = col >> 4, c0 = col & 15;
#pragma unroll
            for (int j = 0; j < 8; ++j) { const int cp = c0 + j; float x;
                if (s < i) x = kk[((0 * 16 + (i - s)) * 16 + c) * 16 + cp];
                else if (s > i) x = kk[((1 * 16 + (s - i)) * 16 + c) * 16 + cp];
                else { x = kk[((0 * 16 + 0) * 16 + c) * 16 + cp] + kk[((1 * 16 + 0) * 16 + c) * 16 + cp]; if (cp == c) x += A->in[I_DSKIP][l * 1024 + g * 16 + c]; }
                v[j] = x; }
        } else { const int k = col - 256, dir = k >> 7, reim = (k >> 6) & 1, p0 = k & 63, e = dir ? 16 - i : i + 1;
#pragma unroll
            for (int j = 0; j < 8; ++j) { const f32x2 cv = cc[(dir * 16 + c) * 64 + p0 + j], pv = pw[(dir * 17 + e) * 64 + p0 + j];
                v[j] = reim ? -(cv.x * pv.y + cv.y * pv.x) : (cv.x * pv.x - cv.y * pv.y); } }
        v4u w; w.x = cvt_pk_bf16(v[0], v[1]); w.y = cvt_pk_bf16(v[2], v[3]); w.z = cvt_pk_bf16(v[4], v[5]); w.w = cvt_pk_bf16(v[6], v[7]);
        *(v4u*)(KGm + (size_t)R * 512 + col) = w; }
    __syncthreads();
}

__device__ __forceinline__ void mod_unit(KAP A, int un, LAS unsigned char* lds, int tid, int wave, int lane) {
    LAS float* sl = (LAS float*)lds;
    LAS float* red = sl + 3 * 4096;
    const int l = un >> 6, nb = un & 63;
    for (int i = tid; i < 3 * 4096; i += 512) { const int v = i >> 12, k = i & 4095; const float x = v == 0 ? A->in[I_CCTX][k] : A->in[I_C][(v - 1) * 4096 + k]; sl[i] = x / (1.0f + expf(-x)); }
    __syncthreads();
    const int ln = lane < 48 ? lane : 47;
    const float* wp = A->in[I_WMOD] + ((size_t)l * 4096 + wave * 512) * 12288 + nb * 192 + ln * 4;
    f32x4 a0 = {0.f, 0.f, 0.f, 0.f}, a1 = a0, a2 = a0;
#pragma unroll 8
    for (int kq = 0; kq < 512; ++kq) { const f32x4 w = *(const f32x4*)(wp + (size_t)kq * 12288); const int k = wave * 512 + kq;
        a0 += sl[k] * w; a1 += sl[4096 + k] * w; a2 += sl[8192 + k] * w; }
    if (lane < 48) {
#pragma unroll
        for (int j = 0; j < 4; ++j) { red[(wave * 3 + 0) * 256 + lane * 4 + j] = a0[j]; red[(wave * 3 + 1) * 256 + lane * 4 + j] = a1[j]; red[(wave * 3 + 2) * 256 + lane * 4 + j] = a2[j]; } }
    __syncthreads();
    for (int i = tid; i < 768; i += 512) { const int v = i >> 8, col = i & 255; if (col < 192) { float s = 0.f;
#pragma unroll
        for (int w = 0; w < 8; ++w) s += red[(w * 3 + v) * 256 + col];
        ((float*)(A->ws + WS_MOD))[(size_t)(l * 3 + v) * 12288 + nb * 192 + col] = s + A->in[I_BMOD][l * 12288 + nb * 192 + col]; } }
    __syncthreads();
}

__device__ __forceinline__ void p0_prologue(KAP A, LAS unsigned char* lds, int G, int bx, int wv) {
    const int tid = tid_of(wv); const int lane = tid & 63, wave = __builtin_amdgcn_readfirstlane(tid >> 6);
    { LAS float* scr = (LAS float*)(lds + wave * 16640);
      const int gw = bx * NWAVES + wave, NGW = G * NWAVES;
      constexpr int I_IN = 64 * 144, I_OUT = 64 * 64, I_GLU = 16 * 32, I_L = I_IN + I_OUT + I_GLU;
      for (int it = gw; it < 4 * I_L; it += NGW) { const int l = it / I_L; int r = it % I_L;
          if (r < I_IN) { tr_item<false>(A->in[I_WIN] + (size_t)l * 4096 * 9216, 4096, 9216, (bf16*)(A->ws + WS_WIN) + (size_t)l * 9216 * 4096, scr, r, lane); continue; } r -= I_IN;
          if (r < I_OUT) { tr_item<false>(A->in[I_WOUT] + (size_t)l * 4096 * 4096, 4096, 4096, (bf16*)(A->ws + WS_WOUT) + (size_t)l * 4096 * 4096, scr, r, lane); continue; } r -= I_OUT;
          tr_item<true>(A->in[I_WGLU] + (size_t)l * 1024 * 2048, 1024, 2048, (bf16*)(A->ws + WS_WGLU) + (size_t)l * 2048 * 1024, scr, r, lane); }
    }
    __syncthreads();
    for (int un = bx; un < 256; un += G) mod_unit(A, un, lds, tid, wave, lane);
    const size_t gt = (size_t)bx * 512 + tid, NGT = (size_t)G * 512;
    { bf16* D2L = (bf16*)(A->ws + WS_D2L);
      LAS bf16* lut = (LAS bf16*)lds;
      for (int i = tid; i < 4096; i += 512) lut[i] = (bf16)(cvt_pk_bf16(cospif((float)i * (1.0f / 2048.0f)), 0.f) & 0xffffu);
      __syncthreads();
      for (size_t q = gt; q < (size_t)4096 * 1024; q += NGT) { const int k = (int)(q >> 10), K0 = (int)(q & 1023) * 8; unsigned h[8];
          const int sh = K0 < 4096 ? 0 : 1024;
#pragma unroll
          for (int j = 0; j < 8; ++j) { const int K = (K0 + j) & 4095; h[j] = lut[(k * K + sh) & 4095]; }
          v4u w; w.x = h[0] | (h[1] << 16); w.y = h[2] | (h[3] << 16); w.z = h[4] | (h[5] << 16); w.w = h[6] | (h[7] << 16);
          *(v4u*)(D2L + (size_t)k * 8192 + K0) = w; }
      __syncthreads(); }
    { bf16* D1 = (bf16*)(A->ws + WS_D1);
      for (size_t q = gt; q < (size_t)256 * 256; q += NGT) { const int mp = (int)(q >> 8), c = (int)(q & 255), m = mp <= 128 ? mp : mp - 128; const float x = (float)((m * c) & 255) * (1.0f / 128.0f);
          const float v = mp <= 128 ? cospif(x) : sinpif(x); D1[q] = (bf16)(cvt_pk_bf16(v, 0.f) & 0xffffu); } }
    { bf16* WFP = (bf16*)(A->ws + WS_WFP);
      for (size_t q = gt; q < (size_t)4 * 144 * 1024; q += NGT) { const int n = (int)(q & 1023), i = (int)((q >> 10) % 144), l = (int)(q / (144 * 1024)); const int kk0 = i * 8;
          const float* W = A->in[I_WFFT] + (size_t)l * 1024 * 1024 + n; float v[8];
          if (kk0 < 1024) { const int g = kk0 >> 8, part = (kk0 >> 7) & 1;
#pragma unroll
              for (int j = 0; j < 8; ++j) { const int m = (kk0 + j) & 127; const float w1 = W[(size_t)(g * 256 + m) * 1024], w2 = W[(size_t)(g * 256 + ((256 - m) & 255)) * 1024];
                  v[j] = part ? (w1 - w2) : (m ? w1 + w2 : w1); } }
          else {
#pragma unroll
              for (int j = 0; j < 8; ++j) v[j] = 0.f;
              if (kk0 == 1024) {
#pragma unroll
                  for (int j = 0; j < 4; ++j) v[j] = W[(size_t)(j * 256 + 128) * 1024]; } }
          v4u w; w.x = cvt_pk_bf16(v[0], v[1]); w.y = cvt_pk_bf16(v[2], v[3]); w.z = cvt_pk_bf16(v[4], v[5]); w.w = cvt_pk_bf16(v[6], v[7]);
          *(v4u*)(WFP + ((size_t)l * 1024 + n) * PK + kk0) = w; }
      bf16* P = (bf16*)(A->ws + WS_P);
      for (size_t q = gt; q < (size_t)NTOK * 31; q += NGT) { const size_t row = q / 31; const int j = (int)(q % 31); *(v2u*)(P + row * PK + 1028 + j * 4) = (v2u){0u, 0u}; } }
    { bf16* D2C = (bf16*)(A->ws + WS_D2C);
      for (size_t q = gt; q < (size_t)256 * 512; q += NGT) { const int k = (int)(q >> 9), K = (int)(q & 511); const float x = (float)((k * (K & 255)) & 255) * (1.0f / 128.0f);
          const float v = K < 256 ? cospif(x) : -sinpif(x); D2C[q] = (bf16)(cvt_pk_bf16(v, 0.f) & 0xffffu); } }
    { f32x2* rope = (f32x2*)(A->ws + WS_ROPE);
      for (size_t q = gt; q < 64 * 32; q += NGT) { const int pos = (int)(q >> 5), i = (int)(q & 31); const float inv = exp2f(-(float)i * (13.287712379549449f / 32.0f));
          const double turns = (double)pos * (double)inv * 0.15915494309189535; const float fr = (float)(turns - rint(turns));
          rope[q] = (f32x2){cospif(2.f * fr), sinpif(2.f * fr)}; } }
    { const size_t n8 = (size_t)2 * 4 * 512 * 512 / 8;
      for (size_t q = gt; q < 2 * n8; q += NGT) { const bool isk = q < n8; const size_t j = isk ? q : q - n8; const float* src = (isk ? A->in[I_CK] : A->in[I_CV]) + j * 8;
          const f32x4 x0 = *(const f32x4*)src, x1 = *(const f32x4*)(src + 4);
          v4u w; w.x = cvt_pk_bf16(x0[0], x0[1]); w.y = cvt_pk_bf16(x0[2], x0[3]); w.z = cvt_pk_bf16(x1[0], x1[1]); w.w = cvt_pk_bf16(x1[2], x1[3]);
          *(v4u*)((bf16*)(A->ws + (isk ? WS_CK : WS_CV)) + j * 8) = w; } }
    __syncthreads();
    for (int lg = bx; lg < 256; lg += G) ssm_matrices(A, lg >> 6, lg & 63, lds, tid);
}

__device__ __forceinline__ f32x4 ldg16(const void* base, unsigned off, int imm) { return *(const f32x4*)(((const char*)base + off) + imm); }
__device__ __forceinline__ void pa_norm(KAP A, int l, int bx, int G, int tid, LAS unsigned char* lds) {
    const float* mod = (const float*)(A->ws + WS_MOD) + (size_t)l * 3 * 12288;
    const f32x4* ng4 = (const f32x4*)(A->in[I_NG] + l * DM);
    bf16* H = (bf16*)(A->ws + WS_H);
    const int lane = tid & 63, wave = __builtin_amdgcn_readfirstlane(tid >> 6);
    const unsigned lo2 = (unsigned)lane * 16u, lo4 = (unsigned)lane * 32u;
    LAS f32x4* avl = (LAS f32x4*)lds; LAS f32x4* svl = avl + 1024;
    for (int rb = bx; rb < NTOK / 64; rb += G) {
        const int m0 = rb * 64; const int v = m0 < NCTX ? 0 : (m0 < NCTX + 4096 ? 1 : 2);
        const f32x4* sh4 = (const f32x4*)(mod + v * 12288); const f32x4* sc4 = (const f32x4*)(mod + v * 12288 + 4096);
        __syncthreads();
        for (int i = tid; i < 1024; i += NWAVES * 64) { const int d = ((i >> 7) * 2 + (i & 1)) * 64 + ((i & 127) >> 1);
            avl[d] = ng4[i] * (sc4[i] + 1.0f); svl[d] = sh4[i]; }
        __syncthreads();
#pragma unroll 2
        for (int r = 0; r < 8; ++r) { const int m = m0 + wave * 8 + r;
            f32x4 x[16]; float ss = 0.f;
            char* xb = (char*)((bf16*)(A->ws + ((l & 1) ? WS_XBF2 : WS_XBF)) + (size_t)m * DM);
            const char* xbi = (const char*)((const bf16*)(A->ws + ((l & 1) ? WS_XBF : WS_XBF2)) + (size_t)m * DM);
            if (l <= 1) { const float* xr = m < NCTX ? A->in[I_XP] + (size_t)m * DM : A->in[I_XS] + (size_t)(m - NCTX) * DM;
#pragma unroll
                for (int j = 0; j < 8; ++j) { x[2 * j] = ldg16(xr, lo4 + (j >> 1) * 4096u, (j & 1) * 2048); x[2 * j + 1] = ldg16(xr, lo4 + (j >> 1) * 4096u, (j & 1) * 2048 + 16); }
            } else {
#pragma unroll
                for (int j = 0; j < 8; ++j) { const v4u d = *(const v4u*)((xbi + (lo2 + (j >> 2) * 4096u)) + (j & 3) * 1024);
                    x[2 * j] = (f32x4){bf_lo(d.x), bf_hi(d.x), bf_lo(d.y), bf_hi(d.y)}; x[2 * j + 1] = (f32x4){bf_lo(d.z), bf_hi(d.z), bf_lo(d.w), bf_hi(d.w)}; }
            }
            if (l > 0) {
                const char* dr = (const char*)((const bf16*)(A->ws + ((l & 1) ? WS_DELTA : WS_DELTA2)) + (size_t)m * DM);
#pragma unroll
                for (int j = 0; j < 8; ++j) { const v4u d = *(const v4u*)((dr + (lo2 + (j >> 2) * 4096u)) + (j & 3) * 1024);
                    x[2 * j] += (f32x4){bf_lo(d.x), bf_hi(d.x), bf_lo(d.y), bf_hi(d.y)}; x[2 * j + 1] += (f32x4){bf_lo(d.z), bf_hi(d.z), bf_lo(d.w), bf_hi(d.w)};
                    v4u w; w.x = cvt_pk_bf16(x[2 * j].x, x[2 * j].y); w.y = cvt_pk_bf16(x[2 * j].z, x[2 * j].w); w.z = cvt_pk_bf16(x[2 * j + 1].x, x[2 * j + 1].y); w.w = cvt_pk_bf16(x[2 * j + 1].z, x[2 * j + 1].w);
                    *(v4u*)((xb + (lo2 + (j >> 2) * 4096u)) + (j & 3) * 1024) = w; }
            }
#pragma unroll
            for (int j = 0; j < 16; ++j) ss += (x[j].x * x[j].x + x[j].y * x[j].y) + (x[j].z * x[j].z + x[j].w * x[j].w);
            const float rstd = rsqrtf(wave_sum(ss, lane) * (1.0f / DM) + NORM_EPS);
            char* orow = (char*)(H + (size_t)m * DM);
#pragma unroll
            for (int j = 0; j < 8; ++j) { const f32x4 y0 = x[2 * j] * rstd * avl[(2 * j) * 64 + lane] + svl[(2 * j) * 64 + lane], y1 = x[2 * j + 1] * rstd * avl[(2 * j + 1) * 64 + lane] + svl[(2 * j + 1) * 64 + lane];
                v4u w; w.x = cvt_pk_bf16(y0.x, y0.y); w.y = cvt_pk_bf16(y0.z, y0.w); w.z = cvt_pk_bf16(y1.x, y1.y); w.w = cvt_pk_bf16(y1.z, y1.w);
                *(v4u*)((orow + (lo2 + (j >> 2) * 4096u)) + (j & 3) * 1024) = w;
                if ((j & 1) == 1) asm volatile("" ::: "memory"); }
        }
    }
    __syncthreads();
}
__device__ __forceinline__ void final_norm(KAP A, int gw, int NGW, int lane) {
    const float* fg = A->in[I_FNG];
    const unsigned lo2 = (unsigned)lane * 16u, lo4 = (unsigned)lane * 32u;
    f32x4 gv[16];
#pragma unroll
    for (int j = 0; j < 8; ++j) { gv[2 * j] = ldg16(fg, lo4 + (j >> 1) * 4096u, (j & 1) * 2048); gv[2 * j + 1] = ldg16(fg, lo4 + (j >> 1) * 4096u, (j & 1) * 2048 + 16); }
    for (int ci = gw; ci < NTOK / 8; ci += NGW) {
#pragma unroll 2
        for (int r = 0; r < 8; ++r) { const int m = ci * 8 + r;
            char* xr = (char*)(A->out + (size_t)m * DM);
            const char* xs = (const char*)((const bf16*)(A->ws + (((DEPTH - 1) & 1) ? WS_XBF2 : WS_XBF)) + (size_t)m * DM);
            const char* dr = (const char*)((const bf16*)(A->ws + (((DEPTH - 1) & 1) ? WS_DELTA2 : WS_DELTA)) + (size_t)m * DM);
            f32x4 x[16]; float ss = 0.f;
#pragma unroll
            for (int j = 0; j < 8; ++j) { const v4u xv = *(const v4u*)((xs + (lo2 + (j >> 2) * 4096u)) + (j & 3) * 1024); const v4u d = *(const v4u*)((dr + (lo2 + (j >> 2) * 4096u)) + (j & 3) * 1024);
                x[2 * j] = (f32x4){bf_lo(xv.x) + bf_lo(d.x), bf_hi(xv.x) + bf_hi(d.x), bf_lo(xv.y) + bf_lo(d.y), bf_hi(xv.y) + bf_hi(d.y)};
                x[2 * j + 1] = (f32x4){bf_lo(xv.z) + bf_lo(d.z), bf_hi(xv.z) + bf_hi(d.z), bf_lo(xv.w) + bf_lo(d.w), bf_hi(xv.w) + bf_hi(d.w)}; }
#pragma unroll
            for (int j = 0; j < 16; ++j) ss += (x[j].x * x[j].x + x[j].y * x[j].y) + (x[j].z * x[j].z + x[j].w * x[j].w);
            const float rstd = rsqrtf(wave_sum(ss, lane) * (1.0f / DM) + NORM_EPS);
#pragma unroll
            for (int j = 0; j < 8; ++j) { *(f32x4*)((xr + (lo4 + (j >> 1) * 4096u)) + (j & 1) * 2048) = x[2 * j] * rstd * gv[2 * j]; *(f32x4*)((xr + (lo4 + (j >> 1) * 4096u)) + (j & 1) * 2048 + 16) = x[2 * j + 1] * rstd * gv[2 * j + 1];
                if ((j & 1) == 1) asm volatile("" ::: "memory"); }
        }
    }
}

__device__ __forceinline__ void kv_prep(KAP A, int l, int gw, int NGW, int lane) {
    const bf16* PROJ = (const bf16*)(A->ws + WS_PROJ);
    const f32x2* rope = (const f32x2*)(A->ws + WS_ROPE);
    const int hl = lane & 15;
    const f32x4 kn0 = *(const f32x4*)(A->in[I_KN] + l * 128 + hl * 8), kn1 = *(const f32x4*)(A->in[I_KN] + l * 128 + hl * 8 + 4);
    for (int ci = gw; ci < NTOK / 4; ci += NGW) {
        const int m0 = ci * 4; const bool ctx = m0 < NCTX;
        v4u kr[4], vr[4];
#pragma unroll
        for (int r = 0; r < 4; ++r) { const bf16* pr = PROJ + (size_t)(m0 + r) * INW; kr[r] = *(const v4u*)(pr + OFF_K + 8 * lane); vr[r] = *(const v4u*)(pr + OFF_V + 8 * lane); }
#pragma unroll
        for (int r = 0; r < 4; ++r) { const int m = m0 + r;
            float k[8] = {bf_lo(kr[r].x), bf_hi(kr[r].x), bf_lo(kr[r].y), bf_hi(kr[r].y), bf_lo(kr[r].z), bf_hi(kr[r].z), bf_lo(kr[r].w), bf_hi(kr[r].w)};
            float ss = 0.f;
#pragma unroll
            for (int j = 0; j < 8; ++j) ss += k[j] * k[j];
            ss += shflx(ss, lane, 1); ss += shflx(ss, lane, 2); ss += shflx(ss, lane, 4); ss += shflx(ss, lane, 8);
            const float rstd = rsqrtf(ss * (1.0f / 128.0f) + NORM_EPS);
#pragma unroll
            for (int j = 0; j < 4; ++j) { k[j] *= rstd * kn0[j]; k[4 + j] *= rstd * kn1[j]; }
            if (ctx) {
                const int b = m >> 8, t = m & 255; const size_t oi = (((size_t)(b * 4 + l) * 256 + t) * 512 + 8 * lane);
                float* ok = A->out + OUT_NEWK + oi; *(f32x4*)ok = (f32x4){k[0], k[1], k[2], k[3]}; *(f32x4*)(ok + 4) = (f32x4){k[4], k[5], k[6], k[7]};
                float* ov = A->out + OUT_NEWV + oi; *(f32x4*)ov = (f32x4){bf_lo(vr[r].x), bf_hi(vr[r].x), bf_lo(vr[r].y), bf_hi(vr[r].y)}; *(f32x4*)(ov + 4) = (f32x4){bf_lo(vr[r].z), bf_hi(vr[r].z), bf_lo(vr[r].w), bf_hi(vr[r].w)};
            } else {
                const int t = (m - NCTX) & 4095, pos = hl < 8 ? (t >> 6) : (t & 63); const f32x2* rp = rope + pos * 32 + (lane & 3) * 8; const bool first = (lane & 4) == 0;
#pragma unroll
                for (int j = 0; j < 8; ++j) { const float other = shflx(k[j], lane, 4); const f32x2 cs = rp[j];
                    k[j] = first ? (k[j] * cs.x - other * cs.y) : (other * cs.y + k[j] * cs.x); }
            }
            v4u w; w.x = cvt_pk_bf16(k[0], k[1]); w.y = cvt_pk_bf16(k[2], k[3]); w.z = cvt_pk_bf16(k[4], k[5]); w.w = cvt_pk_bf16(k[6], k[7]);
            *(v4u*)((bf16*)(A->ws + WS_KC) + (size_t)m * 512 + 8 * lane) = w;
            *(v4u*)((bf16*)(A->ws + WS_VC) + (size_t)m * 512 + 8 * lane) = vr[r];
        }
    }
}

__device__ __forceinline__ void ssm_scan(KAP A, int l, int g, int mt, int tid, LAS unsigned char* lds) {
    bf16* A2 = (bf16*)(A->ws + WS_A2) + (size_t)g * 1024 * 512;
    const int blk = tid >> 5, sub = tid & 31, dir = sub >> 4, p0 = (sub & 15) * 4;
    f32x4 ar, ai;
    { const f32x4* a4 = (const f32x4*)((const float*)(A->ws + WS_A16) + (((size_t)(l * 2 + dir) * 64 + g) * 64 + p0) * 2); const f32x4 t0 = a4[0], t1 = a4[1];
      ar = (f32x4){t0.x, t0.z, t1.x, t1.z}; ai = (f32x4){t0.y, t0.w, t1.y, t1.w}; }
    const int ecol = 256 + dir * 128 + p0, scol = dir * 128 + p0;
    LAS f32x4* T = (LAS f32x4*)lds;
    LAS f32x4* EB = T + 16 * 32 * 2;
    const bool lat = mt >= 2;
    const int rb = mt * 256 + blk * 16;
    f32x4 sr[16], si[16];
#pragma unroll
    for (int i = 0; i < 16; ++i) { const int x = dir ? 15 - i : i, rl = blk * 16 + x;
        const v2u a = *(const LAS v2u*)(lds + rl * 512 + ((((scol >> 3) ^ x) << 4) + (scol & 7) * 2)), b = *(const LAS v2u*)(lds + rl * 512 + (((((scol + 64) >> 3) ^ x) << 4) + (scol & 7) * 2));
        sr[i] = (f32x4){bf_lo(a.x), bf_hi(a.x), bf_lo(a.y), bf_hi(a.y)}; si[i] = (f32x4){bf_lo(b.x), bf_hi(b.x), bf_lo(b.y), bf_hi(b.y)}; }
    __syncthreads();
    f32x4 er = {0.f, 0.f, 0.f, 0.f}, ei = er;
    if (lat) {
#pragma unroll
        for (int i = 0; i < 16; ++i) { const f32x4 nr = ar * er - ai * ei + sr[i], ni = ar * ei + ai * er + si[i]; er = nr; ei = ni; }
        T[(blk * 32 + sub) * 2] = er; T[(blk * 32 + sub) * 2 + 1] = ei;
        __syncthreads();
        if (tid < 32) { const int b = mt - 2; const size_t si0 = (((size_t)b * 4 + l) * 64 + g) * 64 + p0;
            f32x4 cr = *(const f32x4*)(A->in[dir ? I_SBR : I_SFR] + si0), ci = *(const f32x4*)(A->in[dir ? I_SBI : I_SFI] + si0);
            f32x4 qr = ar, qi = ai;
#pragma unroll
            for (int k = 0; k < 4; ++k) { const f32x4 t = qr * qr - qi * qi; qi = 2.f * qr * qi; qr = t; }
#pragma unroll 1
            for (int jb = 0; jb < 16; ++jb) { const int bb = dir ? 15 - jb : jb; EB[(bb * 32 + sub) * 2] = cr; EB[(bb * 32 + sub) * 2 + 1] = ci;
                const f32x4 tr = T[(bb * 32 + sub) * 2], ti = T[(bb * 32 + sub) * 2 + 1];
                const f32x4 nr = qr * cr - qi * ci + tr, ni = qr * ci + qi * cr + ti; cr = nr; ci = ni; } }
        __syncthreads();
        er = EB[(blk * 32 + sub) * 2]; ei = EB[(blk * 32 + sub) * 2 + 1];
    }
#pragma unroll
    for (int i = 0; i < 16; ++i) { const int row = rb + (dir ? 15 - i : i);
        v2u wr, wi; wr.x = cvt_pk_bf16(er.x, er.y); wr.y = cvt_pk_bf16(er.z, er.w); wi.x = cvt_pk_bf16(ei.x, ei.y); wi.y = cvt_pk_bf16(ei.z, ei.w);
        *(v2u*)(A2 + (size_t)row * 512 + ecol) = wr; *(v2u*)(A2 + (size_t)row * 512 + ecol + 64) = wi;
        const f32x4 nr = ar * er - ai * ei + sr[i], ni = ar * ei + ai * er + si[i]; er = nr; ei = ni; }
    if (!lat) { const int b = mt * 16 + blk; const size_t oi = (((size_t)b * 4 + l) * 64 + g) * 64 + p0;
        *(f32x4*)(A->out + (dir ? OUT_BRE : OUT_FRE) + oi) = er; *(f32x4*)(A->out + (dir ? OUT_BIM : OUT_FIM) + oi) = ei; }
}
__device__ __forceinline__ void ssm_step1(KAP A, int l, int un, LAS unsigned char* lds, int wv) {
    const int g = un >> 2, mt = un & 3, lg = l * 64 + g;
    pg8::OneUnit S1; S1.u0.a = (const char*)(A->ws + WS_A2) + ((size_t)g * 1024 + mt * 256) * 512 * 2; S1.u0.b = (const char*)(A->ws + WS_PMAT) + (size_t)lg * 256 * 256 * 2;
    S1.u0.c = nullptr; S1.u0.ldc = 0; S1.u0.pm = mt; S1.u0.pn = g; S1.u0.z = 0; S1.u0.kt = 4;
    pg8::EpiLdsS E{lds}; pg8::gemm_phase<pg8::EpiLdsS, pg8::OneUnit>(lds, wv, 512, 256, S1, E);
}
__device__ __forceinline__ void ssm_step2(KAP A, int l, int un, LAS unsigned char* lds, int wv) {
    const int g = un >> 2, mt = un & 3; const int tid = tid_of(wv); ssm_scan(A, l, g, mt, tid, lds);
}
__device__ __forceinline__ void ssm_step3(KAP A, int l, int un, LAS unsigned char* lds, int wv) {
    const int g = un >> 2, mt = un & 3, lg = l * 64 + g;
    pg8::OneUnit S2; S2.u0.a = (const char*)(A->ws + WS_A2) + ((size_t)g * 1024 + mt * 256) * 512 * 2; S2.u0.b = (const char*)(A->ws + WS_KG) + (size_t)lg * 256 * 512 * 2;
    S2.u0.c = nullptr; S2.u0.ldc = 0; S2.u0.pm = mt; S2.u0.pn = g; S2.u0.z = mt * 256; S2.u0.kt = 8;
    pg8::EpiSsmY E{(bf16*)(A->ws + WS_YSSM)}; pg8::gemm_phase<pg8::EpiSsmY, pg8::OneUnit>(lds, wv, 512, 512, S2, E);
}

struct Fft1Order {
    int G, c; const char* D1; const char* proj; char* zl; char* zc;
    __device__ bool next(int i, pg8::Unit& u) const { const int L = i * G + c; if (L >= 256) return false;
        const int g = L & 3, tt = L >> 2;
        int kt4 = 4; asm volatile("" : "+s"(kt4)); u.kt = kt4;
        u.a = D1; u.b = proj + ((size_t)tt * 256 * INW + OFF_F + g * 256) * 2; u.pm = 0; u.pn = tt; u.z = g;
        if (tt < 32) { u.c = zc + ((size_t)((tt * 4 + g) * 128) * 256) * 2; u.ldc = 256; }
        else { const int b = (tt - 32) >> 4, t0 = ((tt - 32) & 15) * 256; u.c = zl + ((size_t)((b * 4 + g) * 128) * 4096 + t0) * 2; u.ldc = 4096; }
        return true; }
};
struct Fft2LOrder {
    int G, c; const char* D2; const char* z; char* P;
    __device__ bool next(int i, pg8::Unit& u) const { const int L = i * G + c; if (L >= 128) return false;
        const int nt = L & 3, part = (L >> 2) & 1, mt = L >> 3;
        u.kt = 64; u.a = D2 + ((size_t)mt * 256 * 8192 + part * 4096) * 2; u.b = z + (part * ZPART + (size_t)nt * 256 * 4096) * 2; u.pm = mt; u.pn = nt; u.z = part;
        u.c = P + (((size_t)NCTX + (nt >> 1) * 4096 + mt * 256) * PK + (nt & 1) * 512 + part * 128) * 2; u.ldc = PK; return true; }
};
struct Fft2COrder {
    int G, c; const char* D2; const char* z; char* P;
    __device__ bool next(int i, pg8::Unit& u) const { const int L = i * G + c; if (L >= 128) return false;
        const int nt = L & 1, part = (L >> 1) & 1, b = L >> 2;
        u.kt = 4; u.a = D2 + (size_t)part * 256 * 2; u.b = z + (part * ZPART + (size_t)((b * 4 + nt * 2) * 128) * 256) * 2; u.pm = 0; u.pn = nt; u.z = b;
        u.c = P + (((size_t)b * 256) * PK + nt * 512 + part * 128) * 2; u.ldc = PK; return true; }
};
template <int NS, int KS>
__device__ __forceinline__ f32x4 nyq_core(const bf16* arow, size_t lda16, const bf16* bcol, LAS unsigned char* lds, int tid) {
    const int wave = tid >> 6, lane = tid & 63, fq = lane >> 4;
    f32x4 acc[NS];
#pragma unroll
    for (int ns = 0; ns < NS; ++ns) acc[ns] = (f32x4){0.f, 0.f, 0.f, 0.f};
    const int tb = wave * KS * 32 + fq * 8;
#pragma unroll 4
    for (int s2 = 0; s2 < KS; ++s2) { const bf16x8 bv = *(const bf16x8*)(bcol + tb + s2 * 32);
#pragma unroll
        for (int ns = 0; ns < NS; ++ns) { const bf16x8 av = *(const bf16x8*)(arow + ns * lda16 + tb + s2 * 32); acc[ns] = __builtin_amdgcn_mfma_f32_16x16x32_bf16(bv, av, acc[ns], 0, 0, 0); } }
    LAS f32x4* red = (LAS f32x4*)lds;
    __syncthreads();
#pragma unroll
    for (int ns = 0; ns < NS; ++ns) red[(wave * NS + ns) * 64 + lane] = acc[ns];
    __syncthreads();
    f32x4 r = (f32x4){0.f, 0.f, 0.f, 0.f};
    if (tid < NS * 64) {
#pragma unroll
        for (int w = 0; w < 8; ++w) r += red[(w * NS + (tid >> 6)) * 64 + (tid & 63)]; }
    __syncthreads();
    return r;
}
__device__ __forceinline__ void nyq_pass(KAP A, int cA, LAS unsigned char* lds, int wv) {
    const int tid = tid_of(wv); const int fr = tid & 15;
    bf16* P = (bf16*)(A->ws + WS_P);
    {
        const bf16* arow = (const bf16*)(A->ws + WS_D2L) + (size_t)(cA * 32 + fr) * 8192;
        const bf16* bcol = (const bf16*)(A->ws + WS_ZL) + ZPART + (size_t)((fr & 7) * 128) * 4096;
        const f32x4 r = nyq_core<2, 16>(arow, (size_t)16 * 8192, bcol, lds, tid) * (1.0f / 1024.0f);
        const int fq = (tid & 63) >> 4;
        if (tid < 128 && fq < 2) { const int k = cA * 32 + (tid >> 6) * 16 + fr; *(v2u*)(P + ((size_t)NCTX + fq * 4096 + k) * PK + 1024) = (v2u){cvt_pk_bf16(r[0], r[1]), cvt_pk_bf16(r[2], r[3])}; } }
    {
        const int cg = cA & 7, rs = cA >> 3;
        const bf16* arow = (const bf16*)(A->ws + WS_D2C) + (size_t)(rs * 16 + fr) * 512;
        const bf16* bcol = (const bf16*)(A->ws + WS_ZC) + ZPART + (size_t)(((cg * 4 + (fr >> 2)) * 4 + (fr & 3)) * 128) * 256;
        const f32x4 r = nyq_core<1, 1>(arow, 0, bcol, lds, tid) * (1.0f / 256.0f);
        const int fq = (tid & 63) >> 4;
        if (tid < 64) { const int k = rs * 16 + fr, b = cg * 4 + fq; *(v2u*)(P + ((size_t)b * 256 + k) * PK + 1024) = (v2u){cvt_pk_bf16(r[0], r[1]), cvt_pk_bf16(r[2], r[3])}; } }
}

__global__ void __launch_bounds__(NWAVES * 64, 2) hymba_fwd(Args args) {
    extern __shared__ __attribute__((aligned(16))) unsigned char lds_raw[];
    LAS unsigned char* lds = (LAS unsigned char*)lds_raw;
    volatile LAS unsigned* MISC = (volatile LAS unsigned*)(lds + MISC_OFF);
    const int G = gridDim.x, bx = blockIdx.x;
    const int wv = __builtin_amdgcn_readfirstlane(threadIdx.x >> 6);
#define TID_HERE() const int tid = tid_of(wv); const int lane = tid & 63, wave = __builtin_amdgcn_readfirstlane(tid >> 6), gw = bq * NWAVES + wave, NGWq = Gq * NWAVES; (void)lane; (void)gw; (void)NGWq
#define PH_IDS() int Gq = G, bq = bx; asm volatile("" : "+s"(Gq), "+s"(bq))
    for (int u = tid_of(wv); u < (LDS_BYTES - MISC_OFF) / 4; u += NWAVES * 64) ((LAS unsigned*)(lds + MISC_OFF))[u] = 0u;
    __syncthreads();
    int lo, hi; XcdBarrier bar;
    { KA_HERE(); PH_IDS(); lo = ka->ph_lo; hi = ka->ph_hi; unsigned* ctl = (unsigned*)(ka->ws + WS_CTL);
      bar.bar = ctl + CW_BAR; bar.x = 0; bar.st = nullptr;
      if (hi - lo > 1) bar = xcd_barrier_post(ctl + CW_BAR, MISC + 8, tid_of(wv)); }
#define IN(k) (lo <= (k) && (k) < hi)
#define SEAM(k) do { if (IN(k) && IN((k) + 1)) { xcd_barrier(bar, wv); if (((DUP_MASK) >> 12) & 1) xcd_barrier(bar, wv); } } while (0)

    if (IN(0)) DUP(0) { KA_HERE(); PH_IDS(); p0_prologue(ka, lds, Gq, bq, wv); }
    SEAM(0);

    for (int l = 0; l < DEPTH; ++l) for (int lrep_ = 0; lrep_ < 1 + (((DUP_MASK) >> 19) & 1); ++lrep_) {
        const int pb = 1 + 6 * l;
        if (IN(pb)) DUP(1) { KA_HERE(); PH_IDS(); TID_HERE(); pa_norm(ka, l, bq, Gq, tid, lds);
        }
        SEAM(pb);
        if (IN(pb + 1)) DUP(2) {
            KA_HERE(); PH_IDS(); unsigned char* ws = ka->ws;
            pg8::GemmOrder S; S.init(NTOK, INW, Gq, bq, ws + WS_H, DM, ws + WS_WIN + (size_t)l * INW * DM * 2, DM, DM);
            pg8::EpiProj E{(bf16*)(ws + WS_PROJ), (bf16*)(ws + WS_A2)};
            pg8::gemm_phase<pg8::EpiProj, pg8::GemmOrder, GEMM1_ALIGN>(lds, wv, DM, DM, S, E);
        }
        SEAM(pb + 1);
        if (IN(pb + 2)) {
            DUP(16) for (int un = bx; un < 256; un += G) { { KA_HERE(); ssm_step1(ka, l, un, lds, wv); } __syncthreads(); { KA_HERE(); ssm_step2(ka, l, un, lds, wv); } __syncthreads(); }
            DUP(14) { KA_HERE(); PH_IDS(); TID_HERE(); kv_prep(ka, l, gw, NGWq, lane); }
            DUP(3) { KA_HERE(); PH_IDS(); unsigned char* ws = ka->ws;
              Fft1Order S{Gq, bq, (const char*)(ws + WS_D1), (const char*)(ws + WS_PROJ), (char*)(ws + WS_ZL), (char*)(ws + WS_ZC)};
              pg8::EpiBf16X E{1.0f, (int)ZPART, 128}; pg8::gemm_phase<pg8::EpiBf16X, Fft1Order>(lds, wv, 256, INW, S, E); }
            wg_global_sync();
            DUP(18) for (int un = bx; un < 256; un += G) { KA_HERE(); ssm_step3(ka, l, un, lds, wv); }
        }
        SEAM(pb + 2);
        if (IN(pb + 3)) {
            if (bx < (G >> 1)) {
                __syncthreads();
                DUP(7) { KA_HERE(); unsigned char* ws = ka->ws; int nAq = G >> 1, cAq = bx; asm volatile("" : "+s"(nAq), "+s"(cAq));
                  Fft2LOrder S{nAq, cAq, (const char*)(ws + WS_D2L), (const char*)(ws + WS_ZL), (char*)(ws + WS_P)};
                  pg8::EpiBf16X E{1.0f / 1024.0f, 128 * PK, 256}; pg8::gemm_phase<pg8::EpiBf16X, Fft2LOrder>(lds, wv, 8192, 4096, S, E); }
                DUP(8) { KA_HERE(); unsigned char* ws = ka->ws; int nAq = G >> 1, cAq = bx; asm volatile("" : "+s"(nAq), "+s"(cAq));
                  Fft2COrder S{nAq, cAq, (const char*)(ws + WS_D2C), (const char*)(ws + WS_ZC), (char*)(ws + WS_P)};
                  pg8::EpiBf16X E{1.0f / 256.0f, 128 * PK, 256}; pg8::gemm_phase<pg8::EpiBf16X, Fft2COrder>(lds, wv, 512, 256, S, E); }
                DUP(8) { KA_HERE(); for (int it = bx; it < 128; it += (G >> 1)) nyq_pass(ka, it, lds, wv); }
                __syncthreads();
            }
            DUP(5) for (int U = bx; U < 512; U += G) {
                KA_HERE(); PH_IDS(); unsigned char* ws = ka->ws; bf16* const PROJ = (bf16*)(ws + WS_PROJ); bf16* const MIX = (bf16*)(ws + WS_MIX);
                const float* qn = ka->in[I_QN] + l * 128; const f32x2* rope = (const f32x2*)(ws + WS_ROPE);
                const int pr = U & 7, idx = U >> 3, b = pr >> 2, kvh = pr & 3, hq = kvh * 4 + (idx >> 4), qb = idx & 15;
                const size_t row0 = (size_t)NCTX + b * 4096 + qb * 256;
                const bf16* ck = (const bf16*)(ws + WS_CK) + ((size_t)(b * 4 + l) * 512) * 512 + kvh * 128;
                const bf16* cv = (const bf16*)(ws + WS_CV) + ((size_t)(b * 4 + l) * 512) * 512 + kvh * 128;
                const bf16* k1 = (const bf16*)(ws + WS_KC) + ((size_t)NCTX + b * 4096) * 512 + kvh * 128; const bf16* v1 = (const bf16*)(ws + WS_VC) + ((size_t)NCTX + b * 4096) * 512 + kvh * 128;
                att::attn_unit(PROJ + row0 * INW + hq * 128, PROJ + row0 * INW + OFF_GA + hq * 128, MIX + row0 * DM + hq * 128,
                               ck, cv, 512, 8, k1, v1, 512, 64, qn, rope, qb * 256, (char*)lds_raw, wv);
            }
            {
                const int nH = G >> 1, hb = bx >= nH ? 1 : 0, cH = bx - hb * nH, Uend = hb ? 512 : 256;
                DUP(6) for (int U = hb * 256 + cH; U < Uend; U += (hb ? G - nH : nH)) {
                    KA_HERE(); unsigned char* ws = ka->ws; bf16* const PROJ = (bf16*)(ws + WS_PROJ); bf16* const MIX = (bf16*)(ws + WS_MIX);
                    const float* qn = ka->in[I_QN] + l * 128;
                    const int xx = U & 7, idx = U >> 3, b = xx * 4 + (idx >> 4), hq = idx & 15, kvh = hq >> 2;
                    const size_t row0 = (size_t)b * 256;
                    const bf16* k1 = (const bf16*)(ws + WS_KC) + row0 * 512 + kvh * 128; const bf16* v1 = (const bf16*)(ws + WS_VC) + row0 * 512 + kvh * 128;
                    att::attn_unit(PROJ + row0 * INW + hq * 128, PROJ + row0 * INW + OFF_GA + hq * 128, MIX + row0 * DM + hq * 128,
                                   k1, v1, 512, 0, k1, v1, 512, 4, qn, nullptr, 0, (char*)lds_raw, wv);
                }
            }
            if (bx >= (G >> 1)) {
                const int nB = G - (G >> 1), cB = bx - (G >> 1);
                __syncthreads();
                DUP(9) { KA_HERE(); unsigned char* ws = ka->ws; int nBq = nB, cBq = cB; asm volatile("" : "+s"(nBq), "+s"(cBq));
                  pg8::GemmOrder S; S.init(NTOK, 2048, nBq, cBq, ws + WS_YSSM, 1024, ws + WS_WGLU + (size_t)l * 2048 * 1024 * 2, 1024, 1024);
                  pg8::EpiGlu E{(const bf16*)(ws + WS_PROJ), (bf16*)(ws + WS_MIX)}; pg8::gemm_phase<pg8::EpiGlu, pg8::GemmOrder>(lds, wv, 1024, 1024, S, E); }
            }
        }
        SEAM(pb + 3);
        if (IN(pb + 4)) {
            DUP(10) { KA_HERE(); PH_IDS(); unsigned char* ws = ka->ws;
              pg8::GemmOrder S; S.init(NTOK, 1024, Gq, bq, ws + WS_P, PK, ws + WS_WFP + (size_t)l * 1024 * PK * 2, PK, PK);
              pg8::EpiFftW E{(const bf16*)(ws + WS_PROJ), (bf16*)(ws + WS_MIX)}; pg8::gemm_phase<pg8::EpiFftW, pg8::GemmOrder>(lds, wv, PK, PK, S, E); }
        }
        SEAM(pb + 4);
        if (IN(pb + 5)) DUP(11) {
            KA_HERE(); PH_IDS(); unsigned char* ws = ka->ws;
            pg8::GemmOrder S; S.init(NTOK, DM, Gq, bq, ws + WS_MIX, DM, ws + WS_WOUT + (size_t)l * DM * DM * 2, DM, DM);
            pg8::EpiOut E{(bf16*)(ws + ((l & 1) ? WS_DELTA2 : WS_DELTA)), (const float*)(ws + WS_MOD) + (size_t)l * 3 * 12288};
            if (((DUP_MASK) >> 13) & 1) {
                { pg8::SliceOrder<pg8::GemmOrder> S2{S, 0, 2}; pg8::gemm_phase<pg8::EpiOut, pg8::SliceOrder<pg8::GemmOrder>, GEMM1_ALIGN>(lds, wv, DM, DM, S2, E); }
                xcd_barrier(bar, wv);
                { pg8::SliceOrder<pg8::GemmOrder> S2{S, 2, 1000}; pg8::gemm_phase<pg8::EpiOut, pg8::SliceOrder<pg8::GemmOrder>, GEMM1_ALIGN>(lds, wv, DM, DM, S2, E); }
            } else
            pg8::gemm_phase<pg8::EpiOut, pg8::GemmOrder, GEMM1_ALIGN>(lds, wv, DM, DM, S, E);
        }
        SEAM(pb + 5);
    }
    if (IN(25)) DUP(15) { KA_HERE(); PH_IDS(); TID_HERE(); final_norm(ka, gw, NGWq, lane); }
#undef IN
#undef SEAM
}

extern "C" void kernel_launch(void* const* d_in, const int* in_sizes, int n_in, void* d_out, int out_size, void* d_ws, size_t ws_size, hipStream_t stream) {
    static int grid = 0;
    if (grid == 0) {
        if (n_in != 28 || ws_size < WS_END || out_size != 102760448) { fprintf(stderr, "kernel_launch: unexpected shapes (n_in %d, out %d, ws %zu)\n", n_in, out_size, ws_size); grid = -1; return; }
        int dev = 0, cus = 0, per_cu = 0;
        if (hipGetDevice(&dev) != hipSuccess || hipDeviceGetAttribute(&cus, hipDeviceAttributeMultiprocessorCount, dev) != hipSuccess) { grid = -1; return; }
        if (hipFuncSetAttribute((const void*)hymba_fwd, hipFuncAttributeMaxDynamicSharedMemorySize, LDS_BYTES) != hipSuccess) { fprintf(stderr, "kernel_launch: hipFuncSetAttribute failed\n"); grid = -1; return; }
        if (hipOccupancyMaxActiveBlocksPerMultiprocessor(&per_cu, (const void*)hymba_fwd, NWAVES * 64, LDS_BYTES) != hipSuccess || per_cu < 1)
            fprintf(stderr, "kernel_launch: occupancy query reports %d workgroups per CU\n", per_cu);
        (void)hipGetLastError();
        grid = cus;
    }
    if (grid < 0) return;
    (void)hipMemsetAsync((char*)d_ws + WS_CTL, 0, CTL_ZERO_BYTES, stream);
    Args a{};
    for (int i = 0; i < 28; ++i) a.in[i] = (const float*)d_in[i];
    a.out = (float*)d_out; a.ws = (unsigned char*)d_ws;
#if MK_ONE_LAUNCH == 2
    a.ph_lo = 0; a.ph_hi = 1;
    hipLaunchKernelGGL(hymba_fwd, dim3(grid), dim3(NWAVES * 64), LDS_BYTES, stream, a);
    a.ph_lo = 0; a.ph_hi = 26;
    hipLaunchKernelGGL(hymba_fwd, dim3(grid), dim3(NWAVES * 64), LDS_BYTES, stream, a);
#elif MK_ONE_LAUNCH
    a.ph_lo = 0; a.ph_hi = 26;
    hipLaunchKernelGGL(hymba_fwd, dim3(grid), dim3(NWAVES * 64), LDS_BYTES, stream, a);
#else
    for (int ph = 0; ph < 26; ++ph) { a.ph_lo = ph; a.ph_hi = ph + 1; hipLaunchKernelGGL(hymba_fwd, dim3(grid), dim3(NWAVES * 64), LDS_BYTES, stream, a); }
#endif
    const hipError_t le = hipPeekAtLastError();
    if (le != hipSuccess) fprintf(stderr, "kernel_launch: launch failed: %s\n", hipGetErrorName(le));
}
```

```cpp
#include <hip/hip_runtime.h>
#include <cstdio>
#include <cstdint>

#ifndef MK_ONE_LAUNCH
#define MK_ONE_LAUNCH 1
#endif

#ifndef GEMM1_ALIGN
#define GEMM1_ALIGN true
#endif
#ifndef DUP_MASK
#define DUP_MASK 0
#endif
#define DUP(k) for (int rep_ = 0; rep_ < (((DUP_MASK) >> (k)) & 1) + 1; ++rep_)
#define LAS __attribute__((address_space(3)))
#define GAS __attribute__((address_space(1)))
typedef unsigned short bf16;
typedef unsigned v4u __attribute__((ext_vector_type(4)));
typedef unsigned v2u __attribute__((ext_vector_type(2)));
typedef float f32x4 __attribute__((ext_vector_type(4)));
typedef float f32x2 __attribute__((ext_vector_type(2)));
typedef short bf16x8 __attribute__((ext_vector_type(8)));
typedef short s16x4 __attribute__((ext_vector_type(4)));
typedef float f32x16 __attribute__((ext_vector_type(16)));

constexpr int DM = 4096, NTOK = 16384, NCTX = 8192, DEPTH = 4, INW = 9216;
constexpr int OFF_K = 2048, OFF_V = 2560, OFF_GA = 3072, OFF_U = 5120, OFF_GS = 6144, OFF_F = 7168, OFF_GF = 8192;
constexpr float NORM_EPS = 1e-6f;
constexpr size_t OUT_NEWK = 67108864, OUT_NEWV = 83886080, OUT_FRE = 100663296, OUT_FIM = 101187584, OUT_BRE = 101711872, OUT_BIM = 102236160;

constexpr size_t MiB = 1u << 20;
constexpr size_t WS_CTL = 0, CTL_ZERO_BYTES = 1 * MiB;
constexpr size_t WS_MOD = 1 * MiB;
constexpr size_t WS_ROPE = 2 * MiB;
constexpr size_t WS_A16 = 3 * MiB;
constexpr size_t WS_D1 = 4 * MiB;
constexpr size_t WS_D2C = 5 * MiB;
constexpr size_t WS_CK = 6 * MiB;
constexpr size_t WS_CV = 10 * MiB;
constexpr size_t WS_PMAT = 14 * MiB;
constexpr size_t WS_KG = 46 * MiB;
constexpr size_t WS_D2L = 110 * MiB;
constexpr size_t WS_WGLU = 174 * MiB;
constexpr size_t WS_WOUT = 198 * MiB;
constexpr size_t WS_WIN = 326 * MiB;
constexpr size_t WS_H = 614 * MiB;
constexpr size_t WS_PROJ = 742 * MiB;
constexpr size_t WS_MIX = 1030 * MiB;
constexpr size_t WS_A2 = 1158 * MiB;
constexpr size_t WS_SBUF = 1222 * MiB;
constexpr size_t WS_YSSM = 1286 * MiB;
constexpr size_t WS_ZL = 1318 * MiB;
constexpr size_t WS_ZC = 1334 * MiB;
constexpr size_t WS_P = 1350 * MiB;
constexpr size_t WS_WFP = 1386 * MiB;
constexpr int PK = 1152; constexpr size_t ZPART = (size_t)1 << 22;
constexpr size_t WS_DELTA = 1414 * MiB;
constexpr size_t WS_XBF = 1542 * MiB;
constexpr size_t WS_XBF2 = 1702 * MiB;
constexpr size_t WS_KC = 1670 * MiB;
constexpr size_t WS_VC = 1686 * MiB;
constexpr size_t WS_DELTA2 = 1830 * MiB;
constexpr size_t WS_END = 1958 * MiB;
constexpr int CW_BAR = 4096;

constexpr int LDS_BYTES = 147456;
constexpr int MISC_OFF = 143360;
constexpr int NWAVES = 8;

#define LDS_WAIT() asm volatile("s_waitcnt lgkmcnt(0)" ::: "memory")
#define VM_WAIT() asm volatile("s_waitcnt vmcnt(0)" ::: "memory")
#define RLX_AGENT __ATOMIC_RELAXED, __HIP_MEMORY_SCOPE_AGENT

__device__ __forceinline__ int tid_of(int wv) { int t = wv * 64 + (int)__builtin_amdgcn_mbcnt_hi(~0u, __builtin_amdgcn_mbcnt_lo(~0u, 0u)); asm volatile("" : "+v"(t)); return t; }
__device__ __forceinline__ unsigned cvt_pk_bf16(float lo, float hi) { unsigned r; asm volatile("v_cvt_pk_bf16_f32 %0, %1, %2" : "=v"(r) : "v"(lo), "v"(hi)); return r; }
__device__ __forceinline__ float bf_lo(unsigned w) { return __uint_as_float(w << 16); }
__device__ __forceinline__ float bf_hi(unsigned w) { return __uint_as_float(w & 0xffff0000u); }
__device__ __forceinline__ float silu_f(float x) { return x * __builtin_amdgcn_rcpf(1.0f + __expf(-x)); }
__device__ __forceinline__ float sigmoid_f(float x) { return __builtin_amdgcn_rcpf(1.0f + __expf(-x)); }
__device__ __forceinline__ float shflx(float v, int lane, int o) { return __int_as_float(__builtin_amdgcn_ds_bpermute((lane ^ o) << 2, __float_as_int(v))); }
__device__ __forceinline__ float wave_sum(float v, int lane) {
#pragma unroll
    for (int o = 1; o < 64; o <<= 1) v += shflx(v, lane, o);
    return v;
}

namespace pg8 {
constexpr int BM = 256, BK = 64, HALF = 128, HTB = HALF * BK * 2, STAGE_BYTES = 8 * HTB, NXCD = 8, WGM = 8;
__host__ __device__ __forceinline__ int lds_byte(int r, int c) { const int st = (r >> 4) * 2 + (c >> 5), rr = r & 15, cc = c & 31, ob = rr * 64 + cc * 2; return st * 1024 + (ob ^ (((ob >> 9) & 1) << 5)); }
__host__ __device__ __forceinline__ void stage_rc(int b, int& R, int& C) { const int st = b / 1024, sb = b % 1024, swz = sb ^ (((sb >> 9) & 1) << 5); R = (st >> 1) * 16 + swz / 64; C = (st & 1) * 32 + (swz % 64) / 2; }
__host__ __device__ __forceinline__ int perm32(int rho) { const int n = rho >> 4, i = rho & 15; return 8 * (i >> 2) + 4 * n + (i & 3); }

struct Unit { const char* a; const char* b; char* c; int ldc; int pm, pn, z, kt; };

struct GemmOrder {
    int nM, nN, nwg, G, c, kt; const char* A; const char* B; size_t atile, btile;
    __device__ void init(int M, int N, int G_, int c_, const void* A_, int lda, const void* B_, int ldb, int K) { kt = K / BK; nM = M / BM; nN = N / BM; nwg = nM * nN; G = G_; c = c_; A = (const char*)A_; B = (const char*)B_; atile = (size_t)BM * lda * 2; btile = (size_t)BM * ldb * 2; }
    __device__ bool next(int i, Unit& u) const {
        const long L = (long)i * G + c; if (L >= nwg) return false;
        int wgid = (int)L; const int xcd = wgid % NXCD; { const int q = nwg / NXCD, r = nwg % NXCD, off = wgid / NXCD; wgid = (xcd < r ? xcd * (q + 1) : r * (q + 1) + (xcd - r) * q) + off; }
        const int nig = WGM * nN, gid = wgid / nig, fm = gid * WGM, gsz = (nM - fm) < WGM ? (nM - fm) : WGM;
        u.pm = fm + ((wgid % nig) % gsz); u.pn = (wgid % nig) / gsz; u.z = 0; u.c = nullptr; u.ldc = 0; u.kt = kt;
        u.a = A + (size_t)u.pm * atile; u.b = B + (size_t)u.pn * btile; return true;
    }
};
template <class O> struct SliceOrder { O g; int i0, cnt; __device__ bool next(int i, Unit& u) const { if (i >= cnt) return false; return g.next(i0 + i, u); } };
template <class O> struct UnitRange { O g; int first, stride, end; __device__ bool next(int i, Unit& u) const { const int L = first + i * stride; if (L >= end) return false; return g.next(L, u); } };
struct OneUnit { Unit u0; __device__ bool next(int i, Unit& u) const { if (i != 0) return false; u = u0; return true; } };

template <class Epi, class Sched, bool ALIGN_EPI = true>
__device__ __forceinline__ void gemm_phase(LAS unsigned char* lds, const int wv, const int lda, const int ldb, const Sched& S, const Epi& E) {
    const int tid = tid_of(wv);
    const int wid = __builtin_amdgcn_readfirstlane(tid >> 6), lane = tid & 63, wr = wid >> 2, wc = wid & 3, fr = lane & 15, fq = lane >> 4;
    unsigned voffA[2], voffB[2];
#pragma unroll
    for (int i = 0; i < 2; ++i) { int R, C; stage_rc(tid * 16 + i * 8192, R, C); const int Rb = Epi::PERM ? ((R & ~31) + perm32(R & 31)) : R;
        voffA[i] = (unsigned)(R * lda + C) * 2u; voffB[i] = (unsigned)(Rb * ldb + C) * 2u; }
    (void)fr; (void)fq;
    const size_t kstep = (size_t)(BK * 2);
    const unsigned hstepA = (unsigned)HALF * lda * 2u, hstepB = (unsigned)HALF * ldb * 2u;
    const unsigned ldsw = (unsigned)wid * 1024u;
    const int aoff = lds_byte(wr * 64 + fr, fq * 8), boff = lds_byte(wc * 32 + fr, fq * 8);
#define PG8_SA(b, h) (((b) * 2 + (h)) * HTB)
#define PG8_SB(b, h) ((4 + (b) * 2 + (h)) * HTB)
#define PG8_STAGE(bufoff, gbase, voff) do { _Pragma("unroll") for (int _i = 0; _i < 2; ++_i) \
        __builtin_amdgcn_global_load_lds((const unsigned*)((const char*)(gbase) + (voff)[_i]), (LAS unsigned*)(lds + (bufoff) + ldsw + _i * 8192), 16, 0, 0); } while (0)
#define PG8_LDA(dst, b, h) do { _Pragma("unroll") for (int m = 0; m < 4; ++m) _Pragma("unroll") for (int k = 0; k < 2; ++k) dst[m][k] = *(const LAS bf16x8*)(lds + PG8_SA(b, h) + aoff + m * 2048 + k * 1024); } while (0)
#define PG8_LDB(dst, b, h) do { _Pragma("unroll") for (int n = 0; n < 2; ++n) _Pragma("unroll") for (int k = 0; k < 2; ++k) dst[n][k] = *(const LAS bf16x8*)(lds + PG8_SB(b, h) + boff + n * 2048 + k * 1024); } while (0)
#define PG8_MMA(ai, bj, At, Bt) do { __builtin_amdgcn_s_setprio(1); _Pragma("unroll") for (int m = 0; m < 4; ++m) _Pragma("unroll") for (int n = 0; n < 2; ++n) _Pragma("unroll") for (int k = 0; k < 2; ++k) \
        acc[ai][bj][m][n] = __builtin_amdgcn_mfma_f32_16x16x32_bf16(Bt[n][k], At[m][k], acc[ai][bj][m][n], 0, 0, 0); __builtin_amdgcn_s_setprio(0); } while (0)
#define PG8_WAIT_V(n) asm volatile("s_waitcnt vmcnt(" #n ")" ::: "memory")
#define PG8_WAIT_L(n) asm volatile("s_waitcnt lgkmcnt(" #n ")" ::: "memory")
#define PG8_BAR __builtin_amdgcn_s_barrier()
#define PG8_SCHED __builtin_amdgcn_sched_barrier(0)
    int ui = 0, nt;
    const char* cA; const char* cB;
    { Unit u0; if (!S.next(0, u0)) return; cA = u0.a; cB = u0.b; nt = u0.kt; }
    f32x4 acc[2][2][4][2];
#pragma unroll
    for (int a = 0; a < 2; ++a)
#pragma unroll
        for (int b = 0; b < 2; ++b)
#pragma unroll
            for (int m = 0; m < 4; ++m)
#pragma unroll
                for (int n = 0; n < 2; ++n) acc[a][b][m][n] = (f32x4){0.f, 0.f, 0.f, 0.f};
    bf16x8 At[4][2], B0[2][2], B1[2][2];
    PG8_STAGE(PG8_SB(0, 0), cB, voffB); PG8_STAGE(PG8_SB(0, 1), cB + hstepB, voffB); PG8_STAGE(PG8_SA(0, 0), cA, voffA); PG8_STAGE(PG8_SA(0, 1), cA + hstepA, voffA);
    if (wr == 1) PG8_BAR;
    PG8_WAIT_V(2); PG8_BAR;
    PG8_STAGE(PG8_SB(1, 0), cB + kstep, voffB); PG8_STAGE(PG8_SA(1, 0), cA + kstep, voffA); PG8_STAGE(PG8_SB(1, 1), cB + hstepB + kstep, voffB);
    PG8_WAIT_V(6); PG8_BAR;
    for (;;) {
        bool has_next; const char* nA; const char* nB; int nnt;
        { Unit nx; has_next = S.next(ui + 1, nx); nA = has_next ? nx.a : cA; nB = has_next ? nx.b : cB; nnt = has_next ? nx.kt : nt; }
        for (int t = 0; t < nt; t += 2) {
            const bool last = (t == nt - 2);
            const char* a1 = cA + (size_t)(t + 1) * kstep;
            const char* a2 = last ? nA : cA + (size_t)(t + 2) * kstep; const char* b2 = last ? nB : cB + (size_t)(t + 2) * kstep;
            const char* a3 = a2 + kstep; const char* b3 = b2 + kstep;
            PG8_LDB(B0, 0, 0); PG8_LDB(B1, 0, 1); PG8_SCHED; PG8_LDA(At, 0, 0); PG8_STAGE(PG8_SA(1, 1), a1 + hstepA, voffA);
            PG8_WAIT_V(8); PG8_WAIT_L(0); PG8_BAR; PG8_MMA(0, 0, At, B0); PG8_MMA(0, 1, At, B1); PG8_BAR; PG8_SCHED;
            PG8_LDA(At, 0, 1); PG8_STAGE(PG8_SB(0, 0), b2, voffB); PG8_STAGE(PG8_SB(0, 1), b2 + hstepB, voffB); PG8_STAGE(PG8_SA(0, 0), a2, voffA);
            PG8_WAIT_V(8); PG8_WAIT_L(0); PG8_BAR; PG8_MMA(1, 0, At, B0); PG8_MMA(1, 1, At, B1); PG8_BAR; PG8_SCHED;
            PG8_LDB(B0, 1, 0); PG8_LDB(B1, 1, 1); PG8_SCHED; PG8_LDA(At, 1, 0); PG8_STAGE(PG8_SA(0, 1), a2 + hstepA, voffA);
            PG8_WAIT_V(8); PG8_WAIT_L(0); PG8_BAR; PG8_MMA(0, 0, At, B0); PG8_MMA(0, 1, At, B1); PG8_BAR; PG8_SCHED;
            PG8_LDA(At, 1, 1); PG8_STAGE(PG8_SB(1, 0), b3, voffB); PG8_STAGE(PG8_SB(1, 1), b3 + hstepB, voffB); PG8_STAGE(PG8_SA(1, 0), a3, voffA);
            PG8_WAIT_V(8); PG8_WAIT_L(0); PG8_BAR; PG8_MMA(1, 0, At, B0); PG8_MMA(1, 1, At, B1); PG8_BAR; PG8_SCHED;
        }
        if constexpr (ALIGN_EPI) { if (wr == 0) PG8_BAR; }
        { Unit cu; (void)S.next(ui, cu); const int t2 = tid_of(wv);
          const int w2 = __builtin_amdgcn_readfirstlane(t2 >> 6); E(acc, cu, w2 >> 2, w2 & 3, t2 & 15, (t2 & 63) >> 4); }
        if (!has_next) break;
#pragma unroll
        for (int a = 0; a < 2; ++a)
#pragma unroll
            for (int b = 0; b < 2; ++b)
#pragma unroll
                for (int m = 0; m < 4; ++m)
#pragma unroll
                    for (int n = 0; n < 2; ++n) acc[a][b][m][n] = (f32x4){0.f, 0.f, 0.f, 0.f};
        cA = nA; cB = nB; nt = nnt; ++ui;
        if constexpr (ALIGN_EPI) { if (wr == 1) PG8_BAR; }
    }
    PG8_WAIT_V(0);
    if constexpr (!ALIGN_EPI) { if (wr == 0) PG8_BAR; }
    PG8_BAR;
#undef PG8_SA
#undef PG8_SB
#undef PG8_STAGE
#undef PG8_LDA
#undef PG8_LDB
#undef PG8_MMA
#undef PG8_WAIT_V
#undef PG8_WAIT_L
#undef PG8_BAR
#undef PG8_SCHED
}

struct EpiProj {
    static constexpr bool PERM = true;
    bf16* proj; bf16* a2;
    __device__ __forceinline__ void operator()(const f32x4 (&acc)[2][2][4][2], const Unit& u, int wr, int wc, int fr, int fq) const {
        const int pn = u.pn; const bool gate = (pn >= 12 && pn < 20) || (pn >= 24 && pn < 28) || (pn >= 32); const bool isu = (pn >= 20 && pn < 24);
        const int row0 = u.pm * BM + wr * 64 + fr, col0 = pn * BM + wc * 32 + 8 * fq;
#pragma unroll
        for (int ai = 0; ai < 2; ++ai)
#pragma unroll
            for (int m = 0; m < 4; ++m) { const int row = row0 + ai * HALF + m * 16;
#pragma unroll
                for (int bj = 0; bj < 2; ++bj) { f32x4 v0 = acc[ai][bj][m][0], v1 = acc[ai][bj][m][1];
                    if (gate) {
#pragma unroll
                        for (int j = 0; j < 4; ++j) { v0[j] = silu_f(v0[j]); v1[j] = silu_f(v1[j]); } }
                    v4u w; w.x = cvt_pk_bf16(v0[0], v0[1]); w.y = cvt_pk_bf16(v0[2], v0[3]); w.z = cvt_pk_bf16(v1[0], v1[1]); w.w = cvt_pk_bf16(v1[2], v1[3]);
                    const int col = col0 + bj * HALF;
                    bf16* dst;
                    if (isu) { const int g = (col - OFF_U) >> 4, c0 = col & 15; dst = a2 + ((size_t)(g * 1024 + (row >> 4)) * 512 + (row & 15) * 16 + c0); }
                    else dst = proj + (size_t)row * INW + col;
                    *(v4u*)dst = w; } }
    }
};
struct EpiBf16 {
    static constexpr bool PERM = true;
    float scale;
    __device__ __forceinline__ void operator()(const f32x4 (&acc)[2][2][4][2], const Unit& u, int wr, int wc, int fr, int fq) const {
        bf16* base = (bf16*)u.c; const int ldc = u.ldc; const int row0 = wr * 64 + fr, col0 = wc * 32 + 8 * fq;
#pragma unroll
        for (int ai = 0; ai < 2; ++ai)
#pragma unroll
            for (int m = 0; m < 4; ++m) { bf16* rowp = base + (size_t)(row0 + ai * HALF + m * 16) * ldc + col0;
#pragma unroll
                for (int bj = 0; bj < 2; ++bj) { const f32x4 v0 = acc[ai][bj][m][0] * scale, v1 = acc[ai][bj][m][1] * scale;
                    v4u w; w.x = cvt_pk_bf16(v0[0], v0[1]); w.y = cvt_pk_bf16(v0[2], v0[3]); w.z = cvt_pk_bf16(v1[0], v1[1]); w.w = cvt_pk_bf16(v1[2], v1[3]);
                    *(v4u*)(rowp + bj * HALF) = w; } }
    }
};
struct EpiBf16X {
    static constexpr bool PERM = true;
    float scale; int aoff, boff;
    __device__ __forceinline__ void operator()(const f32x4 (&acc)[2][2][4][2], const Unit& u, int wr, int wc, int fr, int fq) const {
        bf16* base = (bf16*)u.c; const int ldc = u.ldc; const int row0 = wr * 64 + fr, col0 = wc * 32 + 8 * fq;
#pragma unroll
        for (int ai = 0; ai < 2; ++ai)
#pragma unroll
            for (int m = 0; m < 4; ++m) { bf16* rowp = base + (ai * aoff + (row0 + m * 16) * ldc + col0);
#pragma unroll
                for (int bj = 0; bj < 2; ++bj) { const f32x4 v0 = acc[ai][bj][m][0] * scale, v1 = acc[ai][bj][m][1] * scale;
                    v4u w; w.x = cvt_pk_bf16(v0[0], v0[1]); w.y = cvt_pk_bf16(v0[2], v0[3]); w.z = cvt_pk_bf16(v1[0], v1[1]); w.w = cvt_pk_bf16(v1[2], v1[3]);
                    *(v4u*)(rowp + bj * boff) = w; } }
    }
};
struct EpiFft2Sym {
    static constexpr bool PERM = true;
    float scale;
    __device__ __forceinline__ void operator()(const f32x4 (&acc)[2][2][4][2], const Unit& u, int wr, int wc, int fr, int fq) const {
        bf16* base = (bf16*)u.c; const int ldc = u.ldc, mt = u.pm; const unsigned flip = u.z ? 0x80008000u : 0u; const int row0 = wr * 64 + fr, col0 = wc * 32 + 8 * fq;
#pragma unroll
        for (int ai = 0; ai < 2; ++ai)
#pragma unroll
            for (int m = 0; m < 4; ++m) { const int r = row0 + ai * HALF + m * 16; bf16* rowp = base + (r * ldc + col0); bf16* rowm = base + ((4096 - 512 * mt - r) * ldc + col0); const bool mir = (mt | r) != 0;
#pragma unroll
                for (int bj = 0; bj < 2; ++bj) { const f32x4 v0 = acc[ai][bj][m][0] * scale, v1 = acc[ai][bj][m][1] * scale;
                    v4u w; w.x = cvt_pk_bf16(v0[0], v0[1]); w.y = cvt_pk_bf16(v0[2], v0[3]); w.z = cvt_pk_bf16(v1[0], v1[1]); w.w = cvt_pk_bf16(v1[2], v1[3]);
                    *(v4u*)(rowp + bj * 256) = w;
                    if (mir) { w.x ^= flip; w.y ^= flip; w.z ^= flip; w.w ^= flip; *(v4u*)(rowm + bj * 256) = w; } } }
    }
};
struct EpiF32 {
    static constexpr bool PERM = false;
    __device__ __forceinline__ void operator()(const f32x4 (&acc)[2][2][4][2], const Unit& u, int wr, int wc, int fr, int fq) const {
        float* base = (float*)u.c; const int ldc = u.ldc; const int row0 = wr * 64 + fr, col0 = wc * 32 + 4 * fq;
#pragma unroll
        for (int ai = 0; ai < 2; ++ai)
#pragma unroll
            for (int m = 0; m < 4; ++m) { float* rowp = base + (size_t)(row0 + ai * HALF + m * 16) * ldc + col0;
#pragma unroll
                for (int bj = 0; bj < 2; ++bj)
#pragma unroll
                    for (int n = 0; n < 2; ++n) *(f32x4*)(rowp + bj * HALF + n * 16) = acc[ai][bj][m][n]; }
    }
};
struct EpiLdsS {
    static constexpr bool PERM = true;
    LAS unsigned char* lds;
    __device__ __forceinline__ void operator()(const f32x4 (&acc)[2][2][4][2], const Unit& u, int wr, int wc, int fr, int fq) const {
        asm volatile("s_waitcnt vmcnt(0)" ::: "memory"); __builtin_amdgcn_s_barrier();
        const int row0 = wr * 64 + fr, ch0 = wc * 4 + fq; (void)u;
#pragma unroll
        for (int ai = 0; ai < 2; ++ai)
#pragma unroll
            for (int m = 0; m < 4; ++m) { const int r = row0 + ai * HALF + m * 16;
#pragma unroll
                for (int bj = 0; bj < 2; ++bj) { const f32x4 v0 = acc[ai][bj][m][0], v1 = acc[ai][bj][m][1];
                    v4u w; w.x = cvt_pk_bf16(v0[0], v0[1]); w.y = cvt_pk_bf16(v0[2], v0[3]); w.z = cvt_pk_bf16(v1[0], v1[1]); w.w = cvt_pk_bf16(v1[2], v1[3]);
                    *(LAS v4u*)(lds + r * 512 + (((ch0 + bj * 16) ^ fr) << 4)) = w; } }
    }
};
struct EpiSsmY {
    static constexpr bool PERM = true;
    bf16* yssm;
    __device__ __forceinline__ void operator()(const f32x4 (&acc)[2][2][4][2], const Unit& u, int wr, int wc, int fr, int fq) const {
        const int row0 = u.z + wr * 64 + fr, col0 = wc * 32 + 8 * fq, g = u.pn;
#pragma unroll
        for (int ai = 0; ai < 2; ++ai)
#pragma unroll
            for (int m = 0; m < 4; ++m) { const int chunk = row0 + ai * HALF + m * 16;
#pragma unroll
                for (int bj = 0; bj < 2; ++bj) { const f32x4 v0 = acc[ai][bj][m][0], v1 = acc[ai][bj][m][1];
                    v4u w; w.x = cvt_pk_bf16(v0[0], v0[1]); w.y = cvt_pk_bf16(v0[2], v0[3]); w.z = cvt_pk_bf16(v1[0], v1[1]); w.w = cvt_pk_bf16(v1[2], v1[3]);
                    const int col = col0 + bj * HALF, i = col >> 4, c0 = col & 15;
                    *(v4u*)(yssm + (size_t)(chunk * 16 + i) * 1024 + g * 16 + c0) = w; } }
    }
};
struct EpiGlu {
    static constexpr bool PERM = true;
    const bf16* proj; bf16* mix;
    __device__ __forceinline__ void operator()(const f32x4 (&acc)[2][2][4][2], const Unit& u, int wr, int wc, int fr, int fq) const {
        const int row0 = u.pm * BM + wr * 64 + fr, col0 = u.pn * HALF + wc * 32 + 8 * fq;
#pragma unroll
        for (int ai = 0; ai < 2; ++ai)
#pragma unroll
            for (int m = 0; m < 4; ++m) { const int row = row0 + ai * HALF + m * 16;
                const v4u gs = *(const v4u*)(proj + (size_t)row * INW + OFF_GS + col0);
                const f32x4 a0 = acc[ai][0][m][0], a1 = acc[ai][0][m][1], g0 = acc[ai][1][m][0], g1 = acc[ai][1][m][1];
                float o[8];
#pragma unroll
                for (int j = 0; j < 4; ++j) { o[j] = a0[j] * sigmoid_f(g0[j]); o[4 + j] = a1[j] * sigmoid_f(g1[j]); }
                o[0] *= bf_lo(gs.x); o[1] *= bf_hi(gs.x); o[2] *= bf_lo(gs.y); o[3] *= bf_hi(gs.y); o[4] *= bf_lo(gs.z); o[5] *= bf_hi(gs.z); o[6] *= bf_lo(gs.w); o[7] *= bf_hi(gs.w);
                v4u w; w.x = cvt_pk_bf16(o[0], o[1]); w.y = cvt_pk_bf16(o[2], o[3]); w.z = cvt_pk_bf16(o[4], o[5]); w.w = cvt_pk_bf16(o[6], o[7]);
                *(v4u*)(mix + (size_t)row * DM + 2048 + col0) = w; }
    }
};
struct EpiFftW {
    static constexpr bool PERM = true;
    const bf16* proj; bf16* mix;
    __device__ __forceinline__ void operator()(const f32x4 (&acc)[2][2][4][2], const Unit& u, int wr, int wc, int fr, int fq) const {
        const int row0 = u.pm * BM + wr * 64 + fr, col0 = u.pn * BM + wc * 32 + 8 * fq;
#pragma unroll
        for (int ai = 0; ai < 2; ++ai)
#pragma unroll
            for (int m = 0; m < 4; ++m) { const int row = row0 + ai * HALF + m * 16;
#pragma unroll
                for (int bj = 0; bj < 2; ++bj) { const int col = col0 + bj * HALF;
                    const v4u gs = *(const v4u*)(proj + (size_t)row * INW + OFF_GF + col);
                    const f32x4 v0 = acc[ai][bj][m][0], v1 = acc[ai][bj][m][1];
                    v4u w; w.x = cvt_pk_bf16(v0[0] * bf_lo(gs.x), v0[1] * bf_hi(gs.x)); w.y = cvt_pk_bf16(v0[2] * bf_lo(gs.y), v0[3] * bf_hi(gs.y));
                    w.z = cvt_pk_bf16(v1[0] * bf_lo(gs.z), v1[1] * bf_hi(gs.z)); w.w = cvt_pk_bf16(v1[2] * bf_lo(gs.w), v1[3] * bf_hi(gs.w));
                    *(v4u*)(mix + (size_t)row * DM + 3072 + col) = w; } }
    }
};
struct EpiOut {
    static constexpr bool PERM = true;
    bf16* delta; const float* modl;
    __device__ __forceinline__ void operator()(const f32x4 (&acc)[2][2][4][2], const Unit& u, int wr, int wc, int fr, int fq) const {
        const int rt = u.pm * BM; const int v = rt < NCTX ? 0 : (rt < NCTX + 4096 ? 1 : 2);
        const float* gv = modl + v * 12288 + 8192;
        const int row0 = rt + wr * 64 + fr, col0 = u.pn * BM + wc * 32 + 8 * fq;
        f32x4 gt[2][2];
#pragma unroll
        for (int bj = 0; bj < 2; ++bj)
#pragma unroll
            for (int n = 0; n < 2; ++n) gt[bj][n] = *(const f32x4*)(gv + col0 + bj * HALF + n * 4);
#pragma unroll
        for (int ai = 0; ai < 2; ++ai)
#pragma unroll
            for (int m = 0; m < 4; ++m) { bf16* rowp = delta + (size_t)(row0 + ai * HALF + m * 16) * DM + col0;
#pragma unroll
                for (int bj = 0; bj < 2; ++bj) { const f32x4 v0 = acc[ai][bj][m][0] * gt[bj][0], v1 = acc[ai][bj][m][1] * gt[bj][1];
                    v4u w; w.x = cvt_pk_bf16(v0[0], v0[1]); w.y = cvt_pk_bf16(v0[2], v0[3]); w.z = cvt_pk_bf16(v1[0], v1[1]); w.w = cvt_pk_bf16(v1[2], v1[3]);
                    *(v4u*)(rowp + bj * HALF) = w; } }
    }
};
}

namespace att {
constexpr int D = 128, QBLK = 32, KVBLK = 64;
constexpr float SCALE = 0.088388347648318440f;
constexpr float THR = 8.f;
constexpr int SHM_V = KVBLK * D * 2, SHM_K = KVBLK * D * 2;
constexpr int WS_OFF = 2 * SHM_V + 2 * SHM_K, OSTG_OFF = WS_OFF + NWAVES * 64 * 4, OSTG_ROW = 272, OSTG_WAVE = 32 * OSTG_ROW;
static_assert(DEPTH >= 2, "the bf16 stream is first written by layer 1's norm phase");
static_assert(OSTG_OFF + NWAVES * OSTG_WAVE <= MISC_OFF, "attention LDS");
#define KSWZ(row, colB) ((row) * 256 + ((colB) ^ (((row) & 7) << 4)))
#define SBAR() __builtin_amdgcn_sched_barrier(0)
__device__ __forceinline__ int crow(int r, int hi) { return (r & 3) + 8 * (r >> 2) + 4 * hi; }
__device__ __forceinline__ void partialSM(f32x16& p0, f32x16& p1, float& m_reg, float& mn, float& alpha) {
  constexpr float C = SCALE * 1.4426950408889634f;
  float pmax = p0[0]; for (int r = 1; r < 16; ++r) pmax = fmaxf(pmax, p0[r]); for (int r = 0; r < 16; ++r) pmax = fmaxf(pmax, p1[r]);
  { auto rr = __builtin_amdgcn_permlane32_swap(__float_as_uint(pmax), __float_as_uint(pmax), false, false);
    pmax = fmaxf(__uint_as_float(rr[0]), __uint_as_float(rr[1])); }
  if (__builtin_expect(__all(pmax - m_reg <= THR / SCALE), 1)) { mn = m_reg; alpha = 1.f; }
  else { mn = fmaxf(m_reg, pmax); alpha = __builtin_amdgcn_exp2f((m_reg - mn) * C); m_reg = mn; }
  float mnC = -mn * C;
  for (int r = 0; r < 16; ++r) p0[r] = fmaf(p0[r], C, mnC); for (int r = 0; r < 16; ++r) p1[r] = fmaf(p1[r], C, mnC);
  for (int r = 0; r < 16; ++r) p0[r] = __builtin_amdgcn_exp2f(p0[r]);
}
__device__ __forceinline__ void finishSM(f32x16& p0, f32x16& p1, float alpha, float& l_reg, bf16x8& pa0, bf16x8& pa1, bf16x8& pa2, bf16x8& pa3) {
  for (int r = 0; r < 16; ++r) p1[r] = __builtin_amdgcn_exp2f(p1[r]);
  float ps = 0; for (int r = 0; r < 16; ++r) ps += p0[r]; for (int r = 0; r < 16; ++r) ps += p1[r];
  { auto rr = __builtin_amdgcn_permlane32_swap(__float_as_uint(ps), __float_as_uint(ps), false, false);
    ps = __uint_as_float(rr[0]) + __uint_as_float(rr[1]); }
  l_reg = l_reg * alpha + ps;
#define PK4(P, BASE, OUT) do { unsigned a0 = cvt_pk_bf16(P[BASE + 0], P[BASE + 1]), a1 = cvt_pk_bf16(P[BASE + 2], P[BASE + 3]);   \
    unsigned b0 = cvt_pk_bf16(P[BASE + 4], P[BASE + 5]), b1 = cvt_pk_bf16(P[BASE + 6], P[BASE + 7]);                              \
    auto r0 = __builtin_amdgcn_permlane32_swap(a0, b0, false, false); auto r1 = __builtin_amdgcn_permlane32_swap(a1, b1, false, false); \
    v4u w = {r0[0], r1[0], r0[1], r1[1]}; OUT = *reinterpret_cast<bf16x8*>(&w); } while (0)
  PK4(p0, 0, pa0); PK4(p0, 8, pa1); PK4(p1, 0, pa2); PK4(p1, 8, pa3);
#undef PK4
}
__device__ __forceinline__ void qkt(f32x16& p0, f32x16& p1, const char* Ks, const bf16x8* qr, int r32, int hi) {
  p0 = f32x16{}; p1 = f32x16{};
  for (int d0 = 0; d0 < 8; ++d0) { int cb = (d0 * 16 + hi * 8) * 2;
    bf16x8 b0 = *reinterpret_cast<const bf16x8*>(Ks + KSWZ(r32, cb));
    bf16x8 b1 = *reinterpret_cast<const bf16x8*>(Ks + KSWZ(32 + r32, cb));
    p0 = __builtin_amdgcn_mfma_f32_32x32x16_bf16(b0, qr[d0], p0, 0, 0, 0);
    p1 = __builtin_amdgcn_mfma_f32_32x32x16_bf16(b1, qr[d0], p1, 0, 0, 0); }
}
__device__ __forceinline__ int v_st(int k, int c) { const int kk = (k & ~0xC) | ((k & 4) << 1) | ((k & 8) >> 1); return ((kk >> 3) * 4 + (c >> 5)) * 512 + ((kk & 7) * 32 + (c & 31)) * 2; }
__device__ __forceinline__ int v_rd_base(int lane) { return ((lane & 3) << 3) | (((lane >> 2) & 3) << 6) | (((lane >> 4) & 1) << 5) | (((lane >> 5) & 1) << 8); }
constexpr int v_rd_off(int d0, int ks, int half) { return d0 * 512 + ks * 4096 + half * 2048; }
template <int OFF> __device__ __forceinline__ s16x4 tr_read(int vb) {
  s16x4 r; asm volatile("ds_read_b64_tr_b16 %0, %1 offset:%2" : "=&v"(r) : "v"(vb), "i"(OFF) : "memory"); return r;
}
template <int D0> __device__ __forceinline__ void pv_one(f32x16& od, int vb, bf16x8 pa0, bf16x8 pa1, bf16x8 pa2, bf16x8 pa3) {
  const s16x4 l0 = tr_read<v_rd_off(D0, 0, 0)>(vb), h0 = tr_read<v_rd_off(D0, 0, 1)>(vb), l1 = tr_read<v_rd_off(D0, 1, 0)>(vb), h1 = tr_read<v_rd_off(D0, 1, 1)>(vb);
  const s16x4 l2 = tr_read<v_rd_off(D0, 2, 0)>(vb), h2 = tr_read<v_rd_off(D0, 2, 1)>(vb), l3 = tr_read<v_rd_off(D0, 3, 0)>(vb), h3 = tr_read<v_rd_off(D0, 3, 1)>(vb);
  asm volatile("s_waitcnt lgkmcnt(0)" ::: "memory"); SBAR();
#define PK(L, H) (bf16x8){L[0], L[1], L[2], L[3], H[0], H[1], H[2], H[3]}
  od = __builtin_amdgcn_mfma_f32_32x32x16_bf16(pa0, PK(l0, h0), od, 0, 0, 0);
  od = __builtin_amdgcn_mfma_f32_32x32x16_bf16(pa1, PK(l1, h1), od, 0, 0, 0);
  od = __builtin_amdgcn_mfma_f32_32x32x16_bf16(pa2, PK(l2, h2), od, 0, 0, 0);
  od = __builtin_amdgcn_mfma_f32_32x32x16_bf16(pa3, PK(l3, h3), od, 0, 0, 0);
#undef PK
}
__device__ __forceinline__ void pv_d0(f32x16* o, int vb, bf16x8 pa0, bf16x8 pa1, bf16x8 pa2, bf16x8 pa3) {
  pv_one<0>(o[0], vb, pa0, pa1, pa2, pa3); pv_one<1>(o[1], vb, pa0, pa1, pa2, pa3); pv_one<2>(o[2], vb, pa0, pa1, pa2, pa3); pv_one<3>(o[3], vb, pa0, pa1, pa2, pa3);
}

__device__ __forceinline__ void attn_unit(const bf16* __restrict__ Qb, const bf16* __restrict__ Gb, bf16* __restrict__ Ob,
                                          const bf16* __restrict__ K0, const bf16* __restrict__ V0, int ld0, int nt0,
                                          const bf16* __restrict__ K1, const bf16* __restrict__ V1, int ld1, int nt1,
                                          const float* __restrict__ qn, const f32x2* __restrict__ rope, int tok0, char* lds, int wv) {
  const int tid = tid_of(wv);
  const int wid = tid >> 6, lane = tid & 63, r32 = lane & 31, hi = lane >> 5;
  char* V_lds = lds; char* K_lds = lds + 2 * SHM_V;
  float* ws = (float*)(lds + WS_OFF) + wid * 64; float* li_l = ws; float* al_l = ws + 32;
  float m_reg = -1e30f, l_reg = 0; f32x16 o[4] = {}; bf16x8 qr[8];
  const int sr = tid >> 4, sc = (tid & 15) * 8, vst0 = v_st(sr, sc), vst1 = v_st(32 + sr, sc);
  const int vb0 = (int)(uintptr_t)V_lds + v_rd_base(lane);
  struct { bf16x8 vs0, vs1, ks0, ks1; } sr_[2];
#define SLOAD(i, jt) do { const bf16* kb_; const bf16* vb_; long ld_; \
    if ((jt) < nt0) { kb_ = K0 + (long)(jt) * KVBLK * ld0; vb_ = V0 + (long)(jt) * KVBLK * ld0; ld_ = ld0; } else { kb_ = K1 + (long)((jt) - nt0) * KVBLK * ld1; vb_ = V1 + (long)((jt) - nt0) * KVBLK * ld1; ld_ = ld1; } \
    sr_[i].vs0 = *reinterpret_cast<const bf16x8*>(vb_ + (long)sr * ld_ + sc); sr_[i].vs1 = *reinterpret_cast<const bf16x8*>(vb_ + (long)(32 + sr) * ld_ + sc); \
    sr_[i].ks0 = *reinterpret_cast<const bf16x8*>(kb_ + (long)sr * ld_ + sc); sr_[i].ks1 = *reinterpret_cast<const bf16x8*>(kb_ + (long)(32 + sr) * ld_ + sc); } while (0)
  SLOAD(0, 0);
  __syncthreads();
  {
    const bf16* Qw = Qb + (long)(wid * QBLK + r32) * INW + hi * 8;
    float x[8][8]; float ss = 0.f;
#pragma unroll
    for (int d0 = 0; d0 < 8; ++d0) { const v4u raw = *reinterpret_cast<const v4u*>(Qw + d0 * 16);
      x[d0][0] = bf_lo(raw.x); x[d0][1] = bf_hi(raw.x); x[d0][2] = bf_lo(raw.y); x[d0][3] = bf_hi(raw.y); x[d0][4] = bf_lo(raw.z); x[d0][5] = bf_hi(raw.z); x[d0][6] = bf_lo(raw.w); x[d0][7] = bf_hi(raw.w);
#pragma unroll
      for (int j = 0; j < 8; ++j) ss += x[d0][j] * x[d0][j]; }
    { auto rr = __builtin_amdgcn_permlane32_swap(__float_as_uint(ss), __float_as_uint(ss), false, false); ss = __uint_as_float(rr[0]) + __uint_as_float(rr[1]); }
    const float rstd = rsqrtf(ss * (1.0f / 128.0f) + NORM_EPS);
#pragma unroll
    for (int d0 = 0; d0 < 8; ++d0) { const f32x4 w0 = *reinterpret_cast<const f32x4*>(qn + d0 * 16 + hi * 8), w1 = *reinterpret_cast<const f32x4*>(qn + d0 * 16 + hi * 8 + 4);
#pragma unroll
      for (int j = 0; j < 4; ++j) { x[d0][j] *= rstd * w0[j]; x[d0][4 + j] *= rstd * w1[j]; } }
    if (rope) {
      const int t = tok0 + wid * QBLK + r32, prow = t >> 6, pcol = t & 63;
#pragma unroll
      for (int half = 0; half < 2; ++half) { const f32x2* rp = rope + (half ? pcol : prow) * 32;
#pragma unroll
        for (int dd = 0; dd < 2; ++dd) { const int d0 = half * 4 + dd;
#pragma unroll
          for (int j = 0; j < 8; ++j) { const f32x2 cs = rp[dd * 16 + hi * 8 + j]; const float x1 = x[d0][j], x2 = x[d0 + 2][j];
            x[d0][j] = x1 * cs.x - x2 * cs.y; x[d0 + 2][j] = x1 * cs.y + x2 * cs.x; } } }
    }
#pragma unroll
    for (int d0 = 0; d0 < 8; ++d0) { v4u w = {cvt_pk_bf16(x[d0][0], x[d0][1]), cvt_pk_bf16(x[d0][2], x[d0][3]), cvt_pk_bf16(x[d0][4], x[d0][5]), cvt_pk_bf16(x[d0][6], x[d0][7])}; qr[d0] = *reinterpret_cast<bf16x8*>(&w); }
  }
#define SWRITE(b, i) do { *(bf16x8*)(V_lds + (b) * SHM_V + vst0) = sr_[i].vs0;          \
    *(bf16x8*)(V_lds + (b) * SHM_V + vst1) = sr_[i].vs1; int kc = sc * 2;               \
    *(bf16x8*)(K_lds + (b) * SHM_K + KSWZ(sr, kc)) = sr_[i].ks0;                       \
    *(bf16x8*)(K_lds + (b) * SHM_K + KSWZ(32 + sr, kc)) = sr_[i].ks1; } while (0)
#define SWAIT() asm volatile("s_waitcnt vmcnt(4)" ::: "memory")
#define RESC(a) do { if (__any((a) < 1.f)) { if (hi == 0) al_l[r32] = (a); asm volatile("s_waitcnt lgkmcnt(0)" ::: "memory"); \
    for (int d = 0; d < 4; ++d) for (int r = 0; r < 16; ++r) o[d][r] *= al_l[crow(r, hi)]; } } while (0)
  f32x16 pA0, pA1, pB0, pB1; float mnA, mnB, alA, alB; bf16x8 pa0, pa1, pa2, pa3; const int NT = nt0 + nt1;
  constexpr int SE = 0, SO = 1;
  asm volatile("s_waitcnt vmcnt(0)" ::: "memory"); SWRITE(0, SE); __syncthreads();
  qkt(pA0, pA1, K_lds, qr, r32, hi); partialSM(pA0, pA1, m_reg, mnA, alA);
  SLOAD(SO, 1); if (2 < NT) SLOAD(SE, 2);
  SWAIT(); SWRITE(1, SO); __syncthreads();
  for (int j = 1; j + 1 < NT; j += 2) {
    SBAR(); qkt(pB0, pB1, K_lds + SHM_K, qr, r32, hi);
    finishSM(pA0, pA1, alA, l_reg, pa0, pa1, pa2, pa3); SBAR();
    SLOAD(SO, j + 2); SBAR();
    pv_d0(o, vb0, pa0, pa1, pa2, pa3); partialSM(pB0, pB1, m_reg, mnB, alB);
    __syncthreads(); SWAIT(); SWRITE(0, SE);
    RESC(alB); __syncthreads();
    SBAR(); qkt(pA0, pA1, K_lds, qr, r32, hi);
    finishSM(pB0, pB1, alB, l_reg, pa0, pa1, pa2, pa3); SBAR();
    if (j + 3 < NT) SLOAD(SE, j + 3); SBAR();
    pv_d0(o, vb0 + SHM_V, pa0, pa1, pa2, pa3); partialSM(pA0, pA1, m_reg, mnA, alA);
    __syncthreads(); SWAIT(); SWRITE(1, SO);
    RESC(alA); __syncthreads();
  }
  SBAR(); qkt(pB0, pB1, K_lds + SHM_K, qr, r32, hi);
  finishSM(pA0, pA1, alA, l_reg, pa0, pa1, pa2, pa3); SBAR();
  pv_d0(o, vb0, pa0, pa1, pa2, pa3); partialSM(pB0, pB1, m_reg, mnB, alB);
  __syncthreads(); RESC(alB);
  finishSM(pB0, pB1, alB, l_reg, pa0, pa1, pa2, pa3); SBAR();
  pv_d0(o, vb0 + SHM_V, pa0, pa1, pa2, pa3);
  if (hi == 0) li_l[r32] = l_reg; asm volatile("s_waitcnt lgkmcnt(0)" ::: "memory");
  char* stg = lds + OSTG_OFF + wid * OSTG_WAVE;
  v4u gvv[8];
#pragma unroll
  for (int it = 0; it < 8; ++it) gvv[it] = *reinterpret_cast<const v4u*>(Gb + (long)(wid * QBLK + it * 4 + (lane >> 4)) * INW + (lane & 15) * 8);
#pragma unroll
  for (int r = 0; r < 16; ++r) { const int orow = crow(r, hi); const float rl = __builtin_amdgcn_rcpf(li_l[orow]);
#pragma unroll
    for (int d0 = 0; d0 < 4; ++d0) { const unsigned w = cvt_pk_bf16(o[d0][r] * rl, 0.f); *(bf16*)(stg + orow * OSTG_ROW + (d0 * 32 + r32) * 2) = (bf16)(w & 0xffffu); }
    if ((r & 3) == 3) asm volatile("" ::: "memory"); }
  asm volatile("s_waitcnt lgkmcnt(0)" ::: "memory");
#pragma unroll
  for (int it = 0; it < 8; ++it) { const int row = it * 4 + (lane >> 4), cc = (lane & 15) * 8;
    const v4u ov = *(const v4u*)(stg + row * OSTG_ROW + cc * 2);
    const v4u gv = gvv[it];
    v4u w; w.x = cvt_pk_bf16(bf_lo(ov.x) * bf_lo(gv.x), bf_hi(ov.x) * bf_hi(gv.x)); w.y = cvt_pk_bf16(bf_lo(ov.y) * bf_lo(gv.y), bf_hi(ov.y) * bf_hi(gv.y));
    w.z = cvt_pk_bf16(bf_lo(ov.z) * bf_lo(gv.z), bf_hi(ov.z) * bf_hi(gv.z)); w.w = cvt_pk_bf16(bf_lo(ov.w) * bf_lo(gv.w), bf_hi(ov.w) * bf_hi(gv.w));
    *reinterpret_cast<v4u*>(Ob + (long)(wid * QBLK + row) * DM + cc) = w; }
#undef SLOAD
#undef SWRITE
#undef SWAIT
#undef RESC
}
}

#define XB_TMO      128
#define XB_XCNT(j)  (256  + 64 * (j))
#define XB_XSUB(j)  (1280 + 64 * (j))
#define XB_XGEN(j)  (2304 + 64 * (j))
#define XB_TOP      3328
#define XB_TOPGEN   3392
#define XCD_BAR_WORDS 3456
#define XB_SPIN_CAP (1u << 18)
__device__ __forceinline__ unsigned xb_ld(unsigned* p)              { return __hip_atomic_load(p, __ATOMIC_RELAXED, __HIP_MEMORY_SCOPE_AGENT); }
__device__ __forceinline__ unsigned xb_add(unsigned* p, unsigned v) { return __hip_atomic_fetch_add(p, v, __ATOMIC_RELAXED, __HIP_MEMORY_SCOPE_AGENT); }
__device__ __forceinline__ unsigned xb_xcc_id() { return (unsigned)__builtin_amdgcn_s_getreg((3 << 11) | 20) & 0xFu; }
#define XB_SPIN(cond, bar) do { unsigned _sp = 0; while (cond) { __builtin_amdgcn_s_sleep(1); \
    if ((++_sp & 255u) == 0u) { if (xb_ld(&(bar)[XB_TMO])) break; if (_sp > XB_SPIN_CAP) { atomicAdd(&(bar)[XB_TMO], 1u); break; } } } } while (0)
struct XcdBarrier { unsigned* bar; unsigned x; volatile LAS unsigned* st; };
__device__ __forceinline__ XcdBarrier xcd_barrier_post(unsigned* bar, volatile LAS unsigned* st, int tid) {
    XcdBarrier b; b.bar = bar; b.x = xb_xcc_id(); b.st = st;
    if (tid == 0) (void)xb_add(&bar[XB_XCNT(b.x)], 1u);
    return b;
}
__device__ __forceinline__ void xcd_barrier_complete(unsigned* bar, unsigned x, unsigned& nloc, unsigned& nx) {
    const unsigned G = gridDim.x * gridDim.y * gridDim.z;
    unsigned sum, cnt, mine, sp = 0u;
    for (;;) {
        sum = 0u; cnt = 0u; mine = 0u;
#pragma nounroll
        for (unsigned j = 0; j < 16; ++j) { const unsigned c = xb_ld(&bar[XB_XCNT(j)]); sum += c; cnt += (c > 0u) ? 1u : 0u; mine = (j == x) ? c : mine; }
        if (sum == G) break;
        __builtin_amdgcn_s_sleep(1);
        if ((++sp & 255u) == 0u) { if (xb_ld(&bar[XB_TMO])) break; if (sp > XB_SPIN_CAP) { atomicAdd(&bar[XB_TMO], 1u); break; } }
    }
    nloc = mine > 0u ? mine : 1u; nx = cnt > 0u ? cnt : 1u;
}
__device__ __forceinline__ void xcd_barrier(const XcdBarrier& b, int wv) {
    asm volatile("s_waitcnt vmcnt(0)" ::: "memory");
    __syncthreads();
    if (tid_of(wv) == 0) {
        unsigned* bar = b.bar;
        __builtin_amdgcn_s_waitcnt(0);
        unsigned nloc = b.st[0], nx = b.st[1];
        if (nloc == 0u) { xcd_barrier_complete(bar, b.x, nloc, nx); b.st[0] = nloc; b.st[1] = nx; }
        const unsigned old = xb_add(&bar[XB_XSUB(b.x)], 1u);
        const unsigned gen = old / nloc;
        if (old + 1u == (gen + 1u) * nloc) {
            __builtin_amdgcn_fence(__ATOMIC_RELEASE, "agent");
            asm volatile("s_waitcnt vmcnt(0)" ::: "memory");
            const unsigned og = xb_add(&bar[XB_TOP], 1u);
            const unsigned tg = og / nx;
            if (og + 1u == (tg + 1u) * nx) xb_add(&bar[XB_TOPGEN], 1u);
            else XB_SPIN(xb_ld(&bar[XB_TOPGEN]) == tg, bar);
            __builtin_amdgcn_fence(__ATOMIC_ACQUIRE, "agent");
            xb_add(&bar[XB_XGEN(b.x)], 1u);
            asm volatile("s_waitcnt vmcnt(0)" ::: "memory");
        } else {
            XB_SPIN(xb_ld(&bar[XB_XGEN(b.x)]) == gen, bar);
            __builtin_amdgcn_fence(__ATOMIC_ACQUIRE, "agent");
            asm volatile("s_waitcnt vmcnt(0)" ::: "memory");
        }
    }
    __syncthreads();
}
__device__ __forceinline__ void wg_global_sync() {
    asm volatile("s_waitcnt vmcnt(0)" ::: "memory");
    __syncthreads();
    __builtin_amdgcn_fence(__ATOMIC_ACQUIRE, "agent");
    asm volatile("s_waitcnt vmcnt(0)" ::: "memory");
}

struct Args { const float* in[28]; float* out; unsigned char* ws; int ph_lo, ph_hi; };
typedef const __attribute__((address_space(4))) Args* KAP;
#define KA_HERE() KAP ka = (KAP)__builtin_amdgcn_kernarg_segment_ptr(); asm volatile("" : "+s"(ka))
enum { I_XP = 0, I_XS, I_CK, I_CV, I_SFR, I_SFI, I_SBR, I_SBI, I_C, I_CCTX, I_NG, I_WMOD, I_BMOD, I_WIN, I_QN, I_KN, I_LRE, I_LIM, I_LSTEP, I_BRE, I_BIM, I_CRE, I_CIM, I_DSKIP, I_WGLU, I_WFFT, I_WOUT, I_FNG };

__device__ __forceinline__ int glu_row(int n) { return n < 1024 ? ((n >> 7) * 256 + (n & 127)) : (((n - 1024) >> 7) * 256 + 128 + ((n - 1024) & 127)); }
template <bool GLU>
__device__ __forceinline__ void tr_item(const float* __restrict__ W, int K, int N, bf16* __restrict__ WT, LAS float* scr, int item, int lane) {
    const int nblk = N / 64, kb = item / nblk, nb = item % nblk, k0 = 64 * kb, n0 = 64 * nb;
#pragma unroll 8
    for (int i = 0; i < 64; ++i) scr[i * 65 + lane] = W[(size_t)(k0 + i) * N + n0 + lane];
    LDS_WAIT(); asm volatile("" ::: "memory");
    const int c = lane & 7;
#pragma unroll
    for (int j = 0; j < 8; ++j) { const int n = (lane >> 3) + 8 * j; const LAS float* s = scr + (8 * c) * 65 + n;
        v4u o; o.x = cvt_pk_bf16(s[0 * 65], s[1 * 65]); o.y = cvt_pk_bf16(s[2 * 65], s[3 * 65]); o.z = cvt_pk_bf16(s[4 * 65], s[5 * 65]); o.w = cvt_pk_bf16(s[6 * 65], s[7 * 65]);
        int nd = n0 + n; if (GLU) nd = glu_row(nd);
        *(v4u*)(WT + (size_t)nd * K + k0 + 8 * c) = o; }
    LDS_WAIT(); asm volatile("" ::: "memory");
}

__device__ __forceinline__ void ssm_matrices(KAP A, int l, int g, LAS unsigned char* lds, int tid) {
    LAS f32x2* pw = (LAS f32x2*)lds;
    LAS f32x2* bb = pw + 2 * 17 * 64;
    LAS f32x2* cc = bb + 2 * 64 * 16;
    LAS float* kk = (LAS float*)(cc + 2 * 16 * 64);
    if (tid < 128) {
        const int dir = tid >> 6, p = tid & 63, ig = (l * 2 + dir) * 64 + g;
        const float dt = expf(A->in[I_LSTEP][ig]);
        const float lr = A->in[I_LRE][(size_t)ig * 64 + p], li = A->in[I_LIM][(size_t)ig * 64 + p];
        for (int tau = 0; tau <= 16; ++tau) {
            const float mag = expf(lr * dt * (float)tau);
            const double turns = (double)li * (double)dt * (double)tau * 0.15915494309189535;
            const float fr = (float)(turns - rint(turns));
            pw[(dir * 17 + tau) * 64 + p] = (f32x2){mag * cospif(2.f * fr), mag * sinpif(2.f * fr)};
        }
        const f32x2 ab = pw[(dir * 17 + 1) * 64 + p];
        const float nr = ab.x - 1.0f, ni = ab.y, den = lr * lr + li * li;
        const float f_re = (nr * lr + ni * li) / den, f_im = (ni * lr - nr * li) / den;
        for (int c = 0; c < 16; ++c) { const float br = A->in[I_BRE][((size_t)ig * 64 + p) * 16 + c], bi = A->in[I_BIM][((size_t)ig * 64 + p) * 16 + c];
            bb[(dir * 64 + p) * 16 + c] = (f32x2){f_re * br - f_im * bi, f_re * bi + f_im * br}; }
        ((f32x2*)(A->ws + WS_A16))[(size_t)ig * 64 + p] = pw[(dir * 17 + 16) * 64 + p];
    }
    for (int idx = tid; idx < 2048; idx += 512) { const int dir = idx >> 10, c = (idx >> 6) & 15, p = idx & 63; const size_t gi = (((size_t)(l * 2 + dir) * 64 + g) * 16 + c) * 64 + p;
        cc[idx] = (f32x2){A->in[I_CRE][gi], A->in[I_CIM][gi]}; }
    __syncthreads();
    {
        const int dir = tid >> 8, tau = (tid >> 4) & 15, c = tid & 15;
        float accv[16];
#pragma unroll
        for (int j = 0; j < 16; ++j) accv[j] = 0.f;
        for (int p = 0; p < 64; ++p) { const f32x2 cv = cc[(dir * 16 + c) * 64 + p], pv = pw[(dir * 17 + tau) * 64 + p];
            const float wre = cv.x * pv.x - cv.y * pv.y, wim = cv.x * pv.y + cv.y * pv.x;
#pragma unroll
            for (int j = 0; j < 16; ++j) { const f32x2 bv = bb[(dir * 64 + p) * 16 + j]; accv[j] += wre * bv.x - wim * bv.y; } }
#pragma unroll
        for (int j = 0; j < 16; ++j) kk[((dir * 16 + tau) * 16 + c) * 16 + j] = accv[j];
    }
    __syncthreads();
    const int lg = l * 64 + g;
    bf16* Pm = (bf16*)(A->ws + WS_PMAT) + (size_t)lg * 256 * 256;
    for (int q = tid; q < 8192; q += 512) { const int R = q >> 5, col = (q & 31) * 8, s = col >> 4, c0 = col & 15, dir = R >> 7, reim = (R >> 6) & 1, p = R & 63, e = dir ? s : 15 - s;
        const f32x2 pv = pw[(dir * 17 + e) * 64 + p]; float v[8];
#pragma unroll
        for (int j = 0; j < 8; ++j) { const f32x2 bv = bb[(dir * 64 + p) * 16 + c0 + j]; v[j] = reim ? (pv.x * bv.y + pv.y * bv.x) : (pv.x * bv.x - pv.y * bv.y); }
        v4u w; w.x = cvt_pk_bf16(v[0], v[1]); w.y = cvt_pk_bf16(v[2], v[3]); w.z = cvt_pk_bf16(v[4], v[5]); w.w = cvt_pk_bf16(v[6], v[7]);
        *(v4u*)(Pm + (size_t)R * 256 + col) = w; }
    bf16* KGm = (bf16*)(A->ws + WS_KG) + (size_t)lg * 256 * 512;
    for (int q = tid; q < 16384; q += 512) { const int R = q >> 6, col = (q & 63) * 8, i = R >> 4, c = R & 15; float v[8];
        if (col < 256) { const int s = col >> 4, c0 = col & 15;
#pragma unroll
            for (int j = 0; j < 8; ++j) { const int cp = c0 + j; float x;
                if (s < i) x = kk[((0 * 16 + (i - s)) * 16 + c) * 16 + cp];
                else if (s > i) x = kk[((1 * 16 + (s - i)) * 16 + c) * 16 + cp];
                else { x = kk[((0 * 16 + 0) * 16 + c) * 16 + cp] + kk[((1 * 16 + 0) * 16 + c) * 16 + cp]; if (cp == c) x += A->in[I_DSKIP][l * 1024 + g * 16 + c]; }
                v[j] = x; }
        } else { const int k = col - 256, dir = k >> 7, reim = (k >> 6) & 1, p0 = k & 63, e = dir ? 16 - i : i + 1;
#pragma unroll
            for (int j = 0; j < 8; ++j) { const f32x2 cv = cc[(dir * 16 + c) * 64 + p0 + j], pv = pw[(dir * 17 + e) * 64 + p0 + j];
                v[j] = reim ? -(cv.x * pv.y + cv.y * pv.x) : (cv.x * pv.x - cv.y * pv.y); } }
        v4u w; w.x = cvt_pk_bf16(v[0], v[1]); w.y = cvt_pk_bf16(v[2], v[3]); w.z = cvt_pk_bf16(v[4], v[5]); w.w = cvt_pk_bf16(v[6], v[7]);
        *(v4u*)(KGm + (size_t)R * 512 + col) = w; }
    __syncthreads();
}

__device__ __forceinline__ void mod_unit(KAP A, int un, LAS unsigned char* lds, int tid, int wave, int lane) {
    LAS float* sl = (LAS float*)lds;
    LAS float* red = sl + 3 * 4096;
    const int l = un >> 6, nb = un & 63;
    for (int i = tid; i < 3 * 4096; i += 512) { const int v = i >> 12, k = i & 4095; const float x = v == 0 ? A->in[I_CCTX][k] : A->in[I_C][(v - 1) * 4096 + k]; sl[i] = x / (1.0f + expf(-x)); }
    __syncthreads();
    const int ln = lane < 48 ? lane : 47;
    const float* wp = A->in[I_WMOD] + ((size_t)l * 4096 + wave * 512) * 12288 + nb * 192 + ln * 4;
    f32x4 a0 = {0.f, 0.f, 0.f, 0.f}, a1 = a0, a2 = a0;
#pragma unroll 8
    for (int kq = 0; kq < 512; ++kq) { const f32x4 w = *(const f32x4*)(wp + (size_t)kq * 12288); const int k = wave * 512 + kq;
        a0 += sl[k] * w; a1 += sl[4096 + k] * w; a2 += sl[8192 + k] * w; }
    if (lane < 48) {
#pragma unroll
        for (int j = 0; j < 4; ++j) { red[(wave * 3 + 0) * 256 + lane * 4 + j] = a0[j]; red[(wave * 3 + 1) * 256 + lane * 4 + j] = a1[j]; red[(wave * 3 + 2) * 256 + lane * 4 + j] = a2[j]; } }
    __syncthreads();
    for (int i = tid; i < 768; i += 512) { const int v = i >> 8, col = i & 255; if (col < 192) { float s = 0.f;
#pragma unroll
        for (int w = 0; w < 8; ++w) s += red[(w * 3 + v) * 256 + col];
        ((float*)(A->ws + WS_MOD))[(size_t)(l * 3 + v) * 12288 + nb * 192 + col] = s + A->in[I_BMOD][l * 12288 + nb * 192 + col]; } }
    __syncthreads();
}

__device__ __forceinline__ void p0_prologue(KAP A, LAS unsigned char* lds, int G, int bx, int wv) {
    const int tid = tid_of(wv); const int lane = tid & 63, wave = __builtin_amdgcn_readfirstlane(tid >> 6);
    { LAS float* scr = (LAS float*)(lds + wave * 16640);
      const int gw = bx * NWAVES + wave, NGW = G * NWAVES;
      constexpr int I_IN = 64 * 144, I_OUT = 64 * 64, I_GLU = 16 * 32, I_L = I_IN + I_OUT + I_GLU;
      for (int it = gw; it < 4 * I_L; it += NGW) { const int l = it / I_L; int r = it % I_L;
          if (r < I_IN) { tr_item<false>(A->in[I_WIN] + (size_t)l * 4096 * 9216, 4096, 9216, (bf16*)(A->ws + WS_WIN) + (size_t)l * 9216 * 4096, scr, r, lane); continue; } r -= I_IN;
          if (r < I_OUT) { tr_item<false>(A->in[I_WOUT] + (size_t)l * 4096 * 4096, 4096, 4096, (bf16*)(A->ws + WS_WOUT) + (size_t)l * 4096 * 4096, scr, r, lane); continue; } r -= I_OUT;
          tr_item<true>(A->in[I_WGLU] + (size_t)l * 1024 * 2048, 1024, 2048, (bf16*)(A->ws + WS_WGLU) + (size_t)l * 2048 * 1024, scr, r, lane); }
    }
    __syncthreads();
    for (int un = bx; un < 256; un += G) mod_unit(A, un, lds, tid, wave, lane);
    const size_t gt = (size_t)bx * 512 + tid, NGT = (size_t)G * 512;
    { bf16* D2L = (bf16*)(A->ws + WS_D2L);
      LAS bf16* lut = (LAS bf16*)lds;
      for (int i = tid; i < 4096; i += 512) lut[i] = (bf16)(cvt_pk_bf16(cospif((float)i * (1.0f / 2048.0f)), 0.f) & 0xffffu);
      __syncthreads();
      for (size_t q = gt; q < (size_t)4096 * 1024; q += NGT) { const int k = (int)(q >> 10), K0 = (int)(q & 1023) * 8; unsigned h[8];
          const int sh = K0 < 4096 ? 0 : 1024;
#pragma unroll
          for (int j = 0; j < 8; ++j) { const int K = (K0 + j) & 4095; h[j] = lut[(k * K + sh) & 4095]; }
          v4u w; w.x = h[0] | (h[1] << 16); w.y = h[2] | (h[3] << 16); w.z = h[4] | (h[5] << 16); w.w = h[6] | (h[7] << 16);
          *(v4u*)(D2L + (size_t)k * 8192 + K0) = w; }
      __syncthreads(); }
    { bf16* D1 = (bf16*)(A->ws + WS_D1);
      for (size_t q = gt; q < (size_t)256 * 256; q += NGT) { const int mp = (int)(q >> 8), c = (int)(q & 255), m = mp <= 128 ? mp : mp - 128; const float x = (float)((m * c) & 255) * (1.0f / 128.0f);
          const float v = mp <= 128 ? cospif(x) : sinpif(x); D1[q] = (bf16)(cvt_pk_bf16(v, 0.f) & 0xffffu); } }
    { bf16* WFP = (bf16*)(A->ws + WS_WFP);
      for (size_t q = gt; q < (size_t)4 * 144 * 1024; q += NGT) { const int n = (int)(q & 1023), i = (int)((q >> 10) % 144), l = (int)(q / (144 * 1024)); const int kk0 = i * 8;
          const float* W = A->in[I_WFFT] + (size_t)l * 1024 * 1024 + n; float v[8];
          if (kk0 < 1024) { const int g = kk0 >> 8, part = (kk0 >> 7) & 1;
#pragma unroll
              for (int j = 0; j < 8; ++j) { const int m = (kk0 + j) & 127; const float w1 = W[(size_t)(g * 256 + m) * 1024], w2 = W[(size_t)(g * 256 + ((256 - m) & 255)) * 1024];
                  v[j] = part ? (w1 - w2) : (m ? w1 + w2 : w1); } }
          else {
#pragma unroll
              for (int j = 0; j < 8; ++j) v[j] = 0.f;
              if (kk0 == 1024) {
#pragma unroll
                  for (int j = 0; j < 4; ++j) v[j] = W[(size_t)(j * 256 + 128) * 1024]; } }
          v4u w; w.x = cvt_pk_bf16(v[0], v[1]); w.y = cvt_pk_bf16(v[2], v[3]); w.z = cvt_pk_bf16(v[4], v[5]); w.w = cvt_pk_bf16(v[6], v[7]);
          *(v4u*)(WFP + ((size_t)l * 1024 + n) * PK + kk0) = w; }
      bf16* P = (bf16*)(A->ws + WS_P);
      for (size_t q = gt; q < (size_t)NTOK * 31; q += NGT) { const size_t row = q / 31; const int j = (int)(q % 31); *(v2u*)(P + row * PK + 1028 + j * 4) = (v2u){0u, 0u}; } }
    { bf16* D2C = (bf16*)(A->ws + WS_D2C);
      for (size_t q = gt; q < (size_t)256 * 512; q += NGT) { const int k = (int)(q >> 9), K = (int)(q & 511); const float x = (float)((k * (K & 255)) & 255) * (1.0f / 128.0f);
          const float v = K < 256 ? cospif(x) : -sinpif(x); D2C[q] = (bf16)(cvt_pk_bf16(v, 0.f) & 0xffffu); } }
    { f32x2* rope = (f32x2*)(A->ws + WS_ROPE);
      for (size_t q = gt; q < 64 * 32; q += NGT) { const int pos = (int)(q >> 5), i = (int)(q & 31); const float inv = exp2f(-(float)i * (13.287712379549449f / 32.0f));
          const double turns = (double)pos * (double)inv * 0.15915494309189535; const float fr = (float)(turns - rint(turns));
          rope[q] = (f32x2){cospif(2.f * fr), sinpif(2.f * fr)}; } }
    { const size_t n8 = (size_t)2 * 4 * 512 * 512 / 8;
      for (size_t q = gt; q < 2 * n8; q += NGT) { const bool isk = q < n8; const size_t j = isk ? q : q - n8; const float* src = (isk ? A->in[I_CK] : A->in[I_CV]) + j * 8;
          const f32x4 x0 = *(const f32x4*)src, x1 = *(const f32x4*)(src + 4);
          v4u w; w.x = cvt_pk_bf16(x0[0], x0[1]); w.y = cvt_pk_bf16(x0[2], x0[3]); w.z = cvt_pk_bf16(x1[0], x1[1]); w.w = cvt_pk_bf16(x1[2], x1[3]);
          *(v4u*)((bf16*)(A->ws + (isk ? WS_CK : WS_CV)) + j * 8) = w; } }
    __syncthreads();
    for (int lg = bx; lg < 256; lg += G) ssm_matrices(A, lg >> 6, lg & 63, lds, tid);
}

__device__ __forceinline__ f32x4 ldg16(const void* base, unsigned off, int imm) { return *(const f32x4*)(((const char*)base + off) + imm); }
__device__ __forceinline__ void pa_norm(KAP A, int l, int bx, int G, int tid, LAS unsigned char* lds) {
    const float* mod = (const float*)(A->ws + WS_MOD) + (size_t)l * 3 * 12288;
    const f32x4* ng4 = (const f32x4*)(A->in[I_NG] + l * DM);
    bf16* H = (bf16*)(A->ws + WS_H);
    const int lane = tid & 63, wave = __builtin_amdgcn_readfirstlane(tid >> 6);
    const unsigned lo2 = (unsigned)lane * 16u, lo4 = (unsigned)lane * 32u;
    LAS f32x4* avl = (LAS f32x4*)lds; LAS f32x4* svl = avl + 1024;
    for (int rb = bx; rb < NTOK / 64; rb += G) {
        const int m0 = rb * 64; const int v = m0 < NCTX ? 0 : (m0 < NCTX + 4096 ? 1 : 2);
        const f32x4* sh4 = (const f32x4*)(mod + v * 12288); const f32x4* sc4 = (const f32x4*)(mod + v * 12288 + 4096);
        __syncthreads();
        for (int i = tid; i < 1024; i += NWAVES * 64) { const int d = ((i >> 7) * 2 + (i & 1)) * 64 + ((i & 127) >> 1);
            avl[d] = ng4[i] * (sc4[i] + 1.0f); svl[d] = sh4[i]; }
        __syncthreads();
#pragma unroll 2
        for (int r = 0; r < 8; ++r) { const int m = m0 + wave * 8 + r;
            f32x4 x[16]; float ss = 0.f;
            char* xb = (char*)((bf16*)(A->ws + ((l & 1) ? WS_XBF2 : WS_XBF)) + (size_t)m * DM);
            const char* xbi = (const char*)((const bf16*)(A->ws + ((l & 1) ? WS_XBF : WS_XBF2)) + (size_t)m * DM);
            if (l <= 1) { const float* xr = m < NCTX ? A->in[I_XP] + (size_t)m * DM : A->in[I_XS] + (size_t)(m - NCTX) * DM;
#pragma unroll
                for (int j = 0; j < 8; ++j) { x[2 * j] = ldg16(xr, lo4 + (j >> 1) * 4096u, (j & 1) * 2048); x[2 * j + 1] = ldg16(xr, lo4 + (j >> 1) * 4096u, (j & 1) * 2048 + 16); }
            } else {
#pragma unroll
                for (int j = 0; j < 8; ++j) { const v4u d = *(const v4u*)((xbi + (lo2 + (j >> 2) * 4096u)) + (j & 3) * 1024);
                    x[2 * j] = (f32x4){bf_lo(d.x), bf_hi(d.x), bf_lo(d.y), bf_hi(d.y)}; x[2 * j + 1] = (f32x4){bf_lo(d.z), bf_hi(d.z), bf_lo(d.w), bf_hi(d.w)}; }
            }
            if (l > 0) {
                const char* dr = (const char*)((const bf16*)(A->ws + ((l & 1) ? WS_DELTA : WS_DELTA2)) + (size_t)m * DM);
#pragma unroll
                for (int j = 0; j < 8; ++j) { const v4u d = *(const v4u*)((dr + (lo2 + (j >> 2) * 4096u)) + (j & 3) * 1024);
                    x[2 * j] += (f32x4){bf_lo(d.x), bf_hi(d.x), bf_lo(d.y), bf_hi(d.y)}; x[2 * j + 1] += (f32x4){bf_lo(d.z), bf_hi(d.z), bf_lo(d.w), bf_hi(d.w)};
                    v4u w; w.x = cvt_pk_bf16(x[2 * j].x, x[2 * j].y); w.y = cvt_pk_bf16(x[2 * j].z, x[2 * j].w); w.z = cvt_pk_bf16(x[2 * j + 1].x, x[2 * j + 1].y); w.w = cvt_pk_bf16(x[2 * j + 1].z, x[2 * j + 1].w);
                    *(v4u*)((xb + (lo2 + (j >> 2) * 4096u)) + (j & 3) * 1024) = w; }
            }
#pragma unroll
            for (int j = 0; j < 16; ++j) ss += (x[j].x * x[j].x + x[j].y * x[j].y) + (x[j].z * x[j].z + x[j].w * x[j].w);
            const float rstd = rsqrtf(wave_sum(ss, lane) * (1.0f / DM) + NORM_EPS);
            char* orow = (char*)(H + (size_t)m * DM);
#pragma unroll
            for (int j = 0; j < 8; ++j) { const f32x4 y0 = x[2 * j] * rstd * avl[(2 * j) * 64 + lane] + svl[(2 * j) * 64 + lane], y1 = x[2 * j + 1] * rstd * avl[(2 * j + 1) * 64 + lane] + svl[(2 * j + 1) * 64 + lane];
                v4u w; w.x = cvt_pk_bf16(y0.x, y0.y); w.y = cvt_pk_bf16(y0.z, y0.w); w.z = cvt_pk_bf16(y1.x, y1.y); w.w = cvt_pk_bf16(y1.z, y1.w);
                *(v4u*)((orow + (lo2 + (j >> 2) * 4096u)) + (j & 3) * 1024) = w;
                if ((j & 1) == 1) asm volatile("" ::: "memory"); }
        }
    }
    __syncthreads();
}
__device__ __forceinline__ void final_norm(KAP A, int gw, int NGW, int lane) {
    const float* fg = A->in[I_FNG];
    const unsigned lo2 = (unsigned)lane * 16u, lo4 = (unsigned)lane * 32u;
    f32x4 gv[16];
#pragma unroll
    for (int j = 0; j < 8; ++j) { gv[2 * j] = ldg16(fg, lo4 + (j >> 1) * 4096u, (j & 1) * 2048); gv[2 * j + 1] = ldg16(fg, lo4 + (j >> 1) * 4096u, (j & 1) * 2048 + 16); }
    for (int ci = gw; ci < NTOK / 8; ci += NGW) {
#pragma unroll 2
        for (int r = 0; r < 8; ++r) { const int m = ci * 8 + r;
            char* xr = (char*)(A->out + (size_t)m * DM);
            const char* xs = (const char*)((const bf16*)(A->ws + (((DEPTH - 1) & 1) ? WS_XBF2 : WS_XBF)) + (size_t)m * DM);
            const char* dr = (const char*)((const bf16*)(A->ws + (((DEPTH - 1) & 1) ? WS_DELTA2 : WS_DELTA)) + (size_t)m * DM);
            f32x4 x[16]; float ss = 0.f;
#pragma unroll
            for (int j = 0; j < 8; ++j) { const v4u xv = *(const v4u*)((xs + (lo2 + (j >> 2) * 4096u)) + (j & 3) * 1024); const v4u d = *(const v4u*)((dr + (lo2 + (j >> 2) * 4096u)) + (j & 3) * 1024);
                x[2 * j] = (f32x4){bf_lo(xv.x) + bf_lo(d.x), bf_hi(xv.x) + bf_hi(d.x), bf_lo(xv.y) + bf_lo(d.y), bf_hi(xv.y) + bf_hi(d.y)};
                x[2 * j + 1] = (f32x4){bf_lo(xv.z) + bf_lo(d.z), bf_hi(xv.z) + bf_hi(d.z), bf_lo(xv.w) + bf_lo(d.w), bf_hi(xv.w) + bf_hi(d.w)}; }
#pragma unroll
            for (int j = 0; j < 16; ++j) ss += (x[j].x * x[j].x + x[j].y * x[j].y) + (x[j].z * x[j].z + x[j].w * x[j].w);
            const float rstd = rsqrtf(wave_sum(ss, lane) * (1.0f / DM) + NORM_EPS);
#pragma unroll
            for (int j = 0; j < 8; ++j) { *(f32x4*)((xr + (lo4 + (j >> 1) * 4096u)) + (j & 1) * 2048) = x[2 * j] * rstd * gv[2 * j]; *(f32x4*)((xr + (lo4 + (j >> 1) * 4096u)) + (j & 1) * 2048 + 16) = x[2 * j + 1] * rstd * gv[2 * j + 1];
                if ((j & 1) == 1) asm volatile("" ::: "memory"); }
        }
    }
}

__device__ __forceinline__ void kv_prep(KAP A, int l, int gw, int NGW, int lane) {
    const bf16* PROJ = (const bf16*)(A->ws + WS_PROJ);
    const f32x2* rope = (const f32x2*)(A->ws + WS_ROPE);
    const int hl = lane & 15;
    const f32x4 kn0 = *(const f32x4*)(A->in[I_KN] + l * 128 + hl * 8), kn1 = *(const f32x4*)(A->in[I_KN] + l * 128 + hl * 8 + 4);
    for (int ci = gw; ci < NTOK / 4; ci += NGW) {
        const int m0 = ci * 4; const bool ctx = m0 < NCTX;
        v4u kr[4], vr[4];
#pragma unroll
        for (int r = 0; r < 4; ++r) { const bf16* pr = PROJ + (size_t)(m0 + r) * INW; kr[r] = *(const v4u*)(pr + OFF_K + 8 * lane); vr[r] = *(const v4u*)(pr + OFF_V + 8 * lane); }
#pragma unroll
        for (int r = 0; r < 4; ++r) { const int m = m0 + r;
            float k[8] = {bf_lo(kr[r].x), bf_hi(kr[r].x), bf_lo(kr[r].y), bf_hi(kr[r].y), bf_lo(kr[r].z), bf_hi(kr[r].z), bf_lo(kr[r].w), bf_hi(kr[r].w)};
            float ss = 0.f;
#pragma unroll
            for (int j = 0; j < 8; ++j) ss += k[j] * k[j];
            ss += shflx(ss, lane, 1); ss += shflx(ss, lane, 2); ss += shflx(ss, lane, 4); ss += shflx(ss, lane, 8);
            const float rstd = rsqrtf(ss * (1.0f / 128.0f) + NORM_EPS);
#pragma unroll
            for (int j = 0; j < 4; ++j) { k[j] *= rstd * kn0[j]; k[4 + j] *= rstd * kn1[j]; }
            if (ctx) {
                const int b = m >> 8, t = m & 255; const size_t oi = (((size_t)(b * 4 + l) * 256 + t) * 512 + 8 * lane);
                float* ok = A->out + OUT_NEWK + oi; *(f32x4*)ok = (f32x4){k[0], k[1], k[2], k[3]}; *(f32x4*)(ok + 4) = (f32x4){k[4], k[5], k[6], k[7]};
                float* ov = A->out + OUT_NEWV + oi; *(f32x4*)ov = (f32x4){bf_lo(vr[r].x), bf_hi(vr[r].x), bf_lo(vr[r].y), bf_hi(vr[r].y)}; *(f32x4*)(ov + 4) = (f32x4){bf_lo(vr[r].z), bf_hi(vr[r].z), bf_lo(vr[r].w), bf_hi(vr[r].w)};
            } else {
                const int t = (m - NCTX) & 4095, pos = hl < 8 ? (t >> 6) : (t & 63); const f32x2* rp = rope + pos * 32 + (lane & 3) * 8; const bool first = (lane & 4) == 0;
#pragma unroll
                for (int j = 0; j < 8; ++j) { const float other = shflx(k[j], lane, 4); const f32x2 cs = rp[j];
                    k[j] = first ? (k[j] * cs.x - other * cs.y) : (other * cs.y + k[j] * cs.x); }
            }
            v4u w; w.x = cvt_pk_bf16(k[0], k[1]); w.y = cvt_pk_bf16(k[2], k[3]); w.z = cvt_pk_bf16(k[4], k[5]); w.w = cvt_pk_bf16(k[6], k[7]);
            *(v4u*)((bf16*)(A->ws + WS_KC) + (size_t)m * 512 + 8 * lane) = w;
            *(v4u*)((bf16*)(A->ws + WS_VC) + (size_t)m * 512 + 8 * lane) = vr[r];
        }
    }
}

__device__ __forceinline__ void ssm_scan(KAP A, int l, int g, int mt, int tid, LAS unsigned char* lds) {
    bf16* A2 = (bf16*)(A->ws + WS_A2) + (size_t)g * 1024 * 512;
    const int blk = tid >> 5, sub = tid & 31, dir = sub >> 4, p0 = (sub & 15) * 4;
    f32x4 ar, ai;
    { const f32x4* a4 = (const f32x4*)((const float*)(A->ws + WS_A16) + (((size_t)(l * 2 + dir) * 64 + g) * 64 + p0) * 2); const f32x4 t0 = a4[0], t1 = a4[1];
      ar = (f32x4){t0.x, t0.z, t1.x, t1.z}; ai = (f32x4){t0.y, t0.w, t1.y, t1.w}; }
    const int ecol = 256 + dir * 128 + p0, scol = dir * 128 + p0;
    LAS f32x4* T = (LAS f32x4*)lds;
    LAS f32x4* EB = T + 16 * 32 * 2;
    const bool lat = mt >= 2;
    const int rb = mt * 256 + blk * 16;
    f32x4 sr[16], si[16];
#pragma unroll
    for (int i = 0; i < 16; ++i) { const int x = dir ? 15 - i : i, rl = blk * 16 + x;
        const v2u a = *(const LAS v2u*)(lds + rl * 512 + ((((scol >> 3) ^ x) << 4) + (scol & 7) * 2)), b = *(const LAS v2u*)(lds + rl * 512 + (((((scol + 64) >> 3) ^ x) << 4) + (scol & 7) * 2));
        sr[i] = (f32x4){bf_lo(a.x), bf_hi(a.x), bf_lo(a.y), bf_hi(a.y)}; si[i] = (f32x4){bf_lo(b.x), bf_hi(b.x), bf_lo(b.y), bf_hi(b.y)}; }
    __syncthreads();
    f32x4 er = {0.f, 0.f, 0.f, 0.f}, ei = er;
    if (lat) {
#pragma unroll
        for (int i = 0; i < 16; ++i) { const f32x4 nr = ar * er - ai * ei + sr[i], ni = ar * ei + ai * er + si[i]; er = nr; ei = ni; }
        T[(blk * 32 + sub) * 2] = er; T[(blk * 32 + sub) * 2 + 1] = ei;
        __syncthreads();
        if (tid < 32) { const int b = mt - 2; const size_t si0 = (((size_t)b * 4 + l) * 64 + g) * 64 + p0;
            f32x4 cr = *(const f32x4*)(A->in[dir ? I_SBR : I_SFR] + si0), ci = *(const f32x4*)(A->in[dir ? I_SBI : I_SFI] + si0);
            f32x4 qr = ar, qi = ai;
#pragma unroll
            for (int k = 0; k < 4; ++k) { const f32x4 t = qr * qr - qi * qi; qi = 2.f * qr * qi; qr = t; }
#pragma unroll 1
            for (int jb = 0; jb < 16; ++jb) { const int bb = dir ? 15 - jb : jb; EB[(bb * 32 + sub) * 2] = cr; EB[(bb * 32 + sub) * 2 + 1] = ci;
                const f32x4 tr = T[(bb * 32 + sub) * 2], ti = T[(bb * 32 + sub) * 2 + 1];
                const f32x4 nr = qr * cr - qi * ci + tr, ni = qr * ci + qi * cr + ti; cr = nr; ci = ni; } }
        __syncthreads();
        er = EB[(blk * 32 + sub) * 2]; ei = EB[(blk * 32 + sub) * 2 + 1];
    }
#pragma unroll
    for (int i = 0; i < 16; ++i) { const int row = rb + (dir ? 15 - i : i);
        v2u wr, wi; wr.x = cvt_pk_bf16(er.x, er.y); wr.y = cvt_pk_bf16(er.z, er.w); wi.x = cvt_pk_bf16(ei.x, ei.y); wi.y = cvt_pk_bf16(ei.z, ei.w);
        *(v2u*)(A2 + (size_t)row * 512 + ecol) = wr; *(v2u*)(A2 + (size_t)row * 512 + ecol + 64) = wi;
        const f32x4 nr = ar * er - ai * ei + sr[i], ni = ar * ei + ai * er + si[i]; er = nr; ei = ni; }
    if (!lat) { const int b = mt * 16 + blk; const size_t oi = (((size_t)b * 4 + l) * 64 + g) * 64 + p0;
        *(f32x4*)(A->out + (dir ? OUT_BRE : OUT_FRE) + oi) = er; *(f32x4*)(A->out + (dir ? OUT_BIM : OUT_FIM) + oi) = ei; }
}
__device__ __forceinline__ void ssm_step1(KAP A, int l, int un, LAS unsigned char* lds, int wv) {
    const int g = un >> 2, mt = un & 3, lg = l * 64 + g;
    pg8::OneUnit S1; S1.u0.a = (const char*)(A->ws + WS_A2) + ((size_t)g * 1024 + mt * 256) * 512 * 2; S1.u0.b = (const char*)(A->ws + WS_PMAT) + (size_t)lg * 256 * 256 * 2;
    S1.u0.c = nullptr; S1.u0.ldc = 0; S1.u0.pm = mt; S1.u0.pn = g; S1.u0.z = 0; S1.u0.kt = 4;
    pg8::EpiLdsS E{lds}; pg8::gemm_phase<pg8::EpiLdsS, pg8::OneUnit>(lds, wv, 512, 256, S1, E);
}
__device__ __forceinline__ void ssm_step2(KAP A, int l, int un, LAS unsigned char* lds, int wv) {
    const int g = un >> 2, mt = un & 3; const int tid = tid_of(wv); ssm_scan(A, l, g, mt, tid, lds);
}
__device__ __forceinline__ void ssm_step3(KAP A, int l, int un, LAS unsigned char* lds, int wv) {
    const int g = un >> 2, mt = un & 3, lg = l * 64 + g;
    pg8::OneUnit S2; S2.u0.a = (const char*)(A->ws + WS_A2) + ((size_t)g * 1024 + mt * 256) * 512 * 2; S2.u0.b = (const char*)(A->ws + WS_KG) + (size_t)lg * 256 * 512 * 2;
    S2.u0.c = nullptr; S2.u0.ldc = 0; S2.u0.pm = mt; S2.u0.pn = g; S2.u0.z = mt * 256; S2.u0.kt = 8;
    pg8::EpiSsmY E{(bf16*)(A->ws + WS_YSSM)}; pg8::gemm_phase<pg8::EpiSsmY, pg8::OneUnit>(lds, wv, 512, 512, S2, E);
}

struct Fft1Order {
    int G, c; const char* D1; const char* proj; char* zl; char* zc;
    __device__ bool next(int i, pg8::Unit& u) const { const int L = i * G + c; if (L >= 256) return false;
        const int g = L & 3, tt = L >> 2;
        int kt4 = 4; asm volatile("" : "+s"(kt4)); u.kt = kt4;
        u.a = D1; u.b = proj + ((size_t)tt * 256 * INW + OFF_F + g * 256) * 2; u.pm = 0; u.pn = tt; u.z = g;
        if (tt < 32) { u.c = zc + ((size_t)((tt * 4 + g) * 128) * 256) * 2; u.ldc = 256; }
        else { const int b = (tt - 32) >> 4, t0 = ((tt - 32) & 15) * 256; u.c = zl + ((size_t)((b * 4 + g) * 128) * 4096 + t0) * 2; u.ldc = 4096; }
        return true; }
};
struct Fft2LOrder {
    int G, c; const char* D2; const char* z; char* P;
    __device__ bool next(int i, pg8::Unit& u) const { const int L = i * G + c; if (L >= 64) return false;
        const int nt = L & 3, part = (L >> 2) & 1, mt = L >> 3;
        u.kt = 64; u.a = D2 + ((size_t)mt * 256 * 8192 + part * 4096) * 2; u.b = z + (part * ZPART + (size_t)nt * 256 * 4096) * 2; u.pm = mt; u.pn = nt; u.z = part;
        u.c = P + (((size_t)NCTX + (nt >> 1) * 4096 + mt * 256) * PK + (nt & 1) * 512 + part * 128) * 2; u.ldc = PK; return true; }
};
struct Fft2COrder {
    int G, c; const char* D2; const char* z; char* P;
    __device__ bool next(int i, pg8::Unit& u) const { const int L = i * G + c; if (L >= 128) return false;
        const int nt = L & 1, part = (L >> 1) & 1, b = L >> 2;
        u.kt = 4; u.a = D2 + (size_t)part * 256 * 2; u.b = z + (part * ZPART + (size_t)((b * 4 + nt * 2) * 128) * 256) * 2; u.pm = 0; u.pn = nt; u.z = b;
        u.c = P + (((size_t)b * 256) * PK + nt * 512 + part * 128) * 2; u.ldc = PK; return true; }
};
template <int NS, int KS>
__device__ __forceinline__ f32x4 nyq_core(const bf16* arow, size_t lda16, const bf16* bcol, LAS unsigned char* lds, int tid) {
    const int wave = tid >> 6, lane = tid & 63, fq = lane >> 4;
    f32x4 acc[NS];
#pragma unroll
    for (int ns = 0; ns < NS; ++ns) acc[ns] = (f32x4){0.f, 0.f, 0.f, 0.f};
    const int tb = wave * KS * 32 + fq * 8;
#pragma unroll 4
    for (int s2 = 0; s2 < KS; ++s2) { const bf16x8 bv = *(const bf16x8*)(bcol + tb + s2 * 32);
#pragma unroll
        for (int ns = 0; ns < NS; ++ns) { const bf16x8 av = *(const bf16x8*)(arow + ns * lda16 + tb + s2 * 32); acc[ns] = __builtin_amdgcn_mfma_f32_16x16x32_bf16(bv, av, acc[ns], 0, 0, 0); } }
    LAS f32x4* red = (LAS f32x4*)lds;
    __syncthreads();
#pragma unroll
    for (int ns = 0; ns < NS; ++ns) red[(wave * NS + ns) * 64 + lane] = acc[ns];
    __syncthreads();
    f32x4 r = (f32x4){0.f, 0.f, 0.f, 0.f};
    if (tid < NS * 64) {
#pragma unroll
        for (int w = 0; w < 8; ++w) r += red[(w * NS + (tid >> 6)) * 64 + (tid & 63)]; }
    __syncthreads();
    return r;
}
__device__ __forceinline__ void nyq_pass(KAP A, int cA, LAS unsigned char* lds, int wv) {
    const int tid = tid_of(wv); const int fr = tid & 15;
    bf16* P = (bf16*)(A->ws + WS_P);
    {
        const bf16* arow = (const bf16*)(A->ws + WS_D2L) + (size_t)(cA * 32 + fr) * 8192;
        const bf16* bcol = (const bf16*)(A->ws + WS_ZL) + ZPART + (size_t)((fr & 7) * 128) * 4096;
        const f32x4 r = nyq_core<2, 16>(arow, (size_t)16 * 8192, bcol, lds, tid) * (1.0f / 1024.0f);
        const int fq = (tid & 63) >> 4;
        if (tid < 128 && fq < 2) { const int k = cA * 32 + (tid >> 6) * 16 + fr; *(v2u*)(P + ((size_t)NCTX + fq * 4096 + k) * PK + 1024) = (v2u){cvt_pk_bf16(r[0], r[1]), cvt_pk_bf16(r[2], r[3])}; } }
    {
        const int cg = cA & 7, rs = cA >> 3;
        const bf16* arow = (const bf16*)(A->ws + WS_D2C) + (size_t)(rs * 16 + fr) * 512;
        const bf16* bcol = (const bf16*)(A->ws + WS_ZC) + ZPART + (size_t)(((cg * 4 + (fr >> 2)) * 4 + (fr & 3)) * 128) * 256;
        const f32x4 r = nyq_core<1, 1>(arow, 0, bcol, lds, tid) * (1.0f / 256.0f);
        const int fq = (tid & 63) >> 4;
        if (tid < 64) { const int k = rs * 16 + fr, b = cg * 4 + fq; *(v2u*)(P + ((size_t)b * 256 + k) * PK + 1024) = (v2u){cvt_pk_bf16(r[0], r[1]), cvt_pk_bf16(r[2], r[3])}; } }
}
__device__ __forceinline__ void fft_row2048(KAP A, int c2, int n2, int wv) {
    const int tid = tid_of(wv); const int lane = tid & 63, wave = __builtin_amdgcn_readfirstlane(tid >> 6);
    bf16* P = (bf16*)(A->ws + WS_P);
    for (int n = c2 * NWAVES + wave; n < 1024; n += n2 * NWAVES) {
        const v4u* zr = (const v4u*)((const bf16*)(A->ws + WS_ZL) + (size_t)n * 4096); float s = 0.f;
#pragma unroll
        for (int j = 0; j < 8; ++j) { const v4u w = zr[j * 64 + lane];
            s += (bf_lo(w.x) - bf_hi(w.x)) + (bf_lo(w.y) - bf_hi(w.y)) + (bf_lo(w.z) - bf_hi(w.z)) + (bf_lo(w.w) - bf_hi(w.w)); }
        s = wave_sum(s, lane) * (1.0f / 1024.0f);
        if (lane == 0) { const int bg = n >> 7, m = n & 127; bf16* row = P + ((size_t)NCTX + (bg >> 2) * 4096 + 2048) * PK + (bg & 3) * 256 + m;
            row[0] = (bf16)(cvt_pk_bf16(s, 0.f) & 0xffffu); row[128] = (bf16)0; }
    }
}

__global__ void __launch_bounds__(NWAVES * 64, 2) hymba_fwd(Args args) {
    extern __shared__ __attribute__((aligned(16))) unsigned char lds_raw[];
    LAS unsigned char* lds = (LAS unsigned char*)lds_raw;
    volatile LAS unsigned* MISC = (volatile LAS unsigned*)(lds + MISC_OFF);
    const int G = gridDim.x, bx = blockIdx.x;
    const int wv = __builtin_amdgcn_readfirstlane(threadIdx.x >> 6);
#define TID_HERE() const int tid = tid_of(wv); const int lane = tid & 63, wave = __builtin_amdgcn_readfirstlane(tid >> 6), gw = bq * NWAVES + wave, NGWq = Gq * NWAVES; (void)lane; (void)gw; (void)NGWq
#define PH_IDS() int Gq = G, bq = bx; asm volatile("" : "+s"(Gq), "+s"(bq))
    for (int u = tid_of(wv); u < (LDS_BYTES - MISC_OFF) / 4; u += NWAVES * 64) ((LAS unsigned*)(lds + MISC_OFF))[u] = 0u;
    __syncthreads();
    int lo, hi; XcdBarrier bar;
    { KA_HERE(); PH_IDS(); lo = ka->ph_lo; hi = ka->ph_hi; unsigned* ctl = (unsigned*)(ka->ws + WS_CTL);
      bar.bar = ctl + CW_BAR; bar.x = 0; bar.st = nullptr;
      if (hi - lo > 1) bar = xcd_barrier_post(ctl + CW_BAR, MISC + 8, tid_of(wv)); }
#define IN(k) (lo <= (k) && (k) < hi)
#define SEAM(k) do { if (IN(k) && IN((k) + 1)) { xcd_barrier(bar, wv); if (((DUP_MASK) >> 12) & 1) xcd_barrier(bar, wv); } } while (0)

    if (IN(0)) DUP(0) { KA_HERE(); PH_IDS(); p0_prologue(ka, lds, Gq, bq, wv); }
    SEAM(0);

    for (int l = 0; l < DEPTH; ++l) for (int lrep_ = 0; lrep_ < 1 + (((DUP_MASK) >> 19) & 1); ++lrep_) {
        const int pb = 1 + 6 * l;
        if (IN(pb)) DUP(1) { KA_HERE(); PH_IDS(); TID_HERE(); pa_norm(ka, l, bq, Gq, tid, lds);
        }
        SEAM(pb);
        if (IN(pb + 1)) DUP(2) {
            KA_HERE(); PH_IDS(); unsigned char* ws = ka->ws;
            pg8::GemmOrder S; S.init(NTOK, INW, Gq, bq, ws + WS_H, DM, ws + WS_WIN + (size_t)l * INW * DM * 2, DM, DM);
            pg8::EpiProj E{(bf16*)(ws + WS_PROJ), (bf16*)(ws + WS_A2)};
            pg8::gemm_phase<pg8::EpiProj, pg8::GemmOrder, GEMM1_ALIGN>(lds, wv, DM, DM, S, E);
        }
        SEAM(pb + 1);
        if (IN(pb + 2)) {
            DUP(16) for (int un = bx; un < 256; un += G) { { KA_HERE(); ssm_step1(ka, l, un, lds, wv); } __syncthreads(); { KA_HERE(); ssm_step2(ka, l, un, lds, wv); } __syncthreads(); }
            DUP(14) { KA_HERE(); PH_IDS(); TID_HERE(); kv_prep(ka, l, gw, NGWq, lane); }
            DUP(3) { KA_HERE(); PH_IDS(); unsigned char* ws = ka->ws;
              Fft1Order S{Gq, bq, (const char*)(ws + WS_D1), (const char*)(ws + WS_PROJ), (char*)(ws + WS_ZL), (char*)(ws + WS_ZC)};
              pg8::EpiBf16X E{1.0f, (int)ZPART, 128}; pg8::gemm_phase<pg8::EpiBf16X, Fft1Order>(lds, wv, 256, INW, S, E); }
            wg_global_sync();
            DUP(18) for (int un = bx; un < 256; un += G) { KA_HERE(); ssm_step3(ka, l, un, lds, wv); }
        }
        SEAM(pb + 2);
        if (IN(pb + 3)) {
            if (bx < (G >> 1)) {
                __syncthreads();
                const int n1 = G >> 2;
                if (bx < n1) {
                  DUP(7) { KA_HERE(); unsigned char* ws = ka->ws; int nAq = n1, cAq = bx; asm volatile("" : "+s"(nAq), "+s"(cAq));
                    Fft2LOrder S{nAq, cAq, (const char*)(ws + WS_D2L), (const char*)(ws + WS_ZL), (char*)(ws + WS_P)};
                    pg8::EpiFft2Sym E{1.0f / 1024.0f}; pg8::gemm_phase<pg8::EpiFft2Sym, Fft2LOrder>(lds, wv, 8192, 4096, S, E); }
                } else {
                  DUP(8) { KA_HERE(); unsigned char* ws = ka->ws; int nAq = (G >> 1) - n1, cAq = bx - n1; asm volatile("" : "+s"(nAq), "+s"(cAq));
                    Fft2COrder S{nAq, cAq, (const char*)(ws + WS_D2C), (const char*)(ws + WS_ZC), (char*)(ws + WS_P)};
                    pg8::EpiBf16X E{1.0f / 256.0f, 128 * PK, 256}; pg8::gemm_phase<pg8::EpiBf16X, Fft2COrder>(lds, wv, 512, 256, S, E); }
                  DUP(8) { KA_HERE(); for (int it = bx - n1; it < 128; it += (G >> 1) - n1) nyq_pass(ka, it, lds, wv); fft_row2048(ka, bx - n1, (G >> 1) - n1, wv); }
                }
                __syncthreads();
            }
            DUP(5) for (int U = bx; U < 512; U += G) {
                KA_HERE(); PH_IDS(); unsigned char* ws = ka->ws; bf16* const PROJ = (bf16*)(ws + WS_PROJ); bf16* const MIX = (bf16*)(ws + WS_MIX);
                const float* qn = ka->in[I_QN] + l * 128; const f32x2* rope = (const f32x2*)(ws + WS_ROPE);
                const int pr = U & 7, idx = U >> 3, b = pr >> 2, kvh = pr & 3, hq = kvh * 4 + (idx >> 4), qb = idx & 15;
                const size_t row0 = (size_t)NCTX + b * 4096 + qb * 256;
                const bf16* ck = (const bf16*)(ws + WS_CK) + ((size_t)(b * 4 + l) * 512) * 512 + kvh * 128;
                const bf16* cv = (const bf16*)(ws + WS_CV) + ((size_t)(b * 4 + l) * 512) * 512 + kvh * 128;
                const bf16* k1 = (const bf16*)(ws + WS_KC) + ((size_t)NCTX + b * 4096) * 512 + kvh * 128; const bf16* v1 = (const bf16*)(ws + WS_VC) + ((size_t)NCTX + b * 4096) * 512 + kvh * 128;
                att::attn_unit(PROJ + row0 * INW + hq * 128, PROJ + row0 * INW + OFF_GA + hq * 128, MIX + row0 * DM + hq * 128,
                               ck, cv, 512, 8, k1, v1, 512, 64, qn, rope, qb * 256, (char*)lds_raw, wv);
            }
            {
                const int nH = G >> 1, hb = bx >= nH ? 1 : 0, cH = bx - hb * nH, Uend = hb ? 512 : 256;
                DUP(6) for (int U = hb * 256 + cH; U < Uend; U += (hb ? G - nH : nH)) {
                    KA_HERE(); unsigned char* ws = ka->ws; bf16* const PROJ = (bf16*)(ws + WS_PROJ); bf16* const MIX = (bf16*)(ws + WS_MIX);
                    const float* qn = ka->in[I_QN] + l * 128;
                    const int xx = U & 7, idx = U >> 3, b = xx * 4 + (idx >> 4), hq = idx & 15, kvh = hq >> 2;
                    const size_t row0 = (size_t)b * 256;
                    const bf16* k1 = (const bf16*)(ws + WS_KC) + row0 * 512 + kvh * 128; const bf16* v1 = (const bf16*)(ws + WS_VC) + row0 * 512 + kvh * 128;
                    att::attn_unit(PROJ + row0 * INW + hq * 128, PROJ + row0 * INW + OFF_GA + hq * 128, MIX + row0 * DM + hq * 128,
                                   k1, v1, 512, 0, k1, v1, 512, 4, qn, nullptr, 0, (char*)lds_raw, wv);
                }
            }
            if (bx >= (G >> 2)) {
                const int hb = bx >= (G >> 1) ? 1 : 0; int first = hb ? bx - (G >> 1) : 384 + bx - (G >> 2), stride = hb ? G - (G >> 1) : (G >> 1) - (G >> 2), end = hb ? 384 : 512;
                __syncthreads();
                DUP(9) { KA_HERE(); unsigned char* ws = ka->ws; asm volatile("" : "+s"(first), "+s"(stride), "+s"(end));
                  pg8::UnitRange<pg8::GemmOrder> S; S.g.init(NTOK, 2048, 1, 0, ws + WS_YSSM, 1024, ws + WS_WGLU + (size_t)l * 2048 * 1024 * 2, 1024, 1024); S.first = first; S.stride = stride; S.end = end;
                  pg8::EpiGlu E{(const bf16*)(ws + WS_PROJ), (bf16*)(ws + WS_MIX)}; pg8::gemm_phase<pg8::EpiGlu, pg8::UnitRange<pg8::GemmOrder>>(lds, wv, 1024, 1024, S, E); }
            }
        }
        SEAM(pb + 3);
        if (IN(pb + 4)) {
            DUP(10) { KA_HERE(); PH_IDS(); unsigned char* ws = ka->ws;
              pg8::GemmOrder S; S.init(NTOK, 1024, Gq, bq, ws + WS_P, PK, ws + WS_WFP + (size_t)l * 1024 * PK * 2, PK, PK);
              pg8::EpiFftW E{(const bf16*)(ws + WS_PROJ), (bf16*)(ws + WS_MIX)}; pg8::gemm_phase<pg8::EpiFftW, pg8::GemmOrder>(lds, wv, PK, PK, S, E); }
        }
        SEAM(pb + 4);
        if (IN(pb + 5)) DUP(11) {
            KA_HERE(); PH_IDS(); unsigned char* ws = ka->ws;
            pg8::GemmOrder S; S.init(NTOK, DM, Gq, bq, ws + WS_MIX, DM, ws + WS_WOUT + (size_t)l * DM * DM * 2, DM, DM);
            pg8::EpiOut E{(bf16*)(ws + ((l & 1) ? WS_DELTA2 : WS_DELTA)), (const float*)(ws + WS_MOD) + (size_t)l * 3 * 12288};
            if (((DUP_MASK) >> 13) & 1) {
                { pg8::SliceOrder<pg8::GemmOrder> S2{S, 0, 2}; pg8::gemm_phase<pg8::EpiOut, pg8::SliceOrder<pg8::GemmOrder>, GEMM1_ALIGN>(lds, wv, DM, DM, S2, E); }
                xcd_barrier(bar, wv);
                { pg8::SliceOrder<pg8::GemmOrder> S2{S, 2, 1000}; pg8::gemm_phase<pg8::EpiOut, pg8::SliceOrder<pg8::GemmOrder>, GEMM1_ALIGN>(lds, wv, DM, DM, S2, E); }
            } else
            pg8::gemm_phase<pg8::EpiOut, pg8::GemmOrder, GEMM1_ALIGN>(lds, wv, DM, DM, S, E);
        }
        SEAM(pb + 5);
    }
    if (IN(25)) DUP(15) { KA_HERE(); PH_IDS(); TID_HERE(); final_norm(ka, gw, NGWq, lane); }
#undef IN
#undef SEAM
}

extern "C" void kernel_launch(void* const* d_in, const int* in_sizes, int n_in, void* d_out, int out_size, void* d_ws, size_t ws_size, hipStream_t stream) {
    static int grid = 0;
    if (grid == 0) {
        if (n_in != 28 || ws_size < WS_END || out_size != 102760448) { fprintf(stderr, "kernel_launch: unexpected shapes (n_in %d, out %d, ws %zu)\n", n_in, out_size, ws_size); grid = -1; return; }
        int dev = 0, cus = 0, per_cu = 0;
        if (hipGetDevice(&dev) != hipSuccess || hipDeviceGetAttribute(&cus, hipDeviceAttributeMultiprocessorCount, dev) != hipSuccess) { grid = -1; return; }
        if (hipFuncSetAttribute((const void*)hymba_fwd, hipFuncAttributeMaxDynamicSharedMemorySize, LDS_BYTES) != hipSuccess) { fprintf(stderr, "kernel_launch: hipFuncSetAttribute failed\n"); grid = -1; return; }
        if (hipOccupancyMaxActiveBlocksPerMultiprocessor(&per_cu, (const void*)hymba_fwd, NWAVES * 64, LDS_BYTES) != hipSuccess || per_cu < 1)
            fprintf(stderr, "kernel_launch: occupancy query reports %d workgroups per CU\n", per_cu);
        (void)hipGetLastError();
        grid = cus;
    }
    if (grid < 0) return;
    (void)hipMemsetAsync((char*)d_ws + WS_CTL, 0, CTL_ZERO_BYTES, stream);
    Args a{};
    for (int i = 0; i < 28; ++i) a.in[i] = (const float*)d_in[i];
    a.out = (float*)d_out; a.ws = (unsigned char*)d_ws;
#if MK_ONE_LAUNCH == 2
    a.ph_lo = 0; a.ph_hi = 1;
    hipLaunchKernelGGL(hymba_fwd, dim3(grid), dim3(NWAVES * 64), LDS_BYTES, stream, a);
    a.ph_lo = 0; a.ph_hi = 26;
    hipLaunchKernelGGL(hymba_fwd, dim3(grid), dim3(NWAVES * 64), LDS_BYTES, stream, a);
#elif MK_ONE_LAUNCH
    a.ph_lo = 0; a.ph_hi = 26;
    hipLaunchKernelGGL(hymba_fwd, dim3(grid), dim3(NWAVES * 64), LDS_BYTES, stream, a);
#else
    for (int ph = 0; ph < 26; ++ph) { a.ph_lo = ph; a.ph_hi = ph + 1; hipLaunchKernelGGL(hymba_fwd, dim3(grid), dim3(NWAVES * 64), LDS_BYTES, stream, a); }
#endif
    const hipError_t le = hipPeekAtLastError();
    if (le != hipSuccess) fprintf(stderr, "kernel_launch: launch failed: %s\n", hipGetErrorName(le));
}
```

```cpp
#include <hip/hip_runtime.h>
#include <cstdio>
#include <cstdint>

#ifndef MK_ONE_LAUNCH
#define MK_ONE_LAUNCH 1
#endif

#ifndef GEMM1_ALIGN
#define GEMM1_ALIGN true
#endif
#ifndef DUP_MASK
#define DUP_MASK 0
#endif
#define DUP(k) for (int rep_ = 0; rep_ < (((DUP_MASK) >> (k)) & 1) + 1; ++rep_)
#define LAS __attribute__((address_space(3)))
#define GAS __attribute__((address_space(1)))
typedef unsigned short bf16;
typedef unsigned v4u __attribute__((ext_vector_type(4)));
typedef unsigned v2u __attribute__((ext_vector_type(2)));
typedef float f32x4 __attribute__((ext_vector_type(4)));
typedef float f32x2 __attribute__((ext_vector_type(2)));
typedef short bf16x8 __attribute__((ext_vector_type(8)));
typedef short s16x4 __attribute__((ext_vector_type(4)));
typedef float f32x16 __attribute__((ext_vector_type(16)));

constexpr int DM = 4096, NTOK = 16384, NCTX = 8192, DEPTH = 4, INW = 9216;
constexpr int OFF_K = 2048, OFF_V = 2560, OFF_GA = 3072, OFF_U = 5120, OFF_GS = 6144, OFF_F = 7168, OFF_GF = 8192;
constexpr float NORM_EPS = 1e-6f;
constexpr size_t OUT_NEWK = 67108864, OUT_NEWV = 83886080, OUT_FRE = 100663296, OUT_FIM = 101187584, OUT_BRE = 101711872, OUT_BIM = 102236160;

constexpr size_t MiB = 1u << 20;
constexpr size_t WS_CTL = 0, CTL_ZERO_BYTES = 1 * MiB;
constexpr size_t WS_MOD = 1 * MiB;
constexpr size_t WS_ROPE = 2 * MiB;
constexpr size_t WS_A16 = 3 * MiB;
constexpr size_t WS_D1 = 4 * MiB;
constexpr size_t WS_D2C = 5 * MiB;
constexpr size_t WS_CK = 6 * MiB;
constexpr size_t WS_CV = 10 * MiB;
constexpr size_t WS_PMAT = 14 * MiB;
constexpr size_t WS_KG = 46 * MiB;
constexpr size_t WS_D2L = 110 * MiB;
constexpr size_t WS_WGLU = 174 * MiB;
constexpr size_t WS_WOUT = 198 * MiB;
constexpr size_t WS_WIN = 326 * MiB;
constexpr size_t WS_H = 614 * MiB;
constexpr size_t WS_PROJ = 742 * MiB;
constexpr size_t WS_MIX = 1030 * MiB;
constexpr size_t WS_A2 = 1158 * MiB;
constexpr size_t WS_SBUF = 1222 * MiB;
constexpr size_t WS_YSSM = 1286 * MiB;
constexpr size_t WS_ZL = 1318 * MiB;
constexpr size_t WS_ZC = 1334 * MiB;
constexpr size_t WS_P = 1350 * MiB;
constexpr size_t WS_WFP = 1386 * MiB;
constexpr int PK = 1152; constexpr size_t ZPART = (size_t)1 << 22;
constexpr size_t WS_DELTA = 1414 * MiB;
constexpr size_t WS_XBF = 1542 * MiB;
constexpr size_t WS_XBF2 = 1702 * MiB;
constexpr size_t WS_KC = 1670 * MiB;
constexpr size_t WS_VC = 1686 * MiB;
constexpr size_t WS_DELTA2 = 1830 * MiB;
constexpr size_t WS_END = 1958 * MiB;
constexpr int CW_BAR = 4096;

constexpr int LDS_BYTES = 147456;
constexpr int MISC_OFF = 143360;
constexpr int NWAVES = 8;

#define LDS_WAIT() asm volatile("s_waitcnt lgkmcnt(0)" ::: "memory")
#define VM_WAIT() asm volatile("s_waitcnt vmcnt(0)" ::: "memory")
#define RLX_AGENT __ATOMIC_RELAXED, __HIP_MEMORY_SCOPE_AGENT

__device__ __forceinline__ int tid_of(int wv) { int t = wv * 64 + (int)__builtin_amdgcn_mbcnt_hi(~0u, __builtin_amdgcn_mbcnt_lo(~0u, 0u)); asm volatile("" : "+v"(t)); return t; }
__device__ __forceinline__ unsigned cvt_pk_bf16(float lo, float hi) { unsigned r; asm volatile("v_cvt_pk_bf16_f32 %0, %1, %2" : "=v"(r) : "v"(lo), "v"(hi)); return r; }
__device__ __forceinline__ float bf_lo(unsigned w) { return __uint_as_float(w << 16); }
__device__ __forceinline__ float bf_hi(unsigned w) { return __uint_as_float(w & 0xffff0000u); }
__device__ __forceinline__ float silu_f(float x) { return x * __builtin_amdgcn_rcpf(1.0f + __expf(-x)); }
__device__ __forceinline__ float sigmoid_f(float x) { return __builtin_amdgcn_rcpf(1.0f + __expf(-x)); }
__device__ __forceinline__ float shflx(float v, int lane, int o) { return __int_as_float(__builtin_amdgcn_ds_bpermute((lane ^ o) << 2, __float_as_int(v))); }
__device__ __forceinline__ float wave_sum(float v, int lane) {
#pragma unroll
    for (int o = 1; o < 64; o <<= 1) v += shflx(v, lane, o);
    return v;
}

namespace pg8 {
constexpr int BM = 256, BK = 64, HALF = 128, HTB = HALF * BK * 2, STAGE_BYTES = 8 * HTB, NXCD = 8, WGM = 8;
__host__ __device__ __forceinline__ int lds_byte(int r, int c) { const int st = (r >> 4) * 2 + (c >> 5), rr = r & 15, cc = c & 31, ob = rr * 64 + cc * 2; return st * 1024 + (ob ^ (((ob >> 9) & 1) << 5)); }
__host__ __device__ __forceinline__ void stage_rc(int b, int& R, int& C) { const int st = b / 1024, sb = b % 1024, swz = sb ^ (((sb >> 9) & 1) << 5); R = (st >> 1) * 16 + swz / 64; C = (st & 1) * 32 + (swz % 64) / 2; }
__host__ __device__ __forceinline__ int perm32(int rho) { const int n = rho >> 4, i = rho & 15; return 8 * (i >> 2) + 4 * n + (i & 3); }

struct Unit { const char* a; const char* b; char* c; int ldc; int pm, pn, z, kt; };

struct GemmOrder {
    int nM, nN, nwg, G, c, kt; const char* A; const char* B; size_t atile, btile;
    __device__ void init(int M, int N, int G_, int c_, const void* A_, int lda, const void* B_, int ldb, int K) { kt = K / BK; nM = M / BM; nN = N / BM; nwg = nM * nN; G = G_; c = c_; A = (const char*)A_; B = (const char*)B_; atile = (size_t)BM * lda * 2; btile = (size_t)BM * ldb * 2; }
    __device__ bool next(int i, Unit& u) const {
        const long L = (long)i * G + c; if (L >= nwg) return false;
        int wgid = (int)L; const int xcd = wgid % NXCD; { const int q = nwg / NXCD, r = nwg % NXCD, off = wgid / NXCD; wgid = (xcd < r ? xcd * (q + 1) : r * (q + 1) + (xcd - r) * q) + off; }
        const int nig = WGM * nN, gid = wgid / nig, fm = gid * WGM, gsz = (nM - fm) < WGM ? (nM - fm) : WGM;
        u.pm = fm + ((wgid % nig) % gsz); u.pn = (wgid % nig) / gsz; u.z = 0; u.c = nullptr; u.ldc = 0; u.kt = kt;
        u.a = A + (size_t)u.pm * atile; u.b = B + (size_t)u.pn * btile; return true;
    }
};
template <class O> struct SliceOrder { O g; int i0, cnt; __device__ bool next(int i, Unit& u) const { if (i >= cnt) return false; return g.next(i0 + i, u); } };
template <class O> struct UnitRange { O g; int first, stride, end; __device__ bool next(int i, Unit& u) const { const int L = first + i * stride; if (L >= end) return false; return g.next(L, u); } };
struct OneUnit { Unit u0; __device__ bool next(int i, Unit& u) const { if (i != 0) return false; u = u0; return true; } };

template <class Epi, class Sched, bool ALIGN_EPI = true>
__device__ __forceinline__ void gemm_phase(LAS unsigned char* lds, const int wv, const int lda, const int ldb, const Sched& S, const Epi& E) {
    const int tid = tid_of(wv);
    const int wid = __builtin_amdgcn_readfirstlane(tid >> 6), lane = tid & 63, wr = wid >> 2, wc = wid & 3, fr = lane & 15, fq = lane >> 4;
    unsigned voffA[2], voffB[2];
#pragma unroll
    for (int i = 0; i < 2; ++i) { int R, C; stage_rc(tid * 16 + i * 8192, R, C); const int Rb = Epi::PERM ? ((R & ~31) + perm32(R & 31)) : R;
        voffA[i] = (unsigned)(R * lda + C) * 2u; voffB[i] = (unsigned)(Rb * ldb + C) * 2u; }
    (void)fr; (void)fq;
    const size_t kstep = (size_t)(BK * 2);
    const unsigned hstepA = (unsigned)HALF * lda * 2u, hstepB = (unsigned)HALF * ldb * 2u;
    const unsigned ldsw = (unsigned)wid * 1024u;
    const int aoff = lds_byte(wr * 64 + fr, fq * 8), boff = lds_byte(wc * 32 + fr, fq * 8);
#define PG8_SA(b, h) (((b) * 2 + (h)) * HTB)
#define PG8_SB(b, h) ((4 + (b) * 2 + (h)) * HTB)
#define PG8_STAGE(bufoff, gbase, voff) do { _Pragma("unroll") for (int _i = 0; _i < 2; ++_i) \
        __builtin_amdgcn_global_load_lds((const unsigned*)((const char*)(gbase) + (voff)[_i]), (LAS unsigned*)(lds + (bufoff) + ldsw + _i * 8192), 16, 0, 0); } while (0)
#define PG8_LDA(dst, b, h) do { _Pragma("unroll") for (int m = 0; m < 4; ++m) _Pragma("unroll") for (int k = 0; k < 2; ++k) dst[m][k] = *(const LAS bf16x8*)(lds + PG8_SA(b, h) + aoff + m * 2048 + k * 1024); } while (0)
#define PG8_LDB(dst, b, h) do { _Pragma("unroll") for (int n = 0; n < 2; ++n) _Pragma("unroll") for (int k = 0; k < 2; ++k) dst[n][k] = *(const LAS bf16x8*)(lds + PG8_SB(b, h) + boff + n * 2048 + k * 1024); } while (0)
#define PG8_MMA(ai, bj, At, Bt) do { __builtin_amdgcn_s_setprio(1); _Pragma("unroll") for (int m = 0; m < 4; ++m) _Pragma("unroll") for (int n = 0; n < 2; ++n) _Pragma("unroll") for (int k = 0; k < 2; ++k) \
        acc[ai][bj][m][n] = __builtin_amdgcn_mfma_f32_16x16x32_bf16(Bt[n][k], At[m][k], acc[ai][bj][m][n], 0, 0, 0); __builtin_amdgcn_s_setprio(0); } while (0)
#define PG8_WAIT_V(n) asm volatile("s_waitcnt vmcnt(" #n ")" ::: "memory")
#define PG8_WAIT_L(n) asm volatile("s_waitcnt lgkmcnt(" #n ")" ::: "memory")
#define PG8_BAR __builtin_amdgcn_s_barrier()
#define PG8_SCHED __builtin_amdgcn_sched_barrier(0)
    int ui = 0, nt;
    const char* cA; const char* cB;
    { Unit u0; if (!S.next(0, u0)) return; cA = u0.a; cB = u0.b; nt = u0.kt; }
    f32x4 acc[2][2][4][2];
#pragma unroll
    for (int a = 0; a < 2; ++a)
#pragma unroll
        for (int b = 0; b < 2; ++b)
#pragma unroll
            for (int m = 0; m < 4; ++m)
#pragma unroll
                for (int n = 0; n < 2; ++n) acc[a][b][m][n] = (f32x4){0.f, 0.f, 0.f, 0.f};
    bf16x8 At[4][2], B0[2][2], B1[2][2];
    PG8_STAGE(PG8_SB(0, 0), cB, voffB); PG8_STAGE(PG8_SB(0, 1), cB + hstepB, voffB); PG8_STAGE(PG8_SA(0, 0), cA, voffA); PG8_STAGE(PG8_SA(0, 1), cA + hstepA, voffA);
    if (wr == 1) PG8_BAR;
    PG8_WAIT_V(2); PG8_BAR;
    PG8_STAGE(PG8_SB(1, 0), cB + kstep, voffB); PG8_STAGE(PG8_SA(1, 0), cA + kstep, voffA); PG8_STAGE(PG8_SB(1, 1), cB + hstepB + kstep, voffB);
    PG8_WAIT_V(6); PG8_BAR;
    for (;;) {
        bool has_next; const char* nA; const char* nB; int nnt;
        { Unit nx; has_next = S.next(ui + 1, nx); nA = has_next ? nx.a : cA; nB = has_next ? nx.b : cB; nnt = has_next ? nx.kt : nt; }
        for (int t = 0; t < nt; t += 2) {
            const bool last = (t == nt - 2);
            const char* a1 = cA + (size_t)(t + 1) * kstep;
            const char* a2 = last ? nA : cA + (size_t)(t + 2) * kstep; const char* b2 = last ? nB : cB + (size_t)(t + 2) * kstep;
            const char* a3 = a2 + kstep; const char* b3 = b2 + kstep;
            PG8_LDB(B0, 0, 0); PG8_LDB(B1, 0, 1); PG8_SCHED; PG8_LDA(At, 0, 0); PG8_STAGE(PG8_SA(1, 1), a1 + hstepA, voffA);
            PG8_WAIT_V(8); PG8_WAIT_L(0); PG8_BAR; PG8_MMA(0, 0, At, B0); PG8_MMA(0, 1, At, B1); PG8_BAR; PG8_SCHED;
            PG8_LDA(At, 0, 1); PG8_STAGE(PG8_SB(0, 0), b2, voffB); PG8_STAGE(PG8_SB(0, 1), b2 + hstepB, voffB); PG8_STAGE(PG8_SA(0, 0), a2, voffA);
            PG8_WAIT_V(8); PG8_WAIT_L(0); PG8_BAR; PG8_MMA(1, 0, At, B0); PG8_MMA(1, 1, At, B1); PG8_BAR; PG8_SCHED;
            PG8_LDB(B0, 1, 0); PG8_LDB(B1, 1, 1); PG8_SCHED; PG8_LDA(At, 1, 0); PG8_STAGE(PG8_SA(0, 1), a2 + hstepA, voffA);
            PG8_WAIT_V(8); PG8_WAIT_L(0); PG8_BAR; PG8_MMA(0, 0, At, B0); PG8_MMA(0, 1, At, B1); PG8_BAR; PG8_SCHED;
            PG8_LDA(At, 1, 1); PG8_STAGE(PG8_SB(1, 0), b3, voffB); PG8_STAGE(PG8_SB(1, 1), b3 + hstepB, voffB); PG8_STAGE(PG8_SA(1, 0), a3, voffA);
            PG8_WAIT_V(8); PG8_WAIT_L(0); PG8_BAR; PG8_MMA(1, 0, At, B0); PG8_MMA(1, 1, At, B1); PG8_BAR; PG8_SCHED;
        }
        if constexpr (ALIGN_EPI) { if (wr == 0) PG8_BAR; }
        { Unit cu; (void)S.next(ui, cu); const int t2 = tid_of(wv);
          const int w2 = __builtin_amdgcn_readfirstlane(t2 >> 6); E(acc, cu, w2 >> 2, w2 & 3, t2 & 15, (t2 & 63) >> 4); }
        if (!has_next) break;
#pragma unroll
        for (int a = 0; a < 2; ++a)
#pragma unroll
            for (int b = 0; b < 2; ++b)
#pragma unroll
                for (int m = 0; m < 4; ++m)
#pragma unroll
                    for (int n = 0; n < 2; ++n) acc[a][b][m][n] = (f32x4){0.f, 0.f, 0.f, 0.f};
        cA = nA; cB = nB; nt = nnt; ++ui;
        if constexpr (ALIGN_EPI) { if (wr == 1) PG8_BAR; }
    }
    PG8_WAIT_V(0);
    if constexpr (!ALIGN_EPI) { if (wr == 0) PG8_BAR; }
    PG8_BAR;
#undef PG8_SA
#undef PG8_SB
#undef PG8_STAGE
#undef PG8_LDA
#undef PG8_LDB
#undef PG8_MMA
#undef PG8_WAIT_V
#undef PG8_WAIT_L
#undef PG8_BAR
#undef PG8_SCHED
}

struct EpiProj {
    static constexpr bool PERM = true;
    bf16* proj; bf16* a2;
    __device__ __forceinline__ void operator()(const f32x4 (&acc)[2][2][4][2], const Unit& u, int wr, int wc, int fr, int fq) const {
        const int pn = u.pn; const bool gate = (pn >= 12 && pn < 20) || (pn >= 24 && pn < 28) || (pn >= 32); const bool isu = (pn >= 20 && pn < 24);
        const int row0 = u.pm * BM + wr * 64 + fr, col0 = pn * BM + wc * 32 + 8 * fq;
#pragma unroll
        for (int ai = 0; ai < 2; ++ai)
#pragma unroll
            for (int m = 0; m < 4; ++m) { const int row = row0 + ai * HALF + m * 16;
#pragma unroll
                for (int bj = 0; bj < 2; ++bj) { f32x4 v0 = acc[ai][bj][m][0], v1 = acc[ai][bj][m][1];
                    if (gate) {
#pragma unroll
                        for (int j = 0; j < 4; ++j) { v0[j] = silu_f(v0[j]); v1[j] = silu_f(v1[j]); } }
                    v4u w; w.x = cvt_pk_bf16(v0[0], v0[1]); w.y = cvt_pk_bf16(v0[2], v0[3]); w.z = cvt_pk_bf16(v1[0], v1[1]); w.w = cvt_pk_bf16(v1[2], v1[3]);
                    const int col = col0 + bj * HALF;
                    bf16* dst;
                    if (isu) { const int g = (col - OFF_U) >> 4, c0 = col & 15; dst = a2 + ((size_t)(g * 1024 + (row >> 4)) * 512 + (row & 15) * 16 + c0); }
                    else dst = proj + (size_t)row * INW + col;
                    *(v4u*)dst = w; } }
    }
};
struct EpiBf16 {
    static constexpr bool PERM = true;
    float scale;
    __device__ __forceinline__ void operator()(const f32x4 (&acc)[2][2][4][2], const Unit& u, int wr, int wc, int fr, int fq) const {
        bf16* base = (bf16*)u.c; const int ldc = u.ldc; const int row0 = wr * 64 + fr, col0 = wc * 32 + 8 * fq;
#pragma unroll
        for (int ai = 0; ai < 2; ++ai)
#pragma unroll
            for (int m = 0; m < 4; ++m) { bf16* rowp = base + (size_t)(row0 + ai * HALF + m * 16) * ldc + col0;
#pragma unroll
                for (int bj = 0; bj < 2; ++bj) { const f32x4 v0 = acc[ai][bj][m][0] * scale, v1 = acc[ai][bj][m][1] * scale;
                    v4u w; w.x = cvt_pk_bf16(v0[0], v0[1]); w.y = cvt_pk_bf16(v0[2], v0[3]); w.z = cvt_pk_bf16(v1[0], v1[1]); w.w = cvt_pk_bf16(v1[2], v1[3]);
                    *(v4u*)(rowp + bj * HALF) = w; } }
    }
};
struct EpiBf16X {
    static constexpr bool PERM = true;
    float scale; int aoff, boff;
    __device__ __forceinline__ void operator()(const f32x4 (&acc)[2][2][4][2], const Unit& u, int wr, int wc, int fr, int fq) const {
        bf16* base = (bf16*)u.c; const int ldc = u.ldc; const int row0 = wr * 64 + fr, col0 = wc * 32 + 8 * fq;
#pragma unroll
        for (int ai = 0; ai < 2; ++ai)
#pragma unroll
            for (int m = 0; m < 4; ++m) { bf16* rowp = base + (ai * aoff + (row0 + m * 16) * ldc + col0);
#pragma unroll
                for (int bj = 0; bj < 2; ++bj) { const f32x4 v0 = acc[ai][bj][m][0] * scale, v1 = acc[ai][bj][m][1] * scale;
                    v4u w; w.x = cvt_pk_bf16(v0[0], v0[1]); w.y = cvt_pk_bf16(v0[2], v0[3]); w.z = cvt_pk_bf16(v1[0], v1[1]); w.w = cvt_pk_bf16(v1[2], v1[3]);
                    *(v4u*)(rowp + bj * boff) = w; } }
    }
};
struct EpiFft2Sym {
    static constexpr bool PERM = true;
    float scale;
    __device__ __forceinline__ void operator()(const f32x4 (&acc)[2][2][4][2], const Unit& u, int wr, int wc, int fr, int fq) const {
        bf16* base = (bf16*)u.c; const int ldc = u.ldc, mt = u.pm; const unsigned flip = u.z ? 0x80008000u : 0u; const int row0 = wr * 64 + fr, col0 = wc * 32 + 8 * fq;
#pragma unroll
        for (int ai = 0; ai < 2; ++ai)
#pragma unroll
            for (int m = 0; m < 4; ++m) { const int r = row0 + ai * HALF + m * 16; bf16* rowp = base + (r * ldc + col0); bf16* rowm = base + ((4096 - 512 * mt - r) * ldc + col0); const bool mir = (mt | r) != 0;
#pragma unroll
                for (int bj = 0; bj < 2; ++bj) { const f32x4 v0 = acc[ai][bj][m][0] * scale, v1 = acc[ai][bj][m][1] * scale;
                    v4u w; w.x = cvt_pk_bf16(v0[0], v0[1]); w.y = cvt_pk_bf16(v0[2], v0[3]); w.z = cvt_pk_bf16(v1[0], v1[1]); w.w = cvt_pk_bf16(v1[2], v1[3]);
                    *(v4u*)(rowp + bj * 256) = w;
                    if (mir) { w.x ^= flip; w.y ^= flip; w.z ^= flip; w.w ^= flip; *(v4u*)(rowm + bj * 256) = w; } } }
    }
};
struct EpiF32 {
    static constexpr bool PERM = false;
    __device__ __forceinline__ void operator()(const f32x4 (&acc)[2][2][4][2], const Unit& u, int wr, int wc, int fr, int fq) const {
        float* base = (float*)u.c; const int ldc = u.ldc; const int row0 = wr * 64 + fr, col0 = wc * 32 + 4 * fq;
#pragma unroll
        for (int ai = 0; ai < 2; ++ai)
#pragma unroll
            for (int m = 0; m < 4; ++m) { float* rowp = base + (size_t)(row0 + ai * HALF + m * 16) * ldc + col0;
#pragma unroll
                for (int bj = 0; bj < 2; ++bj)
#pragma unroll
                    for (int n = 0; n < 2; ++n) *(f32x4*)(rowp + bj * HALF + n * 16) = acc[ai][bj][m][n]; }
    }
};
struct EpiLdsS {
    static constexpr bool PERM = true;
    LAS unsigned char* lds;
    __device__ __forceinline__ void operator()(const f32x4 (&acc)[2][2][4][2], const Unit& u, int wr, int wc, int fr, int fq) const {
        asm volatile("s_waitcnt vmcnt(0)" ::: "memory"); __builtin_amdgcn_s_barrier();
        const int row0 = wr * 64 + fr, ch0 = wc * 4 + fq; (void)u;
#pragma unroll
        for (int ai = 0; ai < 2; ++ai)
#pragma unroll
            for (int m = 0; m < 4; ++m) { const int r = row0 + ai * HALF + m * 16;
#pragma unroll
                for (int bj = 0; bj < 2; ++bj) { const f32x4 v0 = acc[ai][bj][m][0], v1 = acc[ai][bj][m][1];
                    v4u w; w.x = cvt_pk_bf16(v0[0], v0[1]); w.y = cvt_pk_bf16(v0[2], v0[3]); w.z = cvt_pk_bf16(v1[0], v1[1]); w.w = cvt_pk_bf16(v1[2], v1[3]);
                    *(LAS v4u*)(lds + r * 512 + (((ch0 + bj * 16) ^ fr) << 4)) = w; } }
    }
};
struct EpiSsmY {
    static constexpr bool PERM = true;
    bf16* yssm;
    __device__ __forceinline__ void operator()(const f32x4 (&acc)[2][2][4][2], const Unit& u, int wr, int wc, int fr, int fq) const {
        const int row0 = u.z + wr * 64 + fr, col0 = wc * 32 + 8 * fq, g = u.pn;
#pragma unroll
        for (int ai = 0; ai < 2; ++ai)
#pragma unroll
            for (int m = 0; m < 4; ++m) { const int chunk = row0 + ai * HALF + m * 16;
#pragma unroll
                for (int bj = 0; bj < 2; ++bj) { const f32x4 v0 = acc[ai][bj][m][0], v1 = acc[ai][bj][m][1];
                    v4u w; w.x = cvt_pk_bf16(v0[0], v0[1]); w.y = cvt_pk_bf16(v0[2], v0[3]); w.z = cvt_pk_bf16(v1[0], v1[1]); w.w = cvt_pk_bf16(v1[2], v1[3]);
                    const int col = col0 + bj * HALF, i = col >> 4, c0 = col & 15;
                    *(v4u*)(yssm + (size_t)(chunk * 16 + i) * 1024 + g * 16 + c0) = w; } }
    }
};
struct EpiGlu {
    static constexpr bool PERM = true;
    const bf16* proj; bf16* mix;
    __device__ __forceinline__ void operator()(const f32x4 (&acc)[2][2][4][2], const Unit& u, int wr, int wc, int fr, int fq) const {
        const int row0 = u.pm * BM + wr * 64 + fr, col0 = u.pn * HALF + wc * 32 + 8 * fq;
#pragma unroll
        for (int ai = 0; ai < 2; ++ai)
#pragma unroll
            for (int m = 0; m < 4; ++m) { const int row = row0 + ai * HALF + m * 16;
                const v4u gs = *(const v4u*)(proj + (size_t)row * INW + OFF_GS + col0);
                const f32x4 a0 = acc[ai][0][m][0], a1 = acc[ai][0][m][1], g0 = acc[ai][1][m][0], g1 = acc[ai][1][m][1];
                float o[8];
#pragma unroll
                for (int j = 0; j < 4; ++j) { o[j] = a0[j] * sigmoid_f(g0[j]); o[4 + j] = a1[j] * sigmoid_f(g1[j]); }
                o[0] *= bf_lo(gs.x); o[1] *= bf_hi(gs.x); o[2] *= bf_lo(gs.y); o[3] *= bf_hi(gs.y); o[4] *= bf_lo(gs.z); o[5] *= bf_hi(gs.z); o[6] *= bf_lo(gs.w); o[7] *= bf_hi(gs.w);
                v4u w; w.x = cvt_pk_bf16(o[0], o[1]); w.y = cvt_pk_bf16(o[2], o[3]); w.z = cvt_pk_bf16(o[4], o[5]); w.w = cvt_pk_bf16(o[6], o[7]);
                *(v4u*)(mix + (size_t)row * DM + 2048 + col0) = w; }
    }
};
struct EpiFftW {
    static constexpr bool PERM = true;
    const bf16* proj; bf16* mix;
    __device__ __forceinline__ void operator()(const f32x4 (&acc)[2][2][4][2], const Unit& u, int wr, int wc, int fr, int fq) const {
        const int row0 = u.pm * BM + wr * 64 + fr, col0 = u.pn * BM + wc * 32 + 8 * fq;
#pragma unroll
        for (int ai = 0; ai < 2; ++ai)
#pragma unroll
            for (int m = 0; m < 4; ++m) { const int row = row0 + ai * HALF + m * 16;
#pragma unroll
                for (int bj = 0; bj < 2; ++bj) { const int col = col0 + bj * HALF;
                    const v4u gs = *(const v4u*)(proj + (size_t)row * INW + OFF_GF + col);
                    const f32x4 v0 = acc[ai][bj][m][0], v1 = acc[ai][bj][m][1];
                    v4u w; w.x = cvt_pk_bf16(v0[0] * bf_lo(gs.x), v0[1] * bf_hi(gs.x)); w.y = cvt_pk_bf16(v0[2] * bf_lo(gs.y), v0[3] * bf_hi(gs.y));
                    w.z = cvt_pk_bf16(v1[0] * bf_lo(gs.z), v1[1] * bf_hi(gs.z)); w.w = cvt_pk_bf16(v1[2] * bf_lo(gs.w), v1[3] * bf_hi(gs.w));
                    *(v4u*)(mix + (size_t)row * DM + 3072 + col) = w; } }
    }
};
struct EpiOut {
    static constexpr bool PERM = true;
    bf16* delta; const float* modl;
    __device__ __forceinline__ void operator()(const f32x4 (&acc)[2][2][4][2], const Unit& u, int wr, int wc, int fr, int fq) const {
        const int rt = u.pm * BM; const int v = rt < NCTX ? 0 : (rt < NCTX + 4096 ? 1 : 2);
        const float* gv = modl + v * 12288 + 8192;
        const int row0 = rt + wr * 64 + fr, col0 = u.pn * BM + wc * 32 + 8 * fq;
        f32x4 gt[2][2];
#pragma unroll
        for (int bj = 0; bj < 2; ++bj)
#pragma unroll
            for (int n = 0; n < 2; ++n) gt[bj][n] = *(const f32x4*)(gv + col0 + bj * HALF + n * 4);
#pragma unroll
        for (int ai = 0; ai < 2; ++ai)
#pragma unroll
            for (int m = 0; m < 4; ++m) { bf16* rowp = delta + (size_t)(row0 + ai * HALF + m * 16) * DM + col0;
#pragma unroll
                for (int bj = 0; bj < 2; ++bj) { const f32x4 v0 = acc[ai][bj][m][0] * gt[bj][0], v1 = acc[ai][bj][m][1] * gt[bj][1];
                    v4u w; w.x = cvt_pk_bf16(v0[0], v0[1]); w.y = cvt_pk_bf16(v0[2], v0[3]); w.z = cvt_pk_bf16(v1[0], v1[1]); w.w = cvt_pk_bf16(v1[2], v1[3]);
                    *(v4u*)(rowp + bj * HALF) = w; } }
    }
};
}

namespace att {
constexpr int D = 128, QBLK = 32, KVBLK = 64;
constexpr float SCALE = 0.088388347648318440f;
constexpr float THR = 8.f;
constexpr int SHM_V = KVBLK * D * 2, SHM_K = KVBLK * D * 2;
constexpr int WS_OFF = 2 * SHM_V + 2 * SHM_K, OSTG_OFF = WS_OFF + NWAVES * 64 * 4, OSTG_ROW = 272, OSTG_WAVE = 32 * OSTG_ROW;
static_assert(DEPTH >= 2, "the bf16 stream is first written by layer 1's norm phase");
static_assert(OSTG_OFF + NWAVES * OSTG_WAVE <= MISC_OFF, "attention LDS");
#define KSWZ(row, colB) ((row) * 256 + ((colB) ^ (((row) & 7) << 4)))
#define SBAR() __builtin_amdgcn_sched_barrier(0)
__device__ __forceinline__ int crow(int r, int hi) { return (r & 3) + 8 * (r >> 2) + 4 * hi; }
__device__ __forceinline__ void partialSM(f32x16& p0, f32x16& p1, float& m_reg, float& mn, float& alpha) {
  constexpr float C = SCALE * 1.4426950408889634f;
  float pmax = p0[0]; for (int r = 1; r < 16; ++r) pmax = fmaxf(pmax, p0[r]); for (int r = 0; r < 16; ++r) pmax = fmaxf(pmax, p1[r]);
  { auto rr = __builtin_amdgcn_permlane32_swap(__float_as_uint(pmax), __float_as_uint(pmax), false, false);
    pmax = fmaxf(__uint_as_float(rr[0]), __uint_as_float(rr[1])); }
  if (__builtin_expect(__all(pmax - m_reg <= THR / SCALE), 1)) { mn = m_reg; alpha = 1.f; }
  else { mn = fmaxf(m_reg, pmax); alpha = __builtin_amdgcn_exp2f((m_reg - mn) * C); m_reg = mn; }
  float mnC = -mn * C;
  for (int r = 0; r < 16; ++r) p0[r] = fmaf(p0[r], C, mnC); for (int r = 0; r < 16; ++r) p1[r] = fmaf(p1[r], C, mnC);
  for (int r = 0; r < 16; ++r) p0[r] = __builtin_amdgcn_exp2f(p0[r]);
}
__device__ __forceinline__ void finishSM(f32x16& p0, f32x16& p1, float alpha, float& l_reg, bf16x8& pa0, bf16x8& pa1, bf16x8& pa2, bf16x8& pa3) {
  for (int r = 0; r < 16; ++r) p1[r] = __builtin_amdgcn_exp2f(p1[r]);
  float ps = 0; for (int r = 0; r < 16; ++r) ps += p0[r]; for (int r = 0; r < 16; ++r) ps += p1[r];
  { auto rr = __builtin_amdgcn_permlane32_swap(__float_as_uint(ps), __float_as_uint(ps), false, false);
    ps = __uint_as_float(rr[0]) + __uint_as_float(rr[1]); }
  l_reg = l_reg * alpha + ps;
#define PK4(P, BASE, OUT) do { unsigned a0 = cvt_pk_bf16(P[BASE + 0], P[BASE + 1]), a1 = cvt_pk_bf16(P[BASE + 2], P[BASE + 3]);   \
    unsigned b0 = cvt_pk_bf16(P[BASE + 4], P[BASE + 5]), b1 = cvt_pk_bf16(P[BASE + 6], P[BASE + 7]);                              \
    auto r0 = __builtin_amdgcn_permlane32_swap(a0, b0, false, false); auto r1 = __builtin_amdgcn_permlane32_swap(a1, b1, false, false); \
    v4u w = {r0[0], r1[0], r0[1], r1[1]}; OUT = *reinterpret_cast<bf16x8*>(&w); } while (0)
  PK4(p0, 0, pa0); PK4(p0, 8, pa1); PK4(p1, 0, pa2); PK4(p1, 8, pa3);
#undef PK4
}
__device__ __forceinline__ void qkt(f32x16& p0, f32x16& p1, const char* Ks, const bf16x8* qr, int r32, int hi) {
  p0 = f32x16{}; p1 = f32x16{};
  for (int d0 = 0; d0 < 8; ++d0) { int cb = (d0 * 16 + hi * 8) * 2;
    bf16x8 b0 = *reinterpret_cast<const bf16x8*>(Ks + KSWZ(r32, cb));
    bf16x8 b1 = *reinterpret_cast<const bf16x8*>(Ks + KSWZ(32 + r32, cb));
    p0 = __builtin_amdgcn_mfma_f32_32x32x16_bf16(b0, qr[d0], p0, 0, 0, 0);
    p1 = __builtin_amdgcn_mfma_f32_32x32x16_bf16(b1, qr[d0], p1, 0, 0, 0); }
}
__device__ __forceinline__ int v_st(int k, int c) { const int kk = (k & ~0xC) | ((k & 4) << 1) | ((k & 8) >> 1); return ((kk >> 3) * 4 + (c >> 5)) * 512 + ((kk & 7) * 32 + (c & 31)) * 2; }
__device__ __forceinline__ int v_rd_base(int lane) { return ((lane & 3) << 3) | (((lane >> 2) & 3) << 6) | (((lane >> 4) & 1) << 5) | (((lane >> 5) & 1) << 8); }
constexpr int v_rd_off(int d0, int ks, int half) { return d0 * 512 + ks * 4096 + half * 2048; }
template <int OFF> __device__ __forceinline__ s16x4 tr_read(int vb) {
  s16x4 r; asm volatile("ds_read_b64_tr_b16 %0, %1 offset:%2" : "=&v"(r) : "v"(vb), "i"(OFF) : "memory"); return r;
}
template <int D0> __device__ __forceinline__ void pv_one(f32x16& od, int vb, bf16x8 pa0, bf16x8 pa1, bf16x8 pa2, bf16x8 pa3) {
  const s16x4 l0 = tr_read<v_rd_off(D0, 0, 0)>(vb), h0 = tr_read<v_rd_off(D0, 0, 1)>(vb), l1 = tr_read<v_rd_off(D0, 1, 0)>(vb), h1 = tr_read<v_rd_off(D0, 1, 1)>(vb);
  const s16x4 l2 = tr_read<v_rd_off(D0, 2, 0)>(vb), h2 = tr_read<v_rd_off(D0, 2, 1)>(vb), l3 = tr_read<v_rd_off(D0, 3, 0)>(vb), h3 = tr_read<v_rd_off(D0, 3, 1)>(vb);
  asm volatile("s_waitcnt lgkmcnt(0)" ::: "memory"); SBAR();
#define PK(L, H) (bf16x8){L[0], L[1], L[2], L[3], H[0], H[1], H[2], H[3]}
  od = __builtin_amdgcn_mfma_f32_32x32x16_bf16(pa0, PK(l0, h0), od, 0, 0, 0);
  od = __builtin_amdgcn_mfma_f32_32x32x16_bf16(pa1, PK(l1, h1), od, 0, 0, 0);
  od = __builtin_amdgcn_mfma_f32_32x32x16_bf16(pa2, PK(l2, h2), od, 0, 0, 0);
  od = __builtin_amdgcn_mfma_f32_32x32x16_bf16(pa3, PK(l3, h3), od, 0, 0, 0);
#undef PK
}
__device__ __forceinline__ void pv_d0(f32x16* o, int vb, bf16x8 pa0, bf16x8 pa1, bf16x8 pa2, bf16x8 pa3) {
  pv_one<0>(o[0], vb, pa0, pa1, pa2, pa3); pv_one<1>(o[1], vb, pa0, pa1, pa2, pa3); pv_one<2>(o[2], vb, pa0, pa1, pa2, pa3); pv_one<3>(o[3], vb, pa0, pa1, pa2, pa3);
}

__device__ __forceinline__ void attn_unit(const bf16* __restrict__ Qb, const bf16* __restrict__ Gb, bf16* __restrict__ Ob,
                                          const bf16* __restrict__ K0, const bf16* __restrict__ V0, int ld0, int nt0,
                                          const bf16* __restrict__ K1, const bf16* __restrict__ V1, int ld1, int nt1,
                                          const float* __restrict__ qn, const f32x2* __restrict__ rope, int tok0, char* lds, int wv) {
  const int tid = tid_of(wv);
  const int wid = tid >> 6, lane = tid & 63, r32 = lane & 31, hi = lane >> 5;
  char* V_lds = lds; char* K_lds = lds + 2 * SHM_V;
  float* ws = (float*)(lds + WS_OFF) + wid * 64; float* li_l = ws; float* al_l = ws + 32;
  float m_reg = -1e30f, l_reg = 0; f32x16 o[4] = {}; bf16x8 qr[8];
  const int sr = tid >> 4, sc = (tid & 15) * 8, vst0 = v_st(sr, sc), vst1 = v_st(32 + sr, sc);
  const int vb0 = (int)(uintptr_t)V_lds + v_rd_base(lane);
  struct { bf16x8 vs0, vs1, ks0, ks1; } sr_[2];
#define SLOAD(i, jt) do { const bf16* kb_; const bf16* vb_; long ld_; \
    if ((jt) < nt0) { kb_ = K0 + (long)(jt) * KVBLK * ld0; vb_ = V0 + (long)(jt) * KVBLK * ld0; ld_ = ld0; } else { kb_ = K1 + (long)((jt) - nt0) * KVBLK * ld1; vb_ = V1 + (long)((jt) - nt0) * KVBLK * ld1; ld_ = ld1; } \
    sr_[i].vs0 = *reinterpret_cast<const bf16x8*>(vb_ + (long)sr * ld_ + sc); sr_[i].vs1 = *reinterpret_cast<const bf16x8*>(vb_ + (long)(32 + sr) * ld_ + sc); \
    sr_[i].ks0 = *reinterpret_cast<const bf16x8*>(kb_ + (long)sr * ld_ + sc); sr_[i].ks1 = *reinterpret_cast<const bf16x8*>(kb_ + (long)(32 + sr) * ld_ + sc); } while (0)
  SLOAD(0, 0);
  __syncthreads();
  {
    const bf16* Qw = Qb + (long)(wid * QBLK + r32) * INW + hi * 8;
    float x[8][8]; float ss = 0.f;
#pragma unroll
    for (int d0 = 0; d0 < 8; ++d0) { const v4u raw = *reinterpret_cast<const v4u*>(Qw + d0 * 16);
      x[d0][0] = bf_lo(raw.x); x[d0][1] = bf_hi(raw.x); x[d0][2] = bf_lo(raw.y); x[d0][3] = bf_hi(raw.y); x[d0][4] = bf_lo(raw.z); x[d0][5] = bf_hi(raw.z); x[d0][6] = bf_lo(raw.w); x[d0][7] = bf_hi(raw.w);
#pragma unroll
      for (int j = 0; j < 8; ++j) ss += x[d0][j] * x[d0][j]; }
    { auto rr = __builtin_amdgcn_permlane32_swap(__float_as_uint(ss), __float_as_uint(ss), false, false); ss = __uint_as_float(rr[0]) + __uint_as_float(rr[1]); }
    const float rstd = rsqrtf(ss * (1.0f / 128.0f) + NORM_EPS);
#pragma unroll
    for (int d0 = 0; d0 < 8; ++d0) { const f32x4 w0 = *reinterpret_cast<const f32x4*>(qn + d0 * 16 + hi * 8), w1 = *reinterpret_cast<const f32x4*>(qn + d0 * 16 + hi * 8 + 4);
#pragma unroll
      for (int j = 0; j < 4; ++j) { x[d0][j] *= rstd * w0[j]; x[d0][4 + j] *= rstd * w1[j]; } }
    if (rope) {
      const int t = tok0 + wid * QBLK + r32, prow = t >> 6, pcol = t & 63;
#pragma unroll
      for (int half = 0; half < 2; ++half) { const f32x2* rp = rope + (half ? pcol : prow) * 32;
#pragma unroll
        for (int dd = 0; dd < 2; ++dd) { const int d0 = half * 4 + dd;
#pragma unroll
          for (int j = 0; j < 8; ++j) { const f32x2 cs = rp[dd * 16 + hi * 8 + j]; const float x1 = x[d0][j], x2 = x[d0 + 2][j];
            x[d0][j] = x1 * cs.x - x2 * cs.y; x[d0 + 2][j] = x1 * cs.y + x2 * cs.x; } } }
    }
#pragma unroll
    for (int d0 = 0; d0 < 8; ++d0) { v4u w = {cvt_pk_bf16(x[d0][0], x[d0][1]), cvt_pk_bf16(x[d0][2], x[d0][3]), cvt_pk_bf16(x[d0][4], x[d0][5]), cvt_pk_bf16(x[d0][6], x[d0][7])}; qr[d0] = *reinterpret_cast<bf16x8*>(&w); }
  }
#define SWRITE(b, i) do { *(bf16x8*)(V_lds + (b) * SHM_V + vst0) = sr_[i].vs0;          \
    *(bf16x8*)(V_lds + (b) * SHM_V + vst1) = sr_[i].vs1; int kc = sc * 2;               \
    *(bf16x8*)(K_lds + (b) * SHM_K + KSWZ(sr, kc)) = sr_[i].ks0;                       \
    *(bf16x8*)(K_lds + (b) * SHM_K + KSWZ(32 + sr, kc)) = sr_[i].ks1; } while (0)
#define SWAIT() asm volatile("s_waitcnt vmcnt(4)" ::: "memory")
#define RESC(a) do { if (__any((a) < 1.f)) { if (hi == 0) al_l[r32] = (a); asm volatile("s_waitcnt lgkmcnt(0)" ::: "memory"); \
    for (int d = 0; d < 4; ++d) for (int r = 0; r < 16; ++r) o[d][r] *= al_l[crow(r, hi)]; } } while (0)
  f32x16 pA0, pA1, pB0, pB1; float mnA, mnB, alA, alB; bf16x8 pa0, pa1, pa2, pa3; const int NT = nt0 + nt1;
  constexpr int SE = 0, SO = 1;
  asm volatile("s_waitcnt vmcnt(0)" ::: "memory"); SWRITE(0, SE); __syncthreads();
  qkt(pA0, pA1, K_lds, qr, r32, hi); partialSM(pA0, pA1, m_reg, mnA, alA);
  SLOAD(SO, 1); if (2 < NT) SLOAD(SE, 2);
  SWAIT(); SWRITE(1, SO); __syncthreads();
  for (int j = 1; j + 1 < NT; j += 2) {
    SBAR(); qkt(pB0, pB1, K_lds + SHM_K, qr, r32, hi);
    finishSM(pA0, pA1, alA, l_reg, pa0, pa1, pa2, pa3); SBAR();
    SLOAD(SO, j + 2); SBAR();
    pv_d0(o, vb0, pa0, pa1, pa2, pa3); partialSM(pB0, pB1, m_reg, mnB, alB);
    __syncthreads(); SWAIT(); SWRITE(0, SE);
    RESC(alB); __syncthreads();
    SBAR(); qkt(pA0, pA1, K_lds, qr, r32, hi);
    finishSM(pB0, pB1, alB, l_reg, pa0, pa1, pa2, pa3); SBAR();
    if (j + 3 < NT) SLOAD(SE, j + 3); SBAR();
    pv_d0(o, vb0 + SHM_V, pa0, pa1, pa2, pa3); partialSM(pA0, pA1, m_reg, mnA, alA);
    __syncthreads(); SWAIT(); SWRITE(1, SO);
    RESC(alA); __syncthreads();
  }
  SBAR(); qkt(pB0, pB1, K_lds + SHM_K, qr, r32, hi);
  finishSM(pA0, pA1, alA, l_reg, pa0, pa1, pa2, pa3); SBAR();
  pv_d0(o, vb0, pa0, pa1, pa2, pa3); partialSM(pB0, pB1, m_reg, mnB, alB);
  __syncthreads(); RESC(alB);
  finishSM(pB0, pB1, alB, l_reg, pa0, pa1, pa2, pa3); SBAR();
  pv_d0(o, vb0 + SHM_V, pa0, pa1, pa2, pa3);
  if (hi == 0) li_l[r32] = l_reg; asm volatile("s_waitcnt lgkmcnt(0)" ::: "memory");
  char* stg = lds + OSTG_OFF + wid * OSTG_WAVE;
  v4u gvv[8];
#pragma unroll
  for (int it = 0; it < 8; ++it) gvv[it] = *reinterpret_cast<const v4u*>(Gb + (long)(wid * QBLK + it * 4 + (lane >> 4)) * INW + (lane & 15) * 8);
#pragma unroll
  for (int r = 0; r < 16; ++r) { const int orow = crow(r, hi); const float rl = __builtin_amdgcn_rcpf(li_l[orow]);
#pragma unroll
    for (int d0 = 0; d0 < 4; ++d0) { const unsigned w = cvt_pk_bf16(o[d0][r] * rl, 0.f); *(bf16*)(stg + orow * OSTG_ROW + (d0 * 32 + r32) * 2) = (bf16)(w & 0xffffu); }
    if ((r & 3) == 3) asm volatile("" ::: "memory"); }
  asm volatile("s_waitcnt lgkmcnt(0)" ::: "memory");
#pragma unroll
  for (int it = 0; it < 8; ++it) { const int row = it * 4 + (lane >> 4), cc = (lane & 15) * 8;
    const v4u ov = *(const v4u*)(stg + row * OSTG_ROW + cc * 2);
    const v4u gv = gvv[it];
    v4u w; w.x = cvt_pk_bf16(bf_lo(ov.x) * bf_lo(gv.x), bf_hi(ov.x) * bf_hi(gv.x)); w.y = cvt_pk_bf16(bf_lo(ov.y) * bf_lo(gv.y), bf_hi(ov.y) * bf_hi(gv.y));
    w.z = cvt_pk_bf16(bf_lo(ov.z) * bf_lo(gv.z), bf_hi(ov.z) * bf_hi(gv.z)); w.w = cvt_pk_bf16(bf_lo(ov.w) * bf_lo(gv.w), bf_hi(ov.w) * bf_hi(gv.w));
    *reinterpret_cast<v4u*>(Ob + (long)(wid * QBLK + row) * DM + cc) = w; }
#undef SLOAD
#undef SWRITE
#undef SWAIT
#undef RESC
}
}

#define XB_TMO      128
#define XB_XCNT(j)  (256  + 64 * (j))
#define XB_XSUB(j)  (1280 + 64 * (j))
#define XB_XGEN(j)  (2304 + 64 * (j))
#define XB_TOP      3328
#define XB_TOPGEN   3392
#define XCD_BAR_WORDS 3456
#define XB_SPIN_CAP (1u << 18)
__device__ __forceinline__ unsigned xb_ld(unsigned* p)              { return __hip_atomic_load(p, __ATOMIC_RELAXED, __HIP_MEMORY_SCOPE_AGENT); }
__device__ __forceinline__ unsigned xb_add(unsigned* p, unsigned v) { return __hip_atomic_fetch_add(p, v, __ATOMIC_RELAXED, __HIP_MEMORY_SCOPE_AGENT); }
__device__ __forceinline__ unsigned xb_xcc_id() { return (unsigned)__builtin_amdgcn_s_getreg((3 << 11) | 20) & 0xFu; }
#define XB_SPIN(cond, bar) do { unsigned _sp = 0; while (cond) { __builtin_amdgcn_s_sleep(1); \
    if ((++_sp & 255u) == 0u) { if (xb_ld(&(bar)[XB_TMO])) break; if (_sp > XB_SPIN_CAP) { atomicAdd(&(bar)[XB_TMO], 1u); break; } } } } while (0)
struct XcdBarrier { unsigned* bar; unsigned x; volatile LAS unsigned* st; };
__device__ __forceinline__ XcdBarrier xcd_barrier_post(unsigned* bar, volatile LAS unsigned* st, int tid) {
    XcdBarrier b; b.bar = bar; b.x = xb_xcc_id(); b.st = st;
    if (tid == 0) (void)xb_add(&bar[XB_XCNT(b.x)], 1u);
    return b;
}
__device__ __forceinline__ void xcd_barrier_complete(unsigned* bar, unsigned x, unsigned& nloc, unsigned& nx) {
    const unsigned G = gridDim.x * gridDim.y * gridDim.z;
    unsigned sum, cnt, mine, sp = 0u;
    for (;;) {
        sum = 0u; cnt = 0u; mine = 0u;
#pragma nounroll
        for (unsigned j = 0; j < 16; ++j) { const unsigned c = xb_ld(&bar[XB_XCNT(j)]); sum += c; cnt += (c > 0u) ? 1u : 0u; mine = (j == x) ? c : mine; }
        if (sum == G) break;
        __builtin_amdgcn_s_sleep(1);
        if ((++sp & 255u) == 0u) { if (xb_ld(&bar[XB_TMO])) break; if (sp > XB_SPIN_CAP) { atomicAdd(&bar[XB_TMO], 1u); break; } }
    }
    nloc = mine > 0u ? mine : 1u; nx = cnt > 0u ? cnt : 1u;
}
__device__ __forceinline__ void xcd_barrier(const XcdBarrier& b, int wv) {
    asm volatile("s_waitcnt vmcnt(0)" ::: "memory");
    __syncthreads();
    if (tid_of(wv) == 0) {
        unsigned* bar = b.bar;
        __builtin_amdgcn_s_waitcnt(0);
        unsigned nloc = b.st[0], nx = b.st[1];
        if (nloc == 0u) { xcd_barrier_complete(bar, b.x, nloc, nx); b.st[0] = nloc; b.st[1] = nx; }
        const unsigned old = xb_add(&bar[XB_XSUB(b.x)], 1u);
        const unsigned gen = old / nloc;
        if (old + 1u == (gen + 1u) * nloc) {
            __builtin_amdgcn_fence(__ATOMIC_RELEASE, "agent");
            asm volatile("s_waitcnt vmcnt(0)" ::: "memory");
            const unsigned og = xb_add(&bar[XB_TOP], 1u);
            const unsigned tg = og / nx;
            if (og + 1u == (tg + 1u) * nx) xb_add(&bar[XB_TOPGEN], 1u);
            else XB_SPIN(xb_ld(&bar[XB_TOPGEN]) == tg, bar);
            __builtin_amdgcn_fence(__ATOMIC_ACQUIRE, "agent");
            xb_add(&bar[XB_XGEN(b.x)], 1u);
            asm volatile("s_waitcnt vmcnt(0)" ::: "memory");
        } else {
            XB_SPIN(xb_ld(&bar[XB_XGEN(b.x)]) == gen, bar);
            __builtin_amdgcn_fence(__ATOMIC_ACQUIRE, "agent");
            asm volatile("s_waitcnt vmcnt(0)" ::: "memory");
        }
    }
    __syncthreads();
}
__device__ __forceinline__ void wg_global_sync() {
    asm volatile("s_waitcnt vmcnt(0)" ::: "memory");
    __syncthreads();
    __builtin_amdgcn_fence(__ATOMIC_ACQUIRE, "agent");
    asm volatile("s_waitcnt vmcnt(0)" ::: "memory");
}

struct Args { const float* in[28]; float* out; unsigned char* ws; int ph_lo, ph_hi; };
typedef const __attribute__((address_space(4))) Args* KAP;
#define KA_HERE() KAP ka = (KAP)__builtin_amdgcn_kernarg_segment_ptr(); asm volatile("" : "+s"(ka))
enum { I_XP = 0, I_XS, I_CK, I_CV, I_SFR, I_SFI, I_SBR, I_SBI, I_C, I_CCTX, I_NG, I_WMOD, I_BMOD, I_WIN, I_QN, I_KN, I_LRE, I_LIM, I_LSTEP, I_BRE, I_BIM, I_CRE, I_CIM, I_DSKIP, I_WGLU, I_WFFT, I_WOUT, I_FNG };

__device__ __forceinline__ int glu_row(int n) { return n < 1024 ? ((n >> 7) * 256 + (n & 127)) : (((n - 1024) >> 7) * 256 + 128 + ((n - 1024) & 127)); }
template <bool GLU>
__device__ __forceinline__ void tr_item(const float* __restrict__ W, int K, int N, bf16* __restrict__ WT, LAS float* scr, int item, int lane) {
    const int nblk = N / 64, kb = item / nblk, nb = item % nblk, k0 = 64 * kb, n0 = 64 * nb;
#pragma unroll 8
    for (int i = 0; i < 64; ++i) scr[i * 65 + lane] = W[(size_t)(k0 + i) * N + n0 + lane];
    LDS_WAIT(); asm volatile("" ::: "memory");
    const int c = lane & 7;
#pragma unroll
    for (int j = 0; j < 8; ++j) { const int n = (lane >> 3) + 8 * j; const LAS float* s = scr + (8 * c) * 65 + n;
        v4u o; o.x = cvt_pk_bf16(s[0 * 65], s[1 * 65]); o.y = cvt_pk_bf16(s[2 * 65], s[3 * 65]); o.z = cvt_pk_bf16(s[4 * 65], s[5 * 65]); o.w = cvt_pk_bf16(s[6 * 65], s[7 * 65]);
        int nd = n0 + n; if (GLU) nd = glu_row(nd);
        *(v4u*)(WT + (size_t)nd * K + k0 + 8 * c) = o; }
    LDS_WAIT(); asm volatile("" ::: "memory");
}

__device__ __forceinline__ void ssm_matrices(KAP A, int l, int g, LAS unsigned char* lds, int tid) {
    LAS f32x2* pw = (LAS f32x2*)lds;
    LAS f32x2* bb = pw + 2 * 17 * 64;
    LAS f32x2* cc = bb + 2 * 64 * 16;
    LAS float* kk = (LAS float*)(cc + 2 * 16 * 64);
    if (tid < 128) {
        const int dir = tid >> 6, p = tid & 63, ig = (l * 2 + dir) * 64 + g;
        const float dt = expf(A->in[I_LSTEP][ig]);
        const float lr = A->in[I_LRE][(size_t)ig * 64 + p], li = A->in[I_LIM][(size_t)ig * 64 + p];
        for (int tau = 0; tau <= 16; ++tau) {
            const float mag = expf(lr * dt * (float)tau);
            const double turns = (double)li * (double)dt * (double)tau * 0.15915494309189535;
            const float fr = (float)(turns - rint(turns));
            pw[(dir * 17 + tau) * 64 + p] = (f32x2){mag * cospif(2.f * fr), mag * sinpif(2.f * fr)};
        }
        const f32x2 ab = pw[(dir * 17 + 1) * 64 + p];
        const float nr = ab.x - 1.0f, ni = ab.y, den = lr * lr + li * li;
        const float f_re = (nr * lr + ni * li) / den, f_im = (ni * lr - nr * li) / den;
        for (int c = 0; c < 16; ++c) { const float br = A->in[I_BRE][((size_t)ig * 64 + p) * 16 + c], bi = A->in[I_BIM][((size_t)ig * 64 + p) * 16 + c];
            bb[(dir * 64 + p) * 16 + c] = (f32x2){f_re * br - f_im * bi, f_re * bi + f_im * br}; }
        ((f32x2*)(A->ws + WS_A16))[(size_t)ig * 64 + p] = pw[(dir * 17 + 16) * 64 + p];
    }
    for (int idx = tid; idx < 2048; idx += 512) { const int dir = idx >> 10, c = (idx >> 6) & 15, p = idx & 63; const size_t gi = (((size_t)(l * 2 + dir) * 64 + g) * 16 + c) * 64 + p;
        cc[idx] = (f32x2){A->in[I_CRE][gi], A->in[I_CIM][gi]}; }
    __syncthreads();
    {
        const int dir = tid >> 8, tau = (tid >> 4) & 15, c = tid & 15;
        float accv[16];
#pragma unroll
        for (int j = 0; j < 16; ++j) accv[j] = 0.f;
        for (int p = 0; p < 64; ++p) { const f32x2 cv = cc[(dir * 16 + c) * 64 + p], pv = pw[(dir * 17 + tau) * 64 + p];
            const float wre = cv.x * pv.x - cv.y * pv.y, wim = cv.x * pv.y + cv.y * pv.x;
#pragma unroll
            for (int j = 0; j < 16; ++j) { const f32x2 bv = bb[(dir * 64 + p) * 16 + j]; accv[j] += wre * bv.x - wim * bv.y; } }
#pragma unroll
        for (int j = 0; j < 16; ++j) kk[((dir * 16 + tau) * 16 + c) * 16 + j] = accv[j];
    }
    __syncthreads();
    const int lg = l * 64 + g;
    bf16* Pm = (bf16*)(A->ws + WS_PMAT) + (size_t)lg * 256 * 256;
    for (int q = tid; q < 8192; q += 512) { const int R = q >> 5, col = (q & 31) * 8, s = col >> 4, c0 = col & 15, dir = R >> 7, reim = (R >> 6) & 1, p = R & 63, e = dir ? s : 15 - s;
        const f32x2 pv = pw[(dir * 17 + e) * 64 + p]; float v[8];
#pragma unroll
        for (int j = 0; j < 8; ++j) { const f32x2 bv = bb[(dir * 64 + p) * 16 + c0 + j]; v[j] = reim ? (pv.x * bv.y + pv.y * bv.x) : (pv.x * bv.x - pv.y * bv.y); }
        v4u w; w.x = cvt_pk_bf16(v[0], v[1]); w.y = cvt_pk_bf16(v[2], v[3]); w.z = cvt_pk_bf16(v[4], v[5]); w.w = cvt_pk_bf16(v[6], v[7]);
        *(v4u*)(Pm + (size_t)R * 256 + col) = w; }
    bf16* KGm = (bf16*)(A->ws + WS_KG) + (size_t)lg * 256 * 512;
    for (int q = tid; q < 16384; q += 512) { const int R = q >> 6, col = (q & 63) * 8, i = R >> 4, c = R & 15; float v[8];
        if (col < 256) { const int s = col >> 4, c0 = col & 15;
#pragma unroll
            for (int j = 0; j < 8; ++j) { const int cp = c0 + j; float x;
                if (s < i) x = kk[((0 * 16 + (i - s)) * 16 + c) * 16 + cp];
                else if (s > i) x = kk[((1 * 16 + (s - i)) * 16 + c) * 16 + cp];
                else { x = kk[((0 * 16 + 0) * 16 + c) * 16 + cp] + kk[((1 * 16 + 0) * 16 + c) * 16 + cp]; if (cp == c) x += A->in[I_DSKIP][l * 1024 + g * 16 + c]; }
                v[j] = x; }
        } else { const int k = col - 256, dir = k >> 7, reim = (k >> 6) & 1, p0 = k & 63, e = dir ? 16 - i : i + 1;
#pragma unroll
            for (int j = 0; j < 8; ++j) { const f32x2 cv = cc[(dir * 16 + c) * 64 + p0 + j], pv = pw[(dir * 17 + e) * 64 + p0 + j];
                v[j] = reim ? -(cv.x * pv.y + cv.y * pv.x) : (cv.x * pv.x - cv.y * pv.y); } }
        v4u w; w.x = cvt_pk_bf16(v[0], v[1]); w.y = cvt_pk_bf16(v[2], v[3]); w.z = cvt_pk_bf16(v[4], v[5]); w.w = cvt_pk_bf16(v[6], v[7]);
        *(v4u*)(KGm + (size_t)R * 512 + col) = w; }
    __syncthreads();
}

__device__ __forceinline__ void mod_unit(KAP A, int un, LAS unsigned char* lds, int tid, int wave, int lane) {
    LAS float* sl = (LAS float*)lds;
    LAS float* red = sl + 3 * 4096;
    const int l = un >> 6, nb = un & 63;
    for (int i = tid; i < 3 * 4096; i += 512) { const int v = i >> 12, k = i & 4095; const float x = v == 0 ? A->in[I_CCTX][k] : A->in[I_C][(v - 1) * 4096 + k]; sl[i] = x / (1.0f + expf(-x)); }
    __syncthreads();
    const int ln = lane < 48 ? lane : 47;
    const float* wp = A->in[I_WMOD] + ((size_t)l * 4096 + wave * 512) * 12288 + nb * 192 + ln * 4;
    f32x4 a0 = {0.f, 0.f, 0.f, 0.f}, a1 = a0, a2 = a0;
#pragma unroll 8
    for (int kq = 0; kq < 512; ++kq) { const f32x4 w = *(const f32x4*)(wp + (size_t)kq * 12288); const int k = wave * 512 + kq;
        a0 += sl[k] * w; a1 += sl[4096 + k] * w; a2 += sl[8192 + k] * w; }
    if (lane < 48) {
#pragma unroll
        for (int j = 0; j < 4; ++j) { red[(wave * 3 + 0) * 256 + lane * 4 + j] = a0[j]; red[(wave * 3 + 1) * 256 + lane * 4 + j] = a1[j]; red[(wave * 3 + 2) * 256 + lane * 4 + j] = a2[j]; } }
    __syncthreads();
    for (int i = tid; i < 768; i += 512) { const int v = i >> 8, col = i & 255; if (col < 192) { float s = 0.f;
#pragma unroll
        for (int w = 0; w < 8; ++w) s += red[(w * 3 + v) * 256 + col];
        ((float*)(A->ws + WS_MOD))[(size_t)(l * 3 + v) * 12288 + nb * 192 + col] = s + A->in[I_BMOD][l * 12288 + nb * 192 + col]; } }
    __syncthreads();
}

__device__ __forceinline__ void p0_prologue(KAP A, LAS unsigned char* lds, int G, int bx, int wv) {
    const int tid = tid_of(wv); const int lane = tid & 63, wave = __builtin_amdgcn_readfirstlane(tid >> 6);
    { LAS float* scr = (LAS float*)(lds + wave * 16640);
      const int gw = bx * NWAVES + wave, NGW = G * NWAVES;
      constexpr int I_IN = 64 * 144, I_OUT = 64 * 64, I_GLU = 16 * 32, I_L = I_IN + I_OUT + I_GLU;
      for (int it = gw; it < 4 * I_L; it += NGW) { const int l = it / I_L; int r = it % I_L;
          if (r < I_IN) { tr_item<false>(A->in[I_WIN] + (size_t)l * 4096 * 9216, 4096, 9216, (bf16*)(A->ws + WS_WIN) + (size_t)l * 9216 * 4096, scr, r, lane); continue; } r -= I_IN;
          if (r < I_OUT) { tr_item<false>(A->in[I_WOUT] + (size_t)l * 4096 * 4096, 4096, 4096, (bf16*)(A->ws + WS_WOUT) + (size_t)l * 4096 * 4096, scr, r, lane); continue; } r -= I_OUT;
          tr_item<true>(A->in[I_WGLU] + (size_t)l * 1024 * 2048, 1024, 2048, (bf16*)(A->ws + WS_WGLU) + (size_t)l * 2048 * 1024, scr, r, lane); }
    }
    __syncthreads();
    for (int un = bx; un < 256; un += G) mod_unit(A, un, lds, tid, wave, lane);
    const size_t gt = (size_t)bx * 512 + tid, NGT = (size_t)G * 512;
    { bf16* D2L = (bf16*)(A->ws + WS_D2L);
      LAS bf16* lut = (LAS bf16*)lds;
      for (int i = tid; i < 4096; i += 512) lut[i] = (bf16)(cvt_pk_bf16(cospif((float)i * (1.0f / 2048.0f)), 0.f) & 0xffffu);
      __syncthreads();
      for (size_t q = gt; q < (size_t)4096 * 1024; q += NGT) { const int k = (int)(q >> 10), K0 = (int)(q & 1023) * 8; unsigned h[8];
          const int sh = K0 < 4096 ? 0 : 1024;
#pragma unroll
          for (int j = 0; j < 8; ++j) { const int K = (K0 + j) & 4095; h[j] = lut[(k * K + sh) & 4095]; }
          v4u w; w.x = h[0] | (h[1] << 16); w.y = h[2] | (h[3] << 16); w.z = h[4] | (h[5] << 16); w.w = h[6] | (h[7] << 16);
          *(v4u*)(D2L + (size_t)k * 8192 + K0) = w; }
      __syncthreads(); }
    { bf16* D1 = (bf16*)(A->ws + WS_D1);
      for (size_t q = gt; q < (size_t)256 * 256; q += NGT) { const int mp = (int)(q >> 8), c = (int)(q & 255), m = mp <= 128 ? mp : mp - 128; const float x = (float)((m * c) & 255) * (1.0f / 128.0f);
          const float v = mp <= 128 ? cospif(x) : sinpif(x); D1[q] = (bf16)(cvt_pk_bf16(v, 0.f) & 0xffffu); } }
    { bf16* WFP = (bf16*)(A->ws + WS_WFP);
      for (size_t q = gt; q < (size_t)4 * 144 * 1024; q += NGT) { const int n = (int)(q & 1023), i = (int)((q >> 10) % 144), l = (int)(q / (144 * 1024)); const int kk0 = i * 8;
          const float* W = A->in[I_WFFT] + (size_t)l * 1024 * 1024 + n; float v[8];
          if (kk0 < 1024) { const int g = kk0 >> 8, part = (kk0 >> 7) & 1;
#pragma unroll
              for (int j = 0; j < 8; ++j) { const int m = (kk0 + j) & 127; const float w1 = W[(size_t)(g * 256 + m) * 1024], w2 = W[(size_t)(g * 256 + ((256 - m) & 255)) * 1024];
                  v[j] = part ? (w1 - w2) : (m ? w1 + w2 : w1); } }
          else {
#pragma unroll
              for (int j = 0; j < 8; ++j) v[j] = 0.f;
              if (kk0 == 1024) {
#pragma unroll
                  for (int j = 0; j < 4; ++j) v[j] = W[(size_t)(j * 256 + 128) * 1024]; } }
          v4u w; w.x = cvt_pk_bf16(v[0], v[1]); w.y = cvt_pk_bf16(v[2], v[3]); w.z = cvt_pk_bf16(v[4], v[5]); w.w = cvt_pk_bf16(v[6], v[7]);
          *(v4u*)(WFP + ((size_t)l * 1024 + n) * PK + kk0) = w; }
      bf16* P = (bf16*)(A->ws + WS_P);
      for (size_t q = gt; q < (size_t)NTOK * 31; q += NGT) { const size_t row = q / 31; const int j = (int)(q % 31); *(v2u*)(P + row * PK + 1028 + j * 4) = (v2u){0u, 0u}; } }
    { bf16* D2C = (bf16*)(A->ws + WS_D2C);
      for (size_t q = gt; q < (size_t)256 * 512; q += NGT) { const int k = (int)(q >> 9), K = (int)(q & 511); const float x = (float)((k * (K & 255)) & 255) * (1.0f / 128.0f);
          const float v = K < 256 ? cospif(x) : -sinpif(x); D2C[q] = (bf16)(cvt_pk_bf16(v, 0.f) & 0xffffu); } }
    { f32x2* rope = (f32x2*)(A->ws + WS_ROPE);
      for (size_t q = gt; q < 64 * 32; q += NGT) { const int pos = (int)(q >> 5), i = (int)(q & 31); const float inv = exp2f(-(float)i * (13.287712379549449f / 32.0f));
          const double turns = (double)pos * (double)inv * 0.15915494309189535; const float fr = (float)(turns - rint(turns));
          rope[q] = (f32x2){cospif(2.f * fr), sinpif(2.f * fr)}; } }
    { const size_t n8 = (size_t)2 * 4 * 512 * 512 / 8;
      for (size_t q = gt; q < 2 * n8; q += NGT) { const bool isk = q < n8; const size_t j = isk ? q : q - n8; const float* src = (isk ? A->in[I_CK] : A->in[I_CV]) + j * 8;
          const f32x4 x0 = *(const f32x4*)src, x1 = *(const f32x4*)(src + 4);
          v4u w; w.x = cvt_pk_bf16(x0[0], x0[1]); w.y = cvt_pk_bf16(x0[2], x0[3]); w.z = cvt_pk_bf16(x1[0], x1[1]); w.w = cvt_pk_bf16(x1[2], x1[3]);
          *(v4u*)((bf16*)(A->ws + (isk ? WS_CK : WS_CV)) + j * 8) = w; } }
    __syncthreads();
    for (int lg = bx; lg < 256; lg += G) ssm_matrices(A, lg >> 6, lg & 63, lds, tid);
}

__device__ __forceinline__ f32x4 ldg16(const void* base, unsigned off, int imm) { return *(const f32x4*)(((const char*)base + off) + imm); }
__device__ __forceinline__ void pa_norm(KAP A, int l, int bx, int G, int tid, LAS unsigned char* lds) {
    const float* mod = (const float*)(A->ws + WS_MOD) + (size_t)l * 3 * 12288;
    const f32x4* ng4 = (const f32x4*)(A->in[I_NG] + l * DM);
    bf16* H = (bf16*)(A->ws + WS_H);
    const int lane = tid & 63, wave = __builtin_amdgcn_readfirstlane(tid >> 6);
    const unsigned lo2 = (unsigned)lane * 16u, lo4 = (unsigned)lane * 32u;
    LAS f32x4* avl = (LAS f32x4*)lds; LAS f32x4* svl = avl + 1024;
    for (int rb = bx; rb < NTOK / 64; rb += G) {
        const int m0 = rb * 64; const int v = m0 < NCTX ? 0 : (m0 < NCTX + 4096 ? 1 : 2);
        const f32x4* sh4 = (const f32x4*)(mod + v * 12288); const f32x4* sc4 = (const f32x4*)(mod + v * 12288 + 4096);
        __syncthreads();
        for (int i = tid; i < 1024; i += NWAVES * 64) { const int d = ((i >> 7) * 2 + (i & 1)) * 64 + ((i & 127) >> 1);
            avl[d] = ng4[i] * (sc4[i] + 1.0f); svl[d] = sh4[i]; }
        __syncthreads();
#pragma unroll 2
        for (int r = 0; r < 8; ++r) { const int m = m0 + wave * 8 + r;
            f32x4 x[16]; float ss = 0.f;
            char* xb = (char*)((bf16*)(A->ws + ((l & 1) ? WS_XBF2 : WS_XBF)) + (size_t)m * DM);
            const char* xbi = (const char*)((const bf16*)(A->ws + ((l & 1) ? WS_XBF : WS_XBF2)) + (size_t)m * DM);
            if (l <= 1) { const float* xr = m < NCTX ? A->in[I_XP] + (size_t)m * DM : A->in[I_XS] + (size_t)(m - NCTX) * DM;
#pragma unroll
                for (int j = 0; j < 8; ++j) { x[2 * j] = ldg16(xr, lo4 + (j >> 1) * 4096u, (j & 1) * 2048); x[2 * j + 1] = ldg16(xr, lo4 + (j >> 1) * 4096u, (j & 1) * 2048 + 16); }
            } else {
#pragma unroll
                for (int j = 0; j < 8; ++j) { const v4u d = *(const v4u*)((xbi + (lo2 + (j >> 2) * 4096u)) + (j & 3) * 1024);
                    x[2 * j] = (f32x4){bf_lo(d.x), bf_hi(d.x), bf_lo(d.y), bf_hi(d.y)}; x[2 * j + 1] = (f32x4){bf_lo(d.z), bf_hi(d.z), bf_lo(d.w), bf_hi(d.w)}; }
            }
            if (l > 0) {
                const char* dr = (const char*)((const bf16*)(A->ws + ((l & 1) ? WS_DELTA : WS_DELTA2)) + (size_t)m * DM);
#pragma unroll
                for (int j = 0; j < 8; ++j) { const v4u d = *(const v4u*)((dr + (lo2 + (j >> 2) * 4096u)) + (j & 3) * 1024);
                    x[2 * j] += (f32x4){bf_lo(d.x), bf_hi(d.x), bf_lo(d.y), bf_hi(d.y)}; x[2 * j + 1] += (f32x4){bf_lo(d.z), bf_hi(d.z), bf_lo(d.w), bf_hi(d.w)};
                    v4u w; w.x = cvt_pk_bf16(x[2 * j].x, x[2 * j].y); w.y = cvt_pk_bf16(x[2 * j].z, x[2 * j].w); w.z = cvt_pk_bf16(x[2 * j + 1].x, x[2 * j + 1].y); w.w = cvt_pk_bf16(x[2 * j + 1].z, x[2 * j + 1].w);
                    *(v4u*)((xb + (lo2 + (j >> 2) * 4096u)) + (j & 3) * 1024) = w; }
            }
#pragma unroll
            for (int j = 0; j < 16; ++j) ss += (x[j].x * x[j].x + x[j].y * x[j].y) + (x[j].z * x[j].z + x[j].w * x[j].w);
            const float rstd = rsqrtf(wave_sum(ss, lane) * (1.0f / DM) + NORM_EPS);
            char* orow = (char*)(H + (size_t)m * DM);
#pragma unroll
            for (int j = 0; j < 8; ++j) { const f32x4 y0 = x[2 * j] * rstd * avl[(2 * j) * 64 + lane] + svl[(2 * j) * 64 + lane], y1 = x[2 * j + 1] * rstd * avl[(2 * j + 1) * 64 + lane] + svl[(2 * j + 1) * 64 + lane];
                v4u w; w.x = cvt_pk_bf16(y0.x, y0.y); w.y = cvt_pk_bf16(y0.z, y0.w); w.z = cvt_pk_bf16(y1.x, y1.y); w.w = cvt_pk_bf16(y1.z, y1.w);
                *(v4u*)((orow + (lo2 + (j >> 2) * 4096u)) + (j & 3) * 1024) = w;
                if ((j & 1) == 1) asm volatile("" ::: "memory"); }
        }
    }
    __syncthreads();
}
__device__ __forceinline__ void final_norm(KAP A, int gw, int NGW, int lane) {
    const float* fg = A->in[I_FNG];
    const unsigned lo2 = (unsigned)lane * 16u, lo4 = (unsigned)lane * 32u;
    f32x4 gv[16];
#pragma unroll
    for (int j = 0; j < 8; ++j) { gv[2 * j] = ldg16(fg, lo4 + (j >> 1) * 4096u, (j & 1) * 2048); gv[2 * j + 1] = ldg16(fg, lo4 + (j >> 1) * 4096u, (j & 1) * 2048 + 16); }
    for (int ci = gw; ci < NTOK / 8; ci += NGW) {
#pragma unroll 2
        for (int r = 0; r < 8; ++r) { const int m = ci * 8 + r;
            char* xr = (char*)(A->out + (size_t)m * DM);
            const char* xs = (const char*)((const bf16*)(A->ws + (((DEPTH - 1) & 1) ? WS_XBF2 : WS_XBF)) + (size_t)m * DM);
            const char* dr = (const char*)((const bf16*)(A->ws + (((DEPTH - 1) & 1) ? WS_DELTA2 : WS_DELTA)) + (size_t)m * DM);
            f32x4 x[16]; float ss = 0.f;
#pragma unroll
            for (int j = 0; j < 8; ++j) { const v4u xv = *(const v4u*)((xs + (lo2 + (j >> 2) * 4096u)) + (j & 3) * 1024); const v4u d = *(const v4u*)((dr + (lo2 + (j >> 2) * 4096u)) + (j & 3) * 1024);
                x[2 * j] = (f32x4){bf_lo(xv.x) + bf_lo(d.x), bf_hi(xv.x) + bf_hi(d.x), bf_lo(xv.y) + bf_lo(d.y), bf_hi(xv.y) + bf_hi(d.y)};
                x[2 * j + 1] = (f32x4){bf_lo(xv.z) + bf_lo(d.z), bf_hi(xv.z) + bf_hi(d.z), bf_lo(xv.w) + bf_lo(d.w), bf_hi(xv.w) + bf_hi(d.w)}; }
#pragma unroll
            for (int j = 0; j < 16; ++j) ss += (x[j].x * x[j].x + x[j].y * x[j].y) + (x[j].z * x[j].z + x[j].w * x[j].w);
            const float rstd = rsqrtf(wave_sum(ss, lane) * (1.0f / DM) + NORM_EPS);
#pragma unroll
            for (int j = 0; j < 8; ++j) { *(f32x4*)((xr + (lo4 + (j >> 1) * 4096u)) + (j & 1) * 2048) = x[2 * j] * rstd * gv[2 * j]; *(f32x4*)((xr + (lo4 + (j >> 1) * 4096u)) + (j & 1) * 2048 + 16) = x[2 * j + 1] * rstd * gv[2 * j + 1];
                if ((j & 1) == 1) asm volatile("" ::: "memory"); }
        }
    }
}

__device__ __forceinline__ void kv_prep(KAP A, int l, int gw, int NGW, int lane) {
    const bf16* PROJ = (const bf16*)(A->ws + WS_PROJ);
    const f32x2* rope = (const f32x2*)(A->ws + WS_ROPE);
    const int hl = lane & 15;
    const f32x4 kn0 = *(const f32x4*)(A->in[I_KN] + l * 128 + hl * 8), kn1 = *(const f32x4*)(A->in[I_KN] + l * 128 + hl * 8 + 4);
    for (int ci = gw; ci < NTOK / 4; ci += NGW) {
        const int m0 = ci * 4; const bool ctx = m0 < NCTX;
        v4u kr[4], vr[4];
#pragma unroll
        for (int r = 0; r < 4; ++r) { const bf16* pr = PROJ + (size_t)(m0 + r) * INW; kr[r] = *(const v4u*)(pr + OFF_K + 8 * lane); vr[r] = *(const v4u*)(pr + OFF_V + 8 * lane); }
#pragma unroll
        for (int r = 0; r < 4; ++r) { const int m = m0 + r;
            float k[8] = {bf_lo(kr[r].x), bf_hi(kr[r].x), bf_lo(kr[r].y), bf_hi(kr[r].y), bf_lo(kr[r].z), bf_hi(kr[r].z), bf_lo(kr[r].w), bf_hi(kr[r].w)};
            float ss = 0.f;
#pragma unroll
            for (int j = 0; j < 8; ++j) ss += k[j] * k[j];
            ss += shflx(ss, lane, 1); ss += shflx(ss, lane, 2); ss += shflx(ss, lane, 4); ss += shflx(ss, lane, 8);
            const float rstd = rsqrtf(ss * (1.0f / 128.0f) + NORM_EPS);
#pragma unroll
            for (int j = 0; j < 4; ++j) { k[j] *= rstd * kn0[j]; k[4 + j] *= rstd * kn1[j]; }
            if (ctx) {
                const int b = m >> 8, t = m & 255; const size_t oi = (((size_t)(b * 4 + l) * 256 + t) * 512 + 8 * lane);
                float* ok = A->out + OUT_NEWK + oi; *(f32x4*)ok = (f32x4){k[0], k[1], k[2], k[3]}; *(f32x4*)(ok + 4) = (f32x4){k[4], k[5], k[6], k[7]};
                float* ov = A->out + OUT_NEWV + oi; *(f32x4*)ov = (f32x4){bf_lo(vr[r].x), bf_hi(vr[r].x), bf_lo(vr[r].y), bf_hi(vr[r].y)}; *(f32x4*)(ov + 4) = (f32x4){bf_lo(vr[r].z), bf_hi(vr[r].z), bf_lo(vr[r].w), bf_hi(vr[r].w)};
            } else {
                const int t = (m - NCTX) & 4095, pos = hl < 8 ? (t >> 6) : (t & 63); const f32x2* rp = rope + pos * 32 + (lane & 3) * 8; const bool first = (lane & 4) == 0;
#pragma unroll
                for (int j = 0; j < 8; ++j) { const float other = shflx(k[j], lane, 4); const f32x2 cs = rp[j];
                    k[j] = first ? (k[j] * cs.x - other * cs.y) : (other * cs.y + k[j] * cs.x); }
            }
            v4u w; w.x = cvt_pk_bf16(k[0], k[1]); w.y = cvt_pk_bf16(k[2], k[3]); w.z = cvt_pk_bf16(k[4], k[5]); w.w = cvt_pk_bf16(k[6], k[7]);
            *(v4u*)((bf16*)(A->ws + WS_KC) + (size_t)m * 512 + 8 * lane) = w;
            *(v4u*)((bf16*)(A->ws + WS_VC) + (size_t)m * 512 + 8 * lane) = vr[r];
        }
    }
}

__device__ __forceinline__ void ssm_scan(KAP A, int l, int g, int mt, int tid, LAS unsigned char* lds) {
    bf16* A2 = (bf16*)(A->ws + WS_A2) + (size_t)g * 1024 * 512;
    const int blk = tid >> 5, sub = tid & 31, dir = sub >> 4, p0 = (sub & 15) * 4;
    f32x4 ar, ai;
    { const f32x4* a4 = (const f32x4*)((const float*)(A->ws + WS_A16) + (((size_t)(l * 2 + dir) * 64 + g) * 64 + p0) * 2); const f32x4 t0 = a4[0], t1 = a4[1];
      ar = (f32x4){t0.x, t0.z, t1.x, t1.z}; ai = (f32x4){t0.y, t0.w, t1.y, t1.w}; }
    const int ecol = 256 + dir * 128 + p0, scol = dir * 128 + p0;
    LAS f32x4* T = (LAS f32x4*)lds;
    LAS f32x4* EB = T + 16 * 32 * 2;
    const bool lat = mt >= 2;
    const int rb = mt * 256 + blk * 16;
    f32x4 sr[16], si[16];
#pragma unroll
    for (int i = 0; i < 16; ++i) { const int x = dir ? 15 - i : i, rl = blk * 16 + x;
        const v2u a = *(const LAS v2u*)(lds + rl * 512 + ((((scol >> 3) ^ x) << 4) + (scol & 7) * 2)), b = *(const LAS v2u*)(lds + rl * 512 + (((((scol + 64) >> 3) ^ x) << 4) + (scol & 7) * 2));
        sr[i] = (f32x4){bf_lo(a.x), bf_hi(a.x), bf_lo(a.y), bf_hi(a.y)}; si[i] = (f32x4){bf_lo(b.x), bf_hi(b.x), bf_lo(b.y), bf_hi(b.y)}; }
    __syncthreads();
    f32x4 er = {0.f, 0.f, 0.f, 0.f}, ei = er;
    if (lat) {
#pragma unroll
        for (int i = 0; i < 16; ++i) { const f32x4 nr = ar * er - ai * ei + sr[i], ni = ar * ei + ai * er + si[i]; er = nr; ei = ni; }
        T[(blk * 32 + sub) * 2] = er; T[(blk * 32 + sub) * 2 + 1] = ei;
        __syncthreads();
        if (tid < 32) { const int b = mt - 2; const size_t si0 = (((size_t)b * 4 + l) * 64 + g) * 64 + p0;
            f32x4 cr = *(const f32x4*)(A->in[dir ? I_SBR : I_SFR] + si0), ci = *(const f32x4*)(A->in[dir ? I_SBI : I_SFI] + si0);
            f32x4 qr = ar, qi = ai;
#pragma unroll
            for (int k = 0; k < 4; ++k) { const f32x4 t = qr * qr - qi * qi; qi = 2.f * qr * qi; qr = t; }
#pragma unroll 1
            for (int jb = 0; jb < 16; ++jb) { const int bb = dir ? 15 - jb : jb; EB[(bb * 32 + sub) * 2] = cr; EB[(bb * 32 + sub) * 2 + 1] = ci;
                const f32x4 tr = T[(bb * 32 + sub) * 2], ti = T[(bb * 32 + sub) * 2 + 1];
                const f32x4 nr = qr * cr - qi * ci + tr, ni = qr * ci + qi * cr + ti; cr = nr; ci = ni; } }
        __syncthreads();
        er = EB[(blk * 32 + sub) * 2]; ei = EB[(blk * 32 + sub) * 2 + 1];
    }
#pragma unroll
    for (int i = 0; i < 16; ++i) { const int row = rb + (dir ? 15 - i : i);
        v2u wr, wi; wr.x = cvt_pk_bf16(er.x, er.y); wr.y = cvt_pk_bf16(er.z, er.w); wi.x = cvt_pk_bf16(ei.x, ei.y); wi.y = cvt_pk_bf16(ei.z, ei.w);
        *(v2u*)(A2 + (size_t)row * 512 + ecol) = wr; *(v2u*)(A2 + (size_t)row * 512 + ecol + 64) = wi;
        const f32x4 nr = ar * er - ai * ei + sr[i], ni = ar * ei + ai * er + si[i]; er = nr; ei = ni; }
    if (!lat) { const int b = mt * 16 + blk; const size_t oi = (((size_t)b * 4 + l) * 64 + g) * 64 + p0;
        *(f32x4*)(A->out + (dir ? OUT_BRE : OUT_FRE) + oi) = er; *(f32x4*)(A->out + (dir ? OUT_BIM : OUT_FIM) + oi) = ei; }
}
__device__ __forceinline__ void ssm_step1(KAP A, int l, int un, LAS unsigned char* lds, int wv) {
    const int g = un >> 2, mt = un & 3, lg = l * 64 + g;
    pg8::OneUnit S1; S1.u0.a = (const char*)(A->ws + WS_A2) + ((size_t)g * 1024 + mt * 256) * 512 * 2; S1.u0.b = (const char*)(A->ws + WS_PMAT) + (size_t)lg * 256 * 256 * 2;
    S1.u0.c = nullptr; S1.u0.ldc = 0; S1.u0.pm = mt; S1.u0.pn = g; S1.u0.z = 0; S1.u0.kt = 4;
    pg8::EpiLdsS E{lds}; pg8::gemm_phase<pg8::EpiLdsS, pg8::OneUnit>(lds, wv, 512, 256, S1, E);
}
__device__ __forceinline__ void ssm_step2(KAP A, int l, int un, LAS unsigned char* lds, int wv) {
    const int g = un >> 2, mt = un & 3; const int tid = tid_of(wv); ssm_scan(A, l, g, mt, tid, lds);
}
__device__ __forceinline__ void ssm_step3(KAP A, int l, int un, LAS unsigned char* lds, int wv) {
    const int g = un >> 2, mt = un & 3, lg = l * 64 + g;
    pg8::OneUnit S2; S2.u0.a = (const char*)(A->ws + WS_A2) + ((size_t)g * 1024 + mt * 256) * 512 * 2; S2.u0.b = (const char*)(A->ws + WS_KG) + (size_t)lg * 256 * 512 * 2;
    S2.u0.c = nullptr; S2.u0.ldc = 0; S2.u0.pm = mt; S2.u0.pn = g; S2.u0.z = mt * 256; S2.u0.kt = 8;
    pg8::EpiSsmY E{(bf16*)(A->ws + WS_YSSM)}; pg8::gemm_phase<pg8::EpiSsmY, pg8::OneUnit>(lds, wv, 512, 512, S2, E);
}

struct Fft1Order {
    int G, c; const char* D1; const char* proj; char* zl; char* zc;
    __device__ bool next(int i, pg8::Unit& u) const { const int L = i * G + c; if (L >= 256) return false;
        const int g = L & 3, tt = L >> 2;
        int kt4 = 4; asm volatile("" : "+s"(kt4)); u.kt = kt4;
        u.a = D1; u.b = proj + ((size_t)tt * 256 * INW + OFF_F + g * 256) * 2; u.pm = 0; u.pn = tt; u.z = g;
        if (tt < 32) { u.c = zc + ((size_t)((tt * 4 + g) * 128) * 256) * 2; u.ldc = 256; }
        else { const int b = (tt - 32) >> 4, t0 = ((tt - 32) & 15) * 256; u.c = zl + ((size_t)((b * 4 + g) * 128) * 4096 + t0) * 2; u.ldc = 4096; }
        return true; }
};
struct Fft2LOrder {
    int G, c; const char* D2; const char* z; char* P;
    __device__ bool next(int i, pg8::Unit& u) const { const int L = i * G + c; if (L >= 64) return false;
        const int nt = L & 3, part = (L >> 2) & 1, mt = L >> 3;
        u.kt = 64; u.a = D2 + ((size_t)mt * 256 * 8192 + part * 4096) * 2; u.b = z + (part * ZPART + (size_t)nt * 256 * 4096) * 2; u.pm = mt; u.pn = nt; u.z = part;
        u.c = P + (((size_t)NCTX + (nt >> 1) * 4096 + mt * 256) * PK + (nt & 1) * 512 + part * 128) * 2; u.ldc = PK; return true; }
};
struct Fft2COrder {
    int G, c; const char* D2; const char* z; char* P;
    __device__ bool next(int i, pg8::Unit& u) const { const int L = i * G + c; if (L >= 128) return false;
        const int nt = L & 1, part = (L >> 1) & 1, b = L >> 2;
        u.kt = 4; u.a = D2 + (size_t)part * 256 * 2; u.b = z + (part * ZPART + (size_t)((b * 4 + nt * 2) * 128) * 256) * 2; u.pm = 0; u.pn = nt; u.z = b;
        u.c = P + (((size_t)b * 256) * PK + nt * 512 + part * 128) * 2; u.ldc = PK; return true; }
};
template <int NS, int KS>
__device__ __forceinline__ f32x4 nyq_core(const bf16* arow, size_t lda16, const bf16* bcol, LAS unsigned char* lds, int tid) {
    const int wave = tid >> 6, lane = tid & 63, fq = lane >> 4;
    f32x4 acc[NS];
#pragma unroll
    for (int ns = 0; ns < NS; ++ns) acc[ns] = (f32x4){0.f, 0.f, 0.f, 0.f};
    const int tb = wave * KS * 32 + fq * 8;
#pragma unroll 4
    for (int s2 = 0; s2 < KS; ++s2) { const bf16x8 bv = *(const bf16x8*)(bcol + tb + s2 * 32);
#pragma unroll
        for (int ns = 0; ns < NS; ++ns) { const bf16x8 av = *(const bf16x8*)(arow + ns * lda16 + tb + s2 * 32); acc[ns] = __builtin_amdgcn_mfma_f32_16x16x32_bf16(bv, av, acc[ns], 0, 0, 0); } }
    LAS f32x4* red = (LAS f32x4*)lds;
    __syncthreads();
#pragma unroll
    for (int ns = 0; ns < NS; ++ns) red[(wave * NS + ns) * 64 + lane] = acc[ns];
    __syncthreads();
    f32x4 r = (f32x4){0.f, 0.f, 0.f, 0.f};
    if (tid < NS * 64) {
#pragma unroll
        for (int w = 0; w < 8; ++w) r += red[(w * NS + (tid >> 6)) * 64 + (tid & 63)]; }
    __syncthreads();
    return r;
}
__device__ __forceinline__ void nyq_pass(KAP A, int cA, LAS unsigned char* lds, int wv) {
    const int tid = tid_of(wv); const int fr = tid & 15;
    bf16* P = (bf16*)(A->ws + WS_P);
    {
        const bf16* arow = (const bf16*)(A->ws + WS_D2L) + (size_t)(cA * 32 + fr) * 8192;
        const bf16* bcol = (const bf16*)(A->ws + WS_ZL) + ZPART + (size_t)((fr & 7) * 128) * 4096;
        const f32x4 r = nyq_core<2, 16>(arow, (size_t)16 * 8192, bcol, lds, tid) * (1.0f / 1024.0f);
        const int fq = (tid & 63) >> 4;
        if (tid < 128 && fq < 2) { const int k = cA * 32 + (tid >> 6) * 16 + fr; *(v2u*)(P + ((size_t)NCTX + fq * 4096 + k) * PK + 1024) = (v2u){cvt_pk_bf16(r[0], r[1]), cvt_pk_bf16(r[2], r[3])}; } }
    {
        const int cg = cA & 7, rs = cA >> 3;
        const bf16* arow = (const bf16*)(A->ws + WS_D2C) + (size_t)(rs * 16 + fr) * 512;
        const bf16* bcol = (const bf16*)(A->ws + WS_ZC) + ZPART + (size_t)(((cg * 4 + (fr >> 2)) * 4 + (fr & 3)) * 128) * 256;
        const f32x4 r = nyq_core<1, 1>(arow, 0, bcol, lds, tid) * (1.0f / 256.0f);
        const int fq = (tid & 63) >> 4;
        if (tid < 64) { const int k = rs * 16 + fr, b = cg * 4 + fq; *(v2u*)(P + ((size_t)b * 256 + k) * PK + 1024) = (v2u){cvt_pk_bf16(r[0], r[1]), cvt_pk_bf16(r[2], r[3])}; } }
}
__device__ __forceinline__ void fft_row2048(KAP A, int c2, int n2, int wv) {
    const int tid = tid_of(wv); const int lane = tid & 63, wave = __builtin_amdgcn_readfirstlane(tid >> 6);
    bf16* P = (bf16*)(A->ws + WS_P);
    for (int n = c2 * NWAVES + wave; n < 1024; n += n2 * NWAVES) {
        const v4u* zr = (const v4u*)((const bf16*)(A->ws + WS_ZL) + (size_t)n * 4096); float s = 0.f;
#pragma unroll
        for (int j = 0; j < 8; ++j) { const v4u w = zr[j * 64 + lane];
            s += (bf_lo(w.x) - bf_hi(w.x)) + (bf_lo(w.y) - bf_hi(w.y)) + (bf_lo(w.z) - bf_hi(w.z)) + (bf_lo(w.w) - bf_hi(w.w)); }
        s = wave_sum(s, lane) * (1.0f / 1024.0f);
        if (lane == 0) { const int bg = n >> 7, m = n & 127; bf16* row = P + ((size_t)NCTX + (bg >> 2) * 4096 + 2048) * PK + (bg & 3) * 256 + m;
            row[0] = (bf16)(cvt_pk_bf16(s, 0.f) & 0xffffu); row[128] = (bf16)0; }
    }
}

__global__ void __launch_bounds__(NWAVES * 64, 2) hymba_fwd(Args args) {
    extern __shared__ __attribute__((aligned(16))) unsigned char lds_raw[];
    LAS unsigned char* lds = (LAS unsigned char*)lds_raw;
    volatile LAS unsigned* MISC = (volatile LAS unsigned*)(lds + MISC_OFF);
    const int G = gridDim.x, bx = blockIdx.x;
    const int wv = __builtin_amdgcn_readfirstlane(threadIdx.x >> 6);
#define TID_HERE() const int tid = tid_of(wv); const int lane = tid & 63, wave = __builtin_amdgcn_readfirstlane(tid >> 6), gw = bq * NWAVES + wave, NGWq = Gq * NWAVES; (void)lane; (void)gw; (void)NGWq
#define PH_IDS() int Gq = G, bq = bx; asm volatile("" : "+s"(Gq), "+s"(bq))
    for (int u = tid_of(wv); u < (LDS_BYTES - MISC_OFF) / 4; u += NWAVES * 64) ((LAS unsigned*)(lds + MISC_OFF))[u] = 0u;
    __syncthreads();
    int lo, hi; XcdBarrier bar;
    { KA_HERE(); PH_IDS(); lo = ka->ph_lo; hi = ka->ph_hi; unsigned* ctl = (unsigned*)(ka->ws + WS_CTL);
      bar.bar = ctl + CW_BAR; bar.x = 0; bar.st = nullptr;
      if (hi - lo > 1) bar = xcd_barrier_post(ctl + CW_BAR, MISC + 8, tid_of(wv)); }
#define IN(k) (lo <= (k) && (k) < hi)
#define SEAM(k) do { if (IN(k) && IN((k) + 1)) { xcd_barrier(bar, wv); if (((DUP_MASK) >> 12) & 1) xcd_barrier(bar, wv); } } while (0)

    if (IN(0)) DUP(0) { KA_HERE(); PH_IDS(); p0_prologue(ka, lds, Gq, bq, wv); }
    SEAM(0);

#define SSM_UNIT(uq) (((((uq) & 7) * 8 + ((uq) >> 5)) << 2) | (((uq) >> 3) & 3))
    for (int l = 0; l < DEPTH; ++l) for (int lrep_ = 0; lrep_ < 1 + (((DUP_MASK) >> 19) & 1); ++lrep_) {
        const int pb = 1 + 6 * l;
        if (IN(pb)) DUP(1) { KA_HERE(); PH_IDS(); TID_HERE(); pa_norm(ka, l, bq, Gq, tid, lds);
        }
        SEAM(pb);
        if (IN(pb + 1)) DUP(2) {
            KA_HERE(); PH_IDS(); unsigned char* ws = ka->ws;
            pg8::GemmOrder S; S.init(NTOK, INW, Gq, bq, ws + WS_H, DM, ws + WS_WIN + (size_t)l * INW * DM * 2, DM, DM);
            pg8::EpiProj E{(bf16*)(ws + WS_PROJ), (bf16*)(ws + WS_A2)};
            pg8::gemm_phase<pg8::EpiProj, pg8::GemmOrder, GEMM1_ALIGN>(lds, wv, DM, DM, S, E);
        }
        SEAM(pb + 1);
        if (IN(pb + 2)) {
            DUP(16) for (int uq = bx; uq < 256; uq += G) { const int un = SSM_UNIT(uq); { KA_HERE(); ssm_step1(ka, l, un, lds, wv); } __syncthreads(); { KA_HERE(); ssm_step2(ka, l, un, lds, wv); } __syncthreads(); }
            DUP(14) { KA_HERE(); PH_IDS(); TID_HERE(); kv_prep(ka, l, gw, NGWq, lane); }
            DUP(3) { KA_HERE(); PH_IDS(); unsigned char* ws = ka->ws;
              Fft1Order S{Gq, bq, (const char*)(ws + WS_D1), (const char*)(ws + WS_PROJ), (char*)(ws + WS_ZL), (char*)(ws + WS_ZC)};
              pg8::EpiBf16X E{1.0f, (int)ZPART, 128}; pg8::gemm_phase<pg8::EpiBf16X, Fft1Order>(lds, wv, 256, INW, S, E); }
            wg_global_sync();
            DUP(18) for (int uq = bx; uq < 256; uq += G) { const int un = SSM_UNIT(uq); KA_HERE(); ssm_step3(ka, l, un, lds, wv); }
        }
        SEAM(pb + 2);
        if (IN(pb + 3)) {
            if (bx < (G >> 1)) {
                __syncthreads();
                const int n1 = G >> 2;
                if (bx < n1) {
                  DUP(7) { KA_HERE(); unsigned char* ws = ka->ws; int nAq = n1, cAq = bx; asm volatile("" : "+s"(nAq), "+s"(cAq));
                    Fft2LOrder S{nAq, cAq, (const char*)(ws + WS_D2L), (const char*)(ws + WS_ZL), (char*)(ws + WS_P)};
                    pg8::EpiFft2Sym E{1.0f / 1024.0f}; pg8::gemm_phase<pg8::EpiFft2Sym, Fft2LOrder>(lds, wv, 8192, 4096, S, E); }
                } else {
                  DUP(8) { KA_HERE(); unsigned char* ws = ka->ws; int nAq = (G >> 1) - n1, cAq = bx - n1; asm volatile("" : "+s"(nAq), "+s"(cAq));
                    Fft2COrder S{nAq, cAq, (const char*)(ws + WS_D2C), (const char*)(ws + WS_ZC), (char*)(ws + WS_P)};
                    pg8::EpiBf16X E{1.0f / 256.0f, 128 * PK, 256}; pg8::gemm_phase<pg8::EpiBf16X, Fft2COrder>(lds, wv, 512, 256, S, E); }
                  DUP(8) { KA_HERE(); for (int it = bx - n1; it < 128; it += (G >> 1) - n1) nyq_pass(ka, it, lds, wv); fft_row2048(ka, bx - n1, (G >> 1) - n1, wv); }
                }
                __syncthreads();
            }
            DUP(5) for (int U = bx; U < 512; U += G) {
                KA_HERE(); PH_IDS(); unsigned char* ws = ka->ws; bf16* const PROJ = (bf16*)(ws + WS_PROJ); bf16* const MIX = (bf16*)(ws + WS_MIX);
                const float* qn = ka->in[I_QN] + l * 128; const f32x2* rope = (const f32x2*)(ws + WS_ROPE);
                const int pr = U & 7, idx = U >> 3, b = pr >> 2, kvh = pr & 3, hq = kvh * 4 + (idx >> 4), qb = idx & 15;
                const size_t row0 = (size_t)NCTX + b * 4096 + qb * 256;
                const bf16* ck = (const bf16*)(ws + WS_CK) + ((size_t)(b * 4 + l) * 512) * 512 + kvh * 128;
                const bf16* cv = (const bf16*)(ws + WS_CV) + ((size_t)(b * 4 + l) * 512) * 512 + kvh * 128;
                const bf16* k1 = (const bf16*)(ws + WS_KC) + ((size_t)NCTX + b * 4096) * 512 + kvh * 128; const bf16* v1 = (const bf16*)(ws + WS_VC) + ((size_t)NCTX + b * 4096) * 512 + kvh * 128;
                att::attn_unit(PROJ + row0 * INW + hq * 128, PROJ + row0 * INW + OFF_GA + hq * 128, MIX + row0 * DM + hq * 128,
                               ck, cv, 512, 8, k1, v1, 512, 64, qn, rope, qb * 256, (char*)lds_raw, wv);
            }
            {
                const int nH = G >> 1, hb = bx >= nH ? 1 : 0, cH = bx - hb * nH, Uend = hb ? 512 : 256;
                DUP(6) for (int U = hb * 256 + cH; U < Uend; U += (hb ? G - nH : nH)) {
                    KA_HERE(); unsigned char* ws = ka->ws; bf16* const PROJ = (bf16*)(ws + WS_PROJ); bf16* const MIX = (bf16*)(ws + WS_MIX);
                    const float* qn = ka->in[I_QN] + l * 128;
                    const int xx = U & 7, idx = U >> 3, b = xx * 4 + (idx >> 4), hq = idx & 15, kvh = hq >> 2;
                    const size_t row0 = (size_t)b * 256;
                    const bf16* k1 = (const bf16*)(ws + WS_KC) + row0 * 512 + kvh * 128; const bf16* v1 = (const bf16*)(ws + WS_VC) + row0 * 512 + kvh * 128;
                    att::attn_unit(PROJ + row0 * INW + hq * 128, PROJ + row0 * INW + OFF_GA + hq * 128, MIX + row0 * DM + hq * 128,
                                   k1, v1, 512, 0, k1, v1, 512, 4, qn, nullptr, 0, (char*)lds_raw, wv);
                }
            }
            if (bx >= (G >> 2)) {
                const int hb = bx >= (G >> 1) ? 1 : 0; int first = hb ? bx - (G >> 1) : 384 + bx - (G >> 2), stride = hb ? G - (G >> 1) : (G >> 1) - (G >> 2), end = hb ? 384 : 512;
                __syncthreads();
                DUP(9) { KA_HERE(); unsigned char* ws = ka->ws; asm volatile("" : "+s"(first), "+s"(stride), "+s"(end));
                  pg8::UnitRange<pg8::GemmOrder> S; S.g.init(NTOK, 2048, 1, 0, ws + WS_YSSM, 1024, ws + WS_WGLU + (size_t)l * 2048 * 1024 * 2, 1024, 1024); S.first = first; S.stride = stride; S.end = end;
                  pg8::EpiGlu E{(const bf16*)(ws + WS_PROJ), (bf16*)(ws + WS_MIX)}; pg8::gemm_phase<pg8::EpiGlu, pg8::UnitRange<pg8::GemmOrder>>(lds, wv, 1024, 1024, S, E); }
            }
        }
        SEAM(pb + 3);
        if (IN(pb + 4)) {
            DUP(10) { KA_HERE(); PH_IDS(); unsigned char* ws = ka->ws;
              pg8::GemmOrder S; S.init(NTOK, 1024, Gq, bq, ws + WS_P, PK, ws + WS_WFP + (size_t)l * 1024 * PK * 2, PK, PK);
              pg8::EpiFftW E{(const bf16*)(ws + WS_PROJ), (bf16*)(ws + WS_MIX)}; pg8::gemm_phase<pg8::EpiFftW, pg8::GemmOrder>(lds, wv, PK, PK, S, E); }
        }
        SEAM(pb + 4);
        if (IN(pb + 5)) DUP(11) {
            KA_HERE(); PH_IDS(); unsigned char* ws = ka->ws;
            pg8::GemmOrder S; S.init(NTOK, DM, Gq, bq, ws + WS_MIX, DM, ws + WS_WOUT + (size_t)l * DM * DM * 2, DM, DM);
            pg8::EpiOut E{(bf16*)(ws + ((l & 1) ? WS_DELTA2 : WS_DELTA)), (const float*)(ws + WS_MOD) + (size_t)l * 3 * 12288};
            if (((DUP_MASK) >> 13) & 1) {
                { pg8::SliceOrder<pg8::GemmOrder> S2{S, 0, 2}; pg8::gemm_phase<pg8::EpiOut, pg8::SliceOrder<pg8::GemmOrder>, GEMM1_ALIGN>(lds, wv, DM, DM, S2, E); }
                xcd_barrier(bar, wv);
                { pg8::SliceOrder<pg8::GemmOrder> S2{S, 2, 1000}; pg8::gemm_phase<pg8::EpiOut, pg8::SliceOrder<pg8::GemmOrder>, GEMM1_ALIGN>(lds, wv, DM, DM, S2, E); }
            } else
            pg8::gemm_phase<pg8::EpiOut, pg8::GemmOrder, GEMM1_ALIGN>(lds, wv, DM, DM, S, E);
        }
        SEAM(pb + 5);
    }
    if (IN(25)) DUP(15) { KA_HERE(); PH_IDS(); TID_HERE(); final_norm(ka, gw, NGWq, lane); }
#undef IN
#undef SEAM
}

extern "C" void kernel_launch(void* const* d_in, const int* in_sizes, int n_in, void* d_out, int out_size, void* d_ws, size_t ws_size, hipStream_t stream) {
    static int grid = 0;
    if (grid == 0) {
        if (n_in != 28 || ws_size < WS_END || out_size != 102760448) { fprintf(stderr, "kernel_launch: unexpected shapes (n_in %d, out %d, ws %zu)\n", n_in, out_size, ws_size); grid = -1; return; }
        int dev = 0, cus = 0, per_cu = 0;
        if (hipGetDevice(&dev) != hipSuccess || hipDeviceGetAttribute(&cus, hipDeviceAttributeMultiprocessorCount, dev) != hipSuccess) { grid = -1; return; }
        if (hipFuncSetAttribute((const void*)hymba_fwd, hipFuncAttributeMaxDynamicSharedMemorySize, LDS_BYTES) != hipSuccess) { fprintf(stderr, "kernel_launch: hipFuncSetAttribute failed\n"); grid = -1; return; }
        if (hipOccupancyMaxActiveBlocksPerMultiprocessor(&per_cu, (const void*)hymba_fwd, NWAVES * 64, LDS_BYTES) != hipSuccess || per_cu < 1)
            fprintf(stderr, "kernel_launch: occupancy query reports %d workgroups per CU\n", per_cu);
        (void)hipGetLastError();
        grid = cus;
    }
    if (grid < 0) return;
    (void)hipMemsetAsync((char*)d_ws + WS_CTL, 0, CTL_ZERO_BYTES, stream);
    Args a{};
    for (int i = 0; i < 28; ++i) a.in[i] = (const float*)d_in[i];
    a.out = (float*)d_out; a.ws = (unsigned char*)d_ws;
#if MK_ONE_LAUNCH == 2
    a.ph_lo = 0; a.ph_hi = 1;
    hipLaunchKernelGGL(hymba_fwd, dim3(grid), dim3(NWAVES * 64), LDS_BYTES, stream, a);
    a.ph_lo = 0; a.ph_hi = 26;
    hipLaunchKernelGGL(hymba_fwd, dim3(grid), dim3(NWAVES * 64), LDS_BYTES, stream, a);
#elif MK_ONE_LAUNCH
    a.ph_lo = 0; a.ph_hi = 26;
    hipLaunchKernelGGL(hymba_fwd, dim3(grid), dim3(NWAVES * 64), LDS_BYTES, stream, a);
#else
    for (int ph = 0; ph < 26; ++ph) { a.ph_lo = ph; a.ph_hi = ph + 1; hipLaunchKernelGGL(hymba_fwd, dim3(grid), dim3(NWAVES * 64), LDS_BYTES, stream, a); }
#endif
    const hipError_t le = hipPeekAtLastError();
    if (le != hipSuccess) fprintf(stderr, "kernel_launch: launch failed: %s\n", hipGetErrorName(le));
}
```

```cpp
#include <hip/hip_runtime.h>
#include <cstdio>
#include <cstdint>

#ifndef MK_ONE_LAUNCH
#define MK_ONE_LAUNCH 1
#endif

#ifndef GEMM1_ALIGN
#define GEMM1_ALIGN true
#endif
#ifndef DUP_MASK
#define DUP_MASK 0
#endif
#define DUP(k) for (int rep_ = 0; rep_ < (((DUP_MASK) >> (k)) & 1) + 1; ++rep_)
#define LAS __attribute__((address_space(3)))
#define GAS __attribute__((address_space(1)))
typedef unsigned short bf16;
typedef unsigned v4u __attribute__((ext_vector_type(4)));
typedef unsigned v2u __attribute__((ext_vector_type(2)));
typedef float f32x4 __attribute__((ext_vector_type(4)));
typedef float f32x2 __attribute__((ext_vector_type(2)));
typedef short bf16x8 __attribute__((ext_vector_type(8)));
typedef short s16x4 __attribute__((ext_vector_type(4)));
typedef float f32x16 __attribute__((ext_vector_type(16)));

constexpr int DM = 4096, NTOK = 16384, NCTX = 8192, DEPTH = 4, INW = 9216;
constexpr int OFF_K = 2048, OFF_V = 2560, OFF_GA = 3072, OFF_U = 5120, OFF_GS = 6144, OFF_F = 7168, OFF_GF = 8192;
constexpr float NORM_EPS = 1e-6f;
constexpr size_t OUT_NEWK = 67108864, OUT_NEWV = 83886080, OUT_FRE = 100663296, OUT_FIM = 101187584, OUT_BRE = 101711872, OUT_BIM = 102236160;

constexpr size_t MiB = 1u << 20;
constexpr size_t WS_CTL = 0, CTL_ZERO_BYTES = 1 * MiB;
constexpr size_t WS_MOD = 1 * MiB;
constexpr size_t WS_ROPE = 2 * MiB;
constexpr size_t WS_A16 = 3 * MiB;
constexpr size_t WS_D1 = 4 * MiB;
constexpr size_t WS_D2C = 5 * MiB;
constexpr size_t WS_CK = 6 * MiB;
constexpr size_t WS_CV = 10 * MiB;
constexpr size_t WS_PMAT = 14 * MiB;
constexpr size_t WS_KG = 46 * MiB;
constexpr size_t WS_D2L = 110 * MiB;
constexpr size_t WS_WGLU = 174 * MiB;
constexpr size_t WS_WOUT = 198 * MiB;
constexpr size_t WS_WIN = 326 * MiB;
constexpr size_t WS_H = 614 * MiB;
constexpr size_t WS_PROJ = 742 * MiB;
constexpr size_t WS_MIX = 1030 * MiB;
constexpr size_t WS_A2 = 1158 * MiB;
constexpr size_t WS_SBUF = 1222 * MiB;
constexpr size_t WS_YSSM = 1286 * MiB;
constexpr size_t WS_ZL = 1318 * MiB;
constexpr size_t WS_ZC = 1334 * MiB;
constexpr size_t WS_P = 1350 * MiB;
constexpr size_t WS_WFP = 1386 * MiB;
constexpr int PK = 1152; constexpr size_t ZPART = (size_t)1 << 22;
constexpr size_t WS_DELTA = 1414 * MiB;
constexpr size_t WS_XBF = 1542 * MiB;
constexpr size_t WS_XBF2 = 1702 * MiB;
constexpr size_t WS_KC = 1670 * MiB;
constexpr size_t WS_VC = 1686 * MiB;
constexpr size_t WS_DELTA2 = 1830 * MiB;
constexpr size_t WS_END = 1958 * MiB;
constexpr int CW_BAR = 4096;

constexpr int LDS_BYTES = 147456;
constexpr int MISC_OFF = 143360;
constexpr int NWAVES = 8;

#define LDS_WAIT() asm volatile("s_waitcnt lgkmcnt(0)" ::: "memory")
#define VM_WAIT() asm volatile("s_waitcnt vmcnt(0)" ::: "memory")
#define RLX_AGENT __ATOMIC_RELAXED, __HIP_MEMORY_SCOPE_AGENT

__device__ __forceinline__ int tid_of(int wv) { int t = wv * 64 + (int)__builtin_amdgcn_mbcnt_hi(~0u, __builtin_amdgcn_mbcnt_lo(~0u, 0u)); asm volatile("" : "+v"(t)); return t; }
__device__ __forceinline__ unsigned cvt_pk_bf16(float lo, float hi) { unsigned r; asm volatile("v_cvt_pk_bf16_f32 %0, %1, %2" : "=v"(r) : "v"(lo), "v"(hi)); return r; }
__device__ __forceinline__ float bf_lo(unsigned w) { return __uint_as_float(w << 16); }
__device__ __forceinline__ float bf_hi(unsigned w) { return __uint_as_float(w & 0xffff0000u); }
__device__ __forceinline__ float silu_f(float x) { return x * __builtin_amdgcn_rcpf(1.0f + __expf(-x)); }
__device__ __forceinline__ float sigmoid_f(float x) { return __builtin_amdgcn_rcpf(1.0f + __expf(-x)); }
__device__ __forceinline__ float shflx(float v, int lane, int o) { return __int_as_float(__builtin_amdgcn_ds_bpermute((lane ^ o) << 2, __float_as_int(v))); }
__device__ __forceinline__ float wave_sum(float v, int lane) {
#pragma unroll
    for (int o = 1; o < 64; o <<= 1) v += shflx(v, lane, o);
    return v;
}

namespace pg8 {
constexpr int BM = 256, BK = 64, HALF = 128, HTB = HALF * BK * 2, STAGE_BYTES = 8 * HTB, NXCD = 8, WGM = 8;
__host__ __device__ __forceinline__ int lds_byte(int r, int c) { const int st = (r >> 4) * 2 + (c >> 5), rr = r & 15, cc = c & 31, ob = rr * 64 + cc * 2; return st * 1024 + (ob ^ (((ob >> 9) & 1) << 5)); }
__host__ __device__ __forceinline__ void stage_rc(int b, int& R, int& C) { const int st = b / 1024, sb = b % 1024, swz = sb ^ (((sb >> 9) & 1) << 5); R = (st >> 1) * 16 + swz / 64; C = (st & 1) * 32 + (swz % 64) / 2; }
__host__ __device__ __forceinline__ int perm32(int rho) { const int n = rho >> 4, i = rho & 15; return 8 * (i >> 2) + 4 * n + (i & 3); }

struct Unit { const char* a; const char* b; char* c; int ldc; int pm, pn, z, kt; };

struct GemmOrder {
    int nM, nN, nwg, G, c, kt; const char* A; const char* B; size_t atile, btile;
    __device__ void init(int M, int N, int G_, int c_, const void* A_, int lda, const void* B_, int ldb, int K) { kt = K / BK; nM = M / BM; nN = N / BM; nwg = nM * nN; G = G_; c = c_; A = (const char*)A_; B = (const char*)B_; atile = (size_t)BM * lda * 2; btile = (size_t)BM * ldb * 2; }
    __device__ bool next(int i, Unit& u) const {
        const long L = (long)i * G + c; if (L >= nwg) return false;
        int wgid = (int)L; const int xcd = wgid % NXCD; { const int q = nwg / NXCD, r = nwg % NXCD, off = wgid / NXCD; wgid = (xcd < r ? xcd * (q + 1) : r * (q + 1) + (xcd - r) * q) + off; }
        const int nig = WGM * nN, gid = wgid / nig, fm = gid * WGM, gsz = (nM - fm) < WGM ? (nM - fm) : WGM;
        u.pm = fm + ((wgid % nig) % gsz); u.pn = (wgid % nig) / gsz; u.z = 0; u.c = nullptr; u.ldc = 0; u.kt = kt;
        u.a = A + (size_t)u.pm * atile; u.b = B + (size_t)u.pn * btile; return true;
    }
};
template <class O> struct SliceOrder { O g; int i0, cnt; __device__ bool next(int i, Unit& u) const { if (i >= cnt) return false; return g.next(i0 + i, u); } };
template <class O> struct UnitRange { O g; int first, stride, end; __device__ bool next(int i, Unit& u) const { const int L = first + i * stride; if (L >= end) return false; return g.next(L, u); } };
struct OneUnit { Unit u0; __device__ bool next(int i, Unit& u) const { if (i != 0) return false; u = u0; return true; } };

template <class Epi, class Sched, bool ALIGN_EPI = true>
__device__ __forceinline__ void gemm_phase(LAS unsigned char* lds, const int wv, const int lda, const int ldb, const Sched& S, const Epi& E) {
    const int tid = tid_of(wv);
    const int wid = __builtin_amdgcn_readfirstlane(tid >> 6), lane = tid & 63, wr = wid >> 2, wc = wid & 3, fr = lane & 15, fq = lane >> 4;
    unsigned voffA[2], voffB[2];
#pragma unroll
    for (int i = 0; i < 2; ++i) { int R, C; stage_rc(tid * 16 + i * 8192, R, C); const int Rb = Epi::PERM ? ((R & ~31) + perm32(R & 31)) : R;
        voffA[i] = (unsigned)(R * lda + C) * 2u; voffB[i] = (unsigned)(Rb * ldb + C) * 2u; }
    (void)fr; (void)fq;
    const size_t kstep = (size_t)(BK * 2);
    const unsigned hstepA = (unsigned)HALF * lda * 2u, hstepB = (unsigned)HALF * ldb * 2u;
    const unsigned ldsw = (unsigned)wid * 1024u;
    const int aoff = lds_byte(wr * 64 + fr, fq * 8), boff = lds_byte(wc * 32 + fr, fq * 8);
#define PG8_SA(b, h) (((b) * 2 + (h)) * HTB)
#define PG8_SB(b, h) ((4 + (b) * 2 + (h)) * HTB)
#define PG8_STAGE(bufoff, gbase, voff) do { _Pragma("unroll") for (int _i = 0; _i < 2; ++_i) \
        __builtin_amdgcn_global_load_lds((const unsigned*)((const char*)(gbase) + (voff)[_i]), (LAS unsigned*)(lds + (bufoff) + ldsw + _i * 8192), 16, 0, 0); } while (0)
#define PG8_LDA(dst, b, h) do { _Pragma("unroll") for (int m = 0; m < 4; ++m) _Pragma("unroll") for (int k = 0; k < 2; ++k) dst[m][k] = *(const LAS bf16x8*)(lds + PG8_SA(b, h) + aoff + m * 2048 + k * 1024); } while (0)
#define PG8_LDB(dst, b, h) do { _Pragma("unroll") for (int n = 0; n < 2; ++n) _Pragma("unroll") for (int k = 0; k < 2; ++k) dst[n][k] = *(const LAS bf16x8*)(lds + PG8_SB(b, h) + boff + n * 2048 + k * 1024); } while (0)
#define PG8_MMA(ai, bj, At, Bt) do { __builtin_amdgcn_s_setprio(1); _Pragma("unroll") for (int m = 0; m < 4; ++m) _Pragma("unroll") for (int n = 0; n < 2; ++n) _Pragma("unroll") for (int k = 0; k < 2; ++k) \
        acc[ai][bj][m][n] = __builtin_amdgcn_mfma_f32_16x16x32_bf16(Bt[n][k], At[m][k], acc[ai][bj][m][n], 0, 0, 0); __builtin_amdgcn_s_setprio(0); } while (0)
#define PG8_WAIT_V(n) asm volatile("s_waitcnt vmcnt(" #n ")" ::: "memory")
#define PG8_WAIT_L(n) asm volatile("s_waitcnt lgkmcnt(" #n ")" ::: "memory")
#define PG8_BAR __builtin_amdgcn_s_barrier()
#define PG8_SCHED __builtin_amdgcn_sched_barrier(0)
    int ui = 0, nt;
    const char* cA; const char* cB;
    { Unit u0; if (!S.next(0, u0)) return; cA = u0.a; cB = u0.b; nt = u0.kt; }
    f32x4 acc[2][2][4][2];
#pragma unroll
    for (int a = 0; a < 2; ++a)
#pragma unroll
        for (int b = 0; b < 2; ++b)
#pragma unroll
            for (int m = 0; m < 4; ++m)
#pragma unroll
                for (int n = 0; n < 2; ++n) acc[a][b][m][n] = (f32x4){0.f, 0.f, 0.f, 0.f};
    bf16x8 At[4][2], B0[2][2], B1[2][2];
    PG8_STAGE(PG8_SB(0, 0), cB, voffB); PG8_STAGE(PG8_SB(0, 1), cB + hstepB, voffB); PG8_STAGE(PG8_SA(0, 0), cA, voffA); PG8_STAGE(PG8_SA(0, 1), cA + hstepA, voffA);
    if (wr == 1) PG8_BAR;
    PG8_WAIT_V(2); PG8_BAR;
    PG8_STAGE(PG8_SB(1, 0), cB + kstep, voffB); PG8_STAGE(PG8_SA(1, 0), cA + kstep, voffA); PG8_STAGE(PG8_SB(1, 1), cB + hstepB + kstep, voffB);
    PG8_WAIT_V(6); PG8_BAR;
    for (;;) {
        bool has_next; const char* nA; const char* nB; int nnt;
        { Unit nx; has_next = S.next(ui + 1, nx); nA = has_next ? nx.a : cA; nB = has_next ? nx.b : cB; nnt = has_next ? nx.kt : nt; }
        for (int t = 0; t < nt; t += 2) {
            const bool last = (t == nt - 2);
            const char* a1 = cA + (size_t)(t + 1) * kstep;
            const char* a2 = last ? nA : cA + (size_t)(t + 2) * kstep; const char* b2 = last ? nB : cB + (size_t)(t + 2) * kstep;
            const char* a3 = a2 + kstep; const char* b3 = b2 + kstep;
            PG8_LDB(B0, 0, 0); PG8_LDB(B1, 0, 1); PG8_SCHED; PG8_LDA(At, 0, 0); PG8_STAGE(PG8_SA(1, 1), a1 + hstepA, voffA);
            PG8_WAIT_V(8); PG8_WAIT_L(0); PG8_BAR; PG8_MMA(0, 0, At, B0); PG8_MMA(0, 1, At, B1); PG8_BAR; PG8_SCHED;
            PG8_LDA(At, 0, 1); PG8_STAGE(PG8_SB(0, 0), b2, voffB); PG8_STAGE(PG8_SB(0, 1), b2 + hstepB, voffB); PG8_STAGE(PG8_SA(0, 0), a2, voffA);
            PG8_WAIT_V(8); PG8_WAIT_L(0); PG8_BAR; PG8_MMA(1, 0, At, B0); PG8_MMA(1, 1, At, B1); PG8_BAR; PG8_SCHED;
            PG8_LDB(B0, 1, 0); PG8_LDB(B1, 1, 1); PG8_SCHED; PG8_LDA(At, 1, 0); PG8_STAGE(PG8_SA(0, 1), a2 + hstepA, voffA);
            PG8_WAIT_V(8); PG8_WAIT_L(0); PG8_BAR; PG8_MMA(0, 0, At, B0); PG8_MMA(0, 1, At, B1); PG8_BAR; PG8_SCHED;
            PG8_LDA(At, 1, 1); PG8_STAGE(PG8_SB(1, 0), b3, voffB); PG8_STAGE(PG8_SB(1, 1), b3 + hstepB, voffB); PG8_STAGE(PG8_SA(1, 0), a3, voffA);
            PG8_WAIT_V(8); PG8_WAIT_L(0); PG8_BAR; PG8_MMA(1, 0, At, B0); PG8_MMA(1, 1, At, B1); PG8_BAR; PG8_SCHED;
        }
        if constexpr (ALIGN_EPI) { if (wr == 0) PG8_BAR; }
        { Unit cu; (void)S.next(ui, cu); const int t2 = tid_of(wv);
          const int w2 = __builtin_amdgcn_readfirstlane(t2 >> 6); E(acc, cu, w2 >> 2, w2 & 3, t2 & 15, (t2 & 63) >> 4); }
        if (!has_next) break;
#pragma unroll
        for (int a = 0; a < 2; ++a)
#pragma unroll
            for (int b = 0; b < 2; ++b)
#pragma unroll
                for (int m = 0; m < 4; ++m)
#pragma unroll
                    for (int n = 0; n < 2; ++n) acc[a][b][m][n] = (f32x4){0.f, 0.f, 0.f, 0.f};
        cA = nA; cB = nB; nt = nnt; ++ui;
        if constexpr (ALIGN_EPI) { if (wr == 1) PG8_BAR; }
    }
    PG8_WAIT_V(0);
    if constexpr (!ALIGN_EPI) { if (wr == 0) PG8_BAR; }
    PG8_BAR;
#undef PG8_SA
#undef PG8_SB
#undef PG8_STAGE
#undef PG8_LDA
#undef PG8_LDB
#undef PG8_MMA
#undef PG8_WAIT_V
#undef PG8_WAIT_L
#undef PG8_BAR
#undef PG8_SCHED
}

struct EpiProj {
    static constexpr bool PERM = true;
    bf16* proj; bf16* a2;
    __device__ __forceinline__ void operator()(const f32x4 (&acc)[2][2][4][2], const Unit& u, int wr, int wc, int fr, int fq) const {
        const int pn = u.pn; const bool gate = (pn >= 12 && pn < 20) || (pn >= 24 && pn < 28) || (pn >= 32); const bool isu = (pn >= 20 && pn < 24);
        const int row0 = u.pm * BM + wr * 64 + fr, col0 = pn * BM + wc * 32 + 8 * fq;
#pragma unroll
        for (int ai = 0; ai < 2; ++ai)
#pragma unroll
            for (int m = 0; m < 4; ++m) { const int row = row0 + ai * HALF + m * 16;
#pragma unroll
                for (int bj = 0; bj < 2; ++bj) { f32x4 v0 = acc[ai][bj][m][0], v1 = acc[ai][bj][m][1];
                    if (gate) {
#pragma unroll
                        for (int j = 0; j < 4; ++j) { v0[j] = silu_f(v0[j]); v1[j] = silu_f(v1[j]); } }
                    v4u w; w.x = cvt_pk_bf16(v0[0], v0[1]); w.y = cvt_pk_bf16(v0[2], v0[3]); w.z = cvt_pk_bf16(v1[0], v1[1]); w.w = cvt_pk_bf16(v1[2], v1[3]);
                    const int col = col0 + bj * HALF;
                    bf16* dst;
                    if (isu) { const int g = (col - OFF_U) >> 4, c0 = col & 15; dst = a2 + ((size_t)(g * 1024 + (row >> 4)) * 512 + (row & 15) * 16 + c0); }
                    else dst = proj + (size_t)row * INW + col;
                    *(v4u*)dst = w; } }
    }
};
struct EpiBf16 {
    static constexpr bool PERM = true;
    float scale;
    __device__ __forceinline__ void operator()(const f32x4 (&acc)[2][2][4][2], const Unit& u, int wr, int wc, int fr, int fq) const {
        bf16* base = (bf16*)u.c; const int ldc = u.ldc; const int row0 = wr * 64 + fr, col0 = wc * 32 + 8 * fq;
#pragma unroll
        for (int ai = 0; ai < 2; ++ai)
#pragma unroll
            for (int m = 0; m < 4; ++m) { bf16* rowp = base + (size_t)(row0 + ai * HALF + m * 16) * ldc + col0;
#pragma unroll
                for (int bj = 0; bj < 2; ++bj) { const f32x4 v0 = acc[ai][bj][m][0] * scale, v1 = acc[ai][bj][m][1] * scale;
                    v4u w; w.x = cvt_pk_bf16(v0[0], v0[1]); w.y = cvt_pk_bf16(v0[2], v0[3]); w.z = cvt_pk_bf16(v1[0], v1[1]); w.w = cvt_pk_bf16(v1[2], v1[3]);
                    *(v4u*)(rowp + bj * HALF) = w; } }
    }
};
struct EpiBf16X {
    static constexpr bool PERM = true;
    float scale; int aoff, boff;
    __device__ __forceinline__ void operator()(const f32x4 (&acc)[2][2][4][2], const Unit& u, int wr, int wc, int fr, int fq) const {
        bf16* base = (bf16*)u.c; const int ldc = u.ldc; const int row0 = wr * 64 + fr, col0 = wc * 32 + 8 * fq;
#pragma unroll
        for (int ai = 0; ai < 2; ++ai)
#pragma unroll
            for (int m = 0; m < 4; ++m) { bf16* rowp = base + (ai * aoff + (row0 + m * 16) * ldc + col0);
#pragma unroll
                for (int bj = 0; bj < 2; ++bj) { const f32x4 v0 = acc[ai][bj][m][0] * scale, v1 = acc[ai][bj][m][1] * scale;
                    v4u w; w.x = cvt_pk_bf16(v0[0], v0[1]); w.y = cvt_pk_bf16(v0[2], v0[3]); w.z = cvt_pk_bf16(v1[0], v1[1]); w.w = cvt_pk_bf16(v1[2], v1[3]);
                    *(v4u*)(rowp + bj * boff) = w; } }
    }
};
struct EpiFft2Sym {
    static constexpr bool PERM = true;
    float scale;
    __device__ __forceinline__ void operator()(const f32x4 (&acc)[2][2][4][2], const Unit& u, int wr, int wc, int fr, int fq) const {
        bf16* base = (bf16*)u.c; const int ldc = u.ldc, mt = u.pm; const unsigned flip = u.z ? 0x80008000u : 0u; const int row0 = wr * 64 + fr, col0 = wc * 32 + 8 * fq;
#pragma unroll
        for (int ai = 0; ai < 2; ++ai)
#pragma unroll
            for (int m = 0; m < 4; ++m) { const int r = row0 + ai * HALF + m * 16; bf16* rowp = base + (r * ldc + col0); bf16* rowm = base + ((4096 - 512 * mt - r) * ldc + col0); const bool mir = (mt | r) != 0;
#pragma unroll
                for (int bj = 0; bj < 2; ++bj) { const f32x4 v0 = acc[ai][bj][m][0] * scale, v1 = acc[ai][bj][m][1] * scale;
                    v4u w; w.x = cvt_pk_bf16(v0[0], v0[1]); w.y = cvt_pk_bf16(v0[2], v0[3]); w.z = cvt_pk_bf16(v1[0], v1[1]); w.w = cvt_pk_bf16(v1[2], v1[3]);
                    *(v4u*)(rowp + bj * 256) = w;
                    if (mir) { w.x ^= flip; w.y ^= flip; w.z ^= flip; w.w ^= flip; *(v4u*)(rowm + bj * 256) = w; } } }
    }
};
struct EpiF32 {
    static constexpr bool PERM = false;
    __device__ __forceinline__ void operator()(const f32x4 (&acc)[2][2][4][2], const Unit& u, int wr, int wc, int fr, int fq) const {
        float* base = (float*)u.c; const int ldc = u.ldc; const int row0 = wr * 64 + fr, col0 = wc * 32 + 4 * fq;
#pragma unroll
        for (int ai = 0; ai < 2; ++ai)
#pragma unroll
            for (int m = 0; m < 4; ++m) { float* rowp = base + (size_t)(row0 + ai * HALF + m * 16) * ldc + col0;
#pragma unroll
                for (int bj = 0; bj < 2; ++bj)
#pragma unroll
                    for (int n = 0; n < 2; ++n) *(f32x4*)(rowp + bj * HALF + n * 16) = acc[ai][bj][m][n]; }
    }
};
struct EpiLdsS {
    static constexpr bool PERM = true;
    LAS unsigned char* lds;
    __device__ __forceinline__ void operator()(const f32x4 (&acc)[2][2][4][2], const Unit& u, int wr, int wc, int fr, int fq) const {
        asm volatile("s_waitcnt vmcnt(0)" ::: "memory"); __builtin_amdgcn_s_barrier();
        const int row0 = wr * 64 + fr, ch0 = wc * 4 + fq; (void)u;
#pragma unroll
        for (int ai = 0; ai < 2; ++ai)
#pragma unroll
            for (int m = 0; m < 4; ++m) { const int r = row0 + ai * HALF + m * 16;
#pragma unroll
                for (int bj = 0; bj < 2; ++bj) { const f32x4 v0 = acc[ai][bj][m][0], v1 = acc[ai][bj][m][1];
                    v4u w; w.x = cvt_pk_bf16(v0[0], v0[1]); w.y = cvt_pk_bf16(v0[2], v0[3]); w.z = cvt_pk_bf16(v1[0], v1[1]); w.w = cvt_pk_bf16(v1[2], v1[3]);
                    *(LAS v4u*)(lds + r * 512 + (((ch0 + bj * 16) ^ fr) << 4)) = w; } }
    }
};
struct EpiSsmY {
    static constexpr bool PERM = true;
    bf16* yssm;
    __device__ __forceinline__ void operator()(const f32x4 (&acc)[2][2][4][2], const Unit& u, int wr, int wc, int fr, int fq) const {
        const int row0 = u.z + wr * 64 + fr, col0 = wc * 32 + 8 * fq, g = u.pn;
#pragma unroll
        for (int ai = 0; ai < 2; ++ai)
#pragma unroll
            for (int m = 0; m < 4; ++m) { const int chunk = row0 + ai * HALF + m * 16;
#pragma unroll
                for (int bj = 0; bj < 2; ++bj) { const f32x4 v0 = acc[ai][bj][m][0], v1 = acc[ai][bj][m][1];
                    v4u w; w.x = cvt_pk_bf16(v0[0], v0[1]); w.y = cvt_pk_bf16(v0[2], v0[3]); w.z = cvt_pk_bf16(v1[0], v1[1]); w.w = cvt_pk_bf16(v1[2], v1[3]);
                    const int col = col0 + bj * HALF, i = col >> 4, c0 = col & 15;
                    *(v4u*)(yssm + (size_t)(chunk * 16 + i) * 1024 + g * 16 + c0) = w; } }
    }
};
struct EpiGlu {
    static constexpr bool PERM = true;
    const bf16* proj; bf16* mix;
    __device__ __forceinline__ void operator()(const f32x4 (&acc)[2][2][4][2], const Unit& u, int wr, int wc, int fr, int fq) const {
        const int row0 = u.pm * BM + wr * 64 + fr, col0 = u.pn * HALF + wc * 32 + 8 * fq;
#pragma unroll
        for (int ai = 0; ai < 2; ++ai)
#pragma unroll
            for (int m = 0; m < 4; ++m) { const int row = row0 + ai * HALF + m * 16;
                const v4u gs = *(const v4u*)(proj + (size_t)row * INW + OFF_GS + col0);
                const f32x4 a0 = acc[ai][0][m][0], a1 = acc[ai][0][m][1], g0 = acc[ai][1][m][0], g1 = acc[ai][1][m][1];
                float o[8];
#pragma unroll
                for (int j = 0; j < 4; ++j) { o[j] = a0[j] * sigmoid_f(g0[j]); o[4 + j] = a1[j] * sigmoid_f(g1[j]); }
                o[0] *= bf_lo(gs.x); o[1] *= bf_hi(gs.x); o[2] *= bf_lo(gs.y); o[3] *= bf_hi(gs.y); o[4] *= bf_lo(gs.z); o[5] *= bf_hi(gs.z); o[6] *= bf_lo(gs.w); o[7] *= bf_hi(gs.w);
                v4u w; w.x = cvt_pk_bf16(o[0], o[1]); w.y = cvt_pk_bf16(o[2], o[3]); w.z = cvt_pk_bf16(o[4], o[5]); w.w = cvt_pk_bf16(o[6], o[7]);
                *(v4u*)(mix + (size_t)row * DM + 2048 + col0) = w; }
    }
};
struct EpiFftW {
    static constexpr bool PERM = true;
    const bf16* proj; bf16* mix;
    __device__ __forceinline__ void operator()(const f32x4 (&acc)[2][2][4][2], const Unit& u, int wr, int wc, int fr, int fq) const {
        const int row0 = u.pm * BM + wr * 64 + fr, col0 = u.pn * BM + wc * 32 + 8 * fq;
#pragma unroll
        for (int ai = 0; ai < 2; ++ai)
#pragma unroll
            for (int m = 0; m < 4; ++m) { const int row = row0 + ai * HALF + m * 16;
#pragma unroll
                for (int bj = 0; bj < 2; ++bj) { const int col = col0 + bj * HALF;
                    const v4u gs = *(const v4u*)(proj + (size_t)row * INW + OFF_GF + col);
                    const f32x4 v0 = acc[ai][bj][m][0], v1 = acc[ai][bj][m][1];
                    v4u w; w.x = cvt_pk_bf16(v0[0] * bf_lo(gs.x), v0[1] * bf_hi(gs.x)); w.y = cvt_pk_bf16(v0[2] * bf_lo(gs.y), v0[3] * bf_hi(gs.y));
                    w.z = cvt_pk_bf16(v1[0] * bf_lo(gs.z), v1[1] * bf_hi(gs.z)); w.w = cvt_pk_bf16(v1[2] * bf_lo(gs.w), v1[3] * bf_hi(gs.w));
                    *(v4u*)(mix + (size_t)row * DM + 3072 + col) = w; } }
    }
};
struct EpiOut {
    static constexpr bool PERM = true;
    bf16* delta; const float* modl;
    __device__ __forceinline__ void operator()(const f32x4 (&acc)[2][2][4][2], const Unit& u, int wr, int wc, int fr, int fq) const {
        const int rt = u.pm * BM; const int v = rt < NCTX ? 0 : (rt < NCTX + 4096 ? 1 : 2);
        const float* gv = modl + v * 12288 + 8192;
        const int row0 = rt + wr * 64 + fr, col0 = u.pn * BM + wc * 32 + 8 * fq;
        f32x4 gt[2][2];
#pragma unroll
        for (int bj = 0; bj < 2; ++bj)
#pragma unroll
            for (int n = 0; n < 2; ++n) gt[bj][n] = *(const f32x4*)(gv + col0 + bj * HALF + n * 4);
#pragma unroll
        for (int ai = 0; ai < 2; ++ai)
#pragma unroll
            for (int m = 0; m < 4; ++m) { bf16* rowp = delta + (size_t)(row0 + ai * HALF + m * 16) * DM + col0;
#pragma unroll
                for (int bj = 0; bj < 2; ++bj) { const f32x4 v0 = acc[ai][bj][m][0] * gt[bj][0], v1 = acc[ai][bj][m][1] * gt[bj][1];
                    v4u w; w.x = cvt_pk_bf16(v0[0], v0[1]); w.y = cvt_pk_bf16(v0[2], v0[3]); w.z = cvt_pk_bf16(v1[0], v1[1]); w.w = cvt_pk_bf16(v1[2], v1[3]);
                    *(v4u*)(rowp + bj * HALF) = w; } }
    }
};
}

namespace att {
constexpr int D = 128, QBLK = 32, KVBLK = 64;
constexpr float SCALE = 0.088388347648318440f;
constexpr float THR = 8.f;
constexpr int SHM_V = KVBLK * D * 2, SHM_K = KVBLK * D * 2;
constexpr int WS_OFF = 2 * SHM_V + 2 * SHM_K, OSTG_OFF = WS_OFF + NWAVES * 64 * 4, OSTG_ROW = 272, OSTG_WAVE = 32 * OSTG_ROW;
static_assert(DEPTH >= 2, "the bf16 stream is first written by layer 1's norm phase");
static_assert(OSTG_OFF + NWAVES * OSTG_WAVE <= MISC_OFF, "attention LDS");
#define KSWZ(row, colB) ((row) * 256 + ((colB) ^ (((row) & 7) << 4)))
#define SBAR() __builtin_amdgcn_sched_barrier(0)
__device__ __forceinline__ int crow(int r, int hi) { return (r & 3) + 8 * (r >> 2) + 4 * hi; }
__device__ __forceinline__ void partialSM(f32x16& p0, f32x16& p1, float& m_reg, float& mn, float& alpha) {
  constexpr float C = SCALE * 1.4426950408889634f;
  float pmax = p0[0]; for (int r = 1; r < 16; ++r) pmax = fmaxf(pmax, p0[r]); for (int r = 0; r < 16; ++r) pmax = fmaxf(pmax, p1[r]);
  { auto rr = __builtin_amdgcn_permlane32_swap(__float_as_uint(pmax), __float_as_uint(pmax), false, false);
    pmax = fmaxf(__uint_as_float(rr[0]), __uint_as_float(rr[1])); }
  if (__builtin_expect(__all(pmax - m_reg <= THR / SCALE), 1)) { mn = m_reg; alpha = 1.f; }
  else { mn = fmaxf(m_reg, pmax); alpha = __builtin_amdgcn_exp2f((m_reg - mn) * C); m_reg = mn; }
  float mnC = -mn * C;
  for (int r = 0; r < 16; ++r) p0[r] = fmaf(p0[r], C, mnC); for (int r = 0; r < 16; ++r) p1[r] = fmaf(p1[r], C, mnC);
  for (int r = 0; r < 16; ++r) p0[r] = __builtin_amdgcn_exp2f(p0[r]);
}
__device__ __forceinline__ void finishSM(f32x16& p0, f32x16& p1, float alpha, float& l_reg, bf16x8& pa0, bf16x8& pa1, bf16x8& pa2, bf16x8& pa3) {
  for (int r = 0; r < 16; ++r) p1[r] = __builtin_amdgcn_exp2f(p1[r]);
  float ps = 0; for (int r = 0; r < 16; ++r) ps += p0[r]; for (int r = 0; r < 16; ++r) ps += p1[r];
  { auto rr = __builtin_amdgcn_permlane32_swap(__float_as_uint(ps), __float_as_uint(ps), false, false);
    ps = __uint_as_float(rr[0]) + __uint_as_float(rr[1]); }
  l_reg = l_reg * alpha + ps;
#define PK4(P, BASE, OUT) do { unsigned a0 = cvt_pk_bf16(P[BASE + 0], P[BASE + 1]), a1 = cvt_pk_bf16(P[BASE + 2], P[BASE + 3]);   \
    unsigned b0 = cvt_pk_bf16(P[BASE + 4], P[BASE + 5]), b1 = cvt_pk_bf16(P[BASE + 6], P[BASE + 7]);                              \
    auto r0 = __builtin_amdgcn_permlane32_swap(a0, b0, false, false); auto r1 = __builtin_amdgcn_permlane32_swap(a1, b1, false, false); \
    v4u w = {r0[0], r1[0], r0[1], r1[1]}; OUT = *reinterpret_cast<bf16x8*>(&w); } while (0)
  PK4(p0, 0, pa0); PK4(p0, 8, pa1); PK4(p1, 0, pa2); PK4(p1, 8, pa3);
#undef PK4
}
__device__ __forceinline__ void qkt(f32x16& p0, f32x16& p1, const char* Ks, const bf16x8* qr, int r32, int hi) {
  p0 = f32x16{}; p1 = f32x16{};
  for (int d0 = 0; d0 < 8; ++d0) { int cb = (d0 * 16 + hi * 8) * 2;
    bf16x8 b0 = *reinterpret_cast<const bf16x8*>(Ks + KSWZ(r32, cb));
    bf16x8 b1 = *reinterpret_cast<const bf16x8*>(Ks + KSWZ(32 + r32, cb));
    p0 = __builtin_amdgcn_mfma_f32_32x32x16_bf16(b0, qr[d0], p0, 0, 0, 0);
    p1 = __builtin_amdgcn_mfma_f32_32x32x16_bf16(b1, qr[d0], p1, 0, 0, 0); }
}
__device__ __forceinline__ int v_st(int k, int c) { const int kk = (k & ~0xC) | ((k & 4) << 1) | ((k & 8) >> 1); return ((kk >> 3) * 4 + (c >> 5)) * 512 + ((kk & 7) * 32 + (c & 31)) * 2; }
__device__ __forceinline__ int v_rd_base(int lane) { return ((lane & 3) << 3) | (((lane >> 2) & 3) << 6) | (((lane >> 4) & 1) << 5) | (((lane >> 5) & 1) << 8); }
constexpr int v_rd_off(int d0, int ks, int half) { return d0 * 512 + ks * 4096 + half * 2048; }
template <int OFF> __device__ __forceinline__ s16x4 tr_read(int vb) {
  s16x4 r; asm volatile("ds_read_b64_tr_b16 %0, %1 offset:%2" : "=&v"(r) : "v"(vb), "i"(OFF) : "memory"); return r;
}
template <int D0> __device__ __forceinline__ void pv_one(f32x16& od, int vb, bf16x8 pa0, bf16x8 pa1, bf16x8 pa2, bf16x8 pa3) {
  const s16x4 l0 = tr_read<v_rd_off(D0, 0, 0)>(vb), h0 = tr_read<v_rd_off(D0, 0, 1)>(vb), l1 = tr_read<v_rd_off(D0, 1, 0)>(vb), h1 = tr_read<v_rd_off(D0, 1, 1)>(vb);
  const s16x4 l2 = tr_read<v_rd_off(D0, 2, 0)>(vb), h2 = tr_read<v_rd_off(D0, 2, 1)>(vb), l3 = tr_read<v_rd_off(D0, 3, 0)>(vb), h3 = tr_read<v_rd_off(D0, 3, 1)>(vb);
  asm volatile("s_waitcnt lgkmcnt(0)" ::: "memory"); SBAR();
#define PK(L, H) (bf16x8){L[0], L[1], L[2], L[3], H[0], H[1], H[2], H[3]}
  od = __builtin_amdgcn_mfma_f32_32x32x16_bf16(pa0, PK(l0, h0), od, 0, 0, 0);
  od = __builtin_amdgcn_mfma_f32_32x32x16_bf16(pa1, PK(l1, h1), od, 0, 0, 0);
  od = __builtin_amdgcn_mfma_f32_32x32x16_bf16(pa2, PK(l2, h2), od, 0, 0, 0);
  od = __builtin_amdgcn_mfma_f32_32x32x16_bf16(pa3, PK(l3, h3), od, 0, 0, 0);
#undef PK
}
__device__ __forceinline__ void pv_d0(f32x16* o, int vb, bf16x8 pa0, bf16x8 pa1, bf16x8 pa2, bf16x8 pa3) {
  pv_one<0>(o[0], vb, pa0, pa1, pa2, pa3); pv_one<1>(o[1], vb, pa0, pa1, pa2, pa3); pv_one<2>(o[2], vb, pa0, pa1, pa2, pa3); pv_one<3>(o[3], vb, pa0, pa1, pa2, pa3);
}

__device__ __forceinline__ void attn_unit(const bf16* __restrict__ Qb, const bf16* __restrict__ Gb, bf16* __restrict__ Ob,
                                          const bf16* __restrict__ K0, const bf16* __restrict__ V0, int ld0, int nt0,
                                          const bf16* __restrict__ K1, const bf16* __restrict__ V1, int ld1, int nt1,
                                          const float* __restrict__ qn, const f32x2* __restrict__ rope, int tok0, char* lds, int wv) {
  const int tid = tid_of(wv);
  const int wid = tid >> 6, lane = tid & 63, r32 = lane & 31, hi = lane >> 5;
  char* V_lds = lds; char* K_lds = lds + 2 * SHM_V;
  float* ws = (float*)(lds + WS_OFF) + wid * 64; float* li_l = ws; float* al_l = ws + 32;
  float m_reg = -1e30f, l_reg = 0; f32x16 o[4] = {}; bf16x8 qr[8];
  const int sr = tid >> 4, sc = (tid & 15) * 8, vst0 = v_st(sr, sc), vst1 = v_st(32 + sr, sc);
  const int vb0 = (int)(uintptr_t)V_lds + v_rd_base(lane);
  struct { bf16x8 vs0, vs1, ks0, ks1; } sr_[2];
#define SLOAD(i, jt) do { const bf16* kb_; const bf16* vb_; long ld_; \
    if ((jt) < nt0) { kb_ = K0 + (long)(jt) * KVBLK * ld0; vb_ = V0 + (long)(jt) * KVBLK * ld0; ld_ = ld0; } else { kb_ = K1 + (long)((jt) - nt0) * KVBLK * ld1; vb_ = V1 + (long)((jt) - nt0) * KVBLK * ld1; ld_ = ld1; } \
    sr_[i].vs0 = *reinterpret_cast<const bf16x8*>(vb_ + (long)sr * ld_ + sc); sr_[i].vs1 = *reinterpret_cast<const bf16x8*>(vb_ + (long)(32 + sr) * ld_ + sc); \
    sr_[i].ks0 = *reinterpret_cast<const bf16x8*>(kb_ + (long)sr * ld_ + sc); sr_[i].ks1 = *reinterpret_cast<const bf16x8*>(kb_ + (long)(32 + sr) * ld_ + sc); } while (0)
  SLOAD(0, 0);
  __syncthreads();
  {
    const bf16* Qw = Qb + (long)(wid * QBLK + r32) * INW + hi * 8;
    float x[8][8]; float ss = 0.f;
#pragma unroll
    for (int d0 = 0; d0 < 8; ++d0) { const v4u raw = *reinterpret_cast<const v4u*>(Qw + d0 * 16);
      x[d0][0] = bf_lo(raw.x); x[d0][1] = bf_hi(raw.x); x[d0][2] = bf_lo(raw.y); x[d0][3] = bf_hi(raw.y); x[d0][4] = bf_lo(raw.z); x[d0][5] = bf_hi(raw.z); x[d0][6] = bf_lo(raw.w); x[d0][7] = bf_hi(raw.w);
#pragma unroll
      for (int j = 0; j < 8; ++j) ss += x[d0][j] * x[d0][j]; }
    { auto rr = __builtin_amdgcn_permlane32_swap(__float_as_uint(ss), __float_as_uint(ss), false, false); ss = __uint_as_float(rr[0]) + __uint_as_float(rr[1]); }
    const float rstd = rsqrtf(ss * (1.0f / 128.0f) + NORM_EPS);
#pragma unroll
    for (int d0 = 0; d0 < 8; ++d0) { const f32x4 w0 = *reinterpret_cast<const f32x4*>(qn + d0 * 16 + hi * 8), w1 = *reinterpret_cast<const f32x4*>(qn + d0 * 16 + hi * 8 + 4);
#pragma unroll
      for (int j = 0; j < 4; ++j) { x[d0][j] *= rstd * w0[j]; x[d0][4 + j] *= rstd * w1[j]; } }
    if (rope) {
      const int t = tok0 + wid * QBLK + r32, prow = t >> 6, pcol = t & 63;
#pragma unroll
      for (int half = 0; half < 2; ++half) { const f32x2* rp = rope + (half ? pcol : prow) * 32;
#pragma unroll
        for (int dd = 0; dd < 2; ++dd) { const int d0 = half * 4 + dd;
#pragma unroll
          for (int j = 0; j < 8; ++j) { const f32x2 cs = rp[dd * 16 + hi * 8 + j]; const float x1 = x[d0][j], x2 = x[d0 + 2][j];
            x[d0][j] = x1 * cs.x - x2 * cs.y; x[d0 + 2][j] = x1 * cs.y + x2 * cs.x; } } }
    }
#pragma unroll
    for (int d0 = 0; d0 < 8; ++d0) { v4u w = {cvt_pk_bf16(x[d0][0], x[d0][1]), cvt_pk_bf16(x[d0][2], x[d0][3]), cvt_pk_bf16(x[d0][4], x[d0][5]), cvt_pk_bf16(x[d0][6], x[d0][7])}; qr[d0] = *reinterpret_cast<bf16x8*>(&w); }
  }
#define SWRITE(b, i) do { *(bf16x8*)(V_lds + (b) * SHM_V + vst0) = sr_[i].vs0;          \
    *(bf16x8*)(V_lds + (b) * SHM_V + vst1) = sr_[i].vs1; int kc = sc * 2;               \
    *(bf16x8*)(K_lds + (b) * SHM_K + KSWZ(sr, kc)) = sr_[i].ks0;                       \
    *(bf16x8*)(K_lds + (b) * SHM_K + KSWZ(32 + sr, kc)) = sr_[i].ks1; } while (0)
#define SWAIT() asm volatile("s_waitcnt vmcnt(4)" ::: "memory")
#define RESC(a) do { if (__any((a) < 1.f)) { if (hi == 0) al_l[r32] = (a); asm volatile("s_waitcnt lgkmcnt(0)" ::: "memory"); \
    for (int d = 0; d < 4; ++d) for (int r = 0; r < 16; ++r) o[d][r] *= al_l[crow(r, hi)]; } } while (0)
  f32x16 pA0, pA1, pB0, pB1; float mnA, mnB, alA, alB; bf16x8 pa0, pa1, pa2, pa3; const int NT = nt0 + nt1;
  constexpr int SE = 0, SO = 1;
  asm volatile("s_waitcnt vmcnt(0)" ::: "memory"); SWRITE(0, SE); __syncthreads();
  qkt(pA0, pA1, K_lds, qr, r32, hi); partialSM(pA0, pA1, m_reg, mnA, alA);
  SLOAD(SO, 1); if (2 < NT) SLOAD(SE, 2);
  SWAIT(); SWRITE(1, SO); __syncthreads();
  for (int j = 1; j + 1 < NT; j += 2) {
    SBAR(); qkt(pB0, pB1, K_lds + SHM_K, qr, r32, hi);
    finishSM(pA0, pA1, alA, l_reg, pa0, pa1, pa2, pa3); SBAR();
    SLOAD(SO, j + 2); SBAR();
    pv_d0(o, vb0, pa0, pa1, pa2, pa3); partialSM(pB0, pB1, m_reg, mnB, alB);
    __syncthreads(); SWAIT(); SWRITE(0, SE);
    RESC(alB); __syncthreads();
    SBAR(); qkt(pA0, pA1, K_lds, qr, r32, hi);
    finishSM(pB0, pB1, alB, l_reg, pa0, pa1, pa2, pa3); SBAR();
    if (j + 3 < NT) SLOAD(SE, j + 3); SBAR();
    pv_d0(o, vb0 + SHM_V, pa0, pa1, pa2, pa3); partialSM(pA0, pA1, m_reg, mnA, alA);
    __syncthreads(); SWAIT(); SWRITE(1, SO);
    RESC(alA); __syncthreads();
  }
  SBAR(); qkt(pB0, pB1, K_lds + SHM_K, qr, r32, hi);
  finishSM(pA0, pA1, alA, l_reg, pa0, pa1, pa2, pa3); SBAR();
  pv_d0(o, vb0, pa0, pa1, pa2, pa3); partialSM(pB0, pB1, m_reg, mnB, alB);
  __syncthreads(); RESC(alB);
  finishSM(pB0, pB1, alB, l_reg, pa0, pa1, pa2, pa3); SBAR();
  pv_d0(o, vb0 + SHM_V, pa0, pa1, pa2, pa3);
  if (hi == 0) li_l[r32] = l_reg; asm volatile("s_waitcnt lgkmcnt(0)" ::: "memory");
  char* stg = lds + OSTG_OFF + wid * OSTG_WAVE;
  v4u gvv[8];
#pragma unroll
  for (int it = 0; it < 8; ++it) gvv[it] = *reinterpret_cast<const v4u*>(Gb + (long)(wid * QBLK + it * 4 + (lane >> 4)) * INW + (lane & 15) * 8);
#pragma unroll
  for (int r = 0; r < 16; ++r) { const int orow = crow(r, hi); const float rl = __builtin_amdgcn_rcpf(li_l[orow]);
#pragma unroll
    for (int d0 = 0; d0 < 4; ++d0) { const unsigned w = cvt_pk_bf16(o[d0][r] * rl, 0.f); *(bf16*)(stg + orow * OSTG_ROW + (d0 * 32 + r32) * 2) = (bf16)(w & 0xffffu); }
    if ((r & 3) == 3) asm volatile("" ::: "memory"); }
  asm volatile("s_waitcnt lgkmcnt(0)" ::: "memory");
#pragma unroll
  for (int it = 0; it < 8; ++it) { const int row = it * 4 + (lane >> 4), cc = (lane & 15) * 8;
    const v4u ov = *(const v4u*)(stg + row * OSTG_ROW + cc * 2);
    const v4u gv = gvv[it];
    v4u w; w.x = cvt_pk_bf16(bf_lo(ov.x) * bf_lo(gv.x), bf_hi(ov.x) * bf_hi(gv.x)); w.y = cvt_pk_bf16(bf_lo(ov.y) * bf_lo(gv.y), bf_hi(ov.y) * bf_hi(gv.y));
    w.z = cvt_pk_bf16(bf_lo(ov.z) * bf_lo(gv.z), bf_hi(ov.z) * bf_hi(gv.z)); w.w = cvt_pk_bf16(bf_lo(ov.w) * bf_lo(gv.w), bf_hi(ov.w) * bf_hi(gv.w));
    *reinterpret_cast<v4u*>(Ob + (long)(wid * QBLK + row) * DM + cc) = w; }
#undef SLOAD
#undef SWRITE
#undef SWAIT
#undef RESC
}
}

#define XB_TMO      128
#define XB_XCNT(j)  (256  + 64 * (j))
#define XB_XSUB(j)  (1280 + 64 * (j))
#define XB_XGEN(j)  (2304 + 64 * (j))
#define XB_TOP      3328
#define XB_TOPGEN   3392
#define XCD_BAR_WORDS 3456
#define XB_SPIN_CAP (1u << 18)
__device__ __forceinline__ unsigned xb_ld(unsigned* p)              { return __hip_atomic_load(p, __ATOMIC_RELAXED, __HIP_MEMORY_SCOPE_AGENT); }
__device__ __forceinline__ unsigned xb_add(unsigned* p, unsigned v) { return __hip_atomic_fetch_add(p, v, __ATOMIC_RELAXED, __HIP_MEMORY_SCOPE_AGENT); }
__device__ __forceinline__ unsigned xb_xcc_id() { return (unsigned)__builtin_amdgcn_s_getreg((3 << 11) | 20) & 0xFu; }
#define XB_SPIN(cond, bar) do { unsigned _sp = 0; while (cond) { __builtin_amdgcn_s_sleep(1); \
    if ((++_sp & 255u) == 0u) { if (xb_ld(&(bar)[XB_TMO])) break; if (_sp > XB_SPIN_CAP) { atomicAdd(&(bar)[XB_TMO], 1u); break; } } } } while (0)
struct XcdBarrier { unsigned* bar; unsigned x; volatile LAS unsigned* st; };
__device__ __forceinline__ XcdBarrier xcd_barrier_post(unsigned* bar, volatile LAS unsigned* st, int tid) {
    XcdBarrier b; b.bar = bar; b.x = xb_xcc_id(); b.st = st;
    if (tid == 0) (void)xb_add(&bar[XB_XCNT(b.x)], 1u);
    return b;
}
__device__ __forceinline__ void xcd_barrier_complete(unsigned* bar, unsigned x, unsigned& nloc, unsigned& nx) {
    const unsigned G = gridDim.x * gridDim.y * gridDim.z;
    unsigned sum, cnt, mine, sp = 0u;
    for (;;) {
        sum = 0u; cnt = 0u; mine = 0u;
#pragma nounroll
        for (unsigned j = 0; j < 16; ++j) { const unsigned c = xb_ld(&bar[XB_XCNT(j)]); sum += c; cnt += (c > 0u) ? 1u : 0u; mine = (j == x) ? c : mine; }
        if (sum == G) break;
        __builtin_amdgcn_s_sleep(1);
        if ((++sp & 255u) == 0u) { if (xb_ld(&bar[XB_TMO])) break; if (sp > XB_SPIN_CAP) { atomicAdd(&bar[XB_TMO], 1u); break; } }
    }
    nloc = mine > 0u ? mine : 1u; nx = cnt > 0u ? cnt : 1u;
}
__device__ __forceinline__ void xcd_barrier(const XcdBarrier& b, int wv) {
    asm volatile("s_waitcnt vmcnt(0)" ::: "memory");
    __syncthreads();
    if (tid_of(wv) == 0) {
        unsigned* bar = b.bar;
        __builtin_amdgcn_s_waitcnt(0);
        unsigned nloc = b.st[0], nx = b.st[1];
        if (nloc == 0u) { xcd_barrier_complete(bar, b.x, nloc, nx); b.st[0] = nloc; b.st[1] = nx; }
        const unsigned old = xb_add(&bar[XB_XSUB(b.x)], 1u);
        const unsigned gen = old / nloc;
        if (old + 1u == (gen + 1u) * nloc) {
            __builtin_amdgcn_fence(__ATOMIC_RELEASE, "agent");
            asm volatile("s_waitcnt vmcnt(0)" ::: "memory");
            const unsigned og = xb_add(&bar[XB_TOP], 1u);
            const unsigned tg = og / nx;
            if (og + 1u == (tg + 1u) * nx) xb_add(&bar[XB_TOPGEN], 1u);
            else XB_SPIN(xb_ld(&bar[XB_TOPGEN]) == tg, bar);
            __builtin_amdgcn_fence(__ATOMIC_ACQUIRE, "agent");
            xb_add(&bar[XB_XGEN(b.x)], 1u);
            asm volatile("s_waitcnt vmcnt(0)" ::: "memory");
        } else {
            XB_SPIN(xb_ld(&bar[XB_XGEN(b.x)]) == gen, bar);
            __builtin_amdgcn_fence(__ATOMIC_ACQUIRE, "agent");
            asm volatile("s_waitcnt vmcnt(0)" ::: "memory");
        }
    }
    __syncthreads();
}
__device__ __forceinline__ void wg_global_sync() {
    asm volatile("s_waitcnt vmcnt(0)" ::: "memory");
    __syncthreads();
    __builtin_amdgcn_fence(__ATOMIC_ACQUIRE, "agent");
    asm volatile("s_waitcnt vmcnt(0)" ::: "memory");
}

struct Args { const float* in[28]; float* out; unsigned char* ws; int ph_lo, ph_hi; };
typedef const __attribute__((address_space(4))) Args* KAP;
#define KA_HERE() KAP ka = (KAP)__builtin_amdgcn_kernarg_segment_ptr(); asm volatile("" : "+s"(ka))
enum { I_XP = 0, I_XS, I_CK, I_CV, I_SFR, I_SFI, I_SBR, I_SBI, I_C, I_CCTX, I_NG, I_WMOD, I_BMOD, I_WIN, I_QN, I_KN, I_LRE, I_LIM, I_LSTEP, I_BRE, I_BIM, I_CRE, I_CIM, I_DSKIP, I_WGLU, I_WFFT, I_WOUT, I_FNG };

__device__ __forceinline__ int glu_row(int n) { return n < 1024 ? ((n >> 7) * 256 + (n & 127)) : (((n - 1024) >> 7) * 256 + 128 + ((n - 1024) & 127)); }
template <bool GLU>
__device__ __forceinline__ void tr_item(const float* __restrict__ W, int K, int N, bf16* __restrict__ WT, LAS float* scr, int item, int lane) {
    const int nblk = N / 64, kb = item / nblk, nb = item % nblk, k0 = 64 * kb, n0 = 64 * nb;
#pragma unroll 8
    for (int i = 0; i < 64; ++i) scr[i * 65 + lane] = __builtin_nontemporal_load(W + (size_t)(k0 + i) * N + n0 + lane);
    LDS_WAIT(); asm volatile("" ::: "memory");
    const int c = lane & 7;
#pragma unroll
    for (int j = 0; j < 8; ++j) { const int n = (lane >> 3) + 8 * j; const LAS float* s = scr + (8 * c) * 65 + n;
        v4u o; o.x = cvt_pk_bf16(s[0 * 65], s[1 * 65]); o.y = cvt_pk_bf16(s[2 * 65], s[3 * 65]); o.z = cvt_pk_bf16(s[4 * 65], s[5 * 65]); o.w = cvt_pk_bf16(s[6 * 65], s[7 * 65]);
        int nd = n0 + n; if (GLU) nd = glu_row(nd);
        *(v4u*)(WT + (size_t)nd * K + k0 + 8 * c) = o; }
    LDS_WAIT(); asm volatile("" ::: "memory");
}

__device__ __forceinline__ void ssm_matrices(KAP A, int l, int g, LAS unsigned char* lds, int tid) {
    LAS f32x2* pw = (LAS f32x2*)lds;
    LAS f32x2* bb = pw + 2 * 17 * 64;
    LAS f32x2* cc = bb + 2 * 64 * 16;
    LAS float* kk = (LAS float*)(cc + 2 * 16 * 64);
    if (tid < 128) {
        const int dir = tid >> 6, p = tid & 63, ig = (l * 2 + dir) * 64 + g;
        const float dt = expf(A->in[I_LSTEP][ig]);
        const float lr = A->in[I_LRE][(size_t)ig * 64 + p], li = A->in[I_LIM][(size_t)ig * 64 + p];
        for (int tau = 0; tau <= 16; ++tau) {
            const float mag = expf(lr * dt * (float)tau);
            const double turns = (double)li * (double)dt * (double)tau * 0.15915494309189535;
            const float fr = (float)(turns - rint(turns));
            pw[(dir * 17 + tau) * 64 + p] = (f32x2){mag * cospif(2.f * fr), mag * sinpif(2.f * fr)};
        }
        const f32x2 ab = pw[(dir * 17 + 1) * 64 + p];
        const float nr = ab.x - 1.0f, ni = ab.y, den = lr * lr + li * li;
        const float f_re = (nr * lr + ni * li) / den, f_im = (ni * lr - nr * li) / den;
        for (int c = 0; c < 16; ++c) { const float br = A->in[I_BRE][((size_t)ig * 64 + p) * 16 + c], bi = A->in[I_BIM][((size_t)ig * 64 + p) * 16 + c];
            bb[(dir * 64 + p) * 16 + c] = (f32x2){f_re * br - f_im * bi, f_re * bi + f_im * br}; }
        ((f32x2*)(A->ws + WS_A16))[(size_t)ig * 64 + p] = pw[(dir * 17 + 16) * 64 + p];
    }
    for (int idx = tid; idx < 2048; idx += 512) { const int dir = idx >> 10, c = (idx >> 6) & 15, p = idx & 63; const size_t gi = (((size_t)(l * 2 + dir) * 64 + g) * 16 + c) * 64 + p;
        cc[idx] = (f32x2){A->in[I_CRE][gi], A->in[I_CIM][gi]}; }
    __syncthreads();
    {
        const int dir = tid >> 8, tau = (tid >> 4) & 15, c = tid & 15;
        float accv[16];
#pragma unroll
        for (int j = 0; j < 16; ++j) accv[j] = 0.f;
        for (int p = 0; p < 64; ++p) { const f32x2 cv = cc[(dir * 16 + c) * 64 + p], pv = pw[(dir * 17 + tau) * 64 + p];
            const float wre = cv.x * pv.x - cv.y * pv.y, wim = cv.x * pv.y + cv.y * pv.x;
#pragma unroll
            for (int j = 0; j < 16; ++j) { const f32x2 bv = bb[(dir * 64 + p) * 16 + j]; accv[j] += wre * bv.x - wim * bv.y; } }
#pragma unroll
        for (int j = 0; j < 16; ++j) kk[((dir * 16 + tau) * 16 + c) * 16 + j] = accv[j];
    }
    __syncthreads();
    const int lg = l * 64 + g;
    bf16* Pm = (bf16*)(A->ws + WS_PMAT) + (size_t)lg * 256 * 256;
    for (int q = tid; q < 8192; q += 512) { const int R = q >> 5, col = (q & 31) * 8, s = col >> 4, c0 = col & 15, dir = R >> 7, reim = (R >> 6) & 1, p = R & 63, e = dir ? s : 15 - s;
        const f32x2 pv = pw[(dir * 17 + e) * 64 + p]; float v[8];
#pragma unroll
        for (int j = 0; j < 8; ++j) { const f32x2 bv = bb[(dir * 64 + p) * 16 + c0 + j]; v[j] = reim ? (pv.x * bv.y + pv.y * bv.x) : (pv.x * bv.x - pv.y * bv.y); }
        v4u w; w.x = cvt_pk_bf16(v[0], v[1]); w.y = cvt_pk_bf16(v[2], v[3]); w.z = cvt_pk_bf16(v[4], v[5]); w.w = cvt_pk_bf16(v[6], v[7]);
        *(v4u*)(Pm + (size_t)R * 256 + col) = w; }
    bf16* KGm = (bf16*)(A->ws + WS_KG) + (size_t)lg * 256 * 512;
    for (int q = tid; q < 16384; q += 512) { const int R = q >> 6, col = (q & 63) * 8, i = R >> 4, c = R & 15; float v[8];
        if (col < 256) { const int s = col >> 4, c0 = col & 15;
#pragma unroll
            for (int j = 0; j < 8; ++j) { const int cp = c0 + j; float x;
                if (s < i) x = kk[((0 * 16 + (i - s)) * 16 + c) * 16 + cp];
                else if (s > i) x = kk[((1 * 16 + (s - i)) * 16 + c) * 16 + cp];
                else { x = kk[((0 * 16 + 0) * 16 + c) * 16 + cp] + kk[((1 * 16 + 0) * 16 + c) * 16 + cp]; if (cp == c) x += A->in[I_DSKIP][l * 1024 + g * 16 + c]; }
                v[j] = x; }
        } else { const int k = col - 256, dir = k >> 7, reim = (k >> 6) & 1, p0 = k & 63, e = dir ? 16 - i : i + 1;
#pragma unroll
            for (int j = 0; j < 8; ++j) { const f32x2 cv = cc[(dir * 16 + c) * 64 + p0 + j], pv = pw[(dir * 17 + e) * 64 + p0 + j];
                v[j] = reim ? -(cv.x * pv.y + cv.y * pv.x) : (cv.x * pv.x - cv.y * pv.y); } }
        v4u w; w.x = cvt_pk_bf16(v[0], v[1]); w.y = cvt_pk_bf16(v[2], v[3]); w.z = cvt_pk_bf16(v[4], v[5]); w.w = cvt_pk_bf16(v[6], v[7]);
        *(v4u*)(KGm + (size_t)R * 512 + col) = w; }
    __syncthreads();
}

__device__ __forceinline__ void mod_unit(KAP A, int un, LAS unsigned char* lds, int tid, int wave, int lane) {
    LAS float* sl = (LAS float*)lds;
    LAS float* red = sl + 3 * 4096;
    const int l = un >> 6, nb = un & 63;
    for (int i = tid; i < 3 * 4096; i += 512) { const int v = i >> 12, k = i & 4095; const float x = v == 0 ? A->in[I_CCTX][k] : A->in[I_C][(v - 1) * 4096 + k]; sl[i] = x / (1.0f + expf(-x)); }
    __syncthreads();
    const int ln = lane < 48 ? lane : 47;
    const float* wp = A->in[I_WMOD] + ((size_t)l * 4096 + wave * 512) * 12288 + nb * 192 + ln * 4;
    f32x4 a0 = {0.f, 0.f, 0.f, 0.f}, a1 = a0, a2 = a0;
#pragma unroll 8
    for (int kq = 0; kq < 512; ++kq) { const f32x4 w = __builtin_nontemporal_load((const f32x4*)(wp + (size_t)kq * 12288)); const int k = wave * 512 + kq;
        a0 += sl[k] * w; a1 += sl[4096 + k] * w; a2 += sl[8192 + k] * w; }
    if (lane < 48) {
#pragma unroll
        for (int j = 0; j < 4; ++j) { red[(wave * 3 + 0) * 256 + lane * 4 + j] = a0[j]; red[(wave * 3 + 1) * 256 + lane * 4 + j] = a1[j]; red[(wave * 3 + 2) * 256 + lane * 4 + j] = a2[j]; } }
    __syncthreads();
    for (int i = tid; i < 768; i += 512) { const int v = i >> 8, col = i & 255; if (col < 192) { float s = 0.f;
#pragma unroll
        for (int w = 0; w < 8; ++w) s += red[(w * 3 + v) * 256 + col];
        ((float*)(A->ws + WS_MOD))[(size_t)(l * 3 + v) * 12288 + nb * 192 + col] = s + A->in[I_BMOD][l * 12288 + nb * 192 + col]; } }
    __syncthreads();
}

__device__ __forceinline__ void p0_prologue(KAP A, LAS unsigned char* lds, int G, int bx, int wv) {
    const int tid = tid_of(wv); const int lane = tid & 63, wave = __builtin_amdgcn_readfirstlane(tid >> 6);
    { LAS float* scr = (LAS float*)(lds + wave * 16640);
      const int gw = bx * NWAVES + wave, NGW = G * NWAVES;
      constexpr int I_IN = 64 * 144, I_OUT = 64 * 64, I_GLU = 16 * 32, I_L = I_IN + I_OUT + I_GLU;
      for (int it = gw; it < 4 * I_L; it += NGW) { const int l = it / I_L; int r = it % I_L;
          if (r < I_IN) { tr_item<false>(A->in[I_WIN] + (size_t)l * 4096 * 9216, 4096, 9216, (bf16*)(A->ws + WS_WIN) + (size_t)l * 9216 * 4096, scr, r, lane); continue; } r -= I_IN;
          if (r < I_OUT) { tr_item<false>(A->in[I_WOUT] + (size_t)l * 4096 * 4096, 4096, 4096, (bf16*)(A->ws + WS_WOUT) + (size_t)l * 4096 * 4096, scr, r, lane); continue; } r -= I_OUT;
          tr_item<true>(A->in[I_WGLU] + (size_t)l * 1024 * 2048, 1024, 2048, (bf16*)(A->ws + WS_WGLU) + (size_t)l * 2048 * 1024, scr, r, lane); }
    }
    __syncthreads();
    for (int un = bx; un < 256; un += G) mod_unit(A, un, lds, tid, wave, lane);
    const size_t gt = (size_t)bx * 512 + tid, NGT = (size_t)G * 512;
    { bf16* D2L = (bf16*)(A->ws + WS_D2L);
      LAS bf16* lut = (LAS bf16*)lds;
      for (int i = tid; i < 4096; i += 512) lut[i] = (bf16)(cvt_pk_bf16(cospif((float)i * (1.0f / 2048.0f)), 0.f) & 0xffffu);
      __syncthreads();
      for (size_t q = gt; q < (size_t)4096 * 1024; q += NGT) { const int k = (int)(q >> 10), K0 = (int)(q & 1023) * 8; unsigned h[8];
          const int sh = K0 < 4096 ? 0 : 1024;
#pragma unroll
          for (int j = 0; j < 8; ++j) { const int K = (K0 + j) & 4095; h[j] = lut[(k * K + sh) & 4095]; }
          v4u w; w.x = h[0] | (h[1] << 16); w.y = h[2] | (h[3] << 16); w.z = h[4] | (h[5] << 16); w.w = h[6] | (h[7] << 16);
          *(v4u*)(D2L + (size_t)k * 8192 + K0) = w; }
      __syncthreads(); }
    { bf16* D1 = (bf16*)(A->ws + WS_D1);
      for (size_t q = gt; q < (size_t)256 * 256; q += NGT) { const int mp = (int)(q >> 8), c = (int)(q & 255), m = mp <= 128 ? mp : mp - 128; const float x = (float)((m * c) & 255) * (1.0f / 128.0f);
          const float v = mp <= 128 ? cospif(x) : sinpif(x); D1[q] = (bf16)(cvt_pk_bf16(v, 0.f) & 0xffffu); } }
    { bf16* WFP = (bf16*)(A->ws + WS_WFP);
      for (size_t q = gt; q < (size_t)4 * 144 * 1024; q += NGT) { const int n = (int)(q & 1023), i = (int)((q >> 10) % 144), l = (int)(q / (144 * 1024)); const int kk0 = i * 8;
          const float* W = A->in[I_WFFT] + (size_t)l * 1024 * 1024 + n; float v[8];
          if (kk0 < 1024) { const int g = kk0 >> 8, part = (kk0 >> 7) & 1;
#pragma unroll
              for (int j = 0; j < 8; ++j) { const int m = (kk0 + j) & 127; const float w1 = W[(size_t)(g * 256 + m) * 1024], w2 = W[(size_t)(g * 256 + ((256 - m) & 255)) * 1024];
                  v[j] = part ? (w1 - w2) : (m ? w1 + w2 : w1); } }
          else {
#pragma unroll
              for (int j = 0; j < 8; ++j) v[j] = 0.f;
              if (kk0 == 1024) {
#pragma unroll
                  for (int j = 0; j < 4; ++j) v[j] = W[(size_t)(j * 256 + 128) * 1024]; } }
          v4u w; w.x = cvt_pk_bf16(v[0], v[1]); w.y = cvt_pk_bf16(v[2], v[3]); w.z = cvt_pk_bf16(v[4], v[5]); w.w = cvt_pk_bf16(v[6], v[7]);
          *(v4u*)(WFP + ((size_t)l * 1024 + n) * PK + kk0) = w; }
      bf16* P = (bf16*)(A->ws + WS_P);
      for (size_t q = gt; q < (size_t)NTOK * 31; q += NGT) { const size_t row = q / 31; const int j = (int)(q % 31); *(v2u*)(P + row * PK + 1028 + j * 4) = (v2u){0u, 0u}; } }
    { bf16* D2C = (bf16*)(A->ws + WS_D2C);
      for (size_t q = gt; q < (size_t)256 * 512; q += NGT) { const int k = (int)(q >> 9), K = (int)(q & 511); const float x = (float)((k * (K & 255)) & 255) * (1.0f / 128.0f);
          const float v = K < 256 ? cospif(x) : -sinpif(x); D2C[q] = (bf16)(cvt_pk_bf16(v, 0.f) & 0xffffu); } }
    { f32x2* rope = (f32x2*)(A->ws + WS_ROPE);
      for (size_t q = gt; q < 64 * 32; q += NGT) { const int pos = (int)(q >> 5), i = (int)(q & 31); const float inv = exp2f(-(float)i * (13.287712379549449f / 32.0f));
          const double turns = (double)pos * (double)inv * 0.15915494309189535; const float fr = (float)(turns - rint(turns));
          rope[q] = (f32x2){cospif(2.f * fr), sinpif(2.f * fr)}; } }
    { const size_t n8 = (size_t)2 * 4 * 512 * 512 / 8;
      for (size_t q = gt; q < 2 * n8; q += NGT) { const bool isk = q < n8; const size_t j = isk ? q : q - n8; const float* src = (isk ? A->in[I_CK] : A->in[I_CV]) + j * 8;
          const f32x4 x0 = *(const f32x4*)src, x1 = *(const f32x4*)(src + 4);
          v4u w; w.x = cvt_pk_bf16(x0[0], x0[1]); w.y = cvt_pk_bf16(x0[2], x0[3]); w.z = cvt_pk_bf16(x1[0], x1[1]); w.w = cvt_pk_bf16(x1[2], x1[3]);
          *(v4u*)((bf16*)(A->ws + (isk ? WS_CK : WS_CV)) + j * 8) = w; } }
    __syncthreads();
    for (int lg = bx; lg < 256; lg += G) ssm_matrices(A, lg >> 6, lg & 63, lds, tid);
}

__device__ __forceinline__ f32x4 ldg16(const void* base, unsigned off, int imm) { return *(const f32x4*)(((const char*)base + off) + imm); }
__device__ __forceinline__ void pa_norm(KAP A, int l, int bx, int G, int tid, LAS unsigned char* lds) {
    const float* mod = (const float*)(A->ws + WS_MOD) + (size_t)l * 3 * 12288;
    const f32x4* ng4 = (const f32x4*)(A->in[I_NG] + l * DM);
    bf16* H = (bf16*)(A->ws + WS_H);
    const int lane = tid & 63, wave = __builtin_amdgcn_readfirstlane(tid >> 6);
    const unsigned lo2 = (unsigned)lane * 16u, lo4 = (unsigned)lane * 32u;
    LAS f32x4* avl = (LAS f32x4*)lds; LAS f32x4* svl = avl + 1024;
    for (int rb = bx; rb < NTOK / 64; rb += G) {
        const int m0 = rb * 64; const int v = m0 < NCTX ? 0 : (m0 < NCTX + 4096 ? 1 : 2);
        const f32x4* sh4 = (const f32x4*)(mod + v * 12288); const f32x4* sc4 = (const f32x4*)(mod + v * 12288 + 4096);
        __syncthreads();
        for (int i = tid; i < 1024; i += NWAVES * 64) { const int d = ((i >> 7) * 2 + (i & 1)) * 64 + ((i & 127) >> 1);
            avl[d] = ng4[i] * (sc4[i] + 1.0f); svl[d] = sh4[i]; }
        __syncthreads();
#pragma unroll 2
        for (int r = 0; r < 8; ++r) { const int m = m0 + wave * 8 + r;
            f32x4 x[16]; float ss = 0.f;
            char* xb = (char*)((bf16*)(A->ws + ((l & 1) ? WS_XBF2 : WS_XBF)) + (size_t)m * DM);
            const char* xbi = (const char*)((const bf16*)(A->ws + ((l & 1) ? WS_XBF : WS_XBF2)) + (size_t)m * DM);
            if (l <= 1) { const float* xr = m < NCTX ? A->in[I_XP] + (size_t)m * DM : A->in[I_XS] + (size_t)(m - NCTX) * DM;
#pragma unroll
                for (int j = 0; j < 8; ++j) { x[2 * j] = ldg16(xr, lo4 + (j >> 1) * 4096u, (j & 1) * 2048); x[2 * j + 1] = ldg16(xr, lo4 + (j >> 1) * 4096u, (j & 1) * 2048 + 16); }
            } else {
#pragma unroll
                for (int j = 0; j < 8; ++j) { const v4u d = *(const v4u*)((xbi + (lo2 + (j >> 2) * 4096u)) + (j & 3) * 1024);
                    x[2 * j] = (f32x4){bf_lo(d.x), bf_hi(d.x), bf_lo(d.y), bf_hi(d.y)}; x[2 * j + 1] = (f32x4){bf_lo(d.z), bf_hi(d.z), bf_lo(d.w), bf_hi(d.w)}; }
            }
            if (l > 0) {
                const char* dr = (const char*)((const bf16*)(A->ws + ((l & 1) ? WS_DELTA : WS_DELTA2)) + (size_t)m * DM);
#pragma unroll
                for (int j = 0; j < 8; ++j) { const v4u d = *(const v4u*)((dr + (lo2 + (j >> 2) * 4096u)) + (j & 3) * 1024);
                    x[2 * j] += (f32x4){bf_lo(d.x), bf_hi(d.x), bf_lo(d.y), bf_hi(d.y)}; x[2 * j + 1] += (f32x4){bf_lo(d.z), bf_hi(d.z), bf_lo(d.w), bf_hi(d.w)};
                    v4u w; w.x = cvt_pk_bf16(x[2 * j].x, x[2 * j].y); w.y = cvt_pk_bf16(x[2 * j].z, x[2 * j].w); w.z = cvt_pk_bf16(x[2 * j + 1].x, x[2 * j + 1].y); w.w = cvt_pk_bf16(x[2 * j + 1].z, x[2 * j + 1].w);
                    *(v4u*)((xb + (lo2 + (j >> 2) * 4096u)) + (j & 3) * 1024) = w; }
            }
#pragma unroll
            for (int j = 0; j < 16; ++j) ss += (x[j].x * x[j].x + x[j].y * x[j].y) + (x[j].z * x[j].z + x[j].w * x[j].w);
            const float rstd = rsqrtf(wave_sum(ss, lane) * (1.0f / DM) + NORM_EPS);
            char* orow = (char*)(H + (size_t)m * DM);
#pragma unroll
            for (int j = 0; j < 8; ++j) { const f32x4 y0 = x[2 * j] * rstd * avl[(2 * j) * 64 + lane] + svl[(2 * j) * 64 + lane], y1 = x[2 * j + 1] * rstd * avl[(2 * j + 1) * 64 + lane] + svl[(2 * j + 1) * 64 + lane];
                v4u w; w.x = cvt_pk_bf16(y0.x, y0.y); w.y = cvt_pk_bf16(y0.z, y0.w); w.z = cvt_pk_bf16(y1.x, y1.y); w.w = cvt_pk_bf16(y1.z, y1.w);
                *(v4u*)((orow + (lo2 + (j >> 2) * 4096u)) + (j & 3) * 1024) = w;
                if ((j & 1) == 1) asm volatile("" ::: "memory"); }
        }
    }
    __syncthreads();
}
__device__ __forceinline__ void final_norm(KAP A, int gw, int NGW, int lane) {
    const float* fg = A->in[I_FNG];
    const unsigned lo2 = (unsigned)lane * 16u, lo4 = (unsigned)lane * 32u;
    f32x4 gv[16];
#pragma unroll
    for (int j = 0; j < 8; ++j) { gv[2 * j] = ldg16(fg, lo4 + (j >> 1) * 4096u, (j & 1) * 2048); gv[2 * j + 1] = ldg16(fg, lo4 + (j >> 1) * 4096u, (j & 1) * 2048 + 16); }
    for (int ci = gw; ci < NTOK / 8; ci += NGW) {
#pragma unroll 2
        for (int r = 0; r < 8; ++r) { const int m = ci * 8 + r;
            char* xr = (char*)(A->out + (size_t)m * DM);
            const char* xs = (const char*)((const bf16*)(A->ws + (((DEPTH - 1) & 1) ? WS_XBF2 : WS_XBF)) + (size_t)m * DM);
            const char* dr = (const char*)((const bf16*)(A->ws + (((DEPTH - 1) & 1) ? WS_DELTA2 : WS_DELTA)) + (size_t)m * DM);
            f32x4 x[16]; float ss = 0.f;
#pragma unroll
            for (int j = 0; j < 8; ++j) { const v4u xv = *(const v4u*)((xs + (lo2 + (j >> 2) * 4096u)) + (j & 3) * 1024); const v4u d = *(const v4u*)((dr + (lo2 + (j >> 2) * 4096u)) + (j & 3) * 1024);
                x[2 * j] = (f32x4){bf_lo(xv.x) + bf_lo(d.x), bf_hi(xv.x) + bf_hi(d.x), bf_lo(xv.y) + bf_lo(d.y), bf_hi(xv.y) + bf_hi(d.y)};
                x[2 * j + 1] = (f32x4){bf_lo(xv.z) + bf_lo(d.z), bf_hi(xv.z) + bf_hi(d.z), bf_lo(xv.w) + bf_lo(d.w), bf_hi(xv.w) + bf_hi(d.w)}; }
#pragma unroll
            for (int j = 0; j < 16; ++j) ss += (x[j].x * x[j].x + x[j].y * x[j].y) + (x[j].z * x[j].z + x[j].w * x[j].w);
            const float rstd = rsqrtf(wave_sum(ss, lane) * (1.0f / DM) + NORM_EPS);
#pragma unroll
            for (int j = 0; j < 8; ++j) { *(f32x4*)((xr + (lo4 + (j >> 1) * 4096u)) + (j & 1) * 2048) = x[2 * j] * rstd * gv[2 * j]; *(f32x4*)((xr + (lo4 + (j >> 1) * 4096u)) + (j & 1) * 2048 + 16) = x[2 * j + 1] * rstd * gv[2 * j + 1];
                if ((j & 1) == 1) asm volatile("" ::: "memory"); }
        }
    }
}

__device__ __forceinline__ void kv_prep(KAP A, int l, int gw, int NGW, int lane) {
    const bf16* PROJ = (const bf16*)(A->ws + WS_PROJ);
    const f32x2* rope = (const f32x2*)(A->ws + WS_ROPE);
    const int hl = lane & 15;
    const f32x4 kn0 = *(const f32x4*)(A->in[I_KN] + l * 128 + hl * 8), kn1 = *(const f32x4*)(A->in[I_KN] + l * 128 + hl * 8 + 4);
    for (int ci = gw; ci < NTOK / 4; ci += NGW) {
        const int m0 = ci * 4; const bool ctx = m0 < NCTX;
        v4u kr[4], vr[4];
#pragma unroll
        for (int r = 0; r < 4; ++r) { const bf16* pr = PROJ + (size_t)(m0 + r) * INW; kr[r] = *(const v4u*)(pr + OFF_K + 8 * lane); vr[r] = *(const v4u*)(pr + OFF_V + 8 * lane); }
#pragma unroll
        for (int r = 0; r < 4; ++r) { const int m = m0 + r;
            float k[8] = {bf_lo(kr[r].x), bf_hi(kr[r].x), bf_lo(kr[r].y), bf_hi(kr[r].y), bf_lo(kr[r].z), bf_hi(kr[r].z), bf_lo(kr[r].w), bf_hi(kr[r].w)};
            float ss = 0.f;
#pragma unroll
            for (int j = 0; j < 8; ++j) ss += k[j] * k[j];
            ss += shflx(ss, lane, 1); ss += shflx(ss, lane, 2); ss += shflx(ss, lane, 4); ss += shflx(ss, lane, 8);
            const float rstd = rsqrtf(ss * (1.0f / 128.0f) + NORM_EPS);
#pragma unroll
            for (int j = 0; j < 4; ++j) { k[j] *= rstd * kn0[j]; k[4 + j] *= rstd * kn1[j]; }
            if (ctx) {
                const int b = m >> 8, t = m & 255; const size_t oi = (((size_t)(b * 4 + l) * 256 + t) * 512 + 8 * lane);
                float* ok = A->out + OUT_NEWK + oi; *(f32x4*)ok = (f32x4){k[0], k[1], k[2], k[3]}; *(f32x4*)(ok + 4) = (f32x4){k[4], k[5], k[6], k[7]};
                float* ov = A->out + OUT_NEWV + oi; *(f32x4*)ov = (f32x4){bf_lo(vr[r].x), bf_hi(vr[r].x), bf_lo(vr[r].y), bf_hi(vr[r].y)}; *(f32x4*)(ov + 4) = (f32x4){bf_lo(vr[r].z), bf_hi(vr[r].z), bf_lo(vr[r].w), bf_hi(vr[r].w)};
            } else {
                const int t = (m - NCTX) & 4095, pos = hl < 8 ? (t >> 6) : (t & 63); const f32x2* rp = rope + pos * 32 + (lane & 3) * 8; const bool first = (lane & 4) == 0;
#pragma unroll
                for (int j = 0; j < 8; ++j) { const float other = shflx(k[j], lane, 4); const f32x2 cs = rp[j];
                    k[j] = first ? (k[j] * cs.x - other * cs.y) : (other * cs.y + k[j] * cs.x); }
            }
            v4u w; w.x = cvt_pk_bf16(k[0], k[1]); w.y = cvt_pk_bf16(k[2], k[3]); w.z = cvt_pk_bf16(k[4], k[5]); w.w = cvt_pk_bf16(k[6], k[7]);
            *(v4u*)((bf16*)(A->ws + WS_KC) + (size_t)m * 512 + 8 * lane) = w;
            *(v4u*)((bf16*)(A->ws + WS_VC) + (size_t)m * 512 + 8 * lane) = vr[r];
        }
    }
}

__device__ __forceinline__ void ssm_scan(KAP A, int l, int g, int mt, int tid, LAS unsigned char* lds) {
    bf16* A2 = (bf16*)(A->ws + WS_A2) + (size_t)g * 1024 * 512;
    const int blk = tid >> 5, sub = tid & 31, dir = sub >> 4, p0 = (sub & 15) * 4;
    f32x4 ar, ai;
    { const f32x4* a4 = (const f32x4*)((const float*)(A->ws + WS_A16) + (((size_t)(l * 2 + dir) * 64 + g) * 64 + p0) * 2); const f32x4 t0 = a4[0], t1 = a4[1];
      ar = (f32x4){t0.x, t0.z, t1.x, t1.z}; ai = (f32x4){t0.y, t0.w, t1.y, t1.w}; }
    const int ecol = 256 + dir * 128 + p0, scol = dir * 128 + p0;
    LAS f32x4* T = (LAS f32x4*)lds;
    LAS f32x4* EB = T + 16 * 32 * 2;
    const bool lat = mt >= 2;
    const int rb = mt * 256 + blk * 16;
    f32x4 sr[16], si[16];
#pragma unroll
    for (int i = 0; i < 16; ++i) { const int x = dir ? 15 - i : i, rl = blk * 16 + x;
        const v2u a = *(const LAS v2u*)(lds + rl * 512 + ((((scol >> 3) ^ x) << 4) + (scol & 7) * 2)), b = *(const LAS v2u*)(lds + rl * 512 + (((((scol + 64) >> 3) ^ x) << 4) + (scol & 7) * 2));
        sr[i] = (f32x4){bf_lo(a.x), bf_hi(a.x), bf_lo(a.y), bf_hi(a.y)}; si[i] = (f32x4){bf_lo(b.x), bf_hi(b.x), bf_lo(b.y), bf_hi(b.y)}; }
    __syncthreads();
    f32x4 er = {0.f, 0.f, 0.f, 0.f}, ei = er;
    if (lat) {
#pragma unroll
        for (int i = 0; i < 16; ++i) { const f32x4 nr = ar * er - ai * ei + sr[i], ni = ar * ei + ai * er + si[i]; er = nr; ei = ni; }
        T[(blk * 32 + sub) * 2] = er; T[(blk * 32 + sub) * 2 + 1] = ei;
        __syncthreads();
        if (tid < 32) { const int b = mt - 2; const size_t si0 = (((size_t)b * 4 + l) * 64 + g) * 64 + p0;
            f32x4 cr = *(const f32x4*)(A->in[dir ? I_SBR : I_SFR] + si0), ci = *(const f32x4*)(A->in[dir ? I_SBI : I_SFI] + si0);
            f32x4 qr = ar, qi = ai;
#pragma unroll
            for (int k = 0; k < 4; ++k) { const f32x4 t = qr * qr - qi * qi; qi = 2.f * qr * qi; qr = t; }
#pragma unroll 1
            for (int jb = 0; jb < 16; ++jb) { const int bb = dir ? 15 - jb : jb; EB[(bb * 32 + sub) * 2] = cr; EB[(bb * 32 + sub) * 2 + 1] = ci;
                const f32x4 tr = T[(bb * 32 + sub) * 2], ti = T[(bb * 32 + sub) * 2 + 1];
                const f32x4 nr = qr * cr - qi * ci + tr, ni = qr * ci + qi * cr + ti; cr = nr; ci = ni; } }
        __syncthreads();
        er = EB[(blk * 32 + sub) * 2]; ei = EB[(blk * 32 + sub) * 2 + 1];
    }
#pragma unroll
    for (int i = 0; i < 16; ++i) { const int row = rb + (dir ? 15 - i : i);
        v2u wr, wi; wr.x = cvt_pk_bf16(er.x, er.y); wr.y = cvt_pk_bf16(er.z, er.w); wi.x = cvt_pk_bf16(ei.x, ei.y); wi.y = cvt_pk_bf16(ei.z, ei.w);
        *(v2u*)(A2 + (size_t)row * 512 + ecol) = wr; *(v2u*)(A2 + (size_t)row * 512 + ecol + 64) = wi;
        const f32x4 nr = ar * er - ai * ei + sr[i], ni = ar * ei + ai * er + si[i]; er = nr; ei = ni; }
    if (!lat) { const int b = mt * 16 + blk; const size_t oi = (((size_t)b * 4 + l) * 64 + g) * 64 + p0;
        *(f32x4*)(A->out + (dir ? OUT_BRE : OUT_FRE) + oi) = er; *(f32x4*)(A->out + (dir ? OUT_BIM : OUT_FIM) + oi) = ei; }
}
__device__ __forceinline__ void ssm_step1(KAP A, int l, int un, LAS unsigned char* lds, int wv) {
    const int g = un >> 2, mt = un & 3, lg = l * 64 + g;
    pg8::OneUnit S1; S1.u0.a = (const char*)(A->ws + WS_A2) + ((size_t)g * 1024 + mt * 256) * 512 * 2; S1.u0.b = (const char*)(A->ws + WS_PMAT) + (size_t)lg * 256 * 256 * 2;
    S1.u0.c = nullptr; S1.u0.ldc = 0; S1.u0.pm = mt; S1.u0.pn = g; S1.u0.z = 0; S1.u0.kt = 4;
    pg8::EpiLdsS E{lds}; pg8::gemm_phase<pg8::EpiLdsS, pg8::OneUnit>(lds, wv, 512, 256, S1, E);
}
__device__ __forceinline__ void ssm_step2(KAP A, int l, int un, LAS unsigned char* lds, int wv) {
    const int g = un >> 2, mt = un & 3; const int tid = tid_of(wv); ssm_scan(A, l, g, mt, tid, lds);
}
__device__ __forceinline__ void ssm_step3(KAP A, int l, int un, LAS unsigned char* lds, int wv) {
    const int g = un >> 2, mt = un & 3, lg = l * 64 + g;
    pg8::OneUnit S2; S2.u0.a = (const char*)(A->ws + WS_A2) + ((size_t)g * 1024 + mt * 256) * 512 * 2; S2.u0.b = (const char*)(A->ws + WS_KG) + (size_t)lg * 256 * 512 * 2;
    S2.u0.c = nullptr; S2.u0.ldc = 0; S2.u0.pm = mt; S2.u0.pn = g; S2.u0.z = mt * 256; S2.u0.kt = 8;
    pg8::EpiSsmY E{(bf16*)(A->ws + WS_YSSM)}; pg8::gemm_phase<pg8::EpiSsmY, pg8::OneUnit>(lds, wv, 512, 512, S2, E);
}

struct Fft1Order {
    int G, c; const char* D1; const char* proj; char* zl; char* zc;
    __device__ bool next(int i, pg8::Unit& u) const { const int L = i * G + c; if (L >= 256) return false;
        const int g = L & 3, tt = L >> 2;
        int kt4 = 4; asm volatile("" : "+s"(kt4)); u.kt = kt4;
        u.a = D1; u.b = proj + ((size_t)tt * 256 * INW + OFF_F + g * 256) * 2; u.pm = 0; u.pn = tt; u.z = g;
        if (tt < 32) { u.c = zc + ((size_t)((tt * 4 + g) * 128) * 256) * 2; u.ldc = 256; }
        else { const int b = (tt - 32) >> 4, t0 = ((tt - 32) & 15) * 256; u.c = zl + ((size_t)((b * 4 + g) * 128) * 4096 + t0) * 2; u.ldc = 4096; }
        return true; }
};
struct Fft2LOrder {
    int G, c; const char* D2; const char* z; char* P;
    __device__ bool next(int i, pg8::Unit& u) const { const int L = i * G + c; if (L >= 64) return false;
        const int nt = L & 3, part = (L >> 2) & 1, mt = L >> 3;
        u.kt = 64; u.a = D2 + ((size_t)mt * 256 * 8192 + part * 4096) * 2; u.b = z + (part * ZPART + (size_t)nt * 256 * 4096) * 2; u.pm = mt; u.pn = nt; u.z = part;
        u.c = P + (((size_t)NCTX + (nt >> 1) * 4096 + mt * 256) * PK + (nt & 1) * 512 + part * 128) * 2; u.ldc = PK; return true; }
};
struct Fft2COrder {
    int G, c; const char* D2; const char* z; char* P;
    __device__ bool next(int i, pg8::Unit& u) const { const int L = i * G + c; if (L >= 128) return false;
        const int nt = L & 1, part = (L >> 1) & 1, b = L >> 2;
        u.kt = 4; u.a = D2 + (size_t)part * 256 * 2; u.b = z + (part * ZPART + (size_t)((b * 4 + nt * 2) * 128) * 256) * 2; u.pm = 0; u.pn = nt; u.z = b;
        u.c = P + (((size_t)b * 256) * PK + nt * 512 + part * 128) * 2; u.ldc = PK; return true; }
};
template <int NS, int KS>
__device__ __forceinline__ f32x4 nyq_core(const bf16* arow, size_t lda16, const bf16* bcol, LAS unsigned char* lds, int tid) {
    const int wave = tid >> 6, lane = tid & 63, fq = lane >> 4;
    f32x4 acc[NS];
#pragma unroll
    for (int ns = 0; ns < NS; ++ns) acc[ns] = (f32x4){0.f, 0.f, 0.f, 0.f};
    const int tb = wave * KS * 32 + fq * 8;
#pragma unroll 4
    for (int s2 = 0; s2 < KS; ++s2) { const bf16x8 bv = *(const bf16x8*)(bcol + tb + s2 * 32);
#pragma unroll
        for (int ns = 0; ns < NS; ++ns) { const bf16x8 av = *(const bf16x8*)(arow + ns * lda16 + tb + s2 * 32); acc[ns] = __builtin_amdgcn_mfma_f32_16x16x32_bf16(bv, av, acc[ns], 0, 0, 0); } }
    LAS f32x4* red = (LAS f32x4*)lds;
    __syncthreads();
#pragma unroll
    for (int ns = 0; ns < NS; ++ns) red[(wave * NS + ns) * 64 + lane] = acc[ns];
    __syncthreads();
    f32x4 r = (f32x4){0.f, 0.f, 0.f, 0.f};
    if (tid < NS * 64) {
#pragma unroll
        for (int w = 0; w < 8; ++w) r += red[(w * NS + (tid >> 6)) * 64 + (tid & 63)]; }
    __syncthreads();
    return r;
}
__device__ __forceinline__ void nyq_pass(KAP A, int cA, LAS unsigned char* lds, int wv) {
    const int tid = tid_of(wv); const int fr = tid & 15;
    bf16* P = (bf16*)(A->ws + WS_P);
    {
        const bf16* arow = (const bf16*)(A->ws + WS_D2L) + (size_t)(cA * 32 + fr) * 8192;
        const bf16* bcol = (const bf16*)(A->ws + WS_ZL) + ZPART + (size_t)((fr & 7) * 128) * 4096;
        const f32x4 r = nyq_core<2, 16>(arow, (size_t)16 * 8192, bcol, lds, tid) * (1.0f / 1024.0f);
        const int fq = (tid & 63) >> 4;
        if (tid < 128 && fq < 2) { const int k = cA * 32 + (tid >> 6) * 16 + fr; *(v2u*)(P + ((size_t)NCTX + fq * 4096 + k) * PK + 1024) = (v2u){cvt_pk_bf16(r[0], r[1]), cvt_pk_bf16(r[2], r[3])}; } }
    {
        const int cg = cA & 7, rs = cA >> 3;
        const bf16* arow = (const bf16*)(A->ws + WS_D2C) + (size_t)(rs * 16 + fr) * 512;
        const bf16* bcol = (const bf16*)(A->ws + WS_ZC) + ZPART + (size_t)(((cg * 4 + (fr >> 2)) * 4 + (fr & 3)) * 128) * 256;
        const f32x4 r = nyq_core<1, 1>(arow, 0, bcol, lds, tid) * (1.0f / 256.0f);
        const int fq = (tid & 63) >> 4;
        if (tid < 64) { const int k = rs * 16 + fr, b = cg * 4 + fq; *(v2u*)(P + ((size_t)b * 256 + k) * PK + 1024) = (v2u){cvt_pk_bf16(r[0], r[1]), cvt_pk_bf16(r[2], r[3])}; } }
}
__device__ __forceinline__ void fft_row2048(KAP A, int c2, int n2, int wv) {
    const int tid = tid_of(wv); const int lane = tid & 63, wave = __builtin_amdgcn_readfirstlane(tid >> 6);
    bf16* P = (bf16*)(A->ws + WS_P);
    for (int n = c2 * NWAVES + wave; n < 1024; n += n2 * NWAVES) {
        const v4u* zr = (const v4u*)((const bf16*)(A->ws + WS_ZL) + (size_t)n * 4096); float s = 0.f;
#pragma unroll
        for (int j = 0; j < 8; ++j) { const v4u w = zr[j * 64 + lane];
            s += (bf_lo(w.x) - bf_hi(w.x)) + (bf_lo(w.y) - bf_hi(w.y)) + (bf_lo(w.z) - bf_hi(w.z)) + (bf_lo(w.w) - bf_hi(w.w)); }
        s = wave_sum(s, lane) * (1.0f / 1024.0f);
        if (lane == 0) { const int bg = n >> 7, m = n & 127; bf16* row = P + ((size_t)NCTX + (bg >> 2) * 4096 + 2048) * PK + (bg & 3) * 256 + m;
            row[0] = (bf16)(cvt_pk_bf16(s, 0.f) & 0xffffu); row[128] = (bf16)0; }
    }
}

__global__ void __launch_bounds__(NWAVES * 64, 2) hymba_fwd(Args args) {
    extern __shared__ __attribute__((aligned(16))) unsigned char lds_raw[];
    LAS unsigned char* lds = (LAS unsigned char*)lds_raw;
    volatile LAS unsigned* MISC = (volatile LAS unsigned*)(lds + MISC_OFF);
    const int G = gridDim.x, bx = blockIdx.x;
    const int wv = __builtin_amdgcn_readfirstlane(threadIdx.x >> 6);
#define TID_HERE() const int tid = tid_of(wv); const int lane = tid & 63, wave = __builtin_amdgcn_readfirstlane(tid >> 6), gw = bq * NWAVES + wave, NGWq = Gq * NWAVES; (void)lane; (void)gw; (void)NGWq
#define PH_IDS() int Gq = G, bq = bx; asm volatile("" : "+s"(Gq), "+s"(bq))
    for (int u = tid_of(wv); u < (LDS_BYTES - MISC_OFF) / 4; u += NWAVES * 64) ((LAS unsigned*)(lds + MISC_OFF))[u] = 0u;
    __syncthreads();
    int lo, hi; XcdBarrier bar;
    { KA_HERE(); PH_IDS(); lo = ka->ph_lo; hi = ka->ph_hi; unsigned* ctl = (unsigned*)(ka->ws + WS_CTL);
      bar.bar = ctl + CW_BAR; bar.x = 0; bar.st = nullptr;
      if (hi - lo > 1) bar = xcd_barrier_post(ctl + CW_BAR, MISC + 8, tid_of(wv)); }
#define IN(k) (lo <= (k) && (k) < hi)
#define SEAM(k) do { if (IN(k) && IN((k) + 1)) { xcd_barrier(bar, wv); if (((DUP_MASK) >> 12) & 1) xcd_barrier(bar, wv); } } while (0)

    if (IN(0)) DUP(0) { KA_HERE(); PH_IDS(); p0_prologue(ka, lds, Gq, bq, wv); }
    SEAM(0);

#define SSM_UNIT(uq) (((((uq) & 7) * 8 + ((uq) >> 5)) << 2) | (((uq) >> 3) & 3))
    for (int l = 0; l < DEPTH; ++l) for (int lrep_ = 0; lrep_ < 1 + (((DUP_MASK) >> 19) & 1); ++lrep_) {
        const int pb = 1 + 6 * l;
        if (IN(pb)) DUP(1) { KA_HERE(); PH_IDS(); TID_HERE(); pa_norm(ka, l, bq, Gq, tid, lds);
        }
        SEAM(pb);
        if (IN(pb + 1)) DUP(2) {
            KA_HERE(); PH_IDS(); unsigned char* ws = ka->ws;
            pg8::GemmOrder S; S.init(NTOK, INW, Gq, bq, ws + WS_H, DM, ws + WS_WIN + (size_t)l * INW * DM * 2, DM, DM);
            pg8::EpiProj E{(bf16*)(ws + WS_PROJ), (bf16*)(ws + WS_A2)};
            pg8::gemm_phase<pg8::EpiProj, pg8::GemmOrder, GEMM1_ALIGN>(lds, wv, DM, DM, S, E);
        }
        SEAM(pb + 1);
        if (IN(pb + 2)) {
            DUP(16) for (int uq = bx; uq < 256; uq += G) { const int un = SSM_UNIT(uq); { KA_HERE(); ssm_step1(ka, l, un, lds, wv); } __syncthreads(); { KA_HERE(); ssm_step2(ka, l, un, lds, wv); } __syncthreads(); }
            DUP(14) { KA_HERE(); PH_IDS(); TID_HERE(); kv_prep(ka, l, gw, NGWq, lane); }
            DUP(3) { KA_HERE(); PH_IDS(); unsigned char* ws = ka->ws;
              Fft1Order S{Gq, bq, (const char*)(ws + WS_D1), (const char*)(ws + WS_PROJ), (char*)(ws + WS_ZL), (char*)(ws + WS_ZC)};
              pg8::EpiBf16X E{1.0f, (int)ZPART, 128}; pg8::gemm_phase<pg8::EpiBf16X, Fft1Order>(lds, wv, 256, INW, S, E); }
            wg_global_sync();
            DUP(18) for (int uq = bx; uq < 256; uq += G) { const int un = SSM_UNIT(uq); KA_HERE(); ssm_step3(ka, l, un, lds, wv); }
        }
        SEAM(pb + 2);
        if (IN(pb + 3)) {
            if (bx < (G >> 1)) {
                __syncthreads();
                const int n1 = G >> 2;
                if (bx < n1) {
                  DUP(7) { KA_HERE(); unsigned char* ws = ka->ws; int nAq = n1, cAq = bx; asm volatile("" : "+s"(nAq), "+s"(cAq));
                    Fft2LOrder S{nAq, cAq, (const char*)(ws + WS_D2L), (const char*)(ws + WS_ZL), (char*)(ws + WS_P)};
                    pg8::EpiFft2Sym E{1.0f / 1024.0f}; pg8::gemm_phase<pg8::EpiFft2Sym, Fft2LOrder>(lds, wv, 8192, 4096, S, E); }
                } else {
                  DUP(8) { KA_HERE(); unsigned char* ws = ka->ws; int nAq = (G >> 1) - n1, cAq = bx - n1; asm volatile("" : "+s"(nAq), "+s"(cAq));
                    Fft2COrder S{nAq, cAq, (const char*)(ws + WS_D2C), (const char*)(ws + WS_ZC), (char*)(ws + WS_P)};
                    pg8::EpiBf16X E{1.0f / 256.0f, 128 * PK, 256}; pg8::gemm_phase<pg8::EpiBf16X, Fft2COrder>(lds, wv, 512, 256, S, E); }
                }
                __syncthreads();
            }
            if (bx >= (G >> 1)) {
                __syncthreads();
                DUP(8) { KA_HERE(); for (int it = bx - (G >> 1); it < 128; it += G - (G >> 1)) nyq_pass(ka, it, lds, wv); fft_row2048(ka, bx - (G >> 1), G - (G >> 1), wv); }
                __syncthreads();
            }
            DUP(5) for (int U = bx; U < 512; U += G) {
                KA_HERE(); PH_IDS(); unsigned char* ws = ka->ws; bf16* const PROJ = (bf16*)(ws + WS_PROJ); bf16* const MIX = (bf16*)(ws + WS_MIX);
                const float* qn = ka->in[I_QN] + l * 128; const f32x2* rope = (const f32x2*)(ws + WS_ROPE);
                const int pr = U & 7, idx = U >> 3, b = pr >> 2, kvh = pr & 3, hq = kvh * 4 + (idx >> 4), qb = idx & 15;
                const size_t row0 = (size_t)NCTX + b * 4096 + qb * 256;
                const bf16* ck = (const bf16*)(ws + WS_CK) + ((size_t)(b * 4 + l) * 512) * 512 + kvh * 128;
                const bf16* cv = (const bf16*)(ws + WS_CV) + ((size_t)(b * 4 + l) * 512) * 512 + kvh * 128;
                const bf16* k1 = (const bf16*)(ws + WS_KC) + ((size_t)NCTX + b * 4096) * 512 + kvh * 128; const bf16* v1 = (const bf16*)(ws + WS_VC) + ((size_t)NCTX + b * 4096) * 512 + kvh * 128;
                att::attn_unit(PROJ + row0 * INW + hq * 128, PROJ + row0 * INW + OFF_GA + hq * 128, MIX + row0 * DM + hq * 128,
                               ck, cv, 512, 8, k1, v1, 512, 64, qn, rope, qb * 256, (char*)lds_raw, wv);
            }
            {
                const int nH = G >> 1, hb = bx >= nH ? 1 : 0, cH = bx - hb * nH, Uend = hb ? 512 : 256;
                DUP(6) for (int U = hb * 256 + cH; U < Uend; U += (hb ? G - nH : nH)) {
                    KA_HERE(); unsigned char* ws = ka->ws; bf16* const PROJ = (bf16*)(ws + WS_PROJ); bf16* const MIX = (bf16*)(ws + WS_MIX);
                    const float* qn = ka->in[I_QN] + l * 128;
                    const int xx = U & 7, idx = U >> 3, b = xx * 4 + (idx >> 4), hq = idx & 15, kvh = hq >> 2;
                    const size_t row0 = (size_t)b * 256;
                    const bf16* k1 = (const bf16*)(ws + WS_KC) + row0 * 512 + kvh * 128; const bf16* v1 = (const bf16*)(ws + WS_VC) + row0 * 512 + kvh * 128;
                    att::attn_unit(PROJ + row0 * INW + hq * 128, PROJ + row0 * INW + OFF_GA + hq * 128, MIX + row0 * DM + hq * 128,
                                   k1, v1, 512, 0, k1, v1, 512, 4, qn, nullptr, 0, (char*)lds_raw, wv);
                }
            }
            if (bx >= (G >> 2)) {
                const int hb = bx >= (G >> 1) ? 1 : 0; int first = hb ? bx - (G >> 1) : 384 + bx - (G >> 2), stride = hb ? G - (G >> 1) : (G >> 1) - (G >> 2), end = hb ? 384 : 512;
                __syncthreads();
                DUP(9) { KA_HERE(); unsigned char* ws = ka->ws; asm volatile("" : "+s"(first), "+s"(stride), "+s"(end));
                  pg8::UnitRange<pg8::GemmOrder> S; S.g.init(NTOK, 2048, 1, 0, ws + WS_YSSM, 1024, ws + WS_WGLU + (size_t)l * 2048 * 1024 * 2, 1024, 1024); S.first = first; S.stride = stride; S.end = end;
                  pg8::EpiGlu E{(const bf16*)(ws + WS_PROJ), (bf16*)(ws + WS_MIX)}; pg8::gemm_phase<pg8::EpiGlu, pg8::UnitRange<pg8::GemmOrder>>(lds, wv, 1024, 1024, S, E); }
            }
        }
        SEAM(pb + 3);
        if (IN(pb + 4)) {
            DUP(10) { KA_HERE(); PH_IDS(); unsigned char* ws = ka->ws;
              pg8::GemmOrder S; S.init(NTOK, 1024, Gq, bq, ws + WS_P, PK, ws + WS_WFP + (size_t)l * 1024 * PK * 2, PK, PK);
              pg8::EpiFftW E{(const bf16*)(ws + WS_PROJ), (bf16*)(ws + WS_MIX)}; pg8::gemm_phase<pg8::EpiFftW, pg8::GemmOrder>(lds, wv, PK, PK, S, E); }
        }
        SEAM(pb + 4);
        if (IN(pb + 5)) DUP(11) {
            KA_HERE(); PH_IDS(); unsigned char* ws = ka->ws;
            pg8::GemmOrder S; S.init(NTOK, DM, Gq, bq, ws + WS_MIX, DM, ws + WS_WOUT + (size_t)l * DM * DM * 2, DM, DM);
            pg8::EpiOut E{(bf16*)(ws + ((l & 1) ? WS_DELTA2 : WS_DELTA)), (const float*)(ws + WS_MOD) + (size_t)l * 3 * 12288};
            if (((DUP_MASK) >> 13) & 1) {
                { pg8::SliceOrder<pg8::GemmOrder> S2{S, 0, 2}; pg8::gemm_phase<pg8::EpiOut, pg8::SliceOrder<pg8::GemmOrder>, GEMM1_ALIGN>(lds, wv, DM, DM, S2, E); }
                xcd_barrier(bar, wv);
                { pg8::SliceOrder<pg8::GemmOrder> S2{S, 2, 1000}; pg8::gemm_phase<pg8::EpiOut, pg8::SliceOrder<pg8::GemmOrder>, GEMM1_ALIGN>(lds, wv, DM, DM, S2, E); }
            } else
            pg8::gemm_phase<pg8::EpiOut, pg8::GemmOrder, GEMM1_ALIGN>(lds, wv, DM, DM, S, E);
        }
        SEAM(pb + 5);
    }
    if (IN(25)) DUP(15) { KA_HERE(); PH_IDS(); TID_HERE(); final_norm(ka, gw, NGWq, lane); }
#undef IN
#undef SEAM
}

extern "C" void kernel_launch(void* const* d_in, const int* in_sizes, int n_in, void* d_out, int out_size, void* d_ws, size_t ws_size, hipStream_t stream) {
    static int grid = 0;
    if (grid == 0) {
        if (n_in != 28 || ws_size < WS_END || out_size != 102760448) { fprintf(stderr, "kernel_launch: unexpected shapes (n_in %d, out %d, ws %zu)\n", n_in, out_size, ws_size); grid = -1; return; }
        int dev = 0, cus = 0, per_cu = 0;
        if (hipGetDevice(&dev) != hipSuccess || hipDeviceGetAttribute(&cus, hipDeviceAttributeMultiprocessorCount, dev) != hipSuccess) { grid = -1; return; }
        if (hipFuncSetAttribute((const void*)hymba_fwd, hipFuncAttributeMaxDynamicSharedMemorySize, LDS_BYTES) != hipSuccess) { fprintf(stderr, "kernel_launch: hipFuncSetAttribute failed\n"); grid = -1; return; }
        if (hipOccupancyMaxActiveBlocksPerMultiprocessor(&per_cu, (const void*)hymba_fwd, NWAVES * 64, LDS_BYTES) != hipSuccess || per_cu < 1)
            fprintf(stderr, "kernel_launch: occupancy query reports %d workgroups per CU\n", per_cu);
        (void)hipGetLastError();
        grid = cus;
    }
    if (grid < 0) return;
    (void)hipMemsetAsync((char*)d_ws + WS_CTL, 0, CTL_ZERO_BYTES, stream);
    Args a{};
    for (int i = 0; i < 28; ++i) a.in[i] = (const float*)d_in[i];
    a.out = (float*)d_out; a.ws = (unsigned char*)d_ws;
#if MK_ONE_LAUNCH == 2
    a.ph_lo = 0; a.ph_hi = 1;
    hipLaunchKernelGGL(hymba_fwd, dim3(grid), dim3(NWAVES * 64), LDS_BYTES, stream, a);
    a.ph_lo = 0; a.ph_hi = 26;
    hipLaunchKernelGGL(hymba_fwd, dim3(grid), dim3(NWAVES * 64), LDS_BYTES, stream, a);
#elif MK_ONE_LAUNCH
    a.ph_lo = 0; a.ph_hi = 26;
    hipLaunchKernelGGL(hymba_fwd, dim3(grid), dim3(NWAVES * 64), LDS_BYTES, stream, a);
#else
    for (int ph = 0; ph < 26; ++ph) { a.ph_lo = ph; a.ph_hi = ph + 1; hipLaunchKernelGGL(hymba_fwd, dim3(grid), dim3(NWAVES * 64), LDS_BYTES, stream, a); }
#endif
    const hipError_t le = hipPeekAtLastError();
    if (le != hipSuccess) fprintf(stderr, "kernel_launch: launch failed: %s\n", hipGetErrorName(le));
}
```
